# Optimizing an MI355X kernel written in HIP

```python
import jax
import jax.numpy as jnp
from jax import lax
import numpy as np

D_MODEL = 1024
BATCH = 16
SEQ = 2048
DEPTH = 2

N_BRANCH = 4
HEADS = 4
BRANCH_WIDTH = D_MODEL // 4
HEAD_DV = BRANCH_WIDTH // HEADS
RET_DK = HEAD_DV // 2
GLA_DK = HEAD_DV // 2
HGRN_DK = HEAD_DV
RWKV_N = HEAD_DV
RWKV_W_LORA = 64
RWKV_A_LORA = 64
RWKV_G_LORA = 128
GLA_GATE_LORA = 16
GLA_GATE_TEMP = 16.0
CHUNK = 64
RET_ROPE_BASE = 10000.0
RWKV_DECAY_SCALE = 0.6065306597126334
D_FF = 2816
FFN_CONV_WIDTH = 3
PLE_DIM = 256
LN_EPS = 1e-5
HEAD_EPS = 1e-6
RWKV_GN_EPS = 64e-5
ALPHA = (2.0 * DEPTH) ** 0.25
BETA = (8.0 * DEPTH) ** -0.25

RET_COLS = (HEADS * RET_DK, HEADS * RET_DK, BRANCH_WIDTH, BRANCH_WIDTH)
RWKV_COLS = (BRANCH_WIDTH, BRANCH_WIDTH, BRANCH_WIDTH, RWKV_W_LORA, RWKV_A_LORA, RWKV_G_LORA)
GLA_COLS = (HEADS * GLA_DK, HEADS * GLA_DK, BRANCH_WIDTH, GLA_GATE_LORA, BRANCH_WIDTH)
HGRN_COLS = (HEADS * HGRN_DK, HEADS * HGRN_DK, BRANCH_WIDTH, BRANCH_WIDTH)
GROUP_COLS = (sum(RET_COLS), sum(RWKV_COLS), sum(GLA_COLS), sum(HGRN_COLS), N_BRANCH * D_MODEL)
N_IN = sum(GROUP_COLS)

kernel_name = "hybrid_gated_retnet_rwkv7_gla_hgrn2"


def split_cols(a, sizes):
    return jnp.split(a, [int(c) for c in np.cumsum(sizes)[:-1]], axis=-1)


def heads(a, n_heads=HEADS):
    return a.reshape(*a.shape[:-1], n_heads, a.shape[-1] // n_heads)


def bhsd(a):
    return a.transpose(0, 2, 1, 3)


def shift_right(a):
    return jnp.pad(a, ((0, 0), (1, 0), (0, 0)))[:, :-1]


def layer_norm(x, w, b):
    x32 = x.astype(jnp.float32)
    mu = jnp.mean(x32, -1, keepdims=True)
    var = jnp.mean(jnp.square(x32 - mu), -1, keepdims=True)
    return ((x32 - mu) * lax.rsqrt(var + LN_EPS) * w + b).astype(x.dtype)


def head_norm(y, eps):
    y = y.astype(jnp.float32)
    mu = jnp.mean(y, -1, keepdims=True)
    var = jnp.mean(jnp.square(y - mu), -1, keepdims=True)
    return (y - mu) * lax.rsqrt(var + eps)


def head_rms(y, gain):
    y = y.astype(jnp.float32)
    return y * lax.rsqrt(jnp.mean(jnp.square(y), -1, keepdims=True) + HEAD_EPS) * gain


def rotary(x):
    S, d = x.shape[1], x.shape[-1]
    theta = 1.0 / (RET_ROPE_BASE ** jnp.linspace(0.0, 1.0, d // 2))
    ang = jnp.arange(S, dtype=jnp.float32)[:, None] * theta[None, :]
    cos, sin = jnp.cos(ang)[:, None, :], jnp.sin(ang)[:, None, :]
    xr = x.astype(jnp.float32).reshape(*x.shape[:-1], d // 2, 2)
    x1, x2 = xr[..., 0], xr[..., 1]
    return jnp.stack([x1 * cos - x2 * sin, x1 * sin + x2 * cos], -1).reshape(x.shape)


def to_chunks(a):
    B, H, T, d = a.shape
    return a.reshape(B, H, T // CHUNK, CHUNK, d).transpose(2, 0, 1, 3, 4)


def from_chunks(o):
    n, B, H, C, d = o.shape
    return o.transpose(1, 2, 0, 3, 4).reshape(B, H, n * C, d)


def retention_chunkwise(q, k, v, log_gamma):
    B, H, T, dk = q.shape
    dv = v.shape[-1]
    pos = jnp.arange(CHUNK, dtype=jnp.float32)
    causal = pos[:, None] >= pos[None, :]
    rel = jnp.where(causal, pos[:, None] - pos[None, :], 0.0)
    decay = jnp.where(causal[None], jnp.exp(log_gamma[:, None, None] * rel[None]), 0.0)
    xi = jnp.exp(log_gamma[:, None] * (pos + 1.0))[None, :, :, None]
    zeta = jnp.exp(log_gamma[:, None] * (CHUNK - 1.0 - pos))[None, :, :, None]
    gamma_c = jnp.exp(log_gamma * CHUNK)[None, :, None, None]

    def step(R, inp):
        qc, kc, vc = inp
        scores = jnp.einsum('bhtd,bhsd->bhts', qc, kc) * decay[None]
        o = jnp.einsum('bhts,bhse->bhte', scores, vc) + jnp.einsum('bhtd,bhde->bhte', qc, R) * xi
        R = gamma_c * R + jnp.einsum('bhsd,bhse->bhde', kc, vc * zeta)
        return R, o

    R0 = jnp.zeros((B, H, dk, dv), jnp.float32)
    _, o = lax.scan(step, R0, (to_chunks(q), to_chunks(k), to_chunks(v)))
    return from_chunks(o)


def chunk_gated_linear_attention(q, k, v, log_g):
    B, H, T, dk = q.shape
    dv = v.shape[-1]
    causal = jnp.tril(jnp.ones((CHUNK, CHUNK), bool))[:, :, None]

    def step(S, inp):
        qc, kc, vc, gc = inp
        b = jnp.cumsum(gc, axis=2)
        diff = b[:, :, :, None, :] - b[:, :, None, :, :]
        decay = jnp.where(causal, jnp.exp(jnp.where(causal, diff, 0.0)), 0.0)
        scores = jnp.einsum('bhtd,bhsd,bhtsd->bhts', qc, kc, decay)
        o = jnp.einsum('bhts,bhse->bhte', scores, vc) + jnp.einsum('bhtd,bhde->bhte', qc * jnp.exp(b), S)
        b_last = b[:, :, -1:, :]
        S = jnp.exp(b_last[:, :, 0, :, None]) * S + jnp.einsum('bhsd,bhse->bhde', kc * jnp.exp(b_last - b), vc)
        return S, o

    S0 = jnp.zeros((B, H, dk, dv), jnp.float32)
    _, o = lax.scan(step, S0, (to_chunks(q), to_chunks(k), to_chunks(v), to_chunks(log_g)))
    return from_chunks(o)


def rwkv7_recurrence(r, w, k, v, kk, a):
    B, S, H, N = r.shape
    seq = tuple(t.transpose(1, 0, 2, 3) for t in (r, w, k, v, kk, a))

    def step(state, inp):
        rt, wt, kt, vt, kkt, at = inp
        sa = jnp.einsum('bhvk,bhk->bhv', state, kkt)
        state = state * wt[:, :, None, :] - sa[..., None] * (kkt * at)[:, :, None, :] + vt[..., None] * kt[:, :, None, :]
        return state, jnp.einsum('bhvk,bhk->bhv', state, rt)

    _, y = lax.scan(step, jnp.zeros((B, H, N, N), jnp.float32), seq)
    return y.transpose(1, 0, 2, 3)


def retnet_branch(z):
    B, S, _ = z.shape
    q, k, v, g = split_cols(z.astype(jnp.float32), RET_COLS)
    q = rotary(heads(q))
    k = rotary(heads(k)) * RET_DK ** -0.5
    log_gamma = jnp.log1p(-jnp.exp2(-5.0 - jnp.arange(HEADS, dtype=jnp.float32)))
    o = retention_chunkwise(bhsd(q), bhsd(k), bhsd(heads(v)), log_gamma)
    o = head_norm(bhsd(o), HEAD_EPS).reshape(B, S, BRANCH_WIDTH)
    return (jax.nn.silu(g) * o).astype(z.dtype)


def rwkv7_branch(z, mu, w0, w2, a0, a2, g2, k_k, k_a, r_k, ln_w, ln_b):
    B, S, _ = z.shape
    z = z.astype(jnp.float32)
    z = z + (shift_right(z) - z) * mu
    r, k, v, wl, al, gl = split_cols(z, RWKV_COLS)
    w = jnp.exp(-RWKV_DECAY_SCALE * jax.nn.sigmoid(w0 + jnp.tanh(wl) @ w2))
    a = jax.nn.sigmoid(a0 + al @ a2)
    g = jax.nn.sigmoid(gl) @ g2
    kk = heads(k * k_k)
    kk = kk * lax.rsqrt(jnp.sum(jnp.square(kk), -1, keepdims=True) + 1e-12)
    k = k * (1.0 + (a - 1.0) * k_a)
    rh, kh, vh = heads(r), heads(k), heads(v)
    y = rwkv7_recurrence(rh, heads(w), kh, vh, kk, heads(a))
    y = head_norm(y, RWKV_GN_EPS).reshape(B, S, BRANCH_WIDTH) * ln_w + ln_b
    bonus = (jnp.sum(rh * kh * r_k, -1, keepdims=True) * vh).reshape(B, S, BRANCH_WIDTH)
    return ((y + bonus) * g).astype(z.dtype)


def gla_branch(z, w2, b, norm_w):
    B, S, _ = z.shape
    q, k, v, gl, g = split_cols(z.astype(jnp.float32), GLA_COLS)
    log_alpha = jax.nn.log_sigmoid(gl @ w2 + b) / GLA_GATE_TEMP
    o = chunk_gated_linear_attention(bhsd(heads(q) * GLA_DK ** -0.5), bhsd(heads(k)), bhsd(heads(v)), bhsd(heads(log_alpha)))
    o = head_rms(bhsd(o), norm_w).reshape(B, S, BRANCH_WIDTH)
    return (o * jax.nn.silu(g)).astype(z.dtype)


def hgrn2_branch(z, lb, norm_w):
    B, S, _ = z.shape
    q, fz, i, g = split_cols(z.astype(jnp.float32), HGRN_COLS)
    f = lb + (1.0 - lb) * jax.nn.sigmoid(fz)
    log_f = jnp.log(f)
    k = (1.0 - lb) * jax.nn.sigmoid(-fz)
    o = chunk_gated_linear_attention(bhsd(heads(q)), bhsd(heads(k)), bhsd(heads(i)), bhsd(heads(log_f)))
    o = head_rms(bhsd(o), norm_w).reshape(B, S, BRANCH_WIDTH)
    return (o * jax.nn.silu(g)).astype(z.dtype)


def conv_ffn(x, w_up, conv_w, w_down):
    S = x.shape[1]
    u, v = jnp.split(x @ w_up, 2, axis=-1)
    up = jnp.pad(u, ((0, 0), (FFN_CONV_WIDTH - 1, 0), (0, 0)))
    u = sum(conv_w[j] * up[:, j:j + S] for j in range(FFN_CONV_WIDTH))
    return (jax.nn.gelu(u) * v) @ w_down


def _normal(k, shape, scale):
    return scale * jax.random.normal(k, shape, jnp.float32)


def setup_inputs(seed: int = 0) -> dict:
    key = jax.random.key(seed)
    k = jax.random.split(key, 32)
    L, D, W = DEPTH, D_MODEL, BRANCH_WIDTH
    return {
        'x': _normal(k[0], (BATCH, SEQ, D), 1.0),
        'p': _normal(k[1], (DEPTH, BATCH, SEQ, PLE_DIM), 1.0),
        'ln_in_w': 1.0 + _normal(k[2], (D,), 0.02),
        'ln_in_b': _normal(k[3], (D,), 0.02),
        'w_in': _normal(k[4], (L, D, N_IN), D ** -0.5),
        'rwkv_mu': jax.random.uniform(k[5], (L, sum(RWKV_COLS)), jnp.float32),
        'rwkv_w0': _normal(k[6], (L, W), 0.5),
        'rwkv_w2': _normal(k[7], (L, RWKV_W_LORA, W), 0.5 * RWKV_W_LORA ** -0.5),
        'rwkv_a0': _normal(k[8], (L, W), 0.1),
        'rwkv_a2': _normal(k[9], (L, RWKV_A_LORA, W), 0.5 * RWKV_A_LORA ** -0.5),
        'rwkv_g2': _normal(k[10], (L, RWKV_G_LORA, W), RWKV_G_LORA ** -0.5),
        'rwkv_k_k': 0.85 + _normal(k[11], (L, W), 0.05),
        'rwkv_k_a': 1.0 + _normal(k[12], (L, W), 0.05),
        'rwkv_r_k': _normal(k[13], (L, HEADS, RWKV_N), 0.1),
        'rwkv_ln_w': 1.0 + _normal(k[14], (L, W), 0.02),
        'rwkv_ln_b': _normal(k[15], (L, W), 0.02),
        'gla_w2': _normal(k[16], (L, GLA_GATE_LORA, HEADS * GLA_DK), GLA_GATE_LORA ** -0.5),
        'gla_b': _normal(k[17], (L, HEADS * GLA_DK), 0.1),
        'gla_norm_w': 1.0 + _normal(k[18], (L, HEAD_DV), 0.02),
        'hgrn_lb_logits': _normal(k[19], (L, HEADS * HGRN_DK), 0.1),
        'hgrn_norm_w': 1.0 + _normal(k[20], (L, HEAD_DV), 0.02),
        'w_branch': _normal(k[21], (L, N_BRANCH, W, D), W ** -0.5),
        'w_mix_out': _normal(k[22], (L, D, D), BETA * D ** -0.5),
        'ln_mix_w': 1.0 + _normal(k[23], (L, D), 0.02),
        'ln_mix_b': _normal(k[24], (L, D), 0.02),
        'w_ffn_up': _normal(k[25], (L, D, 2 * D_FF), D ** -0.5),
        'ffn_conv': _normal(k[26], (L, FFN_CONV_WIDTH, D_FF), FFN_CONV_WIDTH ** -0.5),
        'w_ffn_down': _normal(k[27], (L, D_FF, D), BETA * D_FF ** -0.5),
        'w_ple_gate': _normal(k[28], (L, D, D), D ** -0.5),
        'w_ple_proj': _normal(k[29], (L, PLE_DIM, D), BETA * PLE_DIM ** -0.5),
        'ln_ffn_w': 1.0 + _normal(k[30], (L, D), 0.02),
        'ln_ffn_b': _normal(k[31], (L, D), 0.02),
    }


def reference(x, p, ln_in_w, ln_in_b, w_in, rwkv_mu, rwkv_w0, rwkv_w2, rwkv_a0, rwkv_a2, rwkv_g2,
              rwkv_k_k, rwkv_k_a, rwkv_r_k, rwkv_ln_w, rwkv_ln_b, gla_w2, gla_b, gla_norm_w,
              hgrn_lb_logits, hgrn_norm_w, w_branch, w_mix_out, ln_mix_w, ln_mix_b,
              w_ffn_up, ffn_conv, w_ffn_down, w_ple_gate, w_ple_proj, ln_ffn_w, ln_ffn_b):
    lb_prob = jax.nn.softmax(hgrn_lb_logits.astype(jnp.float32), axis=0)
    lb_all = jnp.concatenate([jnp.zeros_like(lb_prob[:1]), jnp.cumsum(lb_prob[1:], axis=0)], axis=0)

    x = layer_norm(x, ln_in_w, ln_in_b)
    for i in range(DEPTH):
        z = x @ w_in[i]
        z_ret, z_rwkv, z_gla, z_hgrn, z_gate = split_cols(z, GROUP_COLS)
        branches = (
            retnet_branch(z_ret),
            rwkv7_branch(z_rwkv, rwkv_mu[i], rwkv_w0[i], rwkv_w2[i], rwkv_a0[i], rwkv_a2[i], rwkv_g2[i],
                         rwkv_k_k[i], rwkv_k_a[i], rwkv_r_k[i], rwkv_ln_w[i], rwkv_ln_b[i]),
            gla_branch(z_gla, gla_w2[i], gla_b[i], gla_norm_w[i]),
            hgrn2_branch(z_hgrn, lb_all[i], hgrn_norm_w[i]),
        )
        merged = jnp.zeros_like(x)
        for n in range(N_BRANCH):
            gate = jax.nn.sigmoid(z_gate[..., n * D_MODEL:(n + 1) * D_MODEL])
            merged = merged + gate * (branches[n] @ w_branch[i, n])
        x = layer_norm(ALPHA * x + merged @ w_mix_out[i], ln_mix_w[i], ln_mix_b[i])
        ffn = conv_ffn(x, w_ffn_up[i], ffn_conv[i], w_ffn_down[i])
        ple = jax.nn.sigmoid(x @ w_ple_gate[i]) * (p[i] @ w_ple_proj[i])
        x = layer_norm(ALPHA * x + ffn + ple, ln_ffn_w[i], ln_ffn_b[i])
    return x
```

```cpp
#include <hip/hip_runtime.h>
#include <cstdio>
#include <cstdint>

namespace pg8 {
#define PG8_LAS __attribute__((address_space(3)))
typedef unsigned short bf16_t;
typedef short bf16x8 __attribute__((ext_vector_type(8)));
typedef float f32x4 __attribute__((ext_vector_type(4)));
typedef float f32x2 __attribute__((ext_vector_type(2)));
typedef unsigned u32x4 __attribute__((ext_vector_type(4)));
typedef unsigned u32x2 __attribute__((ext_vector_type(2)));
constexpr int BM = 256, BK = 64, HALF = 128, HTB = HALF * BK * 2  , STAGE_BYTES = 8 * HTB, NXCD = 8, WGM = 8;

__host__ __device__ __forceinline__ int lds_byte(int r, int c) { const int st = (r >> 4) * 2 + (c >> 5), rr = r & 15, cc = c & 31, ob = rr * 64 + cc * 2; return st * 1024 + (ob ^ (((ob >> 9) & 1) << 5)); }
__host__ __device__ __forceinline__ void stage_rc(int b, int& R, int& C) { const int st = b / 1024, sb = b % 1024, swz = sb ^ (((sb >> 9) & 1) << 5); R = (st >> 1) * 16 + swz / 64; C = (st & 1) * 32 + (swz % 64) / 2; }
__host__ __device__ __forceinline__ int perm32(int rho) { const int n = rho >> 4, i = rho & 15; return 8 * (i >> 2) + 4 * n + (i & 3); }

struct Unit { int pm, pn; };
struct Gemm { const bf16_t* A; const bf16_t* Bt; int M, N, K, lda, ldb, a_div, a_coloff; };
__device__ __forceinline__ size_t a_unit_off(const Gemm& g, const Unit& u) { return g.a_div ? (size_t)((u.pn / g.a_div) * g.a_coloff) * 2u : (size_t)0; }

struct StaticOrder {
    int nM, nN, nwg, G, c;
    __host__ __device__ void init(int M, int N, int G_, int c_) { nM = M / BM; nN = N / BM; nwg = nM * nN; G = G_; c = c_; }
    __host__ __device__ bool next(int i, Unit& u) const {
        const long L = (long)i * G + c; if (L >= nwg) return false;
        int wgid = (int)L; { const int q = nwg / NXCD, r = nwg % NXCD, xcd = wgid % NXCD, off = wgid / NXCD; wgid = (xcd < r ? xcd * (q + 1) : r * (q + 1) + (xcd - r) * q) + off; }
        const int nig = WGM * nN, gid = wgid / nig, fm = gid * WGM, gsz = (nM - fm) < WGM ? (nM - fm) : WGM;
        u.pm = fm + ((wgid % nig) % gsz); u.pn = (wgid % nig) / gsz; return true;
    }
    __device__ __forceinline__ void a_ready(const Unit&) const {}
    __device__ __forceinline__ void done(const Unit&) const {}
};

typedef __bf16 bf16x2_t __attribute__((ext_vector_type(2)));
__device__ __forceinline__ unsigned cvt_pk_bf16(float lo, float hi) { const f32x2 v = {lo, hi}; const bf16x2_t b = __builtin_convertvector(v, bf16x2_t); return __builtin_bit_cast(unsigned, b); }
__device__ __forceinline__ float bf_lo(unsigned w) { return __uint_as_float(w << 16); }
__device__ __forceinline__ float bf_hi(unsigned w) { return __uint_as_float(w & 0xffff0000u); }
__device__ __forceinline__ float sigmoid_f(float x) { return __builtin_amdgcn_rcpf(1.0f + __builtin_amdgcn_exp2f(-1.44269504089f * x)); }

template <class Epi, class Sched, bool ALIGN_EPI = false, bool SP2 = false>
__device__ __forceinline__ void gemm_phase(PG8_LAS unsigned char* lds, const Gemm g, const Sched& S, const Epi& E) {
    int tid_o = threadIdx.x; asm volatile("" : "+v"(tid_o));
    const int tid = tid_o, wid = __builtin_amdgcn_readfirstlane(tid >> 6), lane = tid & 63, wr = wid >> 2, wc = wid & 3, fr = lane & 15, fq = lane >> 4;
    const int K = g.K, nt = K / BK;
    unsigned voffA[2], voffB[2];
#pragma unroll
    for (int i = 0; i < 2; ++i) { int R, C; stage_rc(tid * 16 + i * 8192, R, C); const int Rb = Epi::PERM ? ((R & ~31) + perm32(R & 31)) : R;
        voffA[i] = (unsigned)(R * g.lda + C) * 2u; voffB[i] = (unsigned)(Rb * g.ldb + C) * 2u; }
    const size_t kstep = (size_t)(BK * 2);
    const size_t hstepA = (size_t)HALF * g.lda * 2, hstepB = (size_t)HALF * g.ldb * 2;
    const size_t tstepA = 2 * hstepA, tstepB = 2 * hstepB;
    const unsigned ldsw = (unsigned)wid * 1024u;
    const int aoff = lds_byte(wr * 64 + fr, fq * 8), boff = lds_byte(wc * 32 + fr, fq * 8);
#define PG8_SA(b, h) (((b) * 2 + (h)) * HTB)
#define PG8_SB(b, h) ((4 + (b) * 2 + (h)) * HTB)
#define PG8_STAGE(bufoff, gbase, voff) do { _Pragma("unroll") for (int _i = 0; _i < 2; ++_i) \
        __builtin_amdgcn_global_load_lds((const unsigned*)((const char*)(gbase) + (voff)[_i]), (PG8_LAS unsigned*)(lds + (bufoff) + ldsw + _i * 8192), 16, 0, 0); } while (0)
#define PG8_LDA(dst, b, h) do { _Pragma("unroll") for (int m = 0; m < 4; ++m) _Pragma("unroll") for (int k = 0; k < 2; ++k) dst[m][k] = *(const PG8_LAS bf16x8*)(lds + PG8_SA(b, h) + aoff + m * 2048 + k * 1024); } while (0)
#define PG8_LDB(dst, b, h) do { _Pragma("unroll") for (int n = 0; n < 2; ++n) _Pragma("unroll") for (int k = 0; k < 2; ++k) dst[n][k] = *(const PG8_LAS bf16x8*)(lds + PG8_SB(b, h) + boff + n * 2048 + k * 1024); } while (0)
#define PG8_MMA(ai, bj, At, Bt) do { __builtin_amdgcn_s_setprio(1); _Pragma("unroll") for (int m = 0; m < 4; ++m) _Pragma("unroll") for (int n = 0; n < 2; ++n) _Pragma("unroll") for (int k = 0; k < 2; ++k) \
        acc[ai][bj][m][n] = __builtin_amdgcn_mfma_f32_16x16x32_bf16(Bt[n][k], At[m][k], acc[ai][bj][m][n], 0, 0, 0); __builtin_amdgcn_s_setprio(0); } while (0)
#define PG8_WAIT_V(n) asm volatile("s_waitcnt vmcnt(" #n ")" ::: "memory")
#define PG8_WAIT_L(n) asm volatile("s_waitcnt lgkmcnt(" #n ")" ::: "memory")
#define PG8_BAR __builtin_amdgcn_s_barrier()
#define PG8_SCHED __builtin_amdgcn_sched_barrier(0)
    Unit cur, nxt; int ui = 0;
    if (!S.next(0, cur)) return;
    f32x4 acc[2][2][4][2];
#pragma unroll
    for (int a = 0; a < 2; ++a)
#pragma unroll
        for (int b = 0; b < 2; ++b)
#pragma unroll
            for (int m = 0; m < 4; ++m)
#pragma unroll
                for (int n = 0; n < 2; ++n) acc[a][b][m][n] = (f32x4){0.f, 0.f, 0.f, 0.f};
    bf16x8 At[4][2], B0[2][2], B1[2][2];
    const char* cA = (const char*)g.A + (size_t)cur.pm * tstepA + a_unit_off(g, cur); const char* cB = (const char*)g.Bt + (size_t)cur.pn * tstepB;
    S.a_ready(cur);
    if constexpr (SP2) {
        PG8_STAGE(PG8_SB(0, 0), cB, voffB); PG8_STAGE(PG8_SB(0, 1), cB + hstepB, voffB); PG8_STAGE(PG8_SA(0, 0), cA, voffA); PG8_STAGE(PG8_SA(0, 1), cA + hstepA, voffA);
        if (wr == 1) PG8_BAR;
        PG8_WAIT_V(2); PG8_BAR;
        PG8_STAGE(PG8_SB(1, 0), cB + kstep, voffB); PG8_STAGE(PG8_SA(1, 0), cA + kstep, voffA); PG8_STAGE(PG8_SB(1, 1), cB + hstepB + kstep, voffB);
        PG8_WAIT_V(6); PG8_BAR;
    } else {
        PG8_STAGE(PG8_SB(0, 0), cB, voffB); PG8_STAGE(PG8_SA(0, 0), cA, voffA); PG8_STAGE(PG8_SB(0, 1), cB + hstepB, voffB); PG8_STAGE(PG8_SA(0, 1), cA + hstepA, voffA);
        if (wr == 1) PG8_BAR;
        PG8_WAIT_V(4); PG8_BAR;
        PG8_STAGE(PG8_SB(1, 0), cB + kstep, voffB); PG8_STAGE(PG8_SA(1, 0), cA + kstep, voffA); PG8_STAGE(PG8_SB(1, 1), cB + hstepB + kstep, voffB);
        PG8_WAIT_V(6); PG8_BAR;
    }
    for (;;) {
        const bool has_next = S.next(ui + 1, nxt);
        const char* nA = has_next ? (const char*)g.A + (size_t)nxt.pm * tstepA + a_unit_off(g, nxt) : cA; const char* nB = has_next ? (const char*)g.Bt + (size_t)nxt.pn * tstepB : cB;
        for (int t = 0; t < nt; t += 2) {
            const bool last = (t == nt - 2);
            const char* a1 = cA + (size_t)(t + 1) * kstep;
            const char* a2 = last ? nA : cA + (size_t)(t + 2) * kstep; const char* b2 = last ? nB : cB + (size_t)(t + 2) * kstep;
            const char* a3 = a2 + kstep; const char* b3 = b2 + kstep;
            if (last && has_next) S.a_ready(nxt);
            if constexpr (SP2) {
            PG8_LDB(B0, 0, 0); PG8_LDB(B1, 0, 1); PG8_SCHED; PG8_LDA(At, 0, 0); PG8_STAGE(PG8_SA(1, 1), a1 + hstepA, voffA);
            PG8_WAIT_V(8); PG8_WAIT_L(0); PG8_BAR; PG8_MMA(0, 0, At, B0); PG8_MMA(0, 1, At, B1); PG8_BAR; PG8_SCHED;
            PG8_LDA(At, 0, 1); PG8_STAGE(PG8_SB(0, 0), b2, voffB); PG8_STAGE(PG8_SB(0, 1), b2 + hstepB, voffB); PG8_STAGE(PG8_SA(0, 0), a2, voffA);
            PG8_WAIT_V(8); PG8_WAIT_L(0); PG8_BAR; PG8_MMA(1, 0, At, B0); PG8_MMA(1, 1, At, B1); PG8_BAR; PG8_SCHED;
            PG8_LDB(B0, 1, 0); PG8_LDB(B1, 1, 1); PG8_SCHED; PG8_LDA(At, 1, 0); PG8_STAGE(PG8_SA(0, 1), a2 + hstepA, voffA);
            PG8_WAIT_V(8); PG8_WAIT_L(0); PG8_BAR; PG8_MMA(0, 0, At, B0); PG8_MMA(0, 1, At, B1); PG8_BAR; PG8_SCHED;
            PG8_LDA(At, 1, 1); PG8_STAGE(PG8_SB(1, 0), b3, voffB); PG8_STAGE(PG8_SB(1, 1), b3 + hstepB, voffB); PG8_STAGE(PG8_SA(1, 0), a3, voffA);
            PG8_WAIT_V(8); PG8_WAIT_L(0); PG8_BAR; PG8_MMA(1, 0, At, B0); PG8_MMA(1, 1, At, B1); PG8_BAR; PG8_SCHED;
            } else {
            PG8_LDB(B0, 0, 0); PG8_SCHED; PG8_LDA(At, 0, 0); PG8_STAGE(PG8_SA(1, 1), a1 + hstepA, voffA);
            PG8_WAIT_L(8); PG8_BAR; PG8_WAIT_L(0); PG8_MMA(0, 0, At, B0); PG8_BAR; PG8_SCHED;
            PG8_LDB(B1, 0, 1); PG8_STAGE(PG8_SB(0, 0), b2, voffB);
            PG8_BAR; PG8_WAIT_L(0); PG8_MMA(0, 1, At, B1); PG8_BAR;
            PG8_LDA(At, 0, 1); PG8_STAGE(PG8_SA(0, 0), a2, voffA);
            PG8_BAR; PG8_WAIT_L(0); PG8_MMA(1, 0, At, B0); PG8_BAR; PG8_SCHED;
            PG8_STAGE(PG8_SB(0, 1), b2 + hstepB, voffB);
            PG8_WAIT_V(6); PG8_BAR; PG8_MMA(1, 1, At, B1); PG8_BAR;
            PG8_LDB(B0, 1, 0); PG8_SCHED; PG8_LDA(At, 1, 0); PG8_STAGE(PG8_SA(0, 1), a2 + hstepA, voffA);
            PG8_WAIT_L(8); PG8_BAR; PG8_WAIT_L(0); PG8_MMA(0, 0, At, B0); PG8_BAR; PG8_SCHED;
            PG8_LDB(B1, 1, 1); PG8_STAGE(PG8_SB(1, 0), b3, voffB);
            PG8_BAR; PG8_WAIT_L(0); PG8_MMA(0, 1, At, B1); PG8_BAR;
            PG8_LDA(At, 1, 1); PG8_STAGE(PG8_SA(1, 0), a3, voffA);
            PG8_BAR; PG8_WAIT_L(0); PG8_MMA(1, 0, At, B0); PG8_BAR; PG8_SCHED;
            PG8_STAGE(PG8_SB(1, 1), b3 + hstepB, voffB);
            PG8_WAIT_V(6); PG8_BAR; PG8_MMA(1, 1, At, B1); PG8_BAR;
            }
        }
        if constexpr (ALIGN_EPI) { if (wr == 0) PG8_BAR; }
        if constexpr (!Epi::AFTER_DRAIN) { E(acc, cur, wr, wc, fr, fq); S.done(cur); }
        if (!has_next) break;
#pragma unroll
        for (int a = 0; a < 2; ++a)
#pragma unroll
            for (int b = 0; b < 2; ++b)
#pragma unroll
                for (int m = 0; m < 4; ++m)
#pragma unroll
                    for (int n = 0; n < 2; ++n) acc[a][b][m][n] = (f32x4){0.f, 0.f, 0.f, 0.f};
        cur = nxt; cA = nA; cB = nB; ++ui;
        if constexpr (ALIGN_EPI) { if (wr == 1) PG8_BAR; }
    }
    PG8_WAIT_V(0);
    if constexpr (!ALIGN_EPI) { if (wr == 0) PG8_BAR; }
    PG8_BAR;
    if constexpr (Epi::AFTER_DRAIN) { E.fused(acc, cur, wr, wc, fr, fq, lds, wid, lane); S.done(cur); }
#undef PG8_SA
#undef PG8_SB
#undef PG8_STAGE
#undef PG8_LDA
#undef PG8_LDB
#undef PG8_MMA
#undef PG8_WAIT_V
#undef PG8_WAIT_L
#undef PG8_BAR
#undef PG8_SCHED
}


struct EpiStoreBf16 {
    static constexpr bool PERM = true, AFTER_DRAIN = false;
    bf16_t* O; int ldc;
    __device__ __forceinline__ void operator()(const f32x4 (&acc)[2][2][4][2], const Unit& u, int wr, int wc, int fr, int fq) const {
        const int row0 = u.pm * BM + wr * 64 + fr, col0 = u.pn * BM + wc * 32 + 8 * fq;
#pragma unroll
        for (int ai = 0; ai < 2; ++ai)
#pragma unroll
            for (int m = 0; m < 4; ++m) { bf16_t* rowp = O + (size_t)(row0 + ai * HALF + m * 16) * ldc + col0;
#pragma unroll
                for (int bj = 0; bj < 2; ++bj) { const f32x4 v0 = acc[ai][bj][m][0], v1 = acc[ai][bj][m][1];
                    u32x4 w; w.x = cvt_pk_bf16(v0[0], v0[1]); w.y = cvt_pk_bf16(v0[2], v0[3]); w.z = cvt_pk_bf16(v1[0], v1[1]); w.w = cvt_pk_bf16(v1[2], v1[3]);
                    *(u32x4*)(rowp + bj * HALF) = w; } }
    }
};
struct EpiPleGate {
    static constexpr bool PERM = true, AFTER_DRAIN = false;
    bf16_t* PP;
    __device__ __forceinline__ void operator()(const f32x4 (&acc)[2][2][4][2], const Unit& u, int wr, int wc, int fr, int fq) const {
        const int row0 = u.pm * BM + wr * 64 + fr, col0 = u.pn * BM + wc * 32 + 8 * fq;
#pragma unroll
        for (int ai = 0; ai < 2; ++ai)
#pragma unroll
            for (int m = 0; m < 4; ++m) { bf16_t* rowp = PP + (size_t)(row0 + ai * HALF + m * 16) * 1024 + col0;
#pragma unroll
                for (int bj = 0; bj < 2; ++bj) { const f32x4 v0 = acc[ai][bj][m][0], v1 = acc[ai][bj][m][1];
                    const u32x4 p = *(const u32x4*)(rowp + bj * HALF);
                    u32x4 w;
                    w.x = cvt_pk_bf16(sigmoid_f(v0[0]) * bf_lo(p.x), sigmoid_f(v0[1]) * bf_hi(p.x));
                    w.y = cvt_pk_bf16(sigmoid_f(v0[2]) * bf_lo(p.y), sigmoid_f(v0[3]) * bf_hi(p.y));
                    w.z = cvt_pk_bf16(sigmoid_f(v1[0]) * bf_lo(p.z), sigmoid_f(v1[1]) * bf_hi(p.z));
                    w.w = cvt_pk_bf16(sigmoid_f(v1[2]) * bf_lo(p.w), sigmoid_f(v1[3]) * bf_hi(p.w));
                    *(u32x4*)(rowp + bj * HALF) = w; } }
    }
};
struct EpiMerge {
    static constexpr bool PERM = false, AFTER_DRAIN = false;
    const bf16_t* P; bf16_t* MG;
    __device__ __forceinline__ void operator()(const f32x4 (&acc)[2][2][4][2], const Unit& u, int wr, int wc, int fr, int fq) const {
        const int row0 = u.pm * BM + wr * 64 + fr, oc = u.pn * 64 + wc * 16 + fq * 4;
#pragma unroll
        for (int ai = 0; ai < 2; ++ai)
#pragma unroll
            for (int m = 0; m < 4; ++m) { const size_t row = (size_t)(row0 + ai * HALF + m * 16); const bf16_t* prow = P + row * 4096 + oc;
                f32x4 s = (f32x4){0.f, 0.f, 0.f, 0.f};
#pragma unroll
                for (int b = 0; b < 4; ++b) { const u32x2 pv = *(const u32x2*)(prow + b * 1024); const f32x4 g = acc[ai][b >> 1][m][b & 1];
                    s[0] += sigmoid_f(g[0]) * bf_lo(pv.x); s[1] += sigmoid_f(g[1]) * bf_hi(pv.x); s[2] += sigmoid_f(g[2]) * bf_lo(pv.y); s[3] += sigmoid_f(g[3]) * bf_hi(pv.y); }
                u32x2 w; w.x = cvt_pk_bf16(s[0], s[1]); w.y = cvt_pk_bf16(s[2], s[3]);
                *(u32x2*)(MG + row * 1024 + oc) = w; }
    }
};
struct EpiResF32 {
    static constexpr bool PERM = false, AFTER_DRAIN = false;
    const bf16_t* X; const bf16_t* PLE; float* V; float alpha;
    __device__ __forceinline__ void operator()(const f32x4 (&acc)[2][2][4][2], const Unit& u, int wr, int wc, int fr, int fq) const {
        const int row0 = u.pm * BM + wr * 64 + fr, col0 = u.pn * BM + wc * 32 + 4 * fq;
#pragma unroll
        for (int ai = 0; ai < 2; ++ai)
#pragma unroll
            for (int m = 0; m < 4; ++m) { const size_t off = (size_t)(row0 + ai * HALF + m * 16) * 1024 + col0;
#pragma unroll
                for (int bj = 0; bj < 2; ++bj)
#pragma unroll
                    for (int n = 0; n < 2; ++n) { const size_t o = off + bj * HALF + n * 16; const u32x2 xv = *(const u32x2*)(X + o);
                        f32x4 r = acc[ai][bj][m][n];
                        r[0] += alpha * bf_lo(xv.x); r[1] += alpha * bf_hi(xv.x); r[2] += alpha * bf_lo(xv.y); r[3] += alpha * bf_hi(xv.y);
                        if (PLE) { const u32x2 pv = *(const u32x2*)(PLE + o); r[0] += bf_lo(pv.x); r[1] += bf_hi(pv.x); r[2] += bf_lo(pv.y); r[3] += bf_hi(pv.y); }
                        *(f32x4*)(V + o) = r; } }
    }
};
__device__ __forceinline__ float gelu_tanh_f(float x) {
    const float inner = x * (0.7978845608f + 0.0356774081f * x * x);
    return x * __builtin_amdgcn_rcpf(1.0f + __builtin_amdgcn_exp2f(-2.885390082f * inner));
}
struct EpiFfnUp {
    static constexpr bool PERM = false, AFTER_DRAIN = false;
    bf16_t* ACT; const float* conv; float* uhead; float* vhead; float* utail; PG8_LAS float* xch;
    __device__ __forceinline__ void operator()(const f32x4 (&acc)[2][2][4][2], const Unit& u, int wr, int wc, int fr, int fq) const {
        const int lane = threadIdx.x & 63;
        const int cc0 = wc * 32 + 4 * fq, colg = u.pn * 128 + cc0;
        if (fr >= 14) {
#pragma unroll
            for (int ai = 0; ai < 2; ++ai)
#pragma unroll
                for (int n = 0; n < 2; ++n) *(PG8_LAS f32x4*)(xch + ((2 * ai + wr) * 2 + (fr - 14)) * 128 + cc0 + 16 * n) = acc[ai][0][3][n];
            if (wr == 1) {
#pragma unroll
                for (int n = 0; n < 2; ++n) *(f32x4*)(utail + ((size_t)u.pm * 2 + (fr - 14)) * 2816 + colg + 16 * n) = acc[1][0][3][n];
            }
        }
        if (wr == 0 && fr < 2) {
#pragma unroll
            for (int n = 0; n < 2; ++n) { *(f32x4*)(uhead + ((size_t)u.pm * 2 + fr) * 2816 + colg + 16 * n) = acc[0][0][0][n];
                                          *(f32x4*)(vhead + ((size_t)u.pm * 2 + fr) * 2816 + colg + 16 * n) = acc[0][1][0][n]; }
        }
        asm volatile("s_waitcnt lgkmcnt(0)" ::: "memory"); __builtin_amdgcn_s_barrier(); asm volatile("" ::: "memory");
        f32x4 c0[2], c1[2], c2[2];
#pragma unroll
        for (int n = 0; n < 2; ++n) { c0[n] = *(const f32x4*)(conv + colg + 16 * n); c1[n] = *(const f32x4*)(conv + 2816 + colg + 16 * n); c2[n] = *(const f32x4*)(conv + 2 * 2816 + colg + 16 * n); }
        const int src1 = (lane & 48) | ((fr + 15) & 15), src2 = (lane & 48) | ((fr + 14) & 15);
#pragma unroll
        for (int ai = 0; ai < 2; ++ai)
#pragma unroll
            for (int m = 0; m < 4; ++m) { const size_t row = (size_t)(u.pm * BM + ai * HALF + wr * 64 + m * 16 + fr);
#pragma unroll
                for (int n = 0; n < 2; ++n) {
                    const f32x4 cur = acc[ai][0][m][n];
                    f32x4 e1, e2, r1, r2;
                    if (m > 0) { const f32x4 pg = acc[ai][0][m > 0 ? m - 1 : 0][n];
#pragma unroll
                        for (int j = 0; j < 4; ++j) { e1[j] = __shfl(pg[j], src1); e2[j] = __shfl(pg[j], src2); } }
                    else { const int rb = 2 * ai + wr;
                        if (rb > 0) { const f32x4 x62 = *(const PG8_LAS f32x4*)(xch + ((rb - 1) * 2 + 0) * 128 + cc0 + 16 * n), x63 = *(const PG8_LAS f32x4*)(xch + ((rb - 1) * 2 + 1) * 128 + cc0 + 16 * n);
                            e1 = x63; e2 = (fr == 0) ? x62 : x63; }
                        else { e1 = (f32x4){0.f, 0.f, 0.f, 0.f}; e2 = e1; } }
#pragma unroll
                    for (int j = 0; j < 4; ++j) { r1[j] = __shfl(cur[j], src1); r2[j] = __shfl(cur[j], src2); }
                    const f32x4 p1 = (fr >= 1) ? r1 : e1, p2 = (fr >= 2) ? r2 : e2;
                    const f32x4 cv = c2[n] * cur + c1[n] * p1 + c0[n] * p2;
                    const f32x4 vv = acc[ai][1][m][n];
                    u32x2 w; w.x = cvt_pk_bf16(gelu_tanh_f(cv[0]) * vv[0], gelu_tanh_f(cv[1]) * vv[1]); w.y = cvt_pk_bf16(gelu_tanh_f(cv[2]) * vv[2], gelu_tanh_f(cv[3]) * vv[3]);
                    *(u32x2*)(ACT + row * 2816 + colg + 16 * n) = w; } }
    }
};
}

constexpr int D = 1024, BATCH = 16, SEQ = 2048, DEPTH = 2, M = BATCH * SEQ;
constexpr int NMIX = 3600, NMIXP = 3840, NIN = 7696, DFF = 2816, PLE = 256, NCHUNK = SEQ / 64;
constexpr float ALPHA = 1.41421356237f;
constexpr float LN_EPS = 1e-5f;
constexpr int NWAVES = 8;
#ifndef ONE_LAUNCH
#define ONE_LAUNCH 1
#endif

constexpr size_t MiB = 1u << 20;
constexpr size_t WS_CTL = 0, CTL_ZERO_BYTES = 1 * MiB;
constexpr size_t WS_W = 1 * MiB, W_LAYER = 39 * MiB;
constexpr size_t WO_IN = 0, WO_G = 15 * MiB / 2, WO_B = 31 * MiB / 2, WO_MIX = 35 * MiB / 2, WO_UP = 39 * MiB / 2, WO_DN = 61 * MiB / 2, WO_PG = 36 * MiB, WO_PP = 38 * MiB;
constexpr size_t WS_PB = 79 * MiB;
constexpr size_t WS_XB = 111 * MiB;
constexpr size_t WS_R2 = 175 * MiB;
constexpr size_t R2_PPLE = 176 * MiB;
constexpr size_t WS_ROPE = 431 * MiB;
constexpr size_t WS_HALO = 432 * MiB, HALO_ONE = (size_t)128 * 2 * DFF * 4;
constexpr size_t WS_RST = 442 * MiB;
constexpr size_t WS_END = 444 * MiB;
static_assert(WS_HALO + 3 * HALO_ONE <= WS_END && WS_R2 + 256 * MiB <= WS_ROPE, "ws map");
constexpr int CW_BAR = 4096;

constexpr int LDS_BYTES = 163840;
constexpr int LDS_XCH = 131072;
constexpr int LDS_MISC = 163840 - 256;

#define LAS __attribute__((address_space(3)))
typedef unsigned short bf16;
typedef float f32x4 __attribute__((ext_vector_type(4)));
typedef unsigned v4u __attribute__((ext_vector_type(4)));
typedef unsigned v2u __attribute__((ext_vector_type(2)));
#define LDS_WAIT() asm volatile("s_waitcnt lgkmcnt(0)" ::: "memory")
using pg8::cvt_pk_bf16; using pg8::bf_lo; using pg8::bf_hi; using pg8::sigmoid_f;

#define XB_TMO      128
#define XB_XCNT(j)  (256  + 64 * (j))
#define XB_XSUB(j)  (1280 + 64 * (j))
#define XB_XGEN(j)  (2304 + 64 * (j))
#define XB_TOP      3328
#define XB_TOPGEN   3392
#define XCD_BAR_WORDS 3456
#define XB_SPIN_CAP (1u << 18)
__device__ __forceinline__ unsigned xb_ld(unsigned* p)              { return __hip_atomic_load(p, __ATOMIC_RELAXED, __HIP_MEMORY_SCOPE_AGENT); }
__device__ __forceinline__ unsigned xb_add(unsigned* p, unsigned v) { return __hip_atomic_fetch_add(p, v, __ATOMIC_RELAXED, __HIP_MEMORY_SCOPE_AGENT); }
__device__ __forceinline__ unsigned xb_xcc_id() { return (unsigned)__builtin_amdgcn_s_getreg((3 << 11) | 20) & 0xFu; }
#define XB_SPIN(cond, bar) do { unsigned _sp = 0; while (cond) { __builtin_amdgcn_s_sleep(1); \
    if ((++_sp & 255u) == 0u) { if (xb_ld(&(bar)[XB_TMO])) break; if (_sp > XB_SPIN_CAP) { atomicAdd(&(bar)[XB_TMO], 1u); break; } } } } while (0)
struct XcdBarrier { unsigned* bar; unsigned x; volatile LAS unsigned* st; };
__device__ __forceinline__ XcdBarrier xcd_barrier_post(unsigned* bar, volatile LAS unsigned* st) {
    XcdBarrier b; b.bar = bar; b.x = xb_xcc_id(); b.st = st;
    if (threadIdx.x == 0) (void)xb_add(&bar[XB_XCNT(b.x)], 1u);
    return b;
}
__device__ __forceinline__ void xcd_barrier_complete(unsigned* bar, unsigned x, unsigned& nloc, unsigned& nx) {
    const unsigned G = gridDim.x * gridDim.y * gridDim.z;
    unsigned sum, cnt, mine, sp = 0u;
    for (;;) {
        sum = 0u; cnt = 0u; mine = 0u;
#pragma unroll
        for (unsigned j = 0; j < 16; ++j) { const unsigned c = xb_ld(&bar[XB_XCNT(j)]); sum += c; cnt += (c > 0u) ? 1u : 0u; mine = (j == x) ? c : mine; }
        if (sum == G) break;
        __builtin_amdgcn_s_sleep(1);
        if ((++sp & 255u) == 0u) { if (xb_ld(&bar[XB_TMO])) break; if (sp > XB_SPIN_CAP) { atomicAdd(&bar[XB_TMO], 1u); break; } }
    }
    nloc = mine > 0u ? mine : 1u; nx = cnt > 0u ? cnt : 1u;
}
__device__ __forceinline__ void xcd_barrier(const XcdBarrier& b) {
    asm volatile("s_waitcnt vmcnt(0)" ::: "memory");
    __syncthreads();
    if (threadIdx.x == 0) {
        unsigned* bar = b.bar;
        __builtin_amdgcn_s_waitcnt(0);
        unsigned nloc = b.st[0], nx = b.st[1];
        if (nloc == 0u) { xcd_barrier_complete(bar, b.x, nloc, nx); b.st[0] = nloc; b.st[1] = nx; }
        const unsigned old = xb_add(&bar[XB_XSUB(b.x)], 1u);
        const unsigned gen = old / nloc;
        if (old + 1u == (gen + 1u) * nloc) {
            __builtin_amdgcn_fence(__ATOMIC_RELEASE, "agent");
            asm volatile("s_waitcnt vmcnt(0)" ::: "memory");
            const unsigned og = xb_add(&bar[XB_TOP], 1u);
            const unsigned tg = og / nx;
            if (og + 1u == (tg + 1u) * nx) xb_add(&bar[XB_TOPGEN], 1u);
            else XB_SPIN(xb_ld(&bar[XB_TOPGEN]) == tg, bar);
            __builtin_amdgcn_fence(__ATOMIC_ACQUIRE, "agent");
            xb_add(&bar[XB_XGEN(b.x)], 1u);
            asm volatile("s_waitcnt vmcnt(0)" ::: "memory");
        } else {
            XB_SPIN(xb_ld(&bar[XB_XGEN(b.x)]) == gen, bar);
            __builtin_amdgcn_fence(__ATOMIC_ACQUIRE, "agent");
            asm volatile("s_waitcnt vmcnt(0)" ::: "memory");
        }
    }
    __syncthreads();
}

struct Params {
    const float* in[32];
    float* out; unsigned char* ws;
    int ph_lo, ph_hi;
};
enum { I_X = 0, I_P, I_LNINW, I_LNINB, I_WIN, I_MU, I_W0, I_W2, I_A0, I_A2, I_G2, I_KK, I_KA, I_RK, I_RLNW, I_RLNB, I_GLAW2, I_GLAB, I_GLANW, I_HLB, I_HNW,
       I_WBR, I_WMIX, I_LNMW, I_LNMB, I_WUP, I_CONV, I_WDN, I_WPG, I_WPP, I_LNFW, I_LNFB };

typedef const __attribute__((address_space(4))) Params* KP;
__device__ __forceinline__ KP kparams() { KP p = (KP)__builtin_amdgcn_kernarg_segment_ptr(); asm volatile("" : "+s"(p)); return p; }
__device__ __forceinline__ float wave_sum(float v) {
#pragma unroll
    for (int o = 1; o < 64; o <<= 1) v += __shfl_xor(v, o);
    return v;
}
__device__ __forceinline__ int opaque_tid() { int t = threadIdx.x; asm volatile("" : "+v"(t)); return t; }
__device__ __forceinline__ float red8(float v) { v += __shfl_xor(v, 1); v += __shfl_xor(v, 2); v += __shfl_xor(v, 4); return v; }

__constant__ double ROPE_THETA[16] = {1.0, 0.5411695265464637, 0.2928644564625237, 0.15848931924611134, 0.08576958985908942, 0.046415888336127795, 0.025118864315095794, 0.013593563908785255, 0.007356422544596414, 0.003981071705534973, 0.0021544346900318843, 0.0011659144011798323, 0.000630957344480193, 0.0003414548873833601, 0.00018478497974222906, 0.0001};
__device__ __forceinline__ int map_row(int mode, int c) {
    if (mode == 1) { const int b = c >> 10, of = c & 1023, pn = of >> 6, oc = of & 63; return 256 * pn + 128 * (b >> 1) + 32 * (oc >> 4) + 16 * (b & 1) + (oc & 15); }
    if (mode == 2) { return c < DFF ? 256 * (c >> 7) + (c & 127) : 256 * ((c - DFF) >> 7) + 128 + ((c - DFF) & 127); }
    return c;
}
__device__ __forceinline__ void cvt_item(const float* W, int K, int srcld, int c0, int cnt, bf16* dst, int mode, LAS float* scr, int item, int lane) {
    const int nblk = (cnt + 31) / 32, kb = item / nblk, nb = item % nblk, k0 = 64 * kb, n0 = 32 * nb;
    const bool okr = (n0 + (lane & 31)) < cnt;
    float xin[32];
#pragma unroll
    for (int i = 0; i < 32; ++i) { const int kk = 2 * i + (lane >> 5); xin[i] = okr ? W[(size_t)(k0 + kk) * srcld + c0 + n0 + (lane & 31)] : 0.f; }
#pragma unroll
    for (int i = 0; i < 32; ++i) { const int kk = 2 * i + (lane >> 5); scr[kk * 33 + (lane & 31)] = xin[i]; }
    LDS_WAIT(); asm volatile("" ::: "memory");
    const int c = lane & 7;
#pragma unroll
    for (int j = 0; j < 4; ++j) { const int n = (lane >> 3) + 8 * j; const LAS float* s = scr + (8 * c) * 33 + n;
        v4u o; o.x = cvt_pk_bf16(s[0 * 33], s[1 * 33]); o.y = cvt_pk_bf16(s[2 * 33], s[3 * 33]); o.z = cvt_pk_bf16(s[4 * 33], s[5 * 33]); o.w = cvt_pk_bf16(s[6 * 33], s[7 * 33]);
        if (n0 + n < cnt) *(v4u*)(dst + (size_t)map_row(mode, n0 + n) * K + k0 + 8 * c) = o; }
    LDS_WAIT(); asm volatile("" ::: "memory");
}
struct CvtJob { const float* W; int K, srcld, c0, cnt, mode; bf16* dst; int items; };
__device__ __forceinline__ CvtJob get_job(KP P, int j) {
    const int l = j / 11, k = j % 11; unsigned char* wl = P->ws + WS_W + (size_t)l * W_LAYER; CvtJob J;
    if (k == 0)      { J.W = P->in[I_WIN] + (size_t)l * D * NIN; J.K = D; J.srcld = NIN; J.c0 = 0; J.cnt = NMIX; J.mode = 0; J.dst = (bf16*)(wl + WO_IN); }
    else if (k == 1) { J.W = P->in[I_WIN] + (size_t)l * D * NIN; J.K = D; J.srcld = NIN; J.c0 = NMIX; J.cnt = 4096; J.mode = 1; J.dst = (bf16*)(wl + WO_G); }
    else if (k < 6)  { const int b = k - 2; J.W = P->in[I_WBR] + (size_t)(l * 4 + b) * 256 * D; J.K = 256; J.srcld = D; J.c0 = 0; J.cnt = D; J.mode = 0; J.dst = (bf16*)(wl + WO_B) + (size_t)b * D * 256; }
    else if (k == 6) { J.W = P->in[I_WMIX] + (size_t)l * D * D; J.K = D; J.srcld = D; J.c0 = 0; J.cnt = D; J.mode = 0; J.dst = (bf16*)(wl + WO_MIX); }
    else if (k == 7) { J.W = P->in[I_WUP] + (size_t)l * D * 2 * DFF; J.K = D; J.srcld = 2 * DFF; J.c0 = 0; J.cnt = 2 * DFF; J.mode = 2; J.dst = (bf16*)(wl + WO_UP); }
    else if (k == 8) { J.W = P->in[I_WDN] + (size_t)l * DFF * D; J.K = DFF; J.srcld = D; J.c0 = 0; J.cnt = D; J.mode = 0; J.dst = (bf16*)(wl + WO_DN); }
    else if (k == 9) { J.W = P->in[I_WPG] + (size_t)l * D * D; J.K = D; J.srcld = D; J.c0 = 0; J.cnt = D; J.mode = 0; J.dst = (bf16*)(wl + WO_PG); }
    else             { J.W = P->in[I_WPP] + (size_t)l * PLE * D; J.K = PLE; J.srcld = D; J.c0 = 0; J.cnt = D; J.mode = 0; J.dst = (bf16*)(wl + WO_PP); }
    J.items = (J.K / 64) * ((J.cnt + 31) / 32);
    return J;
}
__device__ __forceinline__ void ln_row2(const float* x0, const float* x1, const float* w, const float* b, bf16* o0, bf16* o1, float* f0, float* f1, int lane) {
    const f32x4* xr0 = (const f32x4*)x0 + lane; const f32x4* xr1 = (const f32x4*)x1 + lane;
    f32x4 v0[4], v1[4]; float s0 = 0.f, s1 = 0.f;
#pragma unroll
    for (int j = 0; j < 4; ++j) { v0[j] = xr0[64 * j]; v1[j] = xr1[64 * j]; }
#pragma unroll
    for (int j = 0; j < 4; ++j) { s0 += (v0[j].x + v0[j].y) + (v0[j].z + v0[j].w); s1 += (v1[j].x + v1[j].y) + (v1[j].z + v1[j].w); }
    const float mean0 = wave_sum(s0) * (1.f / D), mean1 = wave_sum(s1) * (1.f / D); float q0 = 0.f, q1 = 0.f;
#pragma unroll
    for (int j = 0; j < 4; ++j) { v0[j] = v0[j] - mean0; v1[j] = v1[j] - mean1; q0 += (v0[j].x * v0[j].x + v0[j].y * v0[j].y) + (v0[j].z * v0[j].z + v0[j].w * v0[j].w); q1 += (v1[j].x * v1[j].x + v1[j].y * v1[j].y) + (v1[j].z * v1[j].z + v1[j].w * v1[j].w); }
    const float rstd0 = 1.f / sqrtf(wave_sum(q0) * (1.f / D) + LN_EPS), rstd1 = 1.f / sqrtf(wave_sum(q1) * (1.f / D) + LN_EPS);
#pragma unroll
    for (int j = 0; j < 4; ++j) { const f32x4 wv = ((const f32x4*)w)[lane + 64 * j], bv = ((const f32x4*)b)[lane + 64 * j]; const f32x4 a0 = v0[j] * rstd0 * wv + bv, a1 = v1[j] * rstd1 * wv + bv;
        if (o0) { v2u pk; pk.x = cvt_pk_bf16(a0.x, a0.y); pk.y = cvt_pk_bf16(a0.z, a0.w); ((v2u*)o0)[lane + 64 * j] = pk; pk.x = cvt_pk_bf16(a1.x, a1.y); pk.y = cvt_pk_bf16(a1.z, a1.w); ((v2u*)o1)[lane + 64 * j] = pk; }
        if (f0) { ((f32x4*)f0)[lane + 64 * j] = a0; ((f32x4*)f1)[lane + 64 * j] = a1; } }
}
__device__ __forceinline__ void ln_phase(const float* V, const float* w, const float* b, bf16* XB, float* OUTF) {
    const int tid = opaque_tid(), lane = tid & 63, gw = blockIdx.x * NWAVES + (tid >> 6), NGW = gridDim.x * NWAVES;
    for (int m = 2 * gw; m < M; m += 2 * NGW) ln_row2(V + (size_t)m * D, V + (size_t)(m + 1) * D, w, b, XB ? XB + (size_t)m * D : nullptr, XB ? XB + (size_t)(m + 1) * D : nullptr,
                                                   OUTF ? OUTF + (size_t)m * D : nullptr, OUTF ? OUTF + (size_t)(m + 1) * D : nullptr, lane);
}
__device__ __forceinline__ void prologue(KP P, LAS unsigned char* lds) {
    const int tid = opaque_tid(), lane = tid & 63, wave = __builtin_amdgcn_readfirstlane(tid >> 6);
    LAS float* scr = (LAS float*)(lds + wave * 16384);
    const int gw = blockIdx.x * NWAVES + wave, NGW = gridDim.x * NWAVES;
    const int gt = blockIdx.x * (NWAVES * 64) + tid, NGT = gridDim.x * NWAVES * 64;
    int total = 0;
    for (int j = 0; j < 22; ++j) total += get_job(P, j).items;
    for (int it = gw; it < total; it += NGW) {
        int r = it, j = 0; CvtJob J = get_job(P, 0);
        while (r >= J.items) { r -= J.items; ++j; J = get_job(P, j); }
        cvt_item(J.W, J.K, J.srcld, J.c0, J.cnt, J.dst, J.mode, scr, r, lane);
    }
    for (int l = 0; l < DEPTH; ++l) { v4u* z = (v4u*)((bf16*)(P->ws + WS_W + (size_t)l * W_LAYER + WO_IN) + (size_t)NMIX * D);
        for (int i = gt; i < (NMIXP - NMIX) * D / 8; i += NGT) z[i] = (v4u){0u, 0u, 0u, 0u}; }
    { const f32x4* ps = (const f32x4*)P->in[I_P]; v2u* pd = (v2u*)(P->ws + WS_PB);
        constexpr size_t NP4 = (size_t)DEPTH * M * PLE / 4;
        for (size_t i = gt; i < NP4; i += (size_t)4 * NGT) { f32x4 v[4];
#pragma unroll
            for (int q = 0; q < 4; ++q) if (i + (size_t)q * NGT < NP4) v[q] = ps[i + (size_t)q * NGT];
#pragma unroll
            for (int q = 0; q < 4; ++q) if (i + (size_t)q * NGT < NP4) { v2u o; o.x = cvt_pk_bf16(v[q].x, v[q].y); o.y = cvt_pk_bf16(v[q].z, v[q].w); pd[i + (size_t)q * NGT] = o; } } }
    { float2* rt = (float2*)(P->ws + WS_ROPE);
        for (int i = gt; i < SEQ * 16; i += NGT) { const int t = i >> 4, k = i & 15; const double a = (double)t * ROPE_THETA[k];
            const double n = __builtin_rint(a * 0.15915494309189535); const double r = a - n * 6.283185307179586, r2 = r * r;
            double ts = r, ss = r, tc = 1.0, sc = 1.0;
            for (int q = 1; q <= 14; ++q) { tc *= -r2 / (double)((2 * q - 1) * (2 * q)); sc += tc; ts *= -r2 / (double)((2 * q) * (2 * q + 1)); ss += ts; }
            rt[i] = make_float2((float)sc, (float)ss); } }
    ln_phase(P->in[I_X], P->in[I_LNINW], P->in[I_LNINB], (bf16*)(P->ws + WS_XB), nullptr);
}

#ifndef REP_PREP
#define REP_PREP 1
#endif
#ifndef REP_REC
#define REP_REC 1
#endif

__device__ __forceinline__ void ld8(const bf16* p, float (&o)[8]) { const v4u w = *(const v4u*)p; o[0] = bf_lo(w.x); o[1] = bf_hi(w.x); o[2] = bf_lo(w.y); o[3] = bf_hi(w.y); o[4] = bf_lo(w.z); o[5] = bf_hi(w.z); o[6] = bf_lo(w.w); o[7] = bf_hi(w.w); }
__device__ __forceinline__ void st8(bf16* p, const float (&o)[8]) { v4u w; w.x = cvt_pk_bf16(o[0], o[1]); w.y = cvt_pk_bf16(o[2], o[3]); w.z = cvt_pk_bf16(o[4], o[5]); w.w = cvt_pk_bf16(o[6], o[7]); *(v4u*)p = w; }
__device__ __forceinline__ float sigmoid_acc(float x) { return __builtin_amdgcn_rcpf(1.0f + __expf(-x)); }
__device__ __forceinline__ float tanh_fast(float x) { return 2.0f * __builtin_amdgcn_rcpf(1.0f + __expf(-2.0f * x)) - 1.0f; }

template <int MX>
__device__ __forceinline__ void linattn_task(LAS float* sm, KP P, int layer, int b, int h) {
    constexpr int DK = (MX == 3) ? 64 : 32;
    const int tid = opaque_tid();
    LAS float* sq = sm;
    LAS float* sk = sm + 4096;
    LAS float* seg = sm + 8192;
    LAS float* sv = sm + 12288;
    LAS float* sg = sm + 16384;
    LAS float* so = sm + 20480;
    LAS float* sx = sm + 24576;
    const bf16* Z = (const bf16*)(P->ws + WS_R2);
    bf16* O = (bf16*)P->out;
    const int t8 = tid >> 3, e0 = (tid & 7) * 8;
    float S[DK];
#pragma unroll
    for (int d = 0; d < DK; ++d) S[d] = 0.f;
    float nw[8];
#pragma unroll
    for (int i = 0; i < 8; ++i) nw[i] = (MX == 2) ? P->in[I_GLANW][layer * 64 + e0 + i] : (MX == 3) ? P->in[I_HNW][layer * 64 + e0 + i] : 1.f;
#pragma unroll 1
    for (int c = 0; c < NCHUNK; ++c) {
        const size_t rowbase = (size_t)b * SEQ + c * 64;
        if (MX == 0) {
            const float2* rope = (const float2*)(P->ws + WS_ROPE);
#pragma unroll
            for (int i = 0; i < 2; ++i) { const int idx = tid + 512 * i, t = idx >> 4, pi = idx & 15; const bf16* zr = Z + (rowbase + t) * NMIXP;
                const unsigned qw = *(const unsigned*)(zr + h * 32 + 2 * pi), kw = *(const unsigned*)(zr + 128 + h * 32 + 2 * pi);
                const float2 cs = rope[(c * 64 + t) * 16 + pi];
                const float q1 = bf_lo(qw), q2 = bf_hi(qw), k1 = bf_lo(kw) * 0.17677669529663687f, k2 = bf_hi(kw) * 0.17677669529663687f;
                sq[t * DK + 2 * pi] = q1 * cs.x - q2 * cs.y; sq[t * DK + 2 * pi + 1] = q1 * cs.y + q2 * cs.x;
                sk[t * DK + 2 * pi] = k1 * cs.x - k2 * cs.y; sk[t * DK + 2 * pi + 1] = k1 * cs.y + k2 * cs.x; }
            const float gam = 1.0f - exp2f(-5.0f - (float)h);
#pragma unroll
            for (int i = 0; i < 4; ++i) seg[tid + 512 * i] = gam;
            const bf16* zr = Z + (rowbase + t8) * NMIXP; float a[8];
            ld8(zr + 256 + h * 64 + e0, a);
#pragma unroll
            for (int i = 0; i < 8; ++i) sv[t8 * 64 + e0 + i] = a[i];
            ld8(zr + 512 + h * 64 + e0, a);
#pragma unroll
            for (int i = 0; i < 8; ++i) sg[t8 * 64 + e0 + i] = a[i];
        } else if (MX == 2) {
            LAS float* sgl = sx; LAS float* sw2 = sx + 1024; LAS float* sbb = sx + 1536;
            const bf16* zr = Z + (rowbase + t8) * NMIXP + 1792; const int d0 = (tid & 7) * 4;
            { const v2u qw = *(const v2u*)(zr + h * 32 + d0), kw = *(const v2u*)(zr + 128 + h * 32 + d0);
              sq[t8 * DK + d0] = bf_lo(qw.x) * 0.17677669529663687f; sq[t8 * DK + d0 + 1] = bf_hi(qw.x) * 0.17677669529663687f; sq[t8 * DK + d0 + 2] = bf_lo(qw.y) * 0.17677669529663687f; sq[t8 * DK + d0 + 3] = bf_hi(qw.y) * 0.17677669529663687f;
              sk[t8 * DK + d0] = bf_lo(kw.x); sk[t8 * DK + d0 + 1] = bf_hi(kw.x); sk[t8 * DK + d0 + 2] = bf_lo(kw.y); sk[t8 * DK + d0 + 3] = bf_hi(kw.y); }
            float a[8];
            ld8(zr + 256 + h * 64 + e0, a);
#pragma unroll
            for (int i = 0; i < 8; ++i) sv[t8 * 64 + e0 + i] = a[i];
            ld8(zr + 528 + h * 64 + e0, a);
#pragma unroll
            for (int i = 0; i < 8; ++i) sg[t8 * 64 + e0 + i] = a[i];
            if (tid < 128) { const int t = tid >> 1, j0 = (tid & 1) * 8; ld8(Z + (rowbase + t) * NMIXP + 1792 + 512 + j0, a);
#pragma unroll
                for (int i = 0; i < 8; ++i) sgl[t * 16 + j0 + i] = a[i]; }
            sw2[tid] = P->in[I_GLAW2][(size_t)layer * 16 * 128 + (tid >> 5) * 128 + h * 32 + (tid & 31)];
            if (tid < 32) sbb[tid] = P->in[I_GLAB][layer * 128 + h * 32 + tid];
            __syncthreads();
#pragma unroll
            for (int i = 0; i < 4; ++i) { const int idx = tid + 512 * i, t = idx >> 5, d = idx & 31; float acc = sbb[d];
#pragma unroll
                for (int j = 0; j < 16; ++j) acc += sgl[t * 16 + j] * sw2[j * 32 + d];
                const float ls = fminf(acc, 0.f) - log1pf(__expf(-fabsf(acc)));
                seg[t * DK + d] = __expf(ls * 0.0625f); }
        } else {
            const bf16* zr = Z + (rowbase + t8) * NMIXP + 2576; float a[8], f[8];
            ld8(zr + h * 64 + e0, a);
#pragma unroll
            for (int i = 0; i < 8; ++i) sq[t8 * DK + e0 + i] = a[i];
            ld8(zr + 256 + h * 64 + e0, f);
#pragma unroll
            for (int i = 0; i < 8; ++i) { float lb = 0.f;
                if (layer > 0) lb = sigmoid_acc(P->in[I_HLB][256 + h * 64 + e0 + i] - P->in[I_HLB][h * 64 + e0 + i]);
                seg[t8 * DK + e0 + i] = lb + (1.f - lb) * sigmoid_acc(f[i]); sk[t8 * DK + e0 + i] = (1.f - lb) * sigmoid_acc(-f[i]); }
            ld8(zr + 512 + h * 64 + e0, a);
#pragma unroll
            for (int i = 0; i < 8; ++i) sv[t8 * 64 + e0 + i] = a[i];
            ld8(zr + 768 + h * 64 + e0, a);
#pragma unroll
            for (int i = 0; i < 8; ++i) sg[t8 * 64 + e0 + i] = a[i];
        }
        __syncthreads();
        if (tid < 64) {
#pragma unroll 1
            for (int t = 0; t < 64; ++t) { const float vv = sv[t * 64 + tid]; float o = 0.f;
#pragma unroll
                for (int d = 0; d < DK; ++d) { S[d] = seg[t * DK + d] * S[d] + sk[t * DK + d] * vv; o += sq[t * DK + d] * S[d]; }
                so[t * 64 + tid] = o; }
        }
        __syncthreads();
        { float ov[8], y[8]; float s = 0.f;
#pragma unroll
            for (int i = 0; i < 8; ++i) { ov[i] = so[t8 * 64 + e0 + i]; s += (MX == 0) ? ov[i] : ov[i] * ov[i]; }
            s = red8(s);
            if (MX == 0) { const float mean = s * (1.f / 64.f); float q = 0.f;
#pragma unroll
                for (int i = 0; i < 8; ++i) { ov[i] -= mean; q += ov[i] * ov[i]; }
                q = red8(q); const float rs = 1.0f / sqrtf(q * (1.f / 64.f) + 1e-6f);
#pragma unroll
                for (int i = 0; i < 8; ++i) y[i] = ov[i] * rs;
            } else { const float rs = 1.0f / sqrtf(s * (1.f / 64.f) + 1e-6f);
#pragma unroll
                for (int i = 0; i < 8; ++i) y[i] = ov[i] * rs * nw[i]; }
#pragma unroll
            for (int i = 0; i < 8; ++i) { const float gv = sg[t8 * 64 + e0 + i]; y[i] *= gv * sigmoid_acc(gv); }
            st8(O + (rowbase + t8) * D + MX * 256 + h * 64 + e0, y); }
        __syncthreads();
    }
}

typedef short bf16x8v __attribute__((ext_vector_type(8)));
#define SWZ(r, c) ((r) * 64 + ((((c) >> 3) ^ ((r) & 7)) << 3) + ((c) & 7))
__device__ __forceinline__ bf16x8v frag64(const LAS bf16* arr, int row, int ch) { return *(const LAS bf16x8v*)(arr + row * 64 + ((ch ^ (row & 7)) << 3)); }
template <int MX>
__device__ __forceinline__ void linattn_fast(LAS unsigned char* lds, KP P, int layer, int b, int h) {
    constexpr int DK = (MX == 3) ? 64 : 32, NDT = DK / 16, NKS = DK / 32, QN = DK / 8;
    asm volatile("" : "+s"(h), "+s"(b));
    const int tid = opaque_tid(), lane = tid & 63, wave = __builtin_amdgcn_readfirstlane(tid >> 6), fr = lane & 15, fq = lane >> 4;
    LAS float* slg = (LAS float*)lds;
    LAS bf16* sQ = (LAS bf16*)(lds + 16384); LAS bf16* sK = (LAS bf16*)(lds + 24576); LAS bf16* sKT = (LAS bf16*)(lds + 32768); LAS bf16* sVT = (LAS bf16*)(lds + 40960);
    LAS bf16* sP = (LAS bf16*)(lds + 49152); LAS bf16* sST = (LAS bf16*)(lds + 57344); LAS bf16* sG = (LAS bf16*)(lds + 65536);
    LAS float* sw2 = (LAS float*)(lds + 73728); LAS float* sbb = sw2 + 512;
    const bf16* Z = (const bf16*)(P->ws + WS_R2);
    bf16* O = (bf16*)P->out;
    const int t8 = tid >> 3, e0 = (tid & 7) * 8, dd0 = (tid & 7) * QN;
    constexpr int zbase = (MX == 0) ? 0 : (MX == 2) ? 1792 : 2576;
    constexpr int qcol = 0, kcol = (MX == 3) ? 256 : 128, vcol = (MX == 3) ? 512 : 256, gcol = (MX == 0) ? 512 : (MX == 2) ? 528 : 768;
    const float lgam = (MX == 0) ? logf(1.0f - exp2f(-5.0f - (float)h)) : 0.f;
    __syncthreads();
    if (MX == 2) { sw2[tid] = P->in[I_GLAW2][(size_t)layer * 16 * 128 + (tid >> 5) * 128 + h * 32 + (tid & 31)]; if (tid < 32) sbb[tid] = P->in[I_GLAB][layer * 128 + h * 32 + tid]; __syncthreads(); }
    float lbv[8];
#pragma unroll
    for (int i = 0; i < 8; ++i) { lbv[i] = 0.f; if (MX == 3 && layer > 0) lbv[i] = sigmoid_acc(P->in[I_HLB][256 + h * 64 + e0 + i] - P->in[I_HLB][h * 64 + e0 + i]); }
    float nw[16];
#pragma unroll
    for (int i = 0; i < 16; ++i) { const int e = 16 * (i >> 2) + 4 * fq + (i & 3); nw[i] = (MX == 2) ? P->in[I_GLANW][layer * 64 + e] : (MX == 3) ? P->in[I_HNW][layer * 64 + e] : 1.f; }
    f32x4 S[NDT];
#pragma unroll
    for (int i = 0; i < NDT; ++i) S[i] = (f32x4){0.f, 0.f, 0.f, 0.f};
#pragma unroll 1
    for (int c = 0; c < NCHUNK; ++c) {
        const size_t rowbase = (size_t)b * SEQ + c * 64;
        const bf16* zr = Z + (rowbase + t8) * NMIXP + zbase;
        float qr[QN], kr[QN];
        { const v4u vw = *(const v4u*)(zr + vcol + h * 64 + e0);
          const unsigned vv[4] = {vw.x, vw.y, vw.z, vw.w};
#pragma unroll
          for (int i = 0; i < 4; ++i) { sVT[SWZ(e0 + 2 * i, t8)] = (bf16)(vv[i] & 0xffffu); sVT[SWZ(e0 + 2 * i + 1, t8)] = (bf16)(vv[i] >> 16); }
          *(LAS v4u*)(sG + SWZ(t8, e0)) = *(const v4u*)(zr + gcol + h * 64 + e0); }
        if (MX == 3) {
            float a[8], f[8]; ld8(zr + qcol + h * 64 + e0, a); ld8(zr + kcol + h * 64 + e0, f);
#pragma unroll
            for (int i = 0; i < 8; ++i) { qr[i] = a[i]; const float ff = lbv[i] + (1.f - lbv[i]) * sigmoid_acc(f[i]); kr[i] = (1.f - lbv[i]) * sigmoid_acc(-f[i]); slg[t8 * 64 + e0 + i] = logf(ff); }
        } else {
            const v2u qw = *(const v2u*)(zr + qcol + h * 32 + dd0), kw = *(const v2u*)(zr + kcol + h * 32 + dd0);
            float q4[4] = {bf_lo(qw.x), bf_hi(qw.x), bf_lo(qw.y), bf_hi(qw.y)}, k4[4] = {bf_lo(kw.x), bf_hi(kw.x), bf_lo(kw.y), bf_hi(kw.y)};
            if (MX == 0) { const float2* rope = (const float2*)(P->ws + WS_ROPE) + (c * 64 + t8) * 16 + (dd0 >> 1);
#pragma unroll
                for (int p2 = 0; p2 < 2; ++p2) { const float2 cs = rope[p2]; const float q1 = q4[2 * p2], q2 = q4[2 * p2 + 1], k1 = k4[2 * p2] * 0.17677669529663687f, k2 = k4[2 * p2 + 1] * 0.17677669529663687f;
                    qr[2 * p2] = q1 * cs.x - q2 * cs.y; qr[2 * p2 + 1] = q1 * cs.y + q2 * cs.x; kr[2 * p2] = k1 * cs.x - k2 * cs.y; kr[2 * p2 + 1] = k1 * cs.y + k2 * cs.x; }
            } else { float gl[16]; { float a[8]; ld8(zr + 512, a);
#pragma unroll
                    for (int i = 0; i < 8; ++i) gl[i] = a[i];
                    ld8(zr + 520, a);
#pragma unroll
                    for (int i = 0; i < 8; ++i) gl[8 + i] = a[i]; }
#pragma unroll
                for (int i = 0; i < 4; ++i) { qr[i] = q4[i] * 0.17677669529663687f; kr[i] = k4[i]; float acc = sbb[dd0 + i];
#pragma unroll
                    for (int j = 0; j < 16; ++j) acc += gl[j] * sw2[j * 32 + dd0 + i];
                    slg[t8 * 64 + dd0 + i] = (fminf(acc, 0.f) - log1pf(__expf(-fabsf(acc)))) * 0.0625f; } }
        }
        if (MX != 0) {
            __syncthreads();
            if (tid < DK) { float run = 0.f;
#pragma unroll 1
                for (int tb = 0; tb < 64; tb += 16) { float x[16];
#pragma unroll
                    for (int i = 0; i < 16; ++i) x[i] = slg[(tb + i) * 64 + tid];
#pragma unroll
                    for (int i = 0; i < 16; ++i) { run += x[i]; x[i] = run; }
#pragma unroll
                    for (int i = 0; i < 16; ++i) slg[(tb + i) * 64 + tid] = x[i]; } }
            __syncthreads();
        }
        { float qs[QN], ks[QN];
#pragma unroll
          for (int i = 0; i < QN; ++i) { float dq;
              if (MX == 0) dq = (float)(t8 - 31) * lgam; else dq = slg[t8 * 64 + dd0 + i] - slg[31 * 64 + dd0 + i];
              qs[i] = qr[i] * __expf(dq); ks[i] = kr[i] * __expf(-dq); }
          if (QN == 8) { v4u o; o.x = cvt_pk_bf16(qs[0], qs[1]); o.y = cvt_pk_bf16(qs[2], qs[3]); o.z = cvt_pk_bf16(qs[4], qs[5]); o.w = cvt_pk_bf16(qs[6], qs[7]); *(LAS v4u*)(sQ + SWZ(t8, dd0)) = o;
                         v4u p; p.x = cvt_pk_bf16(ks[0], ks[1]); p.y = cvt_pk_bf16(ks[2], ks[3]); p.z = cvt_pk_bf16(ks[4], ks[5]); p.w = cvt_pk_bf16(ks[6], ks[7]); *(LAS v4u*)(sK + SWZ(t8, dd0)) = p; }
          else { v2u o; o.x = cvt_pk_bf16(qs[0], qs[1]); o.y = cvt_pk_bf16(qs[2], qs[3]); *(LAS v2u*)(sQ + SWZ(t8, dd0)) = o;
                 v2u p; p.x = cvt_pk_bf16(ks[0], ks[1]); p.y = cvt_pk_bf16(ks[2], ks[3]); *(LAS v2u*)(sK + SWZ(t8, dd0)) = p; }
#pragma unroll
          for (int i = 0; i < QN; i += 2) { const unsigned w = cvt_pk_bf16(ks[i], ks[i + 1]); sKT[SWZ(dd0 + i, t8)] = (bf16)(w & 0xffffu); sKT[SWZ(dd0 + i + 1, t8)] = (bf16)(w >> 16); } }
        __syncthreads();
        bf16x8v bq[NKS];
        if (wave < 4) {
            const int t = 16 * wave + fr;
#pragma unroll
            for (int ks = 0; ks < NKS; ++ks) bq[ks] = frag64(sQ, t, 4 * ks + fq);
#pragma unroll
            for (int j = 0; j < 4; ++j) { f32x4 acc = (f32x4){0.f, 0.f, 0.f, 0.f};
                if (j <= wave) {
#pragma unroll
                    for (int ks = 0; ks < NKS; ++ks) acc = __builtin_amdgcn_mfma_f32_16x16x32_bf16(frag64(sK, 16 * j + fr, 4 * ks + fq), bq[ks], acc, 0, 0, 0); }
                float pv[4];
#pragma unroll
                for (int rg = 0; rg < 4; ++rg) pv[rg] = (j < wave || (j == wave && 4 * fq + rg <= fr)) ? acc[rg] : 0.f;
                v2u o; o.x = cvt_pk_bf16(pv[0], pv[1]); o.y = cvt_pk_bf16(pv[2], pv[3]);
                *(LAS v2u*)(sP + t * 64 + (((2 * j + (fq >> 1)) ^ (t & 7)) << 3) + 4 * (fq & 1)) = o; }
        } else {
            const int e = 16 * (wave - 4) + fr;
#pragma unroll
            for (int i = 0; i < NDT; ++i) { float sc[4];
#pragma unroll
                for (int rg = 0; rg < 4; ++rg) sc[rg] = (MX == 0) ? __expf(32.f * lgam) : __expf(slg[31 * 64 + 16 * i + 4 * fq + rg]);
                v2u o; o.x = cvt_pk_bf16(S[i][0] * sc[0], S[i][1] * sc[1]); o.y = cvt_pk_bf16(S[i][2] * sc[2], S[i][3] * sc[3]);
                *(LAS v2u*)(sST + e * 64 + (((2 * i + (fq >> 1)) ^ (e & 7)) << 3) + 4 * (fq & 1)) = o; }
        }
        __syncthreads();
        if (wave < 4) {
            const int t = 16 * wave + fr;
            bf16x8v bp[2];
#pragma unroll
            for (int ks = 0; ks < 2; ++ks) bp[ks] = frag64(sP, t, 4 * ks + fq);
            f32x4 oacc[4];
#pragma unroll
            for (int i = 0; i < 4; ++i) { f32x4 acc = (f32x4){0.f, 0.f, 0.f, 0.f};
                acc = __builtin_amdgcn_mfma_f32_16x16x32_bf16(frag64(sVT, 16 * i + fr, fq), bp[0], acc, 0, 0, 0);
                if (wave >= 2) acc = __builtin_amdgcn_mfma_f32_16x16x32_bf16(frag64(sVT, 16 * i + fr, 4 + fq), bp[1], acc, 0, 0, 0);
#pragma unroll
                for (int ks = 0; ks < NKS; ++ks) acc = __builtin_amdgcn_mfma_f32_16x16x32_bf16(frag64(sST, 16 * i + fr, 4 * ks + fq), bq[ks], acc, 0, 0, 0);
                oacc[i] = acc; }
            float s1 = 0.f;
#pragma unroll
            for (int i = 0; i < 4; ++i)
#pragma unroll
                for (int rg = 0; rg < 4; ++rg) s1 += (MX == 0) ? oacc[i][rg] : oacc[i][rg] * oacc[i][rg];
            s1 += __shfl_xor(s1, 16); s1 += __shfl_xor(s1, 32);
            float rs;
            if (MX == 0) { const float mean = s1 * (1.f / 64.f); float q2 = 0.f;
#pragma unroll
                for (int i = 0; i < 4; ++i)
#pragma unroll
                    for (int rg = 0; rg < 4; ++rg) { oacc[i][rg] -= mean; q2 += oacc[i][rg] * oacc[i][rg]; }
                q2 += __shfl_xor(q2, 16); q2 += __shfl_xor(q2, 32); rs = 1.0f / sqrtf(q2 * (1.f / 64.f) + 1e-6f);
            } else rs = 1.0f / sqrtf(s1 * (1.f / 64.f) + 1e-6f);
#pragma unroll
            for (int i = 0; i < 4; ++i) { const v2u gw = *(const LAS v2u*)(sG + t * 64 + (((2 * i + (fq >> 1)) ^ (t & 7)) << 3) + 4 * (fq & 1));
                const float g4[4] = {bf_lo(gw.x), bf_hi(gw.x), bf_lo(gw.y), bf_hi(gw.y)}; float y[4];
#pragma unroll
                for (int rg = 0; rg < 4; ++rg) y[rg] = oacc[i][rg] * rs * nw[4 * i + rg] * g4[rg] * sigmoid_acc(g4[rg]);
                v2u o; o.x = cvt_pk_bf16(y[0], y[1]); o.y = cvt_pk_bf16(y[2], y[3]);
                *(v2u*)(O + (rowbase + t) * D + MX * 256 + h * 64 + 16 * i + 4 * fq) = o; }
        } else {
            const int e = 16 * (wave - 4) + fr;
            bf16x8v bv[2];
#pragma unroll
            for (int ks = 0; ks < 2; ++ks) bv[ks] = frag64(sVT, e, 4 * ks + fq);
#pragma unroll
            for (int i = 0; i < NDT; ++i) { f32x4 acc = (f32x4){0.f, 0.f, 0.f, 0.f};
#pragma unroll
                for (int ks = 0; ks < 2; ++ks) acc = __builtin_amdgcn_mfma_f32_16x16x32_bf16(frag64(sKT, 16 * i + fr, 4 * ks + fq), bv[ks], acc, 0, 0, 0);
#pragma unroll
                for (int rg = 0; rg < 4; ++rg) { float el, er;
                    if (MX == 0) { el = __expf(64.f * lgam); er = __expf(32.f * lgam); }
                    else { const float bl = slg[63 * 64 + 16 * i + 4 * fq + rg], br = slg[31 * 64 + 16 * i + 4 * fq + rg]; el = __expf(bl); er = __expf(bl - br); }
                    S[i][rg] = el * S[i][rg] + er * acc[rg]; } }
        }
        __syncthreads();
    }
}

__device__ __forceinline__ float dpp_f(float x, const int ctrl_sel) {
    const int xi = __builtin_bit_cast(int, x); int r;
    if (ctrl_sel == 0) r = __builtin_amdgcn_update_dpp(0, xi, 0xB1, 0xf, 0xf, true);
    else if (ctrl_sel == 1) r = __builtin_amdgcn_update_dpp(0, xi, 0x4E, 0xf, 0xf, true);
    else if (ctrl_sel == 2) r = __builtin_amdgcn_update_dpp(0, xi, 0x141, 0xf, 0xf, true);
    else r = __builtin_amdgcn_update_dpp(0, xi, 0x140, 0xf, 0xf, true);
    return __builtin_bit_cast(float, r);
}
__device__ __forceinline__ float sum16_dpp(float v) { v += dpp_f(v, 0); v += dpp_f(v, 1); v += dpp_f(v, 2); v += dpp_f(v, 3); return v; }
#define DPP_SUM16_2(a_, b_) asm volatile( \
    "s_nop 1\n\t" \
    "v_add_f32_dpp %0, %0, %0 quad_perm:[1,0,3,2] row_mask:0xf bank_mask:0xf bound_ctrl:1\n\t" \
    "v_add_f32_dpp %1, %1, %1 quad_perm:[1,0,3,2] row_mask:0xf bank_mask:0xf bound_ctrl:1\n\t" \
    "s_nop 0\n\t" \
    "v_add_f32_dpp %0, %0, %0 quad_perm:[2,3,0,1] row_mask:0xf bank_mask:0xf bound_ctrl:1\n\t" \
    "v_add_f32_dpp %1, %1, %1 quad_perm:[2,3,0,1] row_mask:0xf bank_mask:0xf bound_ctrl:1\n\t" \
    "s_nop 0\n\t" \
    "v_add_f32_dpp %0, %0, %0 row_half_mirror row_mask:0xf bank_mask:0xf bound_ctrl:1\n\t" \
    "v_add_f32_dpp %1, %1, %1 row_half_mirror row_mask:0xf bank_mask:0xf bound_ctrl:1\n\t" \
    "s_nop 0\n\t" \
    "v_add_f32_dpp %0, %0, %0 row_mirror row_mask:0xf bank_mask:0xf bound_ctrl:1\n\t" \
    "v_add_f32_dpp %1, %1, %1 row_mirror row_mask:0xf bank_mask:0xf bound_ctrl:1\n\t" \
    : "+v"(a_), "+v"(b_));
__device__ __forceinline__ float sum8_dpp(float v) { v += dpp_f(v, 0); v += dpp_f(v, 1); v += dpp_f(v, 2); return v; }

__device__ __forceinline__ void rwkv_task(LAS unsigned char* lds, KP P, int layer, int b, int h, int half) {
    asm volatile("" : "+s"(h), "+s"(b), "+s"(half));
    const int tid = opaque_tid(), lane = tid & 63, wave = __builtin_amdgcn_readfirstlane(tid >> 6);
    LAS float* sr = (LAS float*)lds; LAS float* skm = sr + 4096; LAS float* sw = sr + 8192; LAS float* ska = sr + 12288; LAS float* sv = sr + 16384;
    LAS float* skk = sr + 20480; LAS float* sy = sr + 24576;
    LAS bf16* tw = (LAS bf16*)(lds + 81920); LAS bf16* ta = (LAS bf16*)(lds + 90112); LAS bf16* tg = (LAS bf16*)(lds + 98304);
    LAS bf16* w2T = (LAS bf16*)(lds + 114688); LAS bf16* a2T = (LAS bf16*)(lds + 122880); LAS bf16* g2T = (LAS bf16*)(lds + 131072);
    LAS float* sbon = (LAS float*)(lds + 147456);
    LAS float* smu = (LAS float*)(lds + 147712);
    LAS float* spar = smu + 448;
    const bf16* Z = (const bf16*)(P->ws + WS_R2);
    bf16* O = (bf16*)P->out;
    const int t8 = tid >> 3, e0 = (tid & 7) * 8, colh = h * 64;
    __syncthreads();
    if (tid < 448) { const int seg = tid >> 6, j = tid & 63; const int col = (seg < 3) ? seg * 256 + colh + j : 768 + (seg - 3) * 64 + j; smu[tid] = P->in[I_MU][layer * 1024 + col]; }
    if (tid < 320) { const int seg = tid >> 6, j = tid & 63; const float* src = (seg == 0) ? P->in[I_KK] + layer * 256 + colh : (seg == 1) ? P->in[I_KA] + layer * 256 + colh : (seg == 2) ? P->in[I_RK] + (layer * 4 + h) * 64
                                                                             : (seg == 3) ? P->in[I_RLNW] + layer * 256 + colh : P->in[I_RLNB] + layer * 256 + colh; spar[tid] = src[j]; }
    __syncthreads();
    { const int cc = tid & 63, jb = tid >> 6;
      const float* w2 = P->in[I_W2] + (size_t)layer * 64 * 256 + colh + cc; const float* a2 = P->in[I_A2] + (size_t)layer * 64 * 256 + colh + cc; const float* g2 = P->in[I_G2] + (size_t)layer * 128 * 256 + colh + cc;
      float x[8];
#pragma unroll
      for (int i = 0; i < 8; ++i) x[i] = w2[(8 * jb + i) * 256];
      { v4u o; o.x = cvt_pk_bf16(x[0], x[1]); o.y = cvt_pk_bf16(x[2], x[3]); o.z = cvt_pk_bf16(x[4], x[5]); o.w = cvt_pk_bf16(x[6], x[7]); *(LAS v4u*)(w2T + cc * 64 + ((jb ^ (cc & 7)) << 3)) = o; }
#pragma unroll
      for (int i = 0; i < 8; ++i) x[i] = a2[(8 * jb + i) * 256];
      { v4u o; o.x = cvt_pk_bf16(x[0], x[1]); o.y = cvt_pk_bf16(x[2], x[3]); o.z = cvt_pk_bf16(x[4], x[5]); o.w = cvt_pk_bf16(x[6], x[7]); *(LAS v4u*)(a2T + cc * 64 + ((jb ^ (cc & 7)) << 3)) = o; }
#pragma unroll
      for (int hh = 0; hh < 2; ++hh) { const int ch = jb + 8 * hh;
#pragma unroll
          for (int i = 0; i < 8; ++i) x[i] = g2[(8 * ch + i) * 256];
          v4u o; o.x = cvt_pk_bf16(x[0], x[1]); o.y = cvt_pk_bf16(x[2], x[3]); o.z = cvt_pk_bf16(x[4], x[5]); o.w = cvt_pk_bf16(x[6], x[7]); *(LAS v4u*)(g2T + cc * 128 + ((ch ^ (cc & 7)) << 3)) = o; } }
    const int ti = wave & 3, ci0 = 2 * (wave >> 2), fr = lane & 15, fq = lane >> 4;
    float w0v[2], a0v[2];
#pragma unroll
    for (int q = 0; q < 2; ++q) { w0v[q] = P->in[I_W0][layer * 256 + colh + 16 * (ci0 + q) + fr]; a0v[q] = P->in[I_A0][layer * 256 + colh + 16 * (ci0 + q) + fr]; }
    const int kq = lane & 15, vrow = 32 * half + 2 * (4 * (wave & 3) + (lane >> 4));
    typedef float f32x2 __attribute__((ext_vector_type(2)));
    v4u R[7];
#define RWKV_LOAD(cc_, dst_, back_) { const bf16* zr_ = Z + ((size_t)b * SEQ + (cc_) * 64 + t8) * NMIXP + 768; const bf16* zp_ = ((back_) && !((cc_) == 0 && t8 == 0)) ? zr_ - NMIXP : zr_; \
        const int cols_[7] = {colh + e0, 256 + colh + e0, 512 + colh + e0, 768 + e0, 832 + e0, 896 + e0, 960 + e0}; \
        _Pragma("unroll") for (int q_ = 0; q_ < 7; ++q_) dst_[q_] = *(const v4u*)(zp_ + cols_[q_]); }
    RWKV_LOAD(0, R, 0)
    v4u Rp[7]; RWKV_LOAD(0, Rp, 1)
    f32x2 S2[4];
#pragma unroll
    for (int k = 0; k < 4; ++k) S2[k] = (f32x2){0.f, 0.f};
#pragma unroll 1
    for (int c = 0; c < NCHUNK; ++c) {
        const size_t rowbase = (size_t)b * SEQ + c * 64;
        f32x4 gacc[2];
        for (int rp_ = 0; rp_ < REP_PREP; ++rp_) {
        { const bool first = (c == 0 && t8 == 0);
          float a[8], p[8], z[8];
#define UNPK(vv_, o_) { const v4u u_ = vv_; o_[0] = bf_lo(u_.x); o_[1] = bf_hi(u_.x); o_[2] = bf_lo(u_.y); o_[3] = bf_hi(u_.y); o_[4] = bf_lo(u_.z); o_[5] = bf_hi(u_.z); o_[6] = bf_lo(u_.w); o_[7] = bf_hi(u_.w); }
#define SHIFTED(idx, col) { UNPK(R[idx], a) UNPK(Rp[idx], p) _Pragma("unroll") for (int i = 0; i < 8; ++i) { const float pv = first ? 0.f : p[i]; z[i] = a[i] + (pv - a[i]) * smu[(idx) * 64 + e0 + i]; } }
          SHIFTED(0, colh + e0)
#pragma unroll
          for (int i = 0; i < 8; ++i) sr[t8 * 64 + e0 + i] = z[i];
          SHIFTED(1, 256 + colh + e0)
#pragma unroll
          for (int i = 0; i < 8; ++i) skm[t8 * 64 + e0 + i] = z[i];
          SHIFTED(2, 512 + colh + e0)
#pragma unroll
          for (int i = 0; i < 8; ++i) sv[t8 * 64 + e0 + i] = z[i];
          const int sw8 = ((tid & 7) ^ (t8 & 7)) << 3;
          SHIFTED(3, 768 + e0)
          { v4u o; o.x = cvt_pk_bf16(tanh_fast(z[0]), tanh_fast(z[1])); o.y = cvt_pk_bf16(tanh_fast(z[2]), tanh_fast(z[3])); o.z = cvt_pk_bf16(tanh_fast(z[4]), tanh_fast(z[5])); o.w = cvt_pk_bf16(tanh_fast(z[6]), tanh_fast(z[7])); *(LAS v4u*)(tw + t8 * 64 + sw8) = o; }
          SHIFTED(4, 832 + e0)
          { v4u o; o.x = cvt_pk_bf16(z[0], z[1]); o.y = cvt_pk_bf16(z[2], z[3]); o.z = cvt_pk_bf16(z[4], z[5]); o.w = cvt_pk_bf16(z[6], z[7]); *(LAS v4u*)(ta + t8 * 64 + sw8) = o; }
          SHIFTED(5, 896 + e0)
          { v4u o; o.x = cvt_pk_bf16(sigmoid_acc(z[0]), sigmoid_acc(z[1])); o.y = cvt_pk_bf16(sigmoid_acc(z[2]), sigmoid_acc(z[3])); o.z = cvt_pk_bf16(sigmoid_acc(z[4]), sigmoid_acc(z[5])); o.w = cvt_pk_bf16(sigmoid_acc(z[6]), sigmoid_acc(z[7])); *(LAS v4u*)(tg + t8 * 128 + sw8) = o; }
          SHIFTED(6, 960 + e0)
          { v4u o; o.x = cvt_pk_bf16(sigmoid_acc(z[0]), sigmoid_acc(z[1])); o.y = cvt_pk_bf16(sigmoid_acc(z[2]), sigmoid_acc(z[3])); o.z = cvt_pk_bf16(sigmoid_acc(z[4]), sigmoid_acc(z[5])); o.w = cvt_pk_bf16(sigmoid_acc(z[6]), sigmoid_acc(z[7])); *(LAS v4u*)(tg + t8 * 128 + 64 + sw8) = o; }
#undef UNPK
#undef SHIFTED
        }
        __syncthreads();
        { const int ar = 16 * ti + fr;
          f32x4 wacc[2], aacc[2];
#pragma unroll
          for (int q = 0; q < 2; ++q) { wacc[q] = (f32x4){0.f, 0.f, 0.f, 0.f}; aacc[q] = wacc[q]; gacc[q] = wacc[q]; }
#pragma unroll
          for (int ks = 0; ks < 2; ++ks) { const int ch = ks * 4 + fq;
              const bf16x8v Aw = *(const LAS bf16x8v*)(tw + ar * 64 + ((ch ^ (ar & 7)) << 3)), Aa = *(const LAS bf16x8v*)(ta + ar * 64 + ((ch ^ (ar & 7)) << 3));
#pragma unroll
              for (int q = 0; q < 2; ++q) { const int br = 16 * (ci0 + q) + fr;
                  const bf16x8v Bw = *(const LAS bf16x8v*)(w2T + br * 64 + ((ch ^ (br & 7)) << 3)), Ba = *(const LAS bf16x8v*)(a2T + br * 64 + ((ch ^ (br & 7)) << 3));
                  wacc[q] = __builtin_amdgcn_mfma_f32_16x16x32_bf16(Aw, Bw, wacc[q], 0, 0, 0); aacc[q] = __builtin_amdgcn_mfma_f32_16x16x32_bf16(Aa, Ba, aacc[q], 0, 0, 0); } }
#pragma unroll
          for (int ks = 0; ks < 4; ++ks) { const int ch = ks * 4 + fq;
              const bf16x8v Ag = *(const LAS bf16x8v*)(tg + ar * 128 + ((ch ^ (ar & 7)) << 3));
#pragma unroll
              for (int q = 0; q < 2; ++q) { const int br = 16 * (ci0 + q) + fr;
                  const bf16x8v Bg = *(const LAS bf16x8v*)(g2T + br * 128 + ((ch ^ (br & 7)) << 3));
                  gacc[q] = __builtin_amdgcn_mfma_f32_16x16x32_bf16(Ag, Bg, gacc[q], 0, 0, 0); } }
#pragma unroll
          for (int q = 0; q < 2; ++q)
#pragma unroll
              for (int rg = 0; rg < 4; ++rg) { const int t = 16 * ti + 4 * fq + rg, cc = 16 * (ci0 + q) + fr;
                  sw[t * 64 + cc] = __expf(-0.6065306597126334f * sigmoid_acc(w0v[q] + wacc[q][rg])); ska[t * 64 + cc] = sigmoid_acc(a0v[q] + aacc[q][rg]); } }
        __syncthreads();
        }
        { float ss = 0.f, bon = 0.f; float kk[8], av[8];
#pragma unroll
            for (int i = 0; i < 8; ++i) { const int cc = e0 + i; const float kv = skm[t8 * 64 + cc]; av[i] = ska[t8 * 64 + cc];
                kk[i] = kv * spar[cc]; ss += kk[i] * kk[i];
                const float km = kv * (1.f + (av[i] - 1.f) * spar[64 + cc]); skm[t8 * 64 + cc] = km;
                bon += sr[t8 * 64 + cc] * km * spar[128 + cc]; }
            ss = red8(ss); bon = red8(bon); const float inv = 1.0f / sqrtf(ss + 1e-12f);
#pragma unroll
            for (int i = 0; i < 8; ++i) { const float kn = kk[i] * inv; skk[t8 * 64 + e0 + i] = kn; ska[t8 * 64 + e0 + i] = kn * av[i]; }
            if ((tid & 7) == 0) sbon[t8] = bon; }
        __syncthreads();
        if (c + 1 < NCHUNK) RWKV_LOAD(c + 1, R, 0)
        if (wave < 4) { const LAS f32x4* pw = (const LAS f32x4*)(sw + 4 * kq); const LAS f32x4* pkk = (const LAS f32x4*)(skk + 4 * kq); const LAS f32x4* pka = (const LAS f32x4*)(ska + 4 * kq);
          const LAS f32x4* pkm = (const LAS f32x4*)(skm + 4 * kq); const LAS f32x4* pr = (const LAS f32x4*)(sr + 4 * kq); const LAS f32x2* pv = (const LAS f32x2*)(sv + vrow);
          f32x2 Ssave[4] = {S2[0], S2[1], S2[2], S2[3]};
          for (int rr_ = 0; rr_ < REP_REC; ++rr_) { S2[0] = Ssave[0]; S2[1] = Ssave[1]; S2[2] = Ssave[2]; S2[3] = Ssave[3];
          f32x4 wA = pw[0], kA = pkk[0], aA = pka[0], mA = pkm[0], rA = pr[0]; f32x2 vA = pv[0];
          f32x4 wB, kB, aB, mB, rB; f32x2 vB;
#define RWKV_STEP(tcur, tn, wX, kX, aX, mX, rX, vX, wY, kY, aY, mY, rY, vY) { \
              wY = pw[(tn) * 16]; kY = pkk[(tn) * 16]; aY = pka[(tn) * 16]; mY = pkm[(tn) * 16]; rY = pr[(tn) * 16]; vY = pv[(tn) * 32]; \
              f32x2 sa = S2[0] * kX.x; sa = S2[1] * kX.y + sa; sa = S2[2] * kX.z + sa; sa = S2[3] * kX.w + sa; \
              const f32x2 tm0 = S2[0] * wX.x + vX * mX.x, tm1 = S2[1] * wX.y + vX * mX.y, tm2 = S2[2] * wX.z + vX * mX.z, tm3 = S2[3] * wX.w + vX * mX.w; \
              float s0 = sa.x, s1 = sa.y; DPP_SUM16_2(s0, s1) \
              const f32x2 sar = (f32x2){s0, s1}; \
              S2[0] = tm0 - sar * aX.x; S2[1] = tm1 - sar * aX.y; S2[2] = tm2 - sar * aX.z; S2[3] = tm3 - sar * aX.w; \
              f32x2 yy = S2[0] * rX.x; yy = S2[1] * rX.y + yy; yy = S2[2] * rX.z + yy; yy = S2[3] * rX.w + yy; \
              float y0 = yy.x, y1 = yy.y; DPP_SUM16_2(y0, y1) \
              if (kq == 0) *(LAS f32x2*)(sy + (tcur) * 64 + vrow) = (f32x2){y0, y1}; }
#pragma unroll 1
          for (int t = 0; t < 64; t += 2) {
              RWKV_STEP(t, t + 1, wA, kA, aA, mA, rA, vA, wB, kB, aB, mB, rB, vB)
              RWKV_STEP(t + 1, (t + 2) & 63, wB, kB, aB, mB, rB, vB, wA, kA, aA, mA, rA, vA) }
#undef RWKV_STEP
          } }
        __syncthreads();
        if (c + 1 < NCHUNK) RWKV_LOAD(c + 1, Rp, 1)
#pragma unroll
        for (int q = 0; q < 2; ++q)
#pragma unroll
            for (int rg = 0; rg < 4; ++rg) skk[(16 * ti + 4 * fq + rg) * 64 + 16 * (ci0 + q) + fr] = gacc[q][rg];
        __syncthreads();
        { const int c4 = 32 * half + (tid & 7) * 4; float yv[4]; float s = 0.f;
#pragma unroll
            for (int i = 0; i < 4; ++i) { yv[i] = sy[t8 * 64 + c4 + i]; s += yv[i]; }
            s = red8(s); const float mean = s * (1.f / 32.f); float q = 0.f;
#pragma unroll
            for (int i = 0; i < 4; ++i) { const float d = yv[i] - mean; q += d * d; }
            q = red8(q); const float bon = sbon[t8];
            const size_t off = (rowbase + t8) * 256 + colh + c4;
            *(f32x4*)((float*)(P->out + (size_t)M * D / 2) + off) = (f32x4){yv[0], yv[1], yv[2], yv[3]};
            v2u ad; ad.x = cvt_pk_bf16(bon * sv[t8 * 64 + c4], bon * sv[t8 * 64 + c4 + 1]); ad.y = cvt_pk_bf16(bon * sv[t8 * 64 + c4 + 2], bon * sv[t8 * 64 + c4 + 3]);
            *(v2u*)((bf16*)(P->out + (size_t)M * D / 2 + (size_t)M * 256) + off) = ad;
            v2u gt; gt.x = cvt_pk_bf16(skk[t8 * 64 + c4], skk[t8 * 64 + c4 + 1]); gt.y = cvt_pk_bf16(skk[t8 * 64 + c4 + 2], skk[t8 * 64 + c4 + 3]);
            *(v2u*)((bf16*)(P->out + (size_t)M * D / 2 + (size_t)M * 256) + (size_t)M * 256 + off) = gt;
            if ((tid & 7) == 0) ((float2*)(P->ws + WS_RST))[((rowbase + t8) * 4 + h) * 2 + half] = make_float2(mean, q); }
        __syncthreads();
    }
}

__device__ __forceinline__ void rwkv_finalize(KP P, int layer) {
    const int gt = blockIdx.x * (NWAVES * 64) + opaque_tid(), NGT = gridDim.x * NWAVES * 64;
    const float* YR = P->out + (size_t)M * D / 2; const bf16* AD = (const bf16*)(YR + (size_t)M * 256); const bf16* GT = AD + (size_t)M * 256;
    const float2* ST = (const float2*)(P->ws + WS_RST); bf16* O = (bf16*)P->out;
    for (int i = gt; i < M * 64; i += NGT) { const int row = i >> 6, c4 = (i & 63) * 4, h = c4 >> 6;
        const float2 sa = ST[(row * 4 + h) * 2], sb = ST[(row * 4 + h) * 2 + 1];
        const float mean = 0.5f * (sa.x + sb.x), dm = sa.x - sb.x, m2 = sa.y + sb.y + 16.f * dm * dm, rs = 1.0f / sqrtf(m2 * (1.f / 64.f) + 64e-5f);
        const f32x4 y = *(const f32x4*)(YR + (size_t)row * 256 + c4); const v2u ad = *(const v2u*)(AD + (size_t)row * 256 + c4), g = *(const v2u*)(GT + (size_t)row * 256 + c4);
        const f32x4 lw = *(const f32x4*)(P->in[I_RLNW] + layer * 256 + c4), lb = *(const f32x4*)(P->in[I_RLNB] + layer * 256 + c4);
        v2u o; o.x = cvt_pk_bf16(((y.x - mean) * rs * lw.x + lb.x + bf_lo(ad.x)) * bf_lo(g.x), ((y.y - mean) * rs * lw.y + lb.y + bf_hi(ad.x)) * bf_hi(g.x));
        o.y = cvt_pk_bf16(((y.z - mean) * rs * lw.z + lb.z + bf_lo(ad.y)) * bf_lo(g.y), ((y.w - mean) * rs * lw.w + lb.w + bf_hi(ad.y)) * bf_hi(g.y));
        *(v2u*)(O + (size_t)row * D + 256 + c4) = o; }
}

__device__ __forceinline__ void ffn_fixup(KP P, int layer) {
    const int gt = blockIdx.x * (NWAVES * 64) + opaque_tid(), NGT = gridDim.x * NWAVES * 64;
    const float* uh = (const float*)(P->ws + WS_HALO); const float* vh = (const float*)(P->ws + WS_HALO + HALO_ONE); const float* ut = (const float*)(P->ws + WS_HALO + 2 * HALO_ONE);
    const float* conv = P->in[I_CONV] + (size_t)layer * 3 * DFF; bf16* ACT = (bf16*)(P->ws + WS_R2);
    for (int i = gt; i < 128 * 2 * DFF; i += NGT) { const int pm = i / (2 * DFF), rr = (i / DFF) & 1, cc = i % DFF;
        const float u0 = uh[((size_t)pm * 2) * DFF + cc], u1 = uh[((size_t)pm * 2 + 1) * DFF + cc];
        float t0 = 0.f, t1 = 0.f; if (pm & 7) { t0 = ut[((size_t)(pm - 1) * 2) * DFF + cc]; t1 = ut[((size_t)(pm - 1) * 2 + 1) * DFF + cc]; }
        const float c0 = conv[cc], c1 = conv[DFF + cc], c2 = conv[2 * DFF + cc];
        const float cv = rr ? (c2 * u1 + c1 * u0 + c0 * t1) : (c2 * u0 + c1 * t1 + c0 * t0);
        const float a = pg8::gelu_tanh_f(cv) * vh[((size_t)pm * 2 + rr) * DFF + cc];
        ACT[((size_t)pm * 256 + rr) * DFF + cc] = (bf16)(cvt_pk_bf16(a, 0.f) & 0xffffu); }
}

constexpr int NPH = 1 + 11 * DEPTH;
#ifndef REP_MIX
#define REP_MIX -1
#endif
#ifndef REP_PHASE
#define REP_PHASE -1
#endif
#define REPEAT(k) for (int rep_ = 0; rep_ < ((REP_PHASE == (k)) ? 2 : 1); ++rep_)
__global__ void __launch_bounds__(NWAVES * 64, 2) mega(Params Pk) {
    KP P = kparams();
    extern __shared__ __attribute__((aligned(16))) unsigned char lds_raw[];
    LAS unsigned char* lds = (LAS unsigned char*)lds_raw;
    volatile LAS unsigned* MISC = (volatile LAS unsigned*)(lds + LDS_MISC);
    const int tid = threadIdx.x;
    const int G = gridDim.x, bx = blockIdx.x;
    if (tid < 64) MISC[tid] = 0u;
    __syncthreads();
    const int lo = P->ph_lo, hi = P->ph_hi;
    XcdBarrier bar; bar.bar = (unsigned*)(P->ws + WS_CTL) + CW_BAR; bar.x = 0; bar.st = nullptr;
    if (hi - lo > 1) bar = xcd_barrier_post((unsigned*)(P->ws + WS_CTL) + CW_BAR, MISC + 8);
#define IN(k) (lo <= (k) && (k) < hi)
#define SEAM(k) do { if (IN(k) && IN((k) + 1)) xcd_barrier(bar); } while (0)
#define PHASE_PTRS KP P = kparams(); unsigned char* const wl = P->ws + WS_W + (size_t)l * W_LAYER; bf16* const XB = (bf16*)(P->ws + WS_XB); unsigned char* const R2 = P->ws + WS_R2; \
        bf16* const OB = (bf16*)P->out;   bf16* const MG = (bf16*)P->out + (size_t)M * D;   \
        (void)wl; (void)XB; (void)R2; (void)OB; (void)MG;

    if (IN(0)) prologue(kparams(), lds);
    SEAM(0);
    for (int l = 0; l < DEPTH; ++l) {
        const int pb = 1 + 11 * l;
        REPEAT(0) if (IN(pb + 0)) {
            PHASE_PTRS
            pg8::Gemm g{XB, (const bf16*)(wl + WO_IN), M, NMIXP, D, D, D, 0, 0}; pg8::StaticOrder S; S.init(M, NMIXP, G, bx);
            pg8::EpiStoreBf16 E{(bf16*)R2, NMIXP};
            pg8::gemm_phase<pg8::EpiStoreBf16, pg8::StaticOrder, true, true>(lds, g, S, E);
        }
        SEAM(pb + 0);
        REPEAT(1) if (IN(pb + 1)) {
            PHASE_PTRS
#ifndef NO_MIX
            for (int slot = bx; slot < 256; slot += G) {
                if (slot < 128) { const int bh = slot >> 1; rwkv_task(lds, P, l, bh >> 2, bh & 3, slot & 1); }
                else if (slot < 192) { const int bh = slot - 128; linattn_fast<0>(lds, P, l, bh >> 2, bh & 3); linattn_fast<2>(lds, P, l, bh >> 2, bh & 3); }
                else { const int bh = slot - 192; linattn_fast<3>(lds, P, l, bh >> 2, bh & 3); } }
#endif
        }
        SEAM(pb + 1);
        REPEAT(2) if (IN(pb + 2)) rwkv_finalize(kparams(), l);
        SEAM(pb + 2);
        REPEAT(3) if (IN(pb + 3)) {
            PHASE_PTRS
            pg8::Gemm g{OB, (const bf16*)(wl + WO_B), M, 4096, 256, D, 256, 4, 256}; pg8::StaticOrder S; S.init(M, 4096, G, bx);
            pg8::EpiStoreBf16 E{(bf16*)R2, 4096};
            pg8::gemm_phase<pg8::EpiStoreBf16, pg8::StaticOrder, true, true>(lds, g, S, E);
        }
        SEAM(pb + 3);
        REPEAT(4) if (IN(pb + 4)) {
            PHASE_PTRS
            pg8::Gemm g{XB, (const bf16*)(wl + WO_G), M, 4096, D, D, D, 0, 0}; pg8::StaticOrder S; S.init(M, 4096, G, bx);
            pg8::EpiMerge E{(const bf16*)R2, MG};
            pg8::gemm_phase<pg8::EpiMerge, pg8::StaticOrder, true, true>(lds, g, S, E);
        }
        SEAM(pb + 4);
        REPEAT(5) if (IN(pb + 5)) {
            PHASE_PTRS
            pg8::Gemm g{MG, (const bf16*)(wl + WO_MIX), M, D, D, D, D, 0, 0}; pg8::StaticOrder S; S.init(M, D, G, bx);
            pg8::EpiResF32 E{XB, nullptr, (float*)R2, ALPHA};
            pg8::gemm_phase<pg8::EpiResF32, pg8::StaticOrder, true, true>(lds, g, S, E);
        }
        SEAM(pb + 5);
        REPEAT(6) if (IN(pb + 6)) { PHASE_PTRS ln_phase((const float*)R2, P->in[I_LNMW] + l * D, P->in[I_LNMB] + l * D, XB, nullptr); }
        SEAM(pb + 6);
        REPEAT(7) if (IN(pb + 7)) {
            PHASE_PTRS
            { pg8::Gemm g{XB, (const bf16*)(wl + WO_UP), M, 2 * DFF, D, D, D, 0, 0}; pg8::StaticOrder S; S.init(M, 2 * DFF, G, bx);
              pg8::EpiFfnUp E{(bf16*)R2, P->in[I_CONV] + (size_t)l * 3 * DFF, (float*)(P->ws + WS_HALO), (float*)(P->ws + WS_HALO + HALO_ONE), (float*)(P->ws + WS_HALO + 2 * HALO_ONE), (LAS float*)(lds + LDS_XCH)};
              pg8::gemm_phase<pg8::EpiFfnUp, pg8::StaticOrder, true, true>(lds, g, S, E); }
            { pg8::Gemm g{(const bf16*)(P->ws + WS_PB) + (size_t)l * M * PLE, (const bf16*)(wl + WO_PP), M, D, PLE, PLE, PLE, 0, 0}; pg8::StaticOrder S; S.init(M, D, G, bx);
              pg8::EpiStoreBf16 E{(bf16*)(R2 + R2_PPLE), D};
              pg8::gemm_phase<pg8::EpiStoreBf16, pg8::StaticOrder, true, true>(lds, g, S, E); }
        }
        SEAM(pb + 7);
        REPEAT(8) if (IN(pb + 8)) {
            PHASE_PTRS
            ffn_fixup(P, l);
            pg8::Gemm g{XB, (const bf16*)(wl + WO_PG), M, D, D, D, D, 0, 0}; pg8::StaticOrder S; S.init(M, D, G, bx);
            pg8::EpiPleGate E{(bf16*)(R2 + R2_PPLE)};
            pg8::gemm_phase<pg8::EpiPleGate, pg8::StaticOrder, true, true>(lds, g, S, E);
        }
        SEAM(pb + 8);
        REPEAT(9) if (IN(pb + 9)) {
            PHASE_PTRS
            pg8::Gemm g{(const bf16*)R2, (const bf16*)(wl + WO_DN), M, D, DFF, DFF, DFF, 0, 0}; pg8::StaticOrder S; S.init(M, D, G, bx);
            pg8::EpiResF32 E{XB, (const bf16*)(R2 + R2_PPLE), P->out, ALPHA};
            pg8::gemm_phase<pg8::EpiResF32, pg8::StaticOrder, true, true>(lds, g, S, E);
        }
        SEAM(pb + 9);
        if (IN(pb + 10)) { PHASE_PTRS ln_phase(P->out, P->in[I_LNFW] + l * D, P->in[I_LNFB] + l * D, (l == DEPTH - 1) ? nullptr : XB, (l == DEPTH - 1) ? P->out : nullptr); }
        SEAM(pb + 10);
    }
#undef IN
#undef SEAM
}

extern "C" void kernel_launch(void* const* d_in, const int* in_sizes, int n_in, void* d_out, int out_size, void* d_ws, size_t ws_size, hipStream_t stream) {
    static int grid = 0;
    if (grid == 0) {
        if (n_in != 32 || out_size != M * D || ws_size < WS_END) { fprintf(stderr, "kernel_launch: unexpected shapes (n_in %d, out %d, ws %zu)\n", n_in, out_size, ws_size); grid = -1; return; }
        int dev = 0, cus = 0, per_cu = 0;
        if (hipGetDevice(&dev) != hipSuccess || hipDeviceGetAttribute(&cus, hipDeviceAttributeMultiprocessorCount, dev) != hipSuccess) { grid = -1; return; }
        if (hipFuncSetAttribute((const void*)mega, hipFuncAttributeMaxDynamicSharedMemorySize, LDS_BYTES) != hipSuccess) { fprintf(stderr, "kernel_launch: hipFuncSetAttribute failed\n"); grid = -1; return; }
        if (hipOccupancyMaxActiveBlocksPerMultiprocessor(&per_cu, (const void*)mega, NWAVES * 64, LDS_BYTES) != hipSuccess || per_cu < 1) fprintf(stderr, "kernel_launch: occupancy query reports %d\n", per_cu);
        (void)hipGetLastError();
        grid = cus;
    }
    if (grid < 0) return;
    (void)hipMemsetAsync((char*)d_ws + WS_CTL, 0, CTL_ZERO_BYTES, stream);
    Params p{};
    for (int i = 0; i < 32; ++i) p.in[i] = (const float*)d_in[i];
    p.out = (float*)d_out; p.ws = (unsigned char*)d_ws;
#if ONE_LAUNCH
    p.ph_lo = 0; p.ph_hi = NPH;
    hipLaunchKernelGGL(mega, dim3(grid), dim3(NWAVES * 64), LDS_BYTES, stream, p);
#else
    for (int ph = 0; ph < NPH; ++ph) { p.ph_lo = ph; p.ph_hi = ph + 1; hipLaunchKernelGGL(mega, dim3(grid), dim3(NWAVES * 64), LDS_BYTES, stream, p); }
#endif
}
```

```cpp
#include <hip/hip_runtime.h>
#include <cstdio>
#include <cstdint>
#if defined(__HIP_DEVICE_COMPILE__)
#define NOPK __attribute__((target("no-packed-fp32-ops")))
#else
#define NOPK
#endif

typedef float f32x2g __attribute__((ext_vector_type(2)));
__device__ __forceinline__ NOPK void sync_wg() { __builtin_amdgcn_fence(__ATOMIC_RELEASE, "workgroup"); __builtin_amdgcn_s_barrier(); __builtin_amdgcn_fence(__ATOMIC_ACQUIRE, "workgroup"); }
__device__ __forceinline__ NOPK float u2f(unsigned u) { return __builtin_bit_cast(float, u); }
__device__ __forceinline__ NOPK float shfl_(float v, int src) { return __builtin_bit_cast(float, __builtin_amdgcn_ds_bpermute(src << 2, __builtin_bit_cast(int, v))); }
__device__ __forceinline__ NOPK float shfl_xor_(float v, int m) { const int lane_ = __builtin_amdgcn_mbcnt_hi(~0u, __builtin_amdgcn_mbcnt_lo(~0u, 0u)); return shfl_(v, lane_ ^ m); }
namespace pg8 {
#define PG8_LAS __attribute__((address_space(3)))
typedef unsigned short bf16_t;
typedef short bf16x8 __attribute__((ext_vector_type(8)));
typedef float f32x4 __attribute__((ext_vector_type(4)));
typedef float f32x2 __attribute__((ext_vector_type(2)));
typedef unsigned u32x4 __attribute__((ext_vector_type(4)));
typedef unsigned u32x2 __attribute__((ext_vector_type(2)));
constexpr int BM = 256, BK = 64, HALF = 128, HTB = HALF * BK * 2  , STAGE_BYTES = 8 * HTB, NXCD = 8, WGM = 8;

__host__ __device__ __forceinline__ NOPK int lds_byte(int r, int c) { const int st = (r >> 4) * 2 + (c >> 5), rr = r & 15, cc = c & 31, ob = rr * 64 + cc * 2; return st * 1024 + (ob ^ (((ob >> 9) & 1) << 5)); }
__host__ __device__ __forceinline__ NOPK void stage_rc(int b, int& R, int& C) { const int st = b / 1024, sb = b % 1024, swz = sb ^ (((sb >> 9) & 1) << 5); R = (st >> 1) * 16 + swz / 64; C = (st & 1) * 32 + (swz % 64) / 2; }
__host__ __device__ __forceinline__ NOPK int perm32(int rho) { const int n = rho >> 4, i = rho & 15; return 8 * (i >> 2) + 4 * n + (i & 3); }

struct Unit { int pm, pn; };
struct Gemm { const bf16_t* A; const bf16_t* Bt; int M, N, K, lda, ldb, a_div, a_coloff; };
__device__ __forceinline__ NOPK size_t a_unit_off(const Gemm& g, const Unit& u) { return g.a_div ? (size_t)((u.pn / g.a_div) * g.a_coloff) * 2u : (size_t)0; }

struct StaticOrder {
    int nM, nN, nwg, G, c;
    __host__ __device__ NOPK void init(int M, int N, int G_, int c_) { nM = M / BM; nN = N / BM; nwg = nM * nN; G = G_; c = c_; }
    __host__ __device__ NOPK bool next(int i, Unit& u) const {
        const long L = (long)i * G + c; if (L >= nwg) return false;
        int wgid = (int)L; { const int q = nwg / NXCD, r = nwg % NXCD, xcd = wgid % NXCD, off = wgid / NXCD; wgid = (xcd < r ? xcd * (q + 1) : r * (q + 1) + (xcd - r) * q) + off; }
        const int nig = WGM * nN, gid = wgid / nig, fm = gid * WGM, gsz = (nM - fm) < WGM ? (nM - fm) : WGM;
        u.pm = fm + ((wgid % nig) % gsz); u.pn = (wgid % nig) / gsz; return true;
    }
    __device__ __forceinline__ NOPK void a_ready(const Unit&) const {}
    __device__ __forceinline__ NOPK void done(const Unit&) const {}
};

typedef __bf16 bf16x2_t __attribute__((ext_vector_type(2)));
__device__ __forceinline__ NOPK unsigned cvt_pk_bf16(float lo, float hi) { const f32x2 v = {lo, hi}; const bf16x2_t b = __builtin_convertvector(v, bf16x2_t); return __builtin_bit_cast(unsigned, b); }
__device__ __forceinline__ NOPK float bf_lo(unsigned w) { return u2f(w << 16); }
__device__ __forceinline__ NOPK float bf_hi(unsigned w) { return u2f(w & 0xffff0000u); }
__device__ __forceinline__ NOPK float sigmoid_f(float x) { return __builtin_amdgcn_rcpf(1.0f + __builtin_amdgcn_exp2f(-1.44269504089f * x)); }

template <class Epi, class Sched, bool ALIGN_EPI = false, bool SP2 = false>
__device__ __forceinline__ NOPK void gemm_phase(PG8_LAS unsigned char* lds, const Gemm g, const Sched& S, const Epi& E) {
    int tid_o = threadIdx.x; asm volatile("" : "+v"(tid_o));
    const int tid = tid_o, wid = __builtin_amdgcn_readfirstlane(tid >> 6), lane = tid & 63, wr = wid >> 2, wc = wid & 3, fr = lane & 15, fq = lane >> 4;
    const int K = g.K, nt = K / BK;
    unsigned voffA[2], voffB[2];
#pragma unroll
    for (int i = 0; i < 2; ++i) { int R, C; stage_rc(tid * 16 + i * 8192, R, C); const int Rb = Epi::PERM ? ((R & ~31) + perm32(R & 31)) : R;
        voffA[i] = (unsigned)(R * g.lda + C) * 2u; voffB[i] = (unsigned)(Rb * g.ldb + C) * 2u; }
    const size_t kstep = (size_t)(BK * 2);
    const size_t hstepA = (size_t)HALF * g.lda * 2, hstepB = (size_t)HALF * g.ldb * 2;
    const size_t tstepA = 2 * hstepA, tstepB = 2 * hstepB;
    const unsigned ldsw = (unsigned)wid * 1024u;
    const int aoff = lds_byte(wr * 64 + fr, fq * 8), boff = lds_byte(wc * 32 + fr, fq * 8);
#define PG8_SA(b, h) (((b) * 2 + (h)) * HTB)
#define PG8_SB(b, h) ((4 + (b) * 2 + (h)) * HTB)
#define PG8_STAGE(bufoff, gbase, voff) do { _Pragma("unroll") for (int _i = 0; _i < 2; ++_i) \
        __builtin_amdgcn_global_load_lds((const unsigned*)((const char*)(gbase) + (voff)[_i]), (PG8_LAS unsigned*)(lds + (bufoff) + ldsw + _i * 8192), 16, 0, 0); } while (0)
#define PG8_LDA(dst, b, h) do { _Pragma("unroll") for (int m = 0; m < 4; ++m) _Pragma("unroll") for (int k = 0; k < 2; ++k) dst[m][k] = *(const PG8_LAS bf16x8*)(lds + PG8_SA(b, h) + aoff + m * 2048 + k * 1024); } while (0)
#define PG8_LDB(dst, b, h) do { _Pragma("unroll") for (int n = 0; n < 2; ++n) _Pragma("unroll") for (int k = 0; k < 2; ++k) dst[n][k] = *(const PG8_LAS bf16x8*)(lds + PG8_SB(b, h) + boff + n * 2048 + k * 1024); } while (0)
#define PG8_MMA(ai, bj, At, Bt) do { __builtin_amdgcn_s_setprio(1); _Pragma("unroll") for (int m = 0; m < 4; ++m) _Pragma("unroll") for (int n = 0; n < 2; ++n) _Pragma("unroll") for (int k = 0; k < 2; ++k) \
        acc[ai][bj][m][n] = __builtin_amdgcn_mfma_f32_16x16x32_bf16(Bt[n][k], At[m][k], acc[ai][bj][m][n], 0, 0, 0); __builtin_amdgcn_s_setprio(0); } while (0)
#define PG8_WAIT_V(n) asm volatile("s_waitcnt vmcnt(" #n ")" ::: "memory")
#define PG8_WAIT_L(n) asm volatile("s_waitcnt lgkmcnt(" #n ")" ::: "memory")
#define PG8_BAR __builtin_amdgcn_s_barrier()
#define PG8_SCHED __builtin_amdgcn_sched_barrier(0)
    Unit cur, nxt; int ui = 0;
    if (!S.next(0, cur)) return;
    f32x4 acc[2][2][4][2];
#pragma unroll
    for (int a = 0; a < 2; ++a)
#pragma unroll
        for (int b = 0; b < 2; ++b)
#pragma unroll
            for (int m = 0; m < 4; ++m)
#pragma unroll
                for (int n = 0; n < 2; ++n) acc[a][b][m][n] = (f32x4){0.f, 0.f, 0.f, 0.f};
    bf16x8 At[4][2], B0[2][2], B1[2][2];
    const char* cA = (const char*)g.A + (size_t)cur.pm * tstepA + a_unit_off(g, cur); const char* cB = (const char*)g.Bt + (size_t)cur.pn * tstepB;
    S.a_ready(cur);
    if constexpr (SP2) {
        PG8_STAGE(PG8_SB(0, 0), cB, voffB); PG8_STAGE(PG8_SB(0, 1), cB + hstepB, voffB); PG8_STAGE(PG8_SA(0, 0), cA, voffA); PG8_STAGE(PG8_SA(0, 1), cA + hstepA, voffA);
        if (wr == 1) PG8_BAR;
        PG8_WAIT_V(2); PG8_BAR;
        PG8_STAGE(PG8_SB(1, 0), cB + kstep, voffB); PG8_STAGE(PG8_SA(1, 0), cA + kstep, voffA); PG8_STAGE(PG8_SB(1, 1), cB + hstepB + kstep, voffB);
        PG8_WAIT_V(6); PG8_BAR;
    } else {
        PG8_STAGE(PG8_SB(0, 0), cB, voffB); PG8_STAGE(PG8_SA(0, 0), cA, voffA); PG8_STAGE(PG8_SB(0, 1), cB + hstepB, voffB); PG8_STAGE(PG8_SA(0, 1), cA + hstepA, voffA);
        if (wr == 1) PG8_BAR;
        PG8_WAIT_V(4); PG8_BAR;
        PG8_STAGE(PG8_SB(1, 0), cB + kstep, voffB); PG8_STAGE(PG8_SA(1, 0), cA + kstep, voffA); PG8_STAGE(PG8_SB(1, 1), cB + hstepB + kstep, voffB);
        PG8_WAIT_V(6); PG8_BAR;
    }
    for (;;) {
        const bool has_next = S.next(ui + 1, nxt);
        const char* nA = has_next ? (const char*)g.A + (size_t)nxt.pm * tstepA + a_unit_off(g, nxt) : cA; const char* nB = has_next ? (const char*)g.Bt + (size_t)nxt.pn * tstepB : cB;
        for (int t = 0; t < nt; t += 2) {
            const bool last = (t == nt - 2);
            const char* a1 = cA + (size_t)(t + 1) * kstep;
            const char* a2 = last ? nA : cA + (size_t)(t + 2) * kstep; const char* b2 = last ? nB : cB + (size_t)(t + 2) * kstep;
            const char* a3 = a2 + kstep; const char* b3 = b2 + kstep;
            if (last && has_next) S.a_ready(nxt);
            if constexpr (SP2) {
            PG8_LDB(B0, 0, 0); PG8_LDB(B1, 0, 1); PG8_SCHED; PG8_LDA(At, 0, 0); PG8_STAGE(PG8_SA(1, 1), a1 + hstepA, voffA);
            PG8_WAIT_V(8); PG8_WAIT_L(0); PG8_BAR; PG8_MMA(0, 0, At, B0); PG8_MMA(0, 1, At, B1); PG8_BAR; PG8_SCHED;
            PG8_LDA(At, 0, 1); PG8_STAGE(PG8_SB(0, 0), b2, voffB); PG8_STAGE(PG8_SB(0, 1), b2 + hstepB, voffB); PG8_STAGE(PG8_SA(0, 0), a2, voffA);
            PG8_WAIT_V(8); PG8_WAIT_L(0); PG8_BAR; PG8_MMA(1, 0, At, B0); PG8_MMA(1, 1, At, B1); PG8_BAR; PG8_SCHED;
            PG8_LDB(B0, 1, 0); PG8_LDB(B1, 1, 1); PG8_SCHED; PG8_LDA(At, 1, 0); PG8_STAGE(PG8_SA(0, 1), a2 + hstepA, voffA);
            PG8_WAIT_V(8); PG8_WAIT_L(0); PG8_BAR; PG8_MMA(0, 0, At, B0); PG8_MMA(0, 1, At, B1); PG8_BAR; PG8_SCHED;
            PG8_LDA(At, 1, 1); PG8_STAGE(PG8_SB(1, 0), b3, voffB); PG8_STAGE(PG8_SB(1, 1), b3 + hstepB, voffB); PG8_STAGE(PG8_SA(1, 0), a3, voffA);
            PG8_WAIT_V(8); PG8_WAIT_L(0); PG8_BAR; PG8_MMA(1, 0, At, B0); PG8_MMA(1, 1, At, B1); PG8_BAR; PG8_SCHED;
            } else {
            PG8_LDB(B0, 0, 0); PG8_SCHED; PG8_LDA(At, 0, 0); PG8_STAGE(PG8_SA(1, 1), a1 + hstepA, voffA);
            PG8_WAIT_L(8); PG8_BAR; PG8_WAIT_L(0); PG8_MMA(0, 0, At, B0); PG8_BAR; PG8_SCHED;
            PG8_LDB(B1, 0, 1); PG8_STAGE(PG8_SB(0, 0), b2, voffB);
            PG8_BAR; PG8_WAIT_L(0); PG8_MMA(0, 1, At, B1); PG8_BAR;
            PG8_LDA(At, 0, 1); PG8_STAGE(PG8_SA(0, 0), a2, voffA);
            PG8_BAR; PG8_WAIT_L(0); PG8_MMA(1, 0, At, B0); PG8_BAR; PG8_SCHED;
            PG8_STAGE(PG8_SB(0, 1), b2 + hstepB, voffB);
            PG8_WAIT_V(6); PG8_BAR; PG8_MMA(1, 1, At, B1); PG8_BAR;
            PG8_LDB(B0, 1, 0); PG8_SCHED; PG8_LDA(At, 1, 0); PG8_STAGE(PG8_SA(0, 1), a2 + hstepA, voffA);
            PG8_WAIT_L(8); PG8_BAR; PG8_WAIT_L(0); PG8_MMA(0, 0, At, B0); PG8_BAR; PG8_SCHED;
            PG8_LDB(B1, 1, 1); PG8_STAGE(PG8_SB(1, 0), b3, voffB);
            PG8_BAR; PG8_WAIT_L(0); PG8_MMA(0, 1, At, B1); PG8_BAR;
            PG8_LDA(At, 1, 1); PG8_STAGE(PG8_SA(1, 0), a3, voffA);
            PG8_BAR; PG8_WAIT_L(0); PG8_MMA(1, 0, At, B0); PG8_BAR; PG8_SCHED;
            PG8_STAGE(PG8_SB(1, 1), b3 + hstepB, voffB);
            PG8_WAIT_V(6); PG8_BAR; PG8_MMA(1, 1, At, B1); PG8_BAR;
            }
        }
        if constexpr (ALIGN_EPI) { if (wr == 0) PG8_BAR; }
        if constexpr (!Epi::AFTER_DRAIN) { E(acc, cur, wr, wc, fr, fq); S.done(cur); }
        if (!has_next) break;
#pragma unroll
        for (int a = 0; a < 2; ++a)
#pragma unroll
            for (int b = 0; b < 2; ++b)
#pragma unroll
                for (int m = 0; m < 4; ++m)
#pragma unroll
                    for (int n = 0; n < 2; ++n) acc[a][b][m][n] = (f32x4){0.f, 0.f, 0.f, 0.f};
        cur = nxt; cA = nA; cB = nB; ++ui;
        if constexpr (ALIGN_EPI) { if (wr == 1) PG8_BAR; }
    }
    PG8_WAIT_V(0);
    if constexpr (!ALIGN_EPI) { if (wr == 0) PG8_BAR; }
    PG8_BAR;
    if constexpr (Epi::AFTER_DRAIN) { E.fused(acc, cur, wr, wc, fr, fq, lds, wid, lane); S.done(cur); }
#undef PG8_SA
#undef PG8_SB
#undef PG8_STAGE
#undef PG8_LDA
#undef PG8_LDB
#undef PG8_MMA
#undef PG8_WAIT_V
#undef PG8_WAIT_L
#undef PG8_BAR
#undef PG8_SCHED
}


struct EpiStoreBf16 {
    static constexpr bool PERM = true, AFTER_DRAIN = false;
    bf16_t* O; int ldc;
    __device__ __forceinline__ NOPK void operator()(const f32x4 (&acc)[2][2][4][2], const Unit& u, int wr, int wc, int fr, int fq) const {
        const int row0 = u.pm * BM + wr * 64 + fr, col0 = u.pn * BM + wc * 32 + 8 * fq;
#pragma unroll
        for (int ai = 0; ai < 2; ++ai)
#pragma unroll
            for (int m = 0; m < 4; ++m) { bf16_t* rowp = O + (size_t)(row0 + ai * HALF + m * 16) * ldc + col0;
#pragma unroll
                for (int bj = 0; bj < 2; ++bj) { const f32x4 v0 = acc[ai][bj][m][0], v1 = acc[ai][bj][m][1];
                    u32x4 w; w.x = cvt_pk_bf16(v0[0], v0[1]); w.y = cvt_pk_bf16(v0[2], v0[3]); w.z = cvt_pk_bf16(v1[0], v1[1]); w.w = cvt_pk_bf16(v1[2], v1[3]);
                    *(u32x4*)(rowp + bj * HALF) = w; } }
    }
};
struct EpiPleGate {
    static constexpr bool PERM = true, AFTER_DRAIN = false;
    bf16_t* PP;
    __device__ __forceinline__ NOPK void operator()(const f32x4 (&acc)[2][2][4][2], const Unit& u, int wr, int wc, int fr, int fq) const {
        const int row0 = u.pm * BM + wr * 64 + fr, col0 = u.pn * BM + wc * 32 + 8 * fq;
#pragma unroll
        for (int ai = 0; ai < 2; ++ai)
#pragma unroll
            for (int m = 0; m < 4; ++m) { bf16_t* rowp = PP + (size_t)(row0 + ai * HALF + m * 16) * 1024 + col0;
#pragma unroll
                for (int bj = 0; bj < 2; ++bj) { const f32x4 v0 = acc[ai][bj][m][0], v1 = acc[ai][bj][m][1];
                    const u32x4 p = *(const u32x4*)(rowp + bj * HALF);
                    u32x4 w;
                    w.x = cvt_pk_bf16(sigmoid_f(v0[0]) * bf_lo(p.x), sigmoid_f(v0[1]) * bf_hi(p.x));
                    w.y = cvt_pk_bf16(sigmoid_f(v0[2]) * bf_lo(p.y), sigmoid_f(v0[3]) * bf_hi(p.y));
                    w.z = cvt_pk_bf16(sigmoid_f(v1[0]) * bf_lo(p.z), sigmoid_f(v1[1]) * bf_hi(p.z));
                    w.w = cvt_pk_bf16(sigmoid_f(v1[2]) * bf_lo(p.w), sigmoid_f(v1[3]) * bf_hi(p.w));
                    *(u32x4*)(rowp + bj * HALF) = w; } }
    }
};
struct EpiMerge {
    static constexpr bool PERM = false, AFTER_DRAIN = false;
    const bf16_t* P; bf16_t* MG;
    __device__ __forceinline__ NOPK void operator()(const f32x4 (&acc)[2][2][4][2], const Unit& u, int wr, int wc, int fr, int fq) const {
        const int row0 = u.pm * BM + wr * 64 + fr, oc = u.pn * 64 + wc * 16 + fq * 4;
#pragma unroll
        for (int ai = 0; ai < 2; ++ai)
#pragma unroll
            for (int m = 0; m < 4; ++m) { const size_t row = (size_t)(row0 + ai * HALF + m * 16); const bf16_t* prow = P + row * 4096 + oc;
                f32x4 s = (f32x4){0.f, 0.f, 0.f, 0.f};
#pragma unroll
                for (int b = 0; b < 4; ++b) { const u32x2 pv = *(const u32x2*)(prow + b * 1024); const f32x4 g = acc[ai][b >> 1][m][b & 1];
                    s[0] += sigmoid_f(g[0]) * bf_lo(pv.x); s[1] += sigmoid_f(g[1]) * bf_hi(pv.x); s[2] += sigmoid_f(g[2]) * bf_lo(pv.y); s[3] += sigmoid_f(g[3]) * bf_hi(pv.y); }
                u32x2 w; w.x = cvt_pk_bf16(s[0], s[1]); w.y = cvt_pk_bf16(s[2], s[3]);
                *(u32x2*)(MG + row * 1024 + oc) = w; }
    }
};
struct EpiResF32 {
    static constexpr bool PERM = false, AFTER_DRAIN = false;
    const bf16_t* X; const bf16_t* PLE; float* V; float alpha;
    __device__ __forceinline__ NOPK void operator()(const f32x4 (&acc)[2][2][4][2], const Unit& u, int wr, int wc, int fr, int fq) const {
        const int row0 = u.pm * BM + wr * 64 + fr, col0 = u.pn * BM + wc * 32 + 4 * fq;
#pragma unroll
        for (int ai = 0; ai < 2; ++ai)
#pragma unroll
            for (int m = 0; m < 4; ++m) { const size_t off = (size_t)(row0 + ai * HALF + m * 16) * 1024 + col0;
#pragma unroll
                for (int bj = 0; bj < 2; ++bj)
#pragma unroll
                    for (int n = 0; n < 2; ++n) { const size_t o = off + bj * HALF + n * 16; const u32x2 xv = *(const u32x2*)(X + o);
                        f32x4 r = acc[ai][bj][m][n];
                        r[0] += alpha * bf_lo(xv.x); r[1] += alpha * bf_hi(xv.x); r[2] += alpha * bf_lo(xv.y); r[3] += alpha * bf_hi(xv.y);
                        if (PLE) { const u32x2 pv = *(const u32x2*)(PLE + o); r[0] += bf_lo(pv.x); r[1] += bf_hi(pv.x); r[2] += bf_lo(pv.y); r[3] += bf_hi(pv.y); }
                        *(f32x4*)(V + o) = r; } }
    }
};
__device__ __forceinline__ NOPK float gelu_tanh_f(float x) {
    const float inner = x * (0.7978845608f + 0.0356774081f * x * x);
    return x * __builtin_amdgcn_rcpf(1.0f + __builtin_amdgcn_exp2f(-2.885390082f * inner));
}
struct EpiFfnUp {
    static constexpr bool PERM = false, AFTER_DRAIN = false;
    bf16_t* ACT; const float* conv; float* uhead; float* vhead; float* utail; PG8_LAS float* xch;
    __device__ __forceinline__ NOPK void operator()(const f32x4 (&acc)[2][2][4][2], const Unit& u, int wr, int wc, int fr, int fq) const {
        const int lane = threadIdx.x & 63;
        const int cc0 = wc * 32 + 4 * fq, colg = u.pn * 128 + cc0;
        if (fr >= 14) {
#pragma unroll
            for (int ai = 0; ai < 2; ++ai)
#pragma unroll
                for (int n = 0; n < 2; ++n) *(PG8_LAS f32x4*)(xch + ((2 * ai + wr) * 2 + (fr - 14)) * 128 + cc0 + 16 * n) = acc[ai][0][3][n];
            if (wr == 1) {
#pragma unroll
                for (int n = 0; n < 2; ++n) *(f32x4*)(utail + ((size_t)u.pm * 2 + (fr - 14)) * 2816 + colg + 16 * n) = acc[1][0][3][n];
            }
        }
        if (wr == 0 && fr < 2) {
#pragma unroll
            for (int n = 0; n < 2; ++n) { *(f32x4*)(uhead + ((size_t)u.pm * 2 + fr) * 2816 + colg + 16 * n) = acc[0][0][0][n];
                                          *(f32x4*)(vhead + ((size_t)u.pm * 2 + fr) * 2816 + colg + 16 * n) = acc[0][1][0][n]; }
        }
        asm volatile("s_waitcnt lgkmcnt(0)" ::: "memory"); __builtin_amdgcn_s_barrier(); asm volatile("" ::: "memory");
        f32x4 c0[2], c1[2], c2[2];
#pragma unroll
        for (int n = 0; n < 2; ++n) { c0[n] = *(const f32x4*)(conv + colg + 16 * n); c1[n] = *(const f32x4*)(conv + 2816 + colg + 16 * n); c2[n] = *(const f32x4*)(conv + 2 * 2816 + colg + 16 * n); }
        const int src1 = (lane & 48) | ((fr + 15) & 15), src2 = (lane & 48) | ((fr + 14) & 15);
#pragma unroll
        for (int ai = 0; ai < 2; ++ai)
#pragma unroll
            for (int m = 0; m < 4; ++m) { const size_t row = (size_t)(u.pm * BM + ai * HALF + wr * 64 + m * 16 + fr);
#pragma unroll
                for (int n = 0; n < 2; ++n) {
                    const f32x4 cur = acc[ai][0][m][n];
                    f32x4 e1, e2, r1, r2;
                    if (m > 0) { const f32x4 pg = acc[ai][0][m > 0 ? m - 1 : 0][n];
#pragma unroll
                        for (int j = 0; j < 4; ++j) { e1[j] = shfl_(pg[j], src1); e2[j] = shfl_(pg[j], src2); } }
                    else { const int rb = 2 * ai + wr;
                        if (rb > 0) { const f32x4 x62 = *(const PG8_LAS f32x4*)(xch + ((rb - 1) * 2 + 0) * 128 + cc0 + 16 * n), x63 = *(const PG8_LAS f32x4*)(xch + ((rb - 1) * 2 + 1) * 128 + cc0 + 16 * n);
                            e1 = x63; e2 = (fr == 0) ? x62 : x63; }
                        else { e1 = (f32x4){0.f, 0.f, 0.f, 0.f}; e2 = e1; } }
#pragma unroll
                    for (int j = 0; j < 4; ++j) { r1[j] = shfl_(cur[j], src1); r2[j] = shfl_(cur[j], src2); }
                    const f32x4 p1 = (fr >= 1) ? r1 : e1, p2 = (fr >= 2) ? r2 : e2;
                    const f32x4 cv = c2[n] * cur + c1[n] * p1 + c0[n] * p2;
                    const f32x4 vv = acc[ai][1][m][n];
                    u32x2 w; w.x = cvt_pk_bf16(gelu_tanh_f(cv[0]) * vv[0], gelu_tanh_f(cv[1]) * vv[1]); w.y = cvt_pk_bf16(gelu_tanh_f(cv[2]) * vv[2], gelu_tanh_f(cv[3]) * vv[3]);
                    *(u32x2*)(ACT + row * 2816 + colg + 16 * n) = w; } }
    }
};
}

constexpr int D = 1024, BATCH = 16, SEQ = 2048, DEPTH = 2, M = BATCH * SEQ;
constexpr int NMIX = 3600, NMIXP = 3840, NIN = 7696, DFF = 2816, PLE = 256, NCHUNK = SEQ / 64;
constexpr float ALPHA = 1.41421356237f;
constexpr float LN_EPS = 1e-5f;
constexpr int NWAVES = 8;
#ifndef ONE_LAUNCH
#define ONE_LAUNCH 1
#endif

constexpr size_t MiB = 1u << 20;
constexpr size_t WS_CTL = 0, CTL_ZERO_BYTES = 1 * MiB;
constexpr size_t WS_W = 1 * MiB, W_LAYER = 39 * MiB;
constexpr size_t WO_IN = 0, WO_G = 15 * MiB / 2, WO_B = 31 * MiB / 2, WO_MIX = 35 * MiB / 2, WO_UP = 39 * MiB / 2, WO_DN = 61 * MiB / 2, WO_PG = 36 * MiB, WO_PP = 38 * MiB;
constexpr size_t WS_PB = 79 * MiB;
constexpr size_t WS_XB = 111 * MiB;
constexpr size_t WS_R2 = 175 * MiB;
constexpr size_t R2_PPLE = 176 * MiB;
constexpr size_t WS_ROPE = 431 * MiB;
constexpr size_t WS_HALO = 432 * MiB, HALO_ONE = (size_t)128 * 2 * DFF * 4;
constexpr size_t WS_RST = 442 * MiB;
constexpr size_t WS_END = 444 * MiB;
static_assert(WS_HALO + 3 * HALO_ONE <= WS_END && WS_R2 + 256 * MiB <= WS_ROPE, "ws map");
constexpr int CW_BAR = 4096;

constexpr int LDS_BYTES = 163840;
constexpr int LDS_XCH = 131072;
constexpr int LDS_MISC = 163840 - 256;

#define LAS __attribute__((address_space(3)))
typedef unsigned short bf16;
typedef float f32x4 __attribute__((ext_vector_type(4)));
typedef unsigned v4u __attribute__((ext_vector_type(4)));
typedef unsigned v2u __attribute__((ext_vector_type(2)));
#define LDS_WAIT() asm volatile("s_waitcnt lgkmcnt(0)" ::: "memory")
using pg8::cvt_pk_bf16; using pg8::bf_lo; using pg8::bf_hi; using pg8::sigmoid_f;

#define XB_TMO      128
#define XB_XCNT(j)  (256  + 64 * (j))
#define XB_XSUB(j)  (1280 + 64 * (j))
#define XB_XGEN(j)  (2304 + 64 * (j))
#define XB_TOP      3328
#define XB_TOPGEN   3392
#define XCD_BAR_WORDS 3456
#define XB_SPIN_CAP (1u << 18)
__device__ __forceinline__ NOPK unsigned xb_ld(unsigned* p)              { return __hip_atomic_load(p, __ATOMIC_RELAXED, __HIP_MEMORY_SCOPE_AGENT); }
__device__ __forceinline__ NOPK unsigned xb_add(unsigned* p, unsigned v) { return __hip_atomic_fetch_add(p, v, __ATOMIC_RELAXED, __HIP_MEMORY_SCOPE_AGENT); }
__device__ __forceinline__ NOPK unsigned xb_xcc_id() { return (unsigned)__builtin_amdgcn_s_getreg((3 << 11) | 20) & 0xFu; }
#define XB_SPIN(cond, bar) do { unsigned _sp = 0; while (cond) { __builtin_amdgcn_s_sleep(1); \
    if ((++_sp & 255u) == 0u) { if (xb_ld(&(bar)[XB_TMO])) break; if (_sp > XB_SPIN_CAP) { (void)xb_add(&(bar)[XB_TMO], 1u); break; } } } } while (0)
struct XcdBarrier { unsigned* bar; unsigned x; volatile LAS unsigned* st; };
__device__ __forceinline__ NOPK XcdBarrier xcd_barrier_post(unsigned* bar, volatile LAS unsigned* st) {
    XcdBarrier b; b.bar = bar; b.x = xb_xcc_id(); b.st = st;
    if (threadIdx.x == 0) (void)xb_add(&bar[XB_XCNT(b.x)], 1u);
    return b;
}
__device__ __forceinline__ NOPK void xcd_barrier_complete(unsigned* bar, unsigned x, unsigned& nloc, unsigned& nx) {
    const unsigned G = gridDim.x * gridDim.y * gridDim.z;
    unsigned sum, cnt, mine, sp = 0u;
    for (;;) {
        sum = 0u; cnt = 0u; mine = 0u;
#pragma unroll
        for (unsigned j = 0; j < 16; ++j) { const unsigned c = xb_ld(&bar[XB_XCNT(j)]); sum += c; cnt += (c > 0u) ? 1u : 0u; mine = (j == x) ? c : mine; }
        if (sum == G) break;
        __builtin_amdgcn_s_sleep(1);
        if ((++sp & 255u) == 0u) { if (xb_ld(&bar[XB_TMO])) break; if (sp > XB_SPIN_CAP) { (void)xb_add(&bar[XB_TMO], 1u); break; } }
    }
    nloc = mine > 0u ? mine : 1u; nx = cnt > 0u ? cnt : 1u;
}
__device__ __forceinline__ NOPK void xcd_barrier(const XcdBarrier& b) {
    asm volatile("s_waitcnt vmcnt(0)" ::: "memory");
    sync_wg();
    if (threadIdx.x == 0) {
        unsigned* bar = b.bar;
        __builtin_amdgcn_s_waitcnt(0);
        unsigned nloc = b.st[0], nx = b.st[1];
        if (nloc == 0u) { xcd_barrier_complete(bar, b.x, nloc, nx); b.st[0] = nloc; b.st[1] = nx; }
        const unsigned old = xb_add(&bar[XB_XSUB(b.x)], 1u);
        const unsigned gen = old / nloc;
        if (old + 1u == (gen + 1u) * nloc) {
            __builtin_amdgcn_fence(__ATOMIC_RELEASE, "agent");
            asm volatile("s_waitcnt vmcnt(0)" ::: "memory");
            const unsigned og = xb_add(&bar[XB_TOP], 1u);
            const unsigned tg = og / nx;
            if (og + 1u == (tg + 1u) * nx) xb_add(&bar[XB_TOPGEN], 1u);
            else XB_SPIN(xb_ld(&bar[XB_TOPGEN]) == tg, bar);
            __builtin_amdgcn_fence(__ATOMIC_ACQUIRE, "agent");
            xb_add(&bar[XB_XGEN(b.x)], 1u);
            asm volatile("s_waitcnt vmcnt(0)" ::: "memory");
        } else {
            XB_SPIN(xb_ld(&bar[XB_XGEN(b.x)]) == gen, bar);
            __builtin_amdgcn_fence(__ATOMIC_ACQUIRE, "agent");
            asm volatile("s_waitcnt vmcnt(0)" ::: "memory");
        }
    }
    sync_wg();
}

struct Params {
    const float* in[32];
    float* out; unsigned char* ws;
    int ph_lo, ph_hi;
};
enum { I_X = 0, I_P, I_LNINW, I_LNINB, I_WIN, I_MU, I_W0, I_W2, I_A0, I_A2, I_G2, I_KK, I_KA, I_RK, I_RLNW, I_RLNB, I_GLAW2, I_GLAB, I_GLANW, I_HLB, I_HNW,
       I_WBR, I_WMIX, I_LNMW, I_LNMB, I_WUP, I_CONV, I_WDN, I_WPG, I_WPP, I_LNFW, I_LNFB };

typedef const __attribute__((address_space(4))) Params* KP;
__device__ __forceinline__ NOPK KP kparams() { KP p = (KP)__builtin_amdgcn_kernarg_segment_ptr(); asm volatile("" : "+s"(p)); return p; }
__device__ __forceinline__ NOPK float wave_sum(float v) {
#pragma unroll
    for (int o = 1; o < 64; o <<= 1) v += shfl_xor_(v, o);
    return v;
}
__device__ __forceinline__ NOPK int opaque_tid() { int t = threadIdx.x; asm volatile("" : "+v"(t)); return t; }
__device__ __forceinline__ NOPK float red8(float v) { v += shfl_xor_(v, 1); v += shfl_xor_(v, 2); v += shfl_xor_(v, 4); return v; }

__constant__ double ROPE_THETA[16] = {1.0, 0.5411695265464637, 0.2928644564625237, 0.15848931924611134, 0.08576958985908942, 0.046415888336127795, 0.025118864315095794, 0.013593563908785255, 0.007356422544596414, 0.003981071705534973, 0.0021544346900318843, 0.0011659144011798323, 0.000630957344480193, 0.0003414548873833601, 0.00018478497974222906, 0.0001};
__device__ __forceinline__ NOPK int map_row(int mode, int c) {
    if (mode == 1) { const int b = c >> 10, of = c & 1023, pn = of >> 6, oc = of & 63; return 256 * pn + 128 * (b >> 1) + 32 * (oc >> 4) + 16 * (b & 1) + (oc & 15); }
    if (mode == 2) { return c < DFF ? 256 * (c >> 7) + (c & 127) : 256 * ((c - DFF) >> 7) + 128 + ((c - DFF) & 127); }
    return c;
}
__device__ __forceinline__ NOPK void cvt_item(const float* W, int K, int srcld, int c0, int cnt, bf16* dst, int mode, LAS float* scr, int item, int lane) {
    const int nblk = (cnt + 31) / 32, kb = item / nblk, nb = item % nblk, k0 = 64 * kb, n0 = 32 * nb;
    const bool okr = (n0 + (lane & 31)) < cnt;
    float xin[32];
#pragma unroll
    for (int i = 0; i < 32; ++i) { const int kk = 2 * i + (lane >> 5); xin[i] = okr ? W[(size_t)(k0 + kk) * srcld + c0 + n0 + (lane & 31)] : 0.f; }
#pragma unroll
    for (int i = 0; i < 32; ++i) { const int kk = 2 * i + (lane >> 5); scr[kk * 33 + (lane & 31)] = xin[i]; }
    LDS_WAIT(); asm volatile("" ::: "memory");
    const int c = lane & 7;
#pragma unroll
    for (int j = 0; j < 4; ++j) { const int n = (lane >> 3) + 8 * j; const LAS float* s = scr + (8 * c) * 33 + n;
        v4u o; o.x = cvt_pk_bf16(s[0 * 33], s[1 * 33]); o.y = cvt_pk_bf16(s[2 * 33], s[3 * 33]); o.z = cvt_pk_bf16(s[4 * 33], s[5 * 33]); o.w = cvt_pk_bf16(s[6 * 33], s[7 * 33]);
        if (n0 + n < cnt) *(v4u*)(dst + (size_t)map_row(mode, n0 + n) * K + k0 + 8 * c) = o; }
    LDS_WAIT(); asm volatile("" ::: "memory");
}
struct CvtJob { const float* W; int K, srcld, c0, cnt, mode; bf16* dst; int items; };
__device__ __forceinline__ NOPK CvtJob get_job(KP P, int j) {
    const int l = j / 11, k = j % 11; unsigned char* wl = P->ws + WS_W + (size_t)l * W_LAYER; CvtJob J;
    if (k == 0)      { J.W = P->in[I_WIN] + (size_t)l * D * NIN; J.K = D; J.srcld = NIN; J.c0 = 0; J.cnt = NMIX; J.mode = 0; J.dst = (bf16*)(wl + WO_IN); }
    else if (k == 1) { J.W = P->in[I_WIN] + (size_t)l * D * NIN; J.K = D; J.srcld = NIN; J.c0 = NMIX; J.cnt = 4096; J.mode = 1; J.dst = (bf16*)(wl + WO_G); }
    else if (k < 6)  { const int b = k - 2; J.W = P->in[I_WBR] + (size_t)(l * 4 + b) * 256 * D; J.K = 256; J.srcld = D; J.c0 = 0; J.cnt = D; J.mode = 0; J.dst = (bf16*)(wl + WO_B) + (size_t)b * D * 256; }
    else if (k == 6) { J.W = P->in[I_WMIX] + (size_t)l * D * D; J.K = D; J.srcld = D; J.c0 = 0; J.cnt = D; J.mode = 0; J.dst = (bf16*)(wl + WO_MIX); }
    else if (k == 7) { J.W = P->in[I_WUP] + (size_t)l * D * 2 * DFF; J.K = D; J.srcld = 2 * DFF; J.c0 = 0; J.cnt = 2 * DFF; J.mode = 2; J.dst = (bf16*)(wl + WO_UP); }
    else if (k == 8) { J.W = P->in[I_WDN] + (size_t)l * DFF * D; J.K = DFF; J.srcld = D; J.c0 = 0; J.cnt = D; J.mode = 0; J.dst = (bf16*)(wl + WO_DN); }
    else if (k == 9) { J.W = P->in[I_WPG] + (size_t)l * D * D; J.K = D; J.srcld = D; J.c0 = 0; J.cnt = D; J.mode = 0; J.dst = (bf16*)(wl + WO_PG); }
    else             { J.W = P->in[I_WPP] + (size_t)l * PLE * D; J.K = PLE; J.srcld = D; J.c0 = 0; J.cnt = D; J.mode = 0; J.dst = (bf16*)(wl + WO_PP); }
    J.items = (J.K / 64) * ((J.cnt + 31) / 32);
    return J;
}
__device__ __forceinline__ NOPK void ln_row2(const float* x0, const float* x1, const float* w, const float* b, bf16* o0, bf16* o1, float* f0, float* f1, int lane) {
    const f32x4* xr0 = (const f32x4*)x0 + lane; const f32x4* xr1 = (const f32x4*)x1 + lane;
    f32x4 v0[4], v1[4]; float s0 = 0.f, s1 = 0.f;
#pragma unroll
    for (int j = 0; j < 4; ++j) { v0[j] = xr0[64 * j]; v1[j] = xr1[64 * j]; }
#pragma unroll
    for (int j = 0; j < 4; ++j) { s0 += (v0[j].x + v0[j].y) + (v0[j].z + v0[j].w); s1 += (v1[j].x + v1[j].y) + (v1[j].z + v1[j].w); }
    const float mean0 = wave_sum(s0) * (1.f / D), mean1 = wave_sum(s1) * (1.f / D); float q0 = 0.f, q1 = 0.f;
#pragma unroll
    for (int j = 0; j < 4; ++j) { v0[j] = v0[j] - mean0; v1[j] = v1[j] - mean1; q0 += (v0[j].x * v0[j].x + v0[j].y * v0[j].y) + (v0[j].z * v0[j].z + v0[j].w * v0[j].w); q1 += (v1[j].x * v1[j].x + v1[j].y * v1[j].y) + (v1[j].z * v1[j].z + v1[j].w * v1[j].w); }
    const float rstd0 = 1.f / sqrtf(wave_sum(q0) * (1.f / D) + LN_EPS), rstd1 = 1.f / sqrtf(wave_sum(q1) * (1.f / D) + LN_EPS);
#pragma unroll
    for (int j = 0; j < 4; ++j) { const f32x4 wv = ((const f32x4*)w)[lane + 64 * j], bv = ((const f32x4*)b)[lane + 64 * j]; const f32x4 a0 = v0[j] * rstd0 * wv + bv, a1 = v1[j] * rstd1 * wv + bv;
        if (o0) { v2u pk; pk.x = cvt_pk_bf16(a0.x, a0.y); pk.y = cvt_pk_bf16(a0.z, a0.w); ((v2u*)o0)[lane + 64 * j] = pk; pk.x = cvt_pk_bf16(a1.x, a1.y); pk.y = cvt_pk_bf16(a1.z, a1.w); ((v2u*)o1)[lane + 64 * j] = pk; }
        if (f0) { ((f32x4*)f0)[lane + 64 * j] = a0; ((f32x4*)f1)[lane + 64 * j] = a1; } }
}
__device__ __forceinline__ NOPK void ln_phase(const float* V, const float* w, const float* b, bf16* XB, float* OUTF) {
    const int tid = opaque_tid(), lane = tid & 63, gw = blockIdx.x * NWAVES + (tid >> 6), NGW = gridDim.x * NWAVES;
    for (int m = 2 * gw; m < M; m += 2 * NGW) ln_row2(V + (size_t)m * D, V + (size_t)(m + 1) * D, w, b, XB ? XB + (size_t)m * D : nullptr, XB ? XB + (size_t)(m + 1) * D : nullptr,
                                                   OUTF ? OUTF + (size_t)m * D : nullptr, OUTF ? OUTF + (size_t)(m + 1) * D : nullptr, lane);
}
__device__ __forceinline__ NOPK void prologue(KP P, LAS unsigned char* lds) {
    const int tid = opaque_tid(), lane = tid & 63, wave = __builtin_amdgcn_readfirstlane(tid >> 6);
    LAS float* scr = (LAS float*)(lds + wave * 16384);
    const int gw = blockIdx.x * NWAVES + wave, NGW = gridDim.x * NWAVES;
    const int gt = blockIdx.x * (NWAVES * 64) + tid, NGT = gridDim.x * NWAVES * 64;
    int total = 0;
    for (int j = 0; j < 22; ++j) total += get_job(P, j).items;
    for (int it = gw; it < total; it += NGW) {
        int r = it, j = 0; CvtJob J = get_job(P, 0);
        while (r >= J.items) { r -= J.items; ++j; J = get_job(P, j); }
        cvt_item(J.W, J.K, J.srcld, J.c0, J.cnt, J.dst, J.mode, scr, r, lane);
    }
    for (int l = 0; l < DEPTH; ++l) { v4u* z = (v4u*)((bf16*)(P->ws + WS_W + (size_t)l * W_LAYER + WO_IN) + (size_t)NMIX * D);
        for (int i = gt; i < (NMIXP - NMIX) * D / 8; i += NGT) z[i] = (v4u){0u, 0u, 0u, 0u}; }
    { const f32x4* ps = (const f32x4*)P->in[I_P]; v2u* pd = (v2u*)(P->ws + WS_PB);
        constexpr size_t NP4 = (size_t)DEPTH * M * PLE / 4;
        for (size_t i = gt; i < NP4; i += (size_t)4 * NGT) { f32x4 v[4];
#pragma unroll
            for (int q = 0; q < 4; ++q) if (i + (size_t)q * NGT < NP4) v[q] = ps[i + (size_t)q * NGT];
#pragma unroll
            for (int q = 0; q < 4; ++q) if (i + (size_t)q * NGT < NP4) { v2u o; o.x = cvt_pk_bf16(v[q].x, v[q].y); o.y = cvt_pk_bf16(v[q].z, v[q].w); pd[i + (size_t)q * NGT] = o; } } }
    { f32x2g* rt = (f32x2g*)(P->ws + WS_ROPE);
        for (int i = gt; i < SEQ * 16; i += NGT) { const int t = i >> 4, k = i & 15; const double a = (double)t * ROPE_THETA[k];
            const double n = __builtin_rint(a * 0.15915494309189535); const double r = a - n * 6.283185307179586, r2 = r * r;
            double ts = r, ss = r, tc = 1.0, sc = 1.0;
            for (int q = 1; q <= 14; ++q) { tc *= -r2 / (double)((2 * q - 1) * (2 * q)); sc += tc; ts *= -r2 / (double)((2 * q) * (2 * q + 1)); ss += ts; }
            rt[i] = (f32x2g){(float)sc, (float)ss}; } }
    ln_phase(P->in[I_X], P->in[I_LNINW], P->in[I_LNINB], (bf16*)(P->ws + WS_XB), nullptr);
}

#ifndef REP_PREP
#define REP_PREP 1
#endif
#ifndef REP_REC
#define REP_REC 1
#endif

__device__ __forceinline__ NOPK void ld8(const bf16* p, float (&o)[8]) { const v4u w = *(const v4u*)p; o[0] = bf_lo(w.x); o[1] = bf_hi(w.x); o[2] = bf_lo(w.y); o[3] = bf_hi(w.y); o[4] = bf_lo(w.z); o[5] = bf_hi(w.z); o[6] = bf_lo(w.w); o[7] = bf_hi(w.w); }
__device__ __forceinline__ NOPK void st8(bf16* p, const float (&o)[8]) { v4u w; w.x = cvt_pk_bf16(o[0], o[1]); w.y = cvt_pk_bf16(o[2], o[3]); w.z = cvt_pk_bf16(o[4], o[5]); w.w = cvt_pk_bf16(o[6], o[7]); *(v4u*)p = w; }
__device__ __forceinline__ NOPK float sigmoid_acc(float x) { return __builtin_amdgcn_rcpf(1.0f + __expf(-x)); }
__device__ __forceinline__ NOPK float tanh_fast(float x) { return 2.0f * __builtin_amdgcn_rcpf(1.0f + __expf(-2.0f * x)) - 1.0f; }

template <int MX>
__device__ __forceinline__ NOPK void linattn_task(LAS float* sm, KP P, int layer, int b, int h) {
    constexpr int DK = (MX == 3) ? 64 : 32;
    const int tid = opaque_tid();
    LAS float* sq = sm;
    LAS float* sk = sm + 4096;
    LAS float* seg = sm + 8192;
    LAS float* sv = sm + 12288;
    LAS float* sg = sm + 16384;
    LAS float* so = sm + 20480;
    LAS float* sx = sm + 24576;
    const bf16* Z = (const bf16*)(P->ws + WS_R2);
    bf16* O = (bf16*)P->out;
    const int t8 = tid >> 3, e0 = (tid & 7) * 8;
    float S[DK];
#pragma unroll
    for (int d = 0; d < DK; ++d) S[d] = 0.f;
    float nw[8];
#pragma unroll
    for (int i = 0; i < 8; ++i) nw[i] = (MX == 2) ? P->in[I_GLANW][layer * 64 + e0 + i] : (MX == 3) ? P->in[I_HNW][layer * 64 + e0 + i] : 1.f;
#pragma unroll 1
    for (int c = 0; c < NCHUNK; ++c) {
        const size_t rowbase = (size_t)b * SEQ + c * 64;
        if (MX == 0) {
            const f32x2g* rope = (const f32x2g*)(P->ws + WS_ROPE);
#pragma unroll
            for (int i = 0; i < 2; ++i) { const int idx = tid + 512 * i, t = idx >> 4, pi = idx & 15; const bf16* zr = Z + (rowbase + t) * NMIXP;
                const unsigned qw = *(const unsigned*)(zr + h * 32 + 2 * pi), kw = *(const unsigned*)(zr + 128 + h * 32 + 2 * pi);
                const f32x2g cs = rope[(c * 64 + t) * 16 + pi];
                const float q1 = bf_lo(qw), q2 = bf_hi(qw), k1 = bf_lo(kw) * 0.17677669529663687f, k2 = bf_hi(kw) * 0.17677669529663687f;
                sq[t * DK + 2 * pi] = q1 * cs.x - q2 * cs.y; sq[t * DK + 2 * pi + 1] = q1 * cs.y + q2 * cs.x;
                sk[t * DK + 2 * pi] = k1 * cs.x - k2 * cs.y; sk[t * DK + 2 * pi + 1] = k1 * cs.y + k2 * cs.x; }
            const float gam = 1.0f - exp2f(-5.0f - (float)h);
#pragma unroll
            for (int i = 0; i < 4; ++i) seg[tid + 512 * i] = gam;
            const bf16* zr = Z + (rowbase + t8) * NMIXP; float a[8];
            ld8(zr + 256 + h * 64 + e0, a);
#pragma unroll
            for (int i = 0; i < 8; ++i) sv[t8 * 64 + e0 + i] = a[i];
            ld8(zr + 512 + h * 64 + e0, a);
#pragma unroll
            for (int i = 0; i < 8; ++i) sg[t8 * 64 + e0 + i] = a[i];
        } else if (MX == 2) {
            LAS float* sgl = sx; LAS float* sw2 = sx + 1024; LAS float* sbb = sx + 1536;
            const bf16* zr = Z + (rowbase + t8) * NMIXP + 1792; const int d0 = (tid & 7) * 4;
            { const v2u qw = *(const v2u*)(zr + h * 32 + d0), kw = *(const v2u*)(zr + 128 + h * 32 + d0);
              sq[t8 * DK + d0] = bf_lo(qw.x) * 0.17677669529663687f; sq[t8 * DK + d0 + 1] = bf_hi(qw.x) * 0.17677669529663687f; sq[t8 * DK + d0 + 2] = bf_lo(qw.y) * 0.17677669529663687f; sq[t8 * DK + d0 + 3] = bf_hi(qw.y) * 0.17677669529663687f;
              sk[t8 * DK + d0] = bf_lo(kw.x); sk[t8 * DK + d0 + 1] = bf_hi(kw.x); sk[t8 * DK + d0 + 2] = bf_lo(kw.y); sk[t8 * DK + d0 + 3] = bf_hi(kw.y); }
            float a[8];
            ld8(zr + 256 + h * 64 + e0, a);
#pragma unroll
            for (int i = 0; i < 8; ++i) sv[t8 * 64 + e0 + i] = a[i];
            ld8(zr + 528 + h * 64 + e0, a);
#pragma unroll
            for (int i = 0; i < 8; ++i) sg[t8 * 64 + e0 + i] = a[i];
            if (tid < 128) { const int t = tid >> 1, j0 = (tid & 1) * 8; ld8(Z + (rowbase + t) * NMIXP + 1792 + 512 + j0, a);
#pragma unroll
                for (int i = 0; i < 8; ++i) sgl[t * 16 + j0 + i] = a[i]; }
            sw2[tid] = P->in[I_GLAW2][(size_t)layer * 16 * 128 + (tid >> 5) * 128 + h * 32 + (tid & 31)];
            if (tid < 32) sbb[tid] = P->in[I_GLAB][layer * 128 + h * 32 + tid];
            sync_wg();
#pragma unroll
            for (int i = 0; i < 4; ++i) { const int idx = tid + 512 * i, t = idx >> 5, d = idx & 31; float acc = sbb[d];
#pragma unroll
                for (int j = 0; j < 16; ++j) acc += sgl[t * 16 + j] * sw2[j * 32 + d];
                const float ls = fminf(acc, 0.f) - log1pf(__expf(-fabsf(acc)));
                seg[t * DK + d] = __expf(ls * 0.0625f); }
        } else {
            const bf16* zr = Z + (rowbase + t8) * NMIXP + 2576; float a[8], f[8];
            ld8(zr + h * 64 + e0, a);
#pragma unroll
            for (int i = 0; i < 8; ++i) sq[t8 * DK + e0 + i] = a[i];
            ld8(zr + 256 + h * 64 + e0, f);
#pragma unroll
            for (int i = 0; i < 8; ++i) { float lb = 0.f;
                if (layer > 0) lb = sigmoid_acc(P->in[I_HLB][256 + h * 64 + e0 + i] - P->in[I_HLB][h * 64 + e0 + i]);
                seg[t8 * DK + e0 + i] = lb + (1.f - lb) * sigmoid_acc(f[i]); sk[t8 * DK + e0 + i] = (1.f - lb) * sigmoid_acc(-f[i]); }
            ld8(zr + 512 + h * 64 + e0, a);
#pragma unroll
            for (int i = 0; i < 8; ++i) sv[t8 * 64 + e0 + i] = a[i];
            ld8(zr + 768 + h * 64 + e0, a);
#pragma unroll
            for (int i = 0; i < 8; ++i) sg[t8 * 64 + e0 + i] = a[i];
        }
        sync_wg();
        if (tid < 64) {
#pragma unroll 1
            for (int t = 0; t < 64; ++t) { const float vv = sv[t * 64 + tid]; float o = 0.f;
#pragma unroll
                for (int d = 0; d < DK; ++d) { S[d] = seg[t * DK + d] * S[d] + sk[t * DK + d] * vv; o += sq[t * DK + d] * S[d]; }
                so[t * 64 + tid] = o; }
        }
        sync_wg();
        { float ov[8], y[8]; float s = 0.f;
#pragma unroll
            for (int i = 0; i < 8; ++i) { ov[i] = so[t8 * 64 + e0 + i]; s += (MX == 0) ? ov[i] : ov[i] * ov[i]; }
            s = red8(s);
            if (MX == 0) { const float mean = s * (1.f / 64.f); float q = 0.f;
#pragma unroll
                for (int i = 0; i < 8; ++i) { ov[i] -= mean; q += ov[i] * ov[i]; }
                q = red8(q); const float rs = 1.0f / sqrtf(q * (1.f / 64.f) + 1e-6f);
#pragma unroll
                for (int i = 0; i < 8; ++i) y[i] = ov[i] * rs;
            } else { const float rs = 1.0f / sqrtf(s * (1.f / 64.f) + 1e-6f);
#pragma unroll
                for (int i = 0; i < 8; ++i) y[i] = ov[i] * rs * nw[i]; }
#pragma unroll
            for (int i = 0; i < 8; ++i) { const float gv = sg[t8 * 64 + e0 + i]; y[i] *= gv * sigmoid_acc(gv); }
            st8(O + (rowbase + t8) * D + MX * 256 + h * 64 + e0, y); }
        sync_wg();
    }
}

typedef short bf16x8v __attribute__((ext_vector_type(8)));
#define SWZ(r, c) ((r) * 64 + ((((c) >> 3) ^ ((r) & 7)) << 3) + ((c) & 7))
__device__ __forceinline__ NOPK bf16x8v frag64(const LAS bf16* arr, int row, int ch) { return *(const LAS bf16x8v*)(arr + row * 64 + ((ch ^ (row & 7)) << 3)); }
template <int MX>
__device__ __forceinline__ NOPK void linattn_fast(LAS unsigned char* lds, KP P, int layer, int b, int h) {
    constexpr int DK = (MX == 3) ? 64 : 32, NDT = DK / 16, NKS = DK / 32, QN = DK / 8;
    asm volatile("" : "+s"(h), "+s"(b));
    const int tid = opaque_tid(), lane = tid & 63, wave = __builtin_amdgcn_readfirstlane(tid >> 6), fr = lane & 15, fq = lane >> 4;
    LAS float* slg = (LAS float*)lds;
    LAS bf16* sQ = (LAS bf16*)(lds + 16384); LAS bf16* sK = (LAS bf16*)(lds + 24576); LAS bf16* sKT = (LAS bf16*)(lds + 32768); LAS bf16* sVT = (LAS bf16*)(lds + 40960);
    LAS bf16* sP = (LAS bf16*)(lds + 49152); LAS bf16* sST = (LAS bf16*)(lds + 57344); LAS bf16* sG = (LAS bf16*)(lds + 65536);
    LAS float* sw2 = (LAS float*)(lds + 73728); LAS float* sbb = sw2 + 512;
    const bf16* Z = (const bf16*)(P->ws + WS_R2);
    bf16* O = (bf16*)P->out;
    const int t8 = tid >> 3, e0 = (tid & 7) * 8, dd0 = (tid & 7) * QN;
    constexpr int zbase = (MX == 0) ? 0 : (MX == 2) ? 1792 : 2576;
    constexpr int qcol = 0, kcol = (MX == 3) ? 256 : 128, vcol = (MX == 3) ? 512 : 256, gcol = (MX == 0) ? 512 : (MX == 2) ? 528 : 768;
    const float lgam = (MX == 0) ? logf(1.0f - exp2f(-5.0f - (float)h)) : 0.f;
    sync_wg();
    if (MX == 2) { sw2[tid] = P->in[I_GLAW2][(size_t)layer * 16 * 128 + (tid >> 5) * 128 + h * 32 + (tid & 31)]; if (tid < 32) sbb[tid] = P->in[I_GLAB][layer * 128 + h * 32 + tid]; sync_wg(); }
    float lbv[8];
#pragma unroll
    for (int i = 0; i < 8; ++i) { lbv[i] = 0.f; if (MX == 3 && layer > 0) lbv[i] = sigmoid_acc(P->in[I_HLB][256 + h * 64 + e0 + i] - P->in[I_HLB][h * 64 + e0 + i]); }
    float nw[16];
#pragma unroll
    for (int i = 0; i < 16; ++i) { const int e = 16 * (i >> 2) + 4 * fq + (i & 3); nw[i] = (MX == 2) ? P->in[I_GLANW][layer * 64 + e] : (MX == 3) ? P->in[I_HNW][layer * 64 + e] : 1.f; }
    f32x4 S[NDT];
#pragma unroll
    for (int i = 0; i < NDT; ++i) S[i] = (f32x4){0.f, 0.f, 0.f, 0.f};
#pragma unroll 1
    for (int c = 0; c < NCHUNK; ++c) {
        const size_t rowbase = (size_t)b * SEQ + c * 64;
        const bf16* zr = Z + (rowbase + t8) * NMIXP + zbase;
        float qr[QN], kr[QN];
        { const v4u vw = *(const v4u*)(zr + vcol + h * 64 + e0);
          const unsigned vv[4] = {vw.x, vw.y, vw.z, vw.w};
#pragma unroll
          for (int i = 0; i < 4; ++i) { sVT[SWZ(e0 + 2 * i, t8)] = (bf16)(vv[i] & 0xffffu); sVT[SWZ(e0 + 2 * i + 1, t8)] = (bf16)(vv[i] >> 16); }
          *(LAS v4u*)(sG + SWZ(t8, e0)) = *(const v4u*)(zr + gcol + h * 64 + e0); }
        if (MX == 3) {
            float a[8], f[8]; ld8(zr + qcol + h * 64 + e0, a); ld8(zr + kcol + h * 64 + e0, f);
#pragma unroll
            for (int i = 0; i < 8; ++i) { qr[i] = a[i]; const float ff = lbv[i] + (1.f - lbv[i]) * sigmoid_acc(f[i]); kr[i] = (1.f - lbv[i]) * sigmoid_acc(-f[i]); slg[t8 * 64 + e0 + i] = logf(ff); }
        } else {
            const v2u qw = *(const v2u*)(zr + qcol + h * 32 + dd0), kw = *(const v2u*)(zr + kcol + h * 32 + dd0);
            float q4[4] = {bf_lo(qw.x), bf_hi(qw.x), bf_lo(qw.y), bf_hi(qw.y)}, k4[4] = {bf_lo(kw.x), bf_hi(kw.x), bf_lo(kw.y), bf_hi(kw.y)};
            if (MX == 0) { const f32x2g* rope = (const f32x2g*)(P->ws + WS_ROPE) + (c * 64 + t8) * 16 + (dd0 >> 1);
#pragma unroll
                for (int p2 = 0; p2 < 2; ++p2) { const f32x2g cs = rope[p2]; const float q1 = q4[2 * p2], q2 = q4[2 * p2 + 1], k1 = k4[2 * p2] * 0.17677669529663687f, k2 = k4[2 * p2 + 1] * 0.17677669529663687f;
                    qr[2 * p2] = q1 * cs.x - q2 * cs.y; qr[2 * p2 + 1] = q1 * cs.y + q2 * cs.x; kr[2 * p2] = k1 * cs.x - k2 * cs.y; kr[2 * p2 + 1] = k1 * cs.y + k2 * cs.x; }
            } else { float gl[16]; { float a[8]; ld8(zr + 512, a);
#pragma unroll
                    for (int i = 0; i < 8; ++i) gl[i] = a[i];
                    ld8(zr + 520, a);
#pragma unroll
                    for (int i = 0; i < 8; ++i) gl[8 + i] = a[i]; }
#pragma unroll
                for (int i = 0; i < 4; ++i) { qr[i] = q4[i] * 0.17677669529663687f; kr[i] = k4[i]; float acc = sbb[dd0 + i];
#pragma unroll
                    for (int j = 0; j < 16; ++j) acc += gl[j] * sw2[j * 32 + dd0 + i];
                    slg[t8 * 64 + dd0 + i] = (fminf(acc, 0.f) - log1pf(__expf(-fabsf(acc)))) * 0.0625f; } }
        }
        if (MX != 0) {
            sync_wg();
            if (tid < DK) { float run = 0.f;
#pragma unroll 1
                for (int tb = 0; tb < 64; tb += 16) { float x[16];
#pragma unroll
                    for (int i = 0; i < 16; ++i) x[i] = slg[(tb + i) * 64 + tid];
#pragma unroll
                    for (int i = 0; i < 16; ++i) { run += x[i]; x[i] = run; }
#pragma unroll
                    for (int i = 0; i < 16; ++i) slg[(tb + i) * 64 + tid] = x[i]; } }
            sync_wg();
        }
        { float qs[QN], ks[QN];
#pragma unroll
          for (int i = 0; i < QN; ++i) { float dq;
              if (MX == 0) dq = (float)(t8 - 31) * lgam; else dq = slg[t8 * 64 + dd0 + i] - slg[31 * 64 + dd0 + i];
              qs[i] = qr[i] * __expf(dq); ks[i] = kr[i] * __expf(-dq); }
          if (QN == 8) { v4u o; o.x = cvt_pk_bf16(qs[0], qs[1]); o.y = cvt_pk_bf16(qs[2], qs[3]); o.z = cvt_pk_bf16(qs[4], qs[5]); o.w = cvt_pk_bf16(qs[6], qs[7]); *(LAS v4u*)(sQ + SWZ(t8, dd0)) = o;
                         v4u p; p.x = cvt_pk_bf16(ks[0], ks[1]); p.y = cvt_pk_bf16(ks[2], ks[3]); p.z = cvt_pk_bf16(ks[4], ks[5]); p.w = cvt_pk_bf16(ks[6], ks[7]); *(LAS v4u*)(sK + SWZ(t8, dd0)) = p; }
          else { v2u o; o.x = cvt_pk_bf16(qs[0], qs[1]); o.y = cvt_pk_bf16(qs[2], qs[3]); *(LAS v2u*)(sQ + SWZ(t8, dd0)) = o;
                 v2u p; p.x = cvt_pk_bf16(ks[0], ks[1]); p.y = cvt_pk_bf16(ks[2], ks[3]); *(LAS v2u*)(sK + SWZ(t8, dd0)) = p; }
#pragma unroll
          for (int i = 0; i < QN; i += 2) { const unsigned w = cvt_pk_bf16(ks[i], ks[i + 1]); sKT[SWZ(dd0 + i, t8)] = (bf16)(w & 0xffffu); sKT[SWZ(dd0 + i + 1, t8)] = (bf16)(w >> 16); } }
        sync_wg();
        bf16x8v bq[NKS];
        if (wave < 4) {
            const int t = 16 * wave + fr;
#pragma unroll
            for (int ks = 0; ks < NKS; ++ks) bq[ks] = frag64(sQ, t, 4 * ks + fq);
#pragma unroll
            for (int j = 0; j < 4; ++j) { f32x4 acc = (f32x4){0.f, 0.f, 0.f, 0.f};
                if (j <= wave) {
#pragma unroll
                    for (int ks = 0; ks < NKS; ++ks) acc = __builtin_amdgcn_mfma_f32_16x16x32_bf16(frag64(sK, 16 * j + fr, 4 * ks + fq), bq[ks], acc, 0, 0, 0); }
                float pv[4];
#pragma unroll
                for (int rg = 0; rg < 4; ++rg) pv[rg] = (j < wave || (j == wave && 4 * fq + rg <= fr)) ? acc[rg] : 0.f;
                v2u o; o.x = cvt_pk_bf16(pv[0], pv[1]); o.y = cvt_pk_bf16(pv[2], pv[3]);
                *(LAS v2u*)(sP + t * 64 + (((2 * j + (fq >> 1)) ^ (t & 7)) << 3) + 4 * (fq & 1)) = o; }
        } else {
            const int e = 16 * (wave - 4) + fr;
#pragma unroll
            for (int i = 0; i < NDT; ++i) { float sc[4];
#pragma unroll
                for (int rg = 0; rg < 4; ++rg) sc[rg] = (MX == 0) ? __expf(32.f * lgam) : __expf(slg[31 * 64 + 16 * i + 4 * fq + rg]);
                v2u o; o.x = cvt_pk_bf16(S[i][0] * sc[0], S[i][1] * sc[1]); o.y = cvt_pk_bf16(S[i][2] * sc[2], S[i][3] * sc[3]);
                *(LAS v2u*)(sST + e * 64 + (((2 * i + (fq >> 1)) ^ (e & 7)) << 3) + 4 * (fq & 1)) = o; }
        }
        sync_wg();
        if (wave < 4) {
            const int t = 16 * wave + fr;
            bf16x8v bp[2];
#pragma unroll
            for (int ks = 0; ks < 2; ++ks) bp[ks] = frag64(sP, t, 4 * ks + fq);
            f32x4 oacc[4];
#pragma unroll
            for (int i = 0; i < 4; ++i) { f32x4 acc = (f32x4){0.f, 0.f, 0.f, 0.f};
                acc = __builtin_amdgcn_mfma_f32_16x16x32_bf16(frag64(sVT, 16 * i + fr, fq), bp[0], acc, 0, 0, 0);
                if (wave >= 2) acc = __builtin_amdgcn_mfma_f32_16x16x32_bf16(frag64(sVT, 16 * i + fr, 4 + fq), bp[1], acc, 0, 0, 0);
#pragma unroll
                for (int ks = 0; ks < NKS; ++ks) acc = __builtin_amdgcn_mfma_f32_16x16x32_bf16(frag64(sST, 16 * i + fr, 4 * ks + fq), bq[ks], acc, 0, 0, 0);
                oacc[i] = acc; }
            float s1 = 0.f;
#pragma unroll
            for (int i = 0; i < 4; ++i)
#pragma unroll
                for (int rg = 0; rg < 4; ++rg) s1 += (MX == 0) ? oacc[i][rg] : oacc[i][rg] * oacc[i][rg];
            s1 += shfl_xor_(s1, 16); s1 += shfl_xor_(s1, 32);
            float rs;
            if (MX == 0) { const float mean = s1 * (1.f / 64.f); float q2 = 0.f;
#pragma unroll
                for (int i = 0; i < 4; ++i)
#pragma unroll
                    for (int rg = 0; rg < 4; ++rg) { oacc[i][rg] -= mean; q2 += oacc[i][rg] * oacc[i][rg]; }
                q2 += shfl_xor_(q2, 16); q2 += shfl_xor_(q2, 32); rs = 1.0f / sqrtf(q2 * (1.f / 64.f) + 1e-6f);
            } else rs = 1.0f / sqrtf(s1 * (1.f / 64.f) + 1e-6f);
#pragma unroll
            for (int i = 0; i < 4; ++i) { const v2u gw = *(const LAS v2u*)(sG + t * 64 + (((2 * i + (fq >> 1)) ^ (t & 7)) << 3) + 4 * (fq & 1));
                const float g4[4] = {bf_lo(gw.x), bf_hi(gw.x), bf_lo(gw.y), bf_hi(gw.y)}; float y[4];
#pragma unroll
                for (int rg = 0; rg < 4; ++rg) y[rg] = oacc[i][rg] * rs * nw[4 * i + rg] * g4[rg] * sigmoid_acc(g4[rg]);
                v2u o; o.x = cvt_pk_bf16(y[0], y[1]); o.y = cvt_pk_bf16(y[2], y[3]);
                *(v2u*)(O + (rowbase + t) * D + MX * 256 + h * 64 + 16 * i + 4 * fq) = o; }
        } else {
            const int e = 16 * (wave - 4) + fr;
            bf16x8v bv[2];
#pragma unroll
            for (int ks = 0; ks < 2; ++ks) bv[ks] = frag64(sVT, e, 4 * ks + fq);
#pragma unroll
            for (int i = 0; i < NDT; ++i) { f32x4 acc = (f32x4){0.f, 0.f, 0.f, 0.f};
#pragma unroll
                for (int ks = 0; ks < 2; ++ks) acc = __builtin_amdgcn_mfma_f32_16x16x32_bf16(frag64(sKT, 16 * i + fr, 4 * ks + fq), bv[ks], acc, 0, 0, 0);
#pragma unroll
                for (int rg = 0; rg < 4; ++rg) { float el, er;
                    if (MX == 0) { el = __expf(64.f * lgam); er = __expf(32.f * lgam); }
                    else { const float bl = slg[63 * 64 + 16 * i + 4 * fq + rg], br = slg[31 * 64 + 16 * i + 4 * fq + rg]; el = __expf(bl); er = __expf(bl - br); }
                    S[i][rg] = el * S[i][rg] + er * acc[rg]; } }
        }
        sync_wg();
    }
}

__device__ __forceinline__ NOPK float dpp_f(float x, const int ctrl_sel) {
    const int xi = __builtin_bit_cast(int, x); int r;
    if (ctrl_sel == 0) r = __builtin_amdgcn_update_dpp(0, xi, 0xB1, 0xf, 0xf, true);
    else if (ctrl_sel == 1) r = __builtin_amdgcn_update_dpp(0, xi, 0x4E, 0xf, 0xf, true);
    else if (ctrl_sel == 2) r = __builtin_amdgcn_update_dpp(0, xi, 0x141, 0xf, 0xf, true);
    else r = __builtin_amdgcn_update_dpp(0, xi, 0x140, 0xf, 0xf, true);
    return __builtin_bit_cast(float, r);
}
__device__ __forceinline__ NOPK float sum16_dpp(float v) { v += dpp_f(v, 0); v += dpp_f(v, 1); v += dpp_f(v, 2); v += dpp_f(v, 3); return v; }
#define DPP_SUM16_2(a_, b_) asm volatile( \
    "s_nop 1\n\t" \
    "v_add_f32_dpp %0, %0, %0 quad_perm:[1,0,3,2] row_mask:0xf bank_mask:0xf bound_ctrl:1\n\t" \
    "v_add_f32_dpp %1, %1, %1 quad_perm:[1,0,3,2] row_mask:0xf bank_mask:0xf bound_ctrl:1\n\t" \
    "s_nop 0\n\t" \
    "v_add_f32_dpp %0, %0, %0 quad_perm:[2,3,0,1] row_mask:0xf bank_mask:0xf bound_ctrl:1\n\t" \
    "v_add_f32_dpp %1, %1, %1 quad_perm:[2,3,0,1] row_mask:0xf bank_mask:0xf bound_ctrl:1\n\t" \
    "s_nop 0\n\t" \
    "v_add_f32_dpp %0, %0, %0 row_half_mirror row_mask:0xf bank_mask:0xf bound_ctrl:1\n\t" \
    "v_add_f32_dpp %1, %1, %1 row_half_mirror row_mask:0xf bank_mask:0xf bound_ctrl:1\n\t" \
    "s_nop 0\n\t" \
    "v_add_f32_dpp %0, %0, %0 row_mirror row_mask:0xf bank_mask:0xf bound_ctrl:1\n\t" \
    "v_add_f32_dpp %1, %1, %1 row_mirror row_mask:0xf bank_mask:0xf bound_ctrl:1\n\t" \
    : "+v"(a_), "+v"(b_));
__device__ __forceinline__ NOPK float sum8_dpp(float v) { v += dpp_f(v, 0); v += dpp_f(v, 1); v += dpp_f(v, 2); return v; }

__device__ __forceinline__ NOPK void rwkv_task(LAS unsigned char* lds, KP P, int layer, int b, int h, int half) {
    asm volatile("" : "+s"(h), "+s"(b), "+s"(half));
    const int tid = opaque_tid(), lane = tid & 63, wave = __builtin_amdgcn_readfirstlane(tid >> 6);
    LAS float* sr = (LAS float*)lds; LAS float* skm = sr + 4096; LAS float* sw = sr + 8192; LAS float* ska = sr + 12288; LAS float* sv = sr + 16384;
    LAS float* skk = sr + 20480; LAS float* sy = sr + 24576;
    LAS bf16* tw = (LAS bf16*)(lds + 81920); LAS bf16* ta = (LAS bf16*)(lds + 90112); LAS bf16* tg = (LAS bf16*)(lds + 98304);
    LAS bf16* w2T = (LAS bf16*)(lds + 114688); LAS bf16* a2T = (LAS bf16*)(lds + 122880); LAS bf16* g2T = (LAS bf16*)(lds + 131072);
    LAS float* sbon = (LAS float*)(lds + 147456);
    LAS float* smu = (LAS float*)(lds + 147712);
    LAS float* spar = smu + 448;
    const bf16* Z = (const bf16*)(P->ws + WS_R2);
    bf16* O = (bf16*)P->out;
    const int t8 = tid >> 3, e0 = (tid & 7) * 8, colh = h * 64;
    sync_wg();
    if (tid < 448) { const int seg = tid >> 6, j = tid & 63; const int col = (seg < 3) ? seg * 256 + colh + j : 768 + (seg - 3) * 64 + j; smu[tid] = P->in[I_MU][layer * 1024 + col]; }
    if (tid < 320) { const int seg = tid >> 6, j = tid & 63; const float* src = (seg == 0) ? P->in[I_KK] + layer * 256 + colh : (seg == 1) ? P->in[I_KA] + layer * 256 + colh : (seg == 2) ? P->in[I_RK] + (layer * 4 + h) * 64
                                                                             : (seg == 3) ? P->in[I_RLNW] + layer * 256 + colh : P->in[I_RLNB] + layer * 256 + colh; spar[tid] = src[j]; }
    sync_wg();
    { const int cc = tid & 63, jb = tid >> 6;
      const float* w2 = P->in[I_W2] + (size_t)layer * 64 * 256 + colh + cc; const float* a2 = P->in[I_A2] + (size_t)layer * 64 * 256 + colh + cc; const float* g2 = P->in[I_G2] + (size_t)layer * 128 * 256 + colh + cc;
      float x[8];
#pragma unroll
      for (int i = 0; i < 8; ++i) x[i] = w2[(8 * jb + i) * 256];
      { v4u o; o.x = cvt_pk_bf16(x[0], x[1]); o.y = cvt_pk_bf16(x[2], x[3]); o.z = cvt_pk_bf16(x[4], x[5]); o.w = cvt_pk_bf16(x[6], x[7]); *(LAS v4u*)(w2T + cc * 64 + ((jb ^ (cc & 7)) << 3)) = o; }
#pragma unroll
      for (int i = 0; i < 8; ++i) x[i] = a2[(8 * jb + i) * 256];
      { v4u o; o.x = cvt_pk_bf16(x[0], x[1]); o.y = cvt_pk_bf16(x[2], x[3]); o.z = cvt_pk_bf16(x[4], x[5]); o.w = cvt_pk_bf16(x[6], x[7]); *(LAS v4u*)(a2T + cc * 64 + ((jb ^ (cc & 7)) << 3)) = o; }
#pragma unroll
      for (int hh = 0; hh < 2; ++hh) { const int ch = jb + 8 * hh;
#pragma unroll
          for (int i = 0; i < 8; ++i) x[i] = g2[(8 * ch + i) * 256];
          v4u o; o.x = cvt_pk_bf16(x[0], x[1]); o.y = cvt_pk_bf16(x[2], x[3]); o.z = cvt_pk_bf16(x[4], x[5]); o.w = cvt_pk_bf16(x[6], x[7]); *(LAS v4u*)(g2T + cc * 128 + ((ch ^ (cc & 7)) << 3)) = o; } }
    const int ti = wave & 3, ci0 = 2 * (wave >> 2), fr = lane & 15, fq = lane >> 4;
    float w0v[2], a0v[2];
#pragma unroll
    for (int q = 0; q < 2; ++q) { w0v[q] = P->in[I_W0][layer * 256 + colh + 16 * (ci0 + q) + fr]; a0v[q] = P->in[I_A0][layer * 256 + colh + 16 * (ci0 + q) + fr]; }
    const int kq = lane & 15, vrow = 32 * half + 2 * (4 * (wave & 3) + (lane >> 4));
    typedef float f32x2 __attribute__((ext_vector_type(2)));
    v4u R[7];
#define RWKV_LOAD(cc_, dst_, back_) { const bf16* zr_ = Z + ((size_t)b * SEQ + (cc_) * 64 + t8) * NMIXP + 768; const bf16* zp_ = ((back_) && !((cc_) == 0 && t8 == 0)) ? zr_ - NMIXP : zr_; \
        const int cols_[7] = {colh + e0, 256 + colh + e0, 512 + colh + e0, 768 + e0, 832 + e0, 896 + e0, 960 + e0}; \
        _Pragma("unroll") for (int q_ = 0; q_ < 7; ++q_) dst_[q_] = *(const v4u*)(zp_ + cols_[q_]); }
    RWKV_LOAD(0, R, 0)
    v4u Rp[7]; RWKV_LOAD(0, Rp, 1)
    f32x2 S2[4];
#pragma unroll
    for (int k = 0; k < 4; ++k) S2[k] = (f32x2){0.f, 0.f};
#pragma unroll 1
    for (int c = 0; c < NCHUNK; ++c) {
        const size_t rowbase = (size_t)b * SEQ + c * 64;
        f32x4 gacc[2];
        for (int rp_ = 0; rp_ < REP_PREP; ++rp_) {
        { const bool first = (c == 0 && t8 == 0);
          float a[8], p[8], z[8];
#define UNPK(vv_, o_) { const v4u u_ = vv_; o_[0] = bf_lo(u_.x); o_[1] = bf_hi(u_.x); o_[2] = bf_lo(u_.y); o_[3] = bf_hi(u_.y); o_[4] = bf_lo(u_.z); o_[5] = bf_hi(u_.z); o_[6] = bf_lo(u_.w); o_[7] = bf_hi(u_.w); }
#define SHIFTED(idx, col) { UNPK(R[idx], a) UNPK(Rp[idx], p) _Pragma("unroll") for (int i = 0; i < 8; ++i) { const float pv = first ? 0.f : p[i]; z[i] = a[i] + (pv - a[i]) * smu[(idx) * 64 + e0 + i]; } }
          SHIFTED(0, colh + e0)
#pragma unroll
          for (int i = 0; i < 8; ++i) sr[t8 * 64 + e0 + i] = z[i];
          SHIFTED(1, 256 + colh + e0)
#pragma unroll
          for (int i = 0; i < 8; ++i) skm[t8 * 64 + e0 + i] = z[i];
          SHIFTED(2, 512 + colh + e0)
#pragma unroll
          for (int i = 0; i < 8; ++i) sv[t8 * 64 + e0 + i] = z[i];
          const int sw8 = ((tid & 7) ^ (t8 & 7)) << 3;
          SHIFTED(3, 768 + e0)
          { v4u o; o.x = cvt_pk_bf16(tanh_fast(z[0]), tanh_fast(z[1])); o.y = cvt_pk_bf16(tanh_fast(z[2]), tanh_fast(z[3])); o.z = cvt_pk_bf16(tanh_fast(z[4]), tanh_fast(z[5])); o.w = cvt_pk_bf16(tanh_fast(z[6]), tanh_fast(z[7])); *(LAS v4u*)(tw + t8 * 64 + sw8) = o; }
          SHIFTED(4, 832 + e0)
          { v4u o; o.x = cvt_pk_bf16(z[0], z[1]); o.y = cvt_pk_bf16(z[2], z[3]); o.z = cvt_pk_bf16(z[4], z[5]); o.w = cvt_pk_bf16(z[6], z[7]); *(LAS v4u*)(ta + t8 * 64 + sw8) = o; }
          SHIFTED(5, 896 + e0)
          { v4u o; o.x = cvt_pk_bf16(sigmoid_acc(z[0]), sigmoid_acc(z[1])); o.y = cvt_pk_bf16(sigmoid_acc(z[2]), sigmoid_acc(z[3])); o.z = cvt_pk_bf16(sigmoid_acc(z[4]), sigmoid_acc(z[5])); o.w = cvt_pk_bf16(sigmoid_acc(z[6]), sigmoid_acc(z[7])); *(LAS v4u*)(tg + t8 * 128 + sw8) = o; }
          SHIFTED(6, 960 + e0)
          { v4u o; o.x = cvt_pk_bf16(sigmoid_acc(z[0]), sigmoid_acc(z[1])); o.y = cvt_pk_bf16(sigmoid_acc(z[2]), sigmoid_acc(z[3])); o.z = cvt_pk_bf16(sigmoid_acc(z[4]), sigmoid_acc(z[5])); o.w = cvt_pk_bf16(sigmoid_acc(z[6]), sigmoid_acc(z[7])); *(LAS v4u*)(tg + t8 * 128 + 64 + sw8) = o; }
#undef UNPK
#undef SHIFTED
        }
        sync_wg();
        { const int ar = 16 * ti + fr;
          f32x4 wacc[2], aacc[2];
#pragma unroll
          for (int q = 0; q < 2; ++q) { wacc[q] = (f32x4){0.f, 0.f, 0.f, 0.f}; aacc[q] = wacc[q]; gacc[q] = wacc[q]; }
#pragma unroll
          for (int ks = 0; ks < 2; ++ks) { const int ch = ks * 4 + fq;
              const bf16x8v Aw = *(const LAS bf16x8v*)(tw + ar * 64 + ((ch ^ (ar & 7)) << 3)), Aa = *(const LAS bf16x8v*)(ta + ar * 64 + ((ch ^ (ar & 7)) << 3));
#pragma unroll
              for (int q = 0; q < 2; ++q) { const int br = 16 * (ci0 + q) + fr;
                  const bf16x8v Bw = *(const LAS bf16x8v*)(w2T + br * 64 + ((ch ^ (br & 7)) << 3)), Ba = *(const LAS bf16x8v*)(a2T + br * 64 + ((ch ^ (br & 7)) << 3));
                  wacc[q] = __builtin_amdgcn_mfma_f32_16x16x32_bf16(Aw, Bw, wacc[q], 0, 0, 0); aacc[q] = __builtin_amdgcn_mfma_f32_16x16x32_bf16(Aa, Ba, aacc[q], 0, 0, 0); } }
#pragma unroll
          for (int ks = 0; ks < 4; ++ks) { const int ch = ks * 4 + fq;
              const bf16x8v Ag = *(const LAS bf16x8v*)(tg + ar * 128 + ((ch ^ (ar & 7)) << 3));
#pragma unroll
              for (int q = 0; q < 2; ++q) { const int br = 16 * (ci0 + q) + fr;
                  const bf16x8v Bg = *(const LAS bf16x8v*)(g2T + br * 128 + ((ch ^ (br & 7)) << 3));
                  gacc[q] = __builtin_amdgcn_mfma_f32_16x16x32_bf16(Ag, Bg, gacc[q], 0, 0, 0); } }
#pragma unroll
          for (int q = 0; q < 2; ++q)
#pragma unroll
              for (int rg = 0; rg < 4; ++rg) { const int t = 16 * ti + 4 * fq + rg, cc = 16 * (ci0 + q) + fr;
                  sw[t * 64 + cc] = __expf(-0.6065306597126334f * sigmoid_acc(w0v[q] + wacc[q][rg])); ska[t * 64 + cc] = sigmoid_acc(a0v[q] + aacc[q][rg]); } }
        sync_wg();
        }
        { float ss = 0.f, bon = 0.f; float kk[8], av[8];
#pragma unroll
            for (int i = 0; i < 8; ++i) { const int cc = e0 + i; const float kv = skm[t8 * 64 + cc]; av[i] = ska[t8 * 64 + cc];
                kk[i] = kv * spar[cc]; ss += kk[i] * kk[i];
                const float km = kv * (1.f + (av[i] - 1.f) * spar[64 + cc]); skm[t8 * 64 + cc] = km;
                bon += sr[t8 * 64 + cc] * km * spar[128 + cc]; }
            ss = red8(ss); bon = red8(bon); const float inv = 1.0f / sqrtf(ss + 1e-12f);
#pragma unroll
            for (int i = 0; i < 8; ++i) { const float kn = kk[i] * inv; skk[t8 * 64 + e0 + i] = kn; ska[t8 * 64 + e0 + i] = kn * av[i]; }
            if ((tid & 7) == 0) sbon[t8] = bon; }
        sync_wg();
        if (c + 1 < NCHUNK) RWKV_LOAD(c + 1, R, 0)
        if (wave < 4) { const LAS f32x4* pw = (const LAS f32x4*)(sw + 4 * kq); const LAS f32x4* pkk = (const LAS f32x4*)(skk + 4 * kq); const LAS f32x4* pka = (const LAS f32x4*)(ska + 4 * kq);
          const LAS f32x4* pkm = (const LAS f32x4*)(skm + 4 * kq); const LAS f32x4* pr = (const LAS f32x4*)(sr + 4 * kq); const LAS f32x2* pv = (const LAS f32x2*)(sv + vrow);
          f32x2 Ssave[4] = {S2[0], S2[1], S2[2], S2[3]};
          for (int rr_ = 0; rr_ < REP_REC; ++rr_) { S2[0] = Ssave[0]; S2[1] = Ssave[1]; S2[2] = Ssave[2]; S2[3] = Ssave[3];
          f32x4 wA = pw[0], kA = pkk[0], aA = pka[0], mA = pkm[0], rA = pr[0]; f32x2 vA = pv[0];
          f32x4 wB, kB, aB, mB, rB; f32x2 vB;
#define RWKV_STEP(tcur, tn, wX, kX, aX, mX, rX, vX, wY, kY, aY, mY, rY, vY) { \
              wY = pw[(tn) * 16]; kY = pkk[(tn) * 16]; aY = pka[(tn) * 16]; mY = pkm[(tn) * 16]; rY = pr[(tn) * 16]; vY = pv[(tn) * 32]; \
              f32x2 sa = S2[0] * kX.x; sa = S2[1] * kX.y + sa; sa = S2[2] * kX.z + sa; sa = S2[3] * kX.w + sa; \
              const f32x2 tm0 = S2[0] * wX.x + vX * mX.x, tm1 = S2[1] * wX.y + vX * mX.y, tm2 = S2[2] * wX.z + vX * mX.z, tm3 = S2[3] * wX.w + vX * mX.w; \
              float s0 = sa.x, s1 = sa.y; DPP_SUM16_2(s0, s1) \
              const f32x2 sar = (f32x2){s0, s1}; \
              S2[0] = tm0 - sar * aX.x; S2[1] = tm1 - sar * aX.y; S2[2] = tm2 - sar * aX.z; S2[3] = tm3 - sar * aX.w; \
              f32x2 yy = S2[0] * rX.x; yy = S2[1] * rX.y + yy; yy = S2[2] * rX.z + yy; yy = S2[3] * rX.w + yy; \
              float y0 = yy.x, y1 = yy.y; DPP_SUM16_2(y0, y1) \
              if (kq == 0) *(LAS f32x2*)(sy + (tcur) * 64 + vrow) = (f32x2){y0, y1}; }
#pragma unroll 1
          for (int t = 0; t < 64; t += 2) {
              RWKV_STEP(t, t + 1, wA, kA, aA, mA, rA, vA, wB, kB, aB, mB, rB, vB)
              RWKV_STEP(t + 1, (t + 2) & 63, wB, kB, aB, mB, rB, vB, wA, kA, aA, mA, rA, vA) }
#undef RWKV_STEP
          } }
        sync_wg();
        if (c + 1 < NCHUNK) RWKV_LOAD(c + 1, Rp, 1)
#pragma unroll
        for (int q = 0; q < 2; ++q)
#pragma unroll
            for (int rg = 0; rg < 4; ++rg) skk[(16 * ti + 4 * fq + rg) * 64 + 16 * (ci0 + q) + fr] = gacc[q][rg];
        sync_wg();
        { const int c4 = 32 * half + (tid & 7) * 4; float yv[4]; float s = 0.f;
#pragma unroll
            for (int i = 0; i < 4; ++i) { yv[i] = sy[t8 * 64 + c4 + i]; s += yv[i]; }
            s = red8(s); const float mean = s * (1.f / 32.f); float q = 0.f;
#pragma unroll
            for (int i = 0; i < 4; ++i) { const float d = yv[i] - mean; q += d * d; }
            q = red8(q); const float bon = sbon[t8];
            const size_t off = (rowbase + t8) * 256 + colh + c4;
            *(f32x4*)((float*)(P->out + (size_t)M * D / 2) + off) = (f32x4){yv[0], yv[1], yv[2], yv[3]};
            v2u ad; ad.x = cvt_pk_bf16(bon * sv[t8 * 64 + c4], bon * sv[t8 * 64 + c4 + 1]); ad.y = cvt_pk_bf16(bon * sv[t8 * 64 + c4 + 2], bon * sv[t8 * 64 + c4 + 3]);
            *(v2u*)((bf16*)(P->out + (size_t)M * D / 2 + (size_t)M * 256) + off) = ad;
            v2u gt; gt.x = cvt_pk_bf16(skk[t8 * 64 + c4], skk[t8 * 64 + c4 + 1]); gt.y = cvt_pk_bf16(skk[t8 * 64 + c4 + 2], skk[t8 * 64 + c4 + 3]);
            *(v2u*)((bf16*)(P->out + (size_t)M * D / 2 + (size_t)M * 256) + (size_t)M * 256 + off) = gt;
            if ((tid & 7) == 0) ((f32x2g*)(P->ws + WS_RST))[((rowbase + t8) * 4 + h) * 2 + half] = (f32x2g){mean, q}; }
        sync_wg();
    }
}

constexpr int RW_SET = 40960;
constexpr int RW_SV = 81920, RW_SY = 90112, RW_SG = 98304, RW_SB = 106496;
constexpr int RW_SCR = 108544;
constexpr int RW_W2T = 124928, RW_A2T = 133120, RW_G2T = 141312;
constexpr int RW_MU = 149504, RW_PAR = 151296;
__device__ __forceinline__ NOPK void rwkv_task2(LAS unsigned char* lds, KP P, int layer, int b, int h, int half) {
    asm volatile("" : "+s"(h), "+s"(b), "+s"(half));
    const int tid = opaque_tid(), lane = tid & 63, wave = __builtin_amdgcn_readfirstlane(tid >> 6);
    LAS bf16* w2T = (LAS bf16*)(lds + RW_W2T); LAS bf16* a2T = (LAS bf16*)(lds + RW_A2T); LAS bf16* g2T = (LAS bf16*)(lds + RW_G2T);
    LAS float* smu = (LAS float*)(lds + RW_MU); LAS float* spar = (LAS float*)(lds + RW_PAR);
    const bf16* Z = (const bf16*)(P->ws + WS_R2);
    const int colh = h * 64;
    constexpr int NC2 = SEQ / 32;
    sync_wg();
    if (tid < 448) { const int seg = tid >> 6, j = tid & 63; const int col = (seg < 3) ? seg * 256 + colh + j : 768 + (seg - 3) * 64 + j; smu[tid] = P->in[I_MU][layer * 1024 + col]; }
    if (tid < 320) { const int seg = tid >> 6, j = tid & 63; const float* src = (seg == 0) ? P->in[I_KK] + layer * 256 + colh : (seg == 1) ? P->in[I_KA] + layer * 256 + colh : (seg == 2) ? P->in[I_RK] + (layer * 4 + h) * 64
                                                                             : (seg == 3) ? P->in[I_RLNW] + layer * 256 + colh : P->in[I_RLNB] + layer * 256 + colh; spar[tid] = src[j]; }
    { const int cc = tid & 63, jb = tid >> 6;
      const float* w2 = P->in[I_W2] + (size_t)layer * 64 * 256 + colh + cc; const float* a2 = P->in[I_A2] + (size_t)layer * 64 * 256 + colh + cc;
      float x[8];
#pragma unroll
      for (int i = 0; i < 8; ++i) x[i] = w2[(8 * jb + i) * 256];
      { v4u o; o.x = cvt_pk_bf16(x[0], x[1]); o.y = cvt_pk_bf16(x[2], x[3]); o.z = cvt_pk_bf16(x[4], x[5]); o.w = cvt_pk_bf16(x[6], x[7]); *(LAS v4u*)(w2T + cc * 64 + ((jb ^ (cc & 7)) << 3)) = o; }
#pragma unroll
      for (int i = 0; i < 8; ++i) x[i] = a2[(8 * jb + i) * 256];
      { v4u o; o.x = cvt_pk_bf16(x[0], x[1]); o.y = cvt_pk_bf16(x[2], x[3]); o.z = cvt_pk_bf16(x[4], x[5]); o.w = cvt_pk_bf16(x[6], x[7]); *(LAS v4u*)(a2T + cc * 64 + ((jb ^ (cc & 7)) << 3)) = o; }
      const int cg = tid & 31, ch = tid >> 5; const float* g2 = P->in[I_G2] + (size_t)layer * 128 * 256 + colh + 32 * half + cg;
#pragma unroll
      for (int i = 0; i < 8; ++i) x[i] = g2[(8 * ch + i) * 256];
      { v4u o; o.x = cvt_pk_bf16(x[0], x[1]); o.y = cvt_pk_bf16(x[2], x[3]); o.z = cvt_pk_bf16(x[4], x[5]); o.w = cvt_pk_bf16(x[6], x[7]); *(LAS v4u*)(g2T + cg * 128 + ((ch ^ (cg & 7)) << 3)) = o; } }
    sync_wg();
    const int wrole = wave >> 2, widx = wave & 3;
    if (wrole) {
        const int pw = widx, tl = lane >> 3, e0 = (lane & 7) * 8, tk = 8 * pw + tl;
        const int fr = lane & 15, fq = lane >> 4;
        LAS bf16* tw = (LAS bf16*)(lds + RW_SCR + pw * 4096); LAS bf16* ta = tw + 512; LAS bf16* tg = tw + 1024;
        float w0v[4], a0v[4];
#pragma unroll
        for (int q = 0; q < 4; ++q) { w0v[q] = P->in[I_W0][layer * 256 + colh + 16 * q + fr]; a0v[q] = P->in[I_A0][layer * 256 + colh + 16 * q + fr]; }
        v4u R[7], Rp[7];
#define RW2_LOAD(cc_) { const size_t row_ = (size_t)b * SEQ + (cc_) * 32 + tk; const bf16* zr_ = Z + row_ * NMIXP + 768; const bf16* zp_ = ((cc_) == 0 && tk == 0) ? zr_ : zr_ - NMIXP; \
        const int cols_[7] = {colh + e0, 256 + colh + e0, 512 + colh + e0, 768 + e0, 832 + e0, 896 + e0, 960 + e0}; \
        _Pragma("unroll") for (int q_ = 0; q_ < 7; ++q_) { R[q_] = *(const v4u*)(zr_ + cols_[q_]); Rp[q_] = *(const v4u*)(zp_ + cols_[q_]); } }
        RW2_LOAD(0)
#pragma unroll 1
        for (int it = -1; it <= NC2; ++it) {
            if (it >= 1) { const int oc = it - 1, ob = oc & 1; const int c4 = (lane & 7) * 4;
                const LAS float* sy = (const LAS float*)(lds + RW_SY + ob * 4096); const LAS float* sv = (const LAS float*)(lds + RW_SV + ob * 4096); const LAS float* sg = (const LAS float*)(lds + RW_SG + ob * 4096);
                const f32x4 yv = *(const LAS f32x4*)(sy + tk * 32 + c4), vv = *(const LAS f32x4*)(sv + tk * 32 + c4), gv = *(const LAS f32x4*)(sg + tk * 32 + c4);
                float s = (yv.x + yv.y) + (yv.z + yv.w); s = red8(s); const float mean = s * (1.f / 32.f);
                const f32x4 d = yv - mean; float q = (d.x * d.x + d.y * d.y) + (d.z * d.z + d.w * d.w); q = red8(q);
                const float bon = ((const LAS float*)(lds + RW_SB + ob * 128))[tk];
                const size_t row = (size_t)b * SEQ + oc * 32 + tk; const size_t off = row * 256 + colh + 32 * half + c4;
                *(f32x4*)((float*)(P->out + (size_t)M * D / 2) + off) = yv;
                v2u ad; ad.x = cvt_pk_bf16(bon * vv.x, bon * vv.y); ad.y = cvt_pk_bf16(bon * vv.z, bon * vv.w);
                *(v2u*)((bf16*)(P->out + (size_t)M * D / 2 + (size_t)M * 256) + off) = ad;
                v2u gt; gt.x = cvt_pk_bf16(gv.x, gv.y); gt.y = cvt_pk_bf16(gv.z, gv.w);
                *(v2u*)((bf16*)(P->out + (size_t)M * D / 2 + (size_t)M * 256) + (size_t)M * 256 + off) = gt;
                if ((lane & 7) == 0) ((f32x2g*)(P->ws + WS_RST))[(row * 4 + h) * 2 + half] = (f32x2g){mean, q}; }
            if (it + 1 < NC2) { const int pc = it + 1, pb = pc & 1;
                LAS float* sr = (LAS float*)(lds + pb * RW_SET); LAS float* skm = sr + 2048; LAS float* sw = sr + 4096; LAS float* skk = sr + 6144; LAS float* ska = sr + 8192;
                LAS float* sv = (LAS float*)(lds + RW_SV + pb * 4096); LAS float* sg = (LAS float*)(lds + RW_SG + pb * 4096); LAS float* sb = (LAS float*)(lds + RW_SB + pb * 128);
                { const bool first = (pc == 0 && tk == 0); float a[8], p[8], z[8];
#define UNPK2(vv_, o_) { const v4u u_ = vv_; o_[0] = bf_lo(u_.x); o_[1] = bf_hi(u_.x); o_[2] = bf_lo(u_.y); o_[3] = bf_hi(u_.y); o_[4] = bf_lo(u_.z); o_[5] = bf_hi(u_.z); o_[6] = bf_lo(u_.w); o_[7] = bf_hi(u_.w); }
#define SHIFT2(idx) { UNPK2(R[idx], a) UNPK2(Rp[idx], p) _Pragma("unroll") for (int i = 0; i < 8; ++i) { const float pv = first ? 0.f : p[i]; z[i] = a[i] + (pv - a[i]) * smu[(idx) * 64 + e0 + i]; } }
                  SHIFT2(0)
                  *(LAS f32x4*)(sr + tk * 64 + e0) = (f32x4){z[0], z[1], z[2], z[3]}; *(LAS f32x4*)(sr + tk * 64 + e0 + 4) = (f32x4){z[4], z[5], z[6], z[7]};
                  SHIFT2(1)
                  *(LAS f32x4*)(skm + tk * 64 + e0) = (f32x4){z[0], z[1], z[2], z[3]}; *(LAS f32x4*)(skm + tk * 64 + e0 + 4) = (f32x4){z[4], z[5], z[6], z[7]};
                  SHIFT2(2)
                  if ((e0 >> 5) == half) { *(LAS f32x4*)(sv + tk * 32 + (e0 & 31)) = (f32x4){z[0], z[1], z[2], z[3]}; *(LAS f32x4*)(sv + tk * 32 + (e0 & 31) + 4) = (f32x4){z[4], z[5], z[6], z[7]}; }
                  const int sw8 = ((lane & 7) ^ (tl & 7)) << 3;
                  SHIFT2(3)
                  { v4u o; o.x = cvt_pk_bf16(tanh_fast(z[0]), tanh_fast(z[1])); o.y = cvt_pk_bf16(tanh_fast(z[2]), tanh_fast(z[3])); o.z = cvt_pk_bf16(tanh_fast(z[4]), tanh_fast(z[5])); o.w = cvt_pk_bf16(tanh_fast(z[6]), tanh_fast(z[7])); *(LAS v4u*)(tw + tl * 64 + sw8) = o; }
                  SHIFT2(4)
                  { v4u o; o.x = cvt_pk_bf16(z[0], z[1]); o.y = cvt_pk_bf16(z[2], z[3]); o.z = cvt_pk_bf16(z[4], z[5]); o.w = cvt_pk_bf16(z[6], z[7]); *(LAS v4u*)(ta + tl * 64 + sw8) = o; }
                  SHIFT2(5)
                  { v4u o; o.x = cvt_pk_bf16(sigmoid_acc(z[0]), sigmoid_acc(z[1])); o.y = cvt_pk_bf16(sigmoid_acc(z[2]), sigmoid_acc(z[3])); o.z = cvt_pk_bf16(sigmoid_acc(z[4]), sigmoid_acc(z[5])); o.w = cvt_pk_bf16(sigmoid_acc(z[6]), sigmoid_acc(z[7])); *(LAS v4u*)(tg + tl * 128 + sw8) = o; }
                  SHIFT2(6)
                  { v4u o; o.x = cvt_pk_bf16(sigmoid_acc(z[0]), sigmoid_acc(z[1])); o.y = cvt_pk_bf16(sigmoid_acc(z[2]), sigmoid_acc(z[3])); o.z = cvt_pk_bf16(sigmoid_acc(z[4]), sigmoid_acc(z[5])); o.w = cvt_pk_bf16(sigmoid_acc(z[6]), sigmoid_acc(z[7])); *(LAS v4u*)(tg + tl * 128 + 64 + sw8) = o; }
#undef SHIFT2
#undef UNPK2
                }
                if (pc + 1 < NC2) RW2_LOAD(pc + 1)
                asm volatile("s_waitcnt lgkmcnt(0)" ::: "memory");
                { const int ar = fr & 7;
                  f32x4 wacc[4], aacc[4], gacc[2];
#pragma unroll
                  for (int q = 0; q < 4; ++q) { wacc[q] = (f32x4){0.f, 0.f, 0.f, 0.f}; aacc[q] = wacc[q]; }
                  gacc[0] = (f32x4){0.f, 0.f, 0.f, 0.f}; gacc[1] = gacc[0];
#pragma unroll
                  for (int ks = 0; ks < 2; ++ks) { const int ch = ks * 4 + fq;
                      const bf16x8v Aw = *(const LAS bf16x8v*)(tw + ar * 64 + ((ch ^ (ar & 7)) << 3)), Aa = *(const LAS bf16x8v*)(ta + ar * 64 + ((ch ^ (ar & 7)) << 3));
#pragma unroll
                      for (int q = 0; q < 4; ++q) { const int br = 16 * q + fr;
                          const bf16x8v Bw = *(const LAS bf16x8v*)(w2T + br * 64 + ((ch ^ (br & 7)) << 3)), Ba = *(const LAS bf16x8v*)(a2T + br * 64 + ((ch ^ (br & 7)) << 3));
                          wacc[q] = __builtin_amdgcn_mfma_f32_16x16x32_bf16(Aw, Bw, wacc[q], 0, 0, 0); aacc[q] = __builtin_amdgcn_mfma_f32_16x16x32_bf16(Aa, Ba, aacc[q], 0, 0, 0); } }
#pragma unroll
                  for (int ks = 0; ks < 4; ++ks) { const int ch = ks * 4 + fq;
                      const bf16x8v Ag = *(const LAS bf16x8v*)(tg + ar * 128 + ((ch ^ (ar & 7)) << 3));
#pragma unroll
                      for (int q = 0; q < 2; ++q) { const int br = 16 * q + fr;
                          const bf16x8v Bg = *(const LAS bf16x8v*)(g2T + br * 128 + ((ch ^ (br & 7)) << 3));
                          gacc[q] = __builtin_amdgcn_mfma_f32_16x16x32_bf16(Ag, Bg, gacc[q], 0, 0, 0); } }
                  if (fq < 2) {
#pragma unroll
                      for (int rg = 0; rg < 4; ++rg) { const int t = 8 * pw + 4 * fq + rg;
#pragma unroll
                          for (int q = 0; q < 4; ++q) { const int cc = 16 * q + fr;
                              sw[t * 64 + cc] = __expf(-0.6065306597126334f * sigmoid_acc(w0v[q] + wacc[q][rg])); ska[t * 64 + cc] = sigmoid_acc(a0v[q] + aacc[q][rg]); }
#pragma unroll
                          for (int q = 0; q < 2; ++q) sg[t * 32 + 16 * q + fr] = gacc[q][rg]; } } }
                asm volatile("s_waitcnt lgkmcnt(0)" ::: "memory");
                { float ss = 0.f, bon = 0.f; float kk[8], av[8];
#pragma unroll
                  for (int i = 0; i < 8; ++i) { const int cc = e0 + i; const float kv = skm[tk * 64 + cc]; av[i] = ska[tk * 64 + cc];
                      kk[i] = kv * spar[cc]; ss += kk[i] * kk[i];
                      const float km = kv * (1.f + (av[i] - 1.f) * spar[64 + cc]); skm[tk * 64 + cc] = km;
                      bon += sr[tk * 64 + cc] * km * spar[128 + cc]; }
                  ss = red8(ss); bon = red8(bon); const float inv = 1.0f / sqrtf(ss + 1e-12f);
#pragma unroll
                  for (int i = 0; i < 8; ++i) { const float kn = kk[i] * inv; skk[tk * 64 + e0 + i] = kn; ska[tk * 64 + e0 + i] = kn * av[i]; }
                  if ((lane & 7) == 0) sb[tk] = bon; }
            }
            sync_wg();
        }
#undef RW2_LOAD
    } else {
        const int kq = lane & 15, vloc = 2 * (4 * widx + (lane >> 4));
        typedef float f32x2 __attribute__((ext_vector_type(2)));
        f32x2 S2[4];
#pragma unroll
        for (int i = 0; i < 4; ++i) S2[i] = (f32x2){0.f, 0.f};
        sync_wg();
#pragma unroll 1
        for (int it = 0; it < NC2; ++it) { const int cb = it & 1;
            const LAS f32x4* pr = (const LAS f32x4*)(lds + cb * RW_SET + 16 * kq); const LAS f32x4* pkm = pr + 512; const LAS f32x4* pw = pr + 1024; const LAS f32x4* pkk = pr + 1536; const LAS f32x4* pka = pr + 2048;
            const LAS f32x2* pv = (const LAS f32x2*)(lds + RW_SV + cb * 4096 + 4 * vloc); LAS float* sy = (LAS float*)(lds + RW_SY + cb * 4096);
            f32x4 wA = pw[0], kA = pkk[0], aA = pka[0], mA = pkm[0], rA = pr[0]; f32x2 vA = pv[0];
            f32x4 wB, kB, aB, mB, rB; f32x2 vB;
#define RWKV_STEP(tcur, tn, wX, kX, aX, mX, rX, vX, wY, kY, aY, mY, rY, vY) { \
              wY = pw[(tn) * 16]; kY = pkk[(tn) * 16]; aY = pka[(tn) * 16]; mY = pkm[(tn) * 16]; rY = pr[(tn) * 16]; vY = pv[(tn) * 16]; \
              f32x2 sa = S2[0] * kX.x; sa = S2[1] * kX.y + sa; sa = S2[2] * kX.z + sa; sa = S2[3] * kX.w + sa; \
              const f32x2 tm0 = S2[0] * wX.x + vX * mX.x, tm1 = S2[1] * wX.y + vX * mX.y, tm2 = S2[2] * wX.z + vX * mX.z, tm3 = S2[3] * wX.w + vX * mX.w; \
              float s0 = sa.x, s1 = sa.y; DPP_SUM16_2(s0, s1) \
              const f32x2 sar = (f32x2){s0, s1}; \
              S2[0] = tm0 - sar * aX.x; S2[1] = tm1 - sar * aX.y; S2[2] = tm2 - sar * aX.z; S2[3] = tm3 - sar * aX.w; \
              f32x2 yy = S2[0] * rX.x; yy = S2[1] * rX.y + yy; yy = S2[2] * rX.z + yy; yy = S2[3] * rX.w + yy; \
              float y0 = yy.x, y1 = yy.y; DPP_SUM16_2(y0, y1) \
              if (kq == 0) *(LAS f32x2*)(sy + (tcur) * 32 + vloc) = (f32x2){y0, y1}; }
#pragma unroll 1
            for (int t = 0; t < 32; t += 2) {
                RWKV_STEP(t, t + 1, wA, kA, aA, mA, rA, vA, wB, kB, aB, mB, rB, vB)
                RWKV_STEP(t + 1, (t + 2) & 31, wB, kB, aB, mB, rB, vB, wA, kA, aA, mA, rA, vA) }
#undef RWKV_STEP
            sync_wg();
        }
        sync_wg();
    }
}

__device__ __forceinline__ NOPK void rwkv_finalize(KP P, int layer) {
    const int gt = blockIdx.x * (NWAVES * 64) + opaque_tid(), NGT = gridDim.x * NWAVES * 64;
    const float* YR = P->out + (size_t)M * D / 2; const bf16* AD = (const bf16*)(YR + (size_t)M * 256); const bf16* GT = AD + (size_t)M * 256;
    const f32x2g* ST = (const f32x2g*)(P->ws + WS_RST); bf16* O = (bf16*)P->out;
    for (int i = gt; i < M * 64; i += NGT) { const int row = i >> 6, c4 = (i & 63) * 4, h = c4 >> 6;
        const f32x2g sa = ST[(row * 4 + h) * 2], sb = ST[(row * 4 + h) * 2 + 1];
        const float mean = 0.5f * (sa.x + sb.x), dm = sa.x - sb.x, m2 = sa.y + sb.y + 16.f * dm * dm, rs = 1.0f / sqrtf(m2 * (1.f / 64.f) + 64e-5f);
        const f32x4 y = *(const f32x4*)(YR + (size_t)row * 256 + c4); const v2u ad = *(const v2u*)(AD + (size_t)row * 256 + c4), g = *(const v2u*)(GT + (size_t)row * 256 + c4);
        const f32x4 lw = *(const f32x4*)(P->in[I_RLNW] + layer * 256 + c4), lb = *(const f32x4*)(P->in[I_RLNB] + layer * 256 + c4);
        v2u o; o.x = cvt_pk_bf16(((y.x - mean) * rs * lw.x + lb.x + bf_lo(ad.x)) * bf_lo(g.x), ((y.y - mean) * rs * lw.y + lb.y + bf_hi(ad.x)) * bf_hi(g.x));
        o.y = cvt_pk_bf16(((y.z - mean) * rs * lw.z + lb.z + bf_lo(ad.y)) * bf_lo(g.y), ((y.w - mean) * rs * lw.w + lb.w + bf_hi(ad.y)) * bf_hi(g.y));
        *(v2u*)(O + (size_t)row * D + 256 + c4) = o; }
}

__device__ __forceinline__ NOPK void ffn_fixup(KP P, int layer) {
    const int gt = blockIdx.x * (NWAVES * 64) + opaque_tid(), NGT = gridDim.x * NWAVES * 64;
    const float* uh = (const float*)(P->ws + WS_HALO); const float* vh = (const float*)(P->ws + WS_HALO + HALO_ONE); const float* ut = (const float*)(P->ws + WS_HALO + 2 * HALO_ONE);
    const float* conv = P->in[I_CONV] + (size_t)layer * 3 * DFF; bf16* ACT = (bf16*)(P->ws + WS_R2);
    for (int i = gt; i < 128 * 2 * DFF; i += NGT) { const int pm = i / (2 * DFF), rr = (i / DFF) & 1, cc = i % DFF;
        const float u0 = uh[((size_t)pm * 2) * DFF + cc], u1 = uh[((size_t)pm * 2 + 1) * DFF + cc];
        float t0 = 0.f, t1 = 0.f; if (pm & 7) { t0 = ut[((size_t)(pm - 1) * 2) * DFF + cc]; t1 = ut[((size_t)(pm - 1) * 2 + 1) * DFF + cc]; }
        const float c0 = conv[cc], c1 = conv[DFF + cc], c2 = conv[2 * DFF + cc];
        const float cv = rr ? (c2 * u1 + c1 * u0 + c0 * t1) : (c2 * u0 + c1 * t1 + c0 * t0);
        const float a = pg8::gelu_tanh_f(cv) * vh[((size_t)pm * 2 + rr) * DFF + cc];
        ACT[((size_t)pm * 256 + rr) * DFF + cc] = (bf16)(cvt_pk_bf16(a, 0.f) & 0xffffu); }
}

constexpr int NPH = 1 + 11 * DEPTH;
#ifndef REP_MIX
#define REP_MIX -1
#endif
#ifndef REP_PHASE
#define REP_PHASE -1
#endif
#define REPEAT(k) for (int rep_ = 0; rep_ < ((REP_PHASE == (k)) ? 2 : 1); ++rep_)
__global__ void __launch_bounds__(NWAVES * 64, 2) NOPK mega(Params Pk) {
    KP P = kparams();
    extern __shared__ __attribute__((aligned(16))) unsigned char lds_raw[];
    LAS unsigned char* lds = (LAS unsigned char*)lds_raw;
    volatile LAS unsigned* MISC = (volatile LAS unsigned*)(lds + LDS_MISC);
    const int tid = threadIdx.x;
    const int G = gridDim.x, bx = blockIdx.x;
    if (tid < 64) MISC[tid] = 0u;
    sync_wg();
    const int lo = P->ph_lo, hi = P->ph_hi;
    XcdBarrier bar; bar.bar = (unsigned*)(P->ws + WS_CTL) + CW_BAR; bar.x = 0; bar.st = nullptr;
    if (hi - lo > 1) bar = xcd_barrier_post((unsigned*)(P->ws + WS_CTL) + CW_BAR, MISC + 8);
#define IN(k) (lo <= (k) && (k) < hi)
#define SEAM(k) do { if (IN(k) && IN((k) + 1)) xcd_barrier(bar); } while (0)
#define PHASE_PTRS KP P = kparams(); unsigned char* const wl = P->ws + WS_W + (size_t)l * W_LAYER; bf16* const XB = (bf16*)(P->ws + WS_XB); unsigned char* const R2 = P->ws + WS_R2; \
        bf16* const OB = (bf16*)P->out;   bf16* const MG = (bf16*)P->out + (size_t)M * D;   \
        (void)wl; (void)XB; (void)R2; (void)OB; (void)MG;

    if (IN(0)) prologue(kparams(), lds);
    SEAM(0);
    for (int l = 0; l < DEPTH; ++l) {
        const int pb = 1 + 11 * l;
        REPEAT(0) if (IN(pb + 0)) {
            PHASE_PTRS
            pg8::Gemm g{XB, (const bf16*)(wl + WO_IN), M, NMIXP, D, D, D, 0, 0}; pg8::StaticOrder S; S.init(M, NMIXP, G, bx);
            pg8::EpiStoreBf16 E{(bf16*)R2, NMIXP};
            pg8::gemm_phase<pg8::EpiStoreBf16, pg8::StaticOrder, true, true>(lds, g, S, E);
        }
        SEAM(pb + 0);
        REPEAT(1) if (IN(pb + 1)) {
            PHASE_PTRS
#ifndef NO_MIX
            for (int slot = bx; slot < 256; slot += G) {
                if (slot < 128) { const int bh = slot >> 1; rwkv_task2(lds, P, l, bh >> 2, bh & 3, slot & 1); }
                else if (slot < 192) { const int bh = slot - 128; linattn_fast<0>(lds, P, l, bh >> 2, bh & 3); linattn_fast<2>(lds, P, l, bh >> 2, bh & 3); }
                else { const int bh = slot - 192; linattn_fast<3>(lds, P, l, bh >> 2, bh & 3); } }
#endif
        }
        SEAM(pb + 1);
        REPEAT(2) if (IN(pb + 2)) rwkv_finalize(kparams(), l);
        SEAM(pb + 2);
        REPEAT(3) if (IN(pb + 3)) {
            PHASE_PTRS
            pg8::Gemm g{OB, (const bf16*)(wl + WO_B), M, 4096, 256, D, 256, 4, 256}; pg8::StaticOrder S; S.init(M, 4096, G, bx);
            pg8::EpiStoreBf16 E{(bf16*)R2, 4096};
            pg8::gemm_phase<pg8::EpiStoreBf16, pg8::StaticOrder, true, true>(lds, g, S, E);
        }
        SEAM(pb + 3);
        REPEAT(4) if (IN(pb + 4)) {
            PHASE_PTRS
            pg8::Gemm g{XB, (const bf16*)(wl + WO_G), M, 4096, D, D, D, 0, 0}; pg8::StaticOrder S; S.init(M, 4096, G, bx);
            pg8::EpiMerge E{(const bf16*)R2, MG};
            pg8::gemm_phase<pg8::EpiMerge, pg8::StaticOrder, true, true>(lds, g, S, E);
        }
        SEAM(pb + 4);
        REPEAT(5) if (IN(pb + 5)) {
            PHASE_PTRS
            pg8::Gemm g{MG, (const bf16*)(wl + WO_MIX), M, D, D, D, D, 0, 0}; pg8::StaticOrder S; S.init(M, D, G, bx);
            pg8::EpiResF32 E{XB, nullptr, (float*)R2, ALPHA};
            pg8::gemm_phase<pg8::EpiResF32, pg8::StaticOrder, true, true>(lds, g, S, E);
        }
        SEAM(pb + 5);
        REPEAT(6) if (IN(pb + 6)) { PHASE_PTRS ln_phase((const float*)R2, P->in[I_LNMW] + l * D, P->in[I_LNMB] + l * D, XB, nullptr); }
        SEAM(pb + 6);
        REPEAT(7) if (IN(pb + 7)) {
            PHASE_PTRS
            { pg8::Gemm g{XB, (const bf16*)(wl + WO_UP), M, 2 * DFF, D, D, D, 0, 0}; pg8::StaticOrder S; S.init(M, 2 * DFF, G, bx);
              pg8::EpiFfnUp E{(bf16*)R2, P->in[I_CONV] + (size_t)l * 3 * DFF, (float*)(P->ws + WS_HALO), (float*)(P->ws + WS_HALO + HALO_ONE), (float*)(P->ws + WS_HALO + 2 * HALO_ONE), (LAS float*)(lds + LDS_XCH)};
              pg8::gemm_phase<pg8::EpiFfnUp, pg8::StaticOrder, true, true>(lds, g, S, E); }
            { pg8::Gemm g{(const bf16*)(P->ws + WS_PB) + (size_t)l * M * PLE, (const bf16*)(wl + WO_PP), M, D, PLE, PLE, PLE, 0, 0}; pg8::StaticOrder S; S.init(M, D, G, bx);
              pg8::EpiStoreBf16 E{(bf16*)(R2 + R2_PPLE), D};
              pg8::gemm_phase<pg8::EpiStoreBf16, pg8::StaticOrder, true, true>(lds, g, S, E); }
        }
        SEAM(pb + 7);
        REPEAT(8) if (IN(pb + 8)) {
            PHASE_PTRS
            ffn_fixup(P, l);
            pg8::Gemm g{XB, (const bf16*)(wl + WO_PG), M, D, D, D, D, 0, 0}; pg8::StaticOrder S; S.init(M, D, G, bx);
            pg8::EpiPleGate E{(bf16*)(R2 + R2_PPLE)};
            pg8::gemm_phase<pg8::EpiPleGate, pg8::StaticOrder, true, true>(lds, g, S, E);
        }
        SEAM(pb + 8);
        REPEAT(9) if (IN(pb + 9)) {
            PHASE_PTRS
            pg8::Gemm g{(const bf16*)R2, (const bf16*)(wl + WO_DN), M, D, DFF, DFF, DFF, 0, 0}; pg8::StaticOrder S; S.init(M, D, G, bx);
            pg8::EpiResF32 E{XB, (const bf16*)(R2 + R2_PPLE), P->out, ALPHA};
            pg8::gemm_phase<pg8::EpiResF32, pg8::StaticOrder, true, true>(lds, g, S, E);
        }
        SEAM(pb + 9);
        if (IN(pb + 10)) { PHASE_PTRS ln_phase(P->out, P->in[I_LNFW] + l * D, P->in[I_LNFB] + l * D, (l == DEPTH - 1) ? nullptr : XB, (l == DEPTH - 1) ? P->out : nullptr); }
        SEAM(pb + 10);
    }
#undef IN
#undef SEAM
}

extern "C" void kernel_launch(void* const* d_in, const int* in_sizes, int n_in, void* d_out, int out_size, void* d_ws, size_t ws_size, hipStream_t stream) {
    static int grid = 0;
    if (grid == 0) {
        if (n_in != 32 || out_size != M * D || ws_size < WS_END) { fprintf(stderr, "kernel_launch: unexpected shapes (n_in %d, out %d, ws %zu)\n", n_in, out_size, ws_size); grid = -1; return; }
        int dev = 0, cus = 0, per_cu = 0;
        if (hipGetDevice(&dev) != hipSuccess || hipDeviceGetAttribute(&cus, hipDeviceAttributeMultiprocessorCount, dev) != hipSuccess) { grid = -1; return; }
        if (hipFuncSetAttribute((const void*)mega, hipFuncAttributeMaxDynamicSharedMemorySize, LDS_BYTES) != hipSuccess) { fprintf(stderr, "kernel_launch: hipFuncSetAttribute failed\n"); grid = -1; return; }
        if (hipOccupancyMaxActiveBlocksPerMultiprocessor(&per_cu, (const void*)mega, NWAVES * 64, LDS_BYTES) != hipSuccess || per_cu < 1) fprintf(stderr, "kernel_launch: occupancy query reports %d\n", per_cu);
        (void)hipGetLastError();
        grid = cus;
    }
    if (grid < 0) return;
    (void)hipMemsetAsync((char*)d_ws + WS_CTL, 0, CTL_ZERO_BYTES, stream);
    Params p{};
    for (int i = 0; i < 32; ++i) p.in[i] = (const float*)d_in[i];
    p.out = (float*)d_out; p.ws = (unsigned char*)d_ws;
#if ONE_LAUNCH
    p.ph_lo = 0; p.ph_hi = NPH;
    hipLaunchKernelGGL(mega, dim3(grid), dim3(NWAVES * 64), LDS_BYTES, stream, p);
#else
    for (int ph = 0; ph < NPH; ++ph) { p.ph_lo = ph; p.ph_hi = ph + 1; hipLaunchKernelGGL(mega, dim3(grid), dim3(NWAVES * 64), LDS_BYTES, stream, p); }
#endif
}
```

```cpp
#include <hip/hip_runtime.h>
#include <cstdio>
#include <cstdint>
#if defined(__HIP_DEVICE_COMPILE__)
#define NOPK __attribute__((target("no-packed-fp32-ops")))
#else
#define NOPK
#endif

typedef float f32x2g __attribute__((ext_vector_type(2)));
__device__ __forceinline__ NOPK void sync_wg() { __builtin_amdgcn_fence(__ATOMIC_RELEASE, "workgroup"); __builtin_amdgcn_s_barrier(); __builtin_amdgcn_fence(__ATOMIC_ACQUIRE, "workgroup"); }
__device__ __forceinline__ NOPK float u2f(unsigned u) { return __builtin_bit_cast(float, u); }
__device__ __forceinline__ NOPK float shfl_(float v, int src) { return __builtin_bit_cast(float, __builtin_amdgcn_ds_bpermute(src << 2, __builtin_bit_cast(int, v))); }
__device__ __forceinline__ NOPK float shfl_xor_(float v, int m) { const int lane_ = __builtin_amdgcn_mbcnt_hi(~0u, __builtin_amdgcn_mbcnt_lo(~0u, 0u)); return shfl_(v, lane_ ^ m); }
namespace pg8 {
#define PG8_LAS __attribute__((address_space(3)))
typedef unsigned short bf16_t;
typedef short bf16x8 __attribute__((ext_vector_type(8)));
typedef float f32x4 __attribute__((ext_vector_type(4)));
typedef float f32x2 __attribute__((ext_vector_type(2)));
typedef unsigned u32x4 __attribute__((ext_vector_type(4)));
typedef unsigned u32x2 __attribute__((ext_vector_type(2)));
constexpr int BM = 256, BK = 64, HALF = 128, HTB = HALF * BK * 2  , STAGE_BYTES = 8 * HTB, NXCD = 8, WGM = 8;

__host__ __device__ __forceinline__ NOPK int lds_byte(int r, int c) { const int st = (r >> 4) * 2 + (c >> 5), rr = r & 15, cc = c & 31, ob = rr * 64 + cc * 2; return st * 1024 + (ob ^ (((ob >> 9) & 1) << 5)); }
__host__ __device__ __forceinline__ NOPK void stage_rc(int b, int& R, int& C) { const int st = b / 1024, sb = b % 1024, swz = sb ^ (((sb >> 9) & 1) << 5); R = (st >> 1) * 16 + swz / 64; C = (st & 1) * 32 + (swz % 64) / 2; }
__host__ __device__ __forceinline__ NOPK int perm32(int rho) { const int n = rho >> 4, i = rho & 15; return 8 * (i >> 2) + 4 * n + (i & 3); }

struct Unit { int pm, pn; };
struct Gemm { const bf16_t* A; const bf16_t* Bt; int M, N, K, lda, ldb, a_div, a_coloff; };
__device__ __forceinline__ NOPK size_t a_unit_off(const Gemm& g, const Unit& u) { return g.a_div ? (size_t)((u.pn / g.a_div) * g.a_coloff) * 2u : (size_t)0; }

struct StaticOrder {
    int nM, nN, nwg, G, c;
    __host__ __device__ NOPK void init(int M, int N, int G_, int c_) { nM = M / BM; nN = N / BM; nwg = nM * nN; G = G_; c = c_; }
    __host__ __device__ NOPK bool next(int i, Unit& u) const {
        const long L = (long)i * G + c; if (L >= nwg) return false;
        int wgid = (int)L; { const int q = nwg / NXCD, r = nwg % NXCD, xcd = wgid % NXCD, off = wgid / NXCD; wgid = (xcd < r ? xcd * (q + 1) : r * (q + 1) + (xcd - r) * q) + off; }
        const int nig = WGM * nN, gid = wgid / nig, fm = gid * WGM, gsz = (nM - fm) < WGM ? (nM - fm) : WGM;
        u.pm = fm + ((wgid % nig) % gsz); u.pn = (wgid % nig) / gsz; return true;
    }
    __device__ __forceinline__ NOPK void a_ready(const Unit&) const {}
    __device__ __forceinline__ NOPK void done(const Unit&) const {}
};

typedef __bf16 bf16x2_t __attribute__((ext_vector_type(2)));
__device__ __forceinline__ NOPK unsigned cvt_pk_bf16(float lo, float hi) { const f32x2 v = {lo, hi}; const bf16x2_t b = __builtin_convertvector(v, bf16x2_t); return __builtin_bit_cast(unsigned, b); }
__device__ __forceinline__ NOPK float bf_lo(unsigned w) { return u2f(w << 16); }
__device__ __forceinline__ NOPK float bf_hi(unsigned w) { return u2f(w & 0xffff0000u); }
__device__ __forceinline__ NOPK float sigmoid_f(float x) { return __builtin_amdgcn_rcpf(1.0f + __builtin_amdgcn_exp2f(-1.44269504089f * x)); }

template <class Epi, class Sched, bool ALIGN_EPI = false, bool SP2 = false>
__device__ __forceinline__ NOPK void gemm_phase(PG8_LAS unsigned char* lds, const Gemm g, const Sched& S, const Epi& E) {
    int tid_o = threadIdx.x; asm volatile("" : "+v"(tid_o));
    const int tid = tid_o, wid = __builtin_amdgcn_readfirstlane(tid >> 6), lane = tid & 63, wr = wid >> 2, wc = wid & 3, fr = lane & 15, fq = lane >> 4;
    const int K = g.K, nt = K / BK;
    unsigned voffA[2], voffB[2];
#pragma unroll
    for (int i = 0; i < 2; ++i) { int R, C; stage_rc(tid * 16 + i * 8192, R, C); const int Rb = Epi::PERM ? ((R & ~31) + perm32(R & 31)) : R;
        voffA[i] = (unsigned)(R * g.lda + C) * 2u; voffB[i] = (unsigned)(Rb * g.ldb + C) * 2u; }
    const size_t kstep = (size_t)(BK * 2);
    const size_t hstepA = (size_t)HALF * g.lda * 2, hstepB = (size_t)HALF * g.ldb * 2;
    const size_t tstepA = 2 * hstepA, tstepB = 2 * hstepB;
    const unsigned ldsw = (unsigned)wid * 1024u;
    const int aoff = lds_byte(wr * 64 + fr, fq * 8), boff = lds_byte(wc * 32 + fr, fq * 8);
#define PG8_SA(b, h) (((b) * 2 + (h)) * HTB)
#define PG8_SB(b, h) ((4 + (b) * 2 + (h)) * HTB)
#define PG8_STAGE(bufoff, gbase, voff) do { _Pragma("unroll") for (int _i = 0; _i < 2; ++_i) \
        __builtin_amdgcn_global_load_lds((const unsigned*)((const char*)(gbase) + (voff)[_i]), (PG8_LAS unsigned*)(lds + (bufoff) + ldsw + _i * 8192), 16, 0, 0); } while (0)
#define PG8_LDA(dst, b, h) do { _Pragma("unroll") for (int m = 0; m < 4; ++m) _Pragma("unroll") for (int k = 0; k < 2; ++k) dst[m][k] = *(const PG8_LAS bf16x8*)(lds + PG8_SA(b, h) + aoff + m * 2048 + k * 1024); } while (0)
#define PG8_LDB(dst, b, h) do { _Pragma("unroll") for (int n = 0; n < 2; ++n) _Pragma("unroll") for (int k = 0; k < 2; ++k) dst[n][k] = *(const PG8_LAS bf16x8*)(lds + PG8_SB(b, h) + boff + n * 2048 + k * 1024); } while (0)
#define PG8_MMA(ai, bj, At, Bt) do { __builtin_amdgcn_s_setprio(1); _Pragma("unroll") for (int m = 0; m < 4; ++m) _Pragma("unroll") for (int n = 0; n < 2; ++n) _Pragma("unroll") for (int k = 0; k < 2; ++k) \
        acc[ai][bj][m][n] = __builtin_amdgcn_mfma_f32_16x16x32_bf16(Bt[n][k], At[m][k], acc[ai][bj][m][n], 0, 0, 0); __builtin_amdgcn_s_setprio(0); } while (0)
#define PG8_WAIT_V(n) asm volatile("s_waitcnt vmcnt(" #n ")" ::: "memory")
#define PG8_WAIT_L(n) asm volatile("s_waitcnt lgkmcnt(" #n ")" ::: "memory")
#define PG8_BAR __builtin_amdgcn_s_barrier()
#define PG8_SCHED __builtin_amdgcn_sched_barrier(0)
    Unit cur, nxt; int ui = 0;
    if (!S.next(0, cur)) return;
    f32x4 acc[2][2][4][2];
#pragma unroll
    for (int a = 0; a < 2; ++a)
#pragma unroll
        for (int b = 0; b < 2; ++b)
#pragma unroll
            for (int m = 0; m < 4; ++m)
#pragma unroll
                for (int n = 0; n < 2; ++n) acc[a][b][m][n] = (f32x4){0.f, 0.f, 0.f, 0.f};
    bf16x8 At[4][2], B0[2][2], B1[2][2];
    const char* cA = (const char*)g.A + (size_t)cur.pm * tstepA + a_unit_off(g, cur); const char* cB = (const char*)g.Bt + (size_t)cur.pn * tstepB;
    S.a_ready(cur);
    if constexpr (SP2) {
        PG8_STAGE(PG8_SB(0, 0), cB, voffB); PG8_STAGE(PG8_SB(0, 1), cB + hstepB, voffB); PG8_STAGE(PG8_SA(0, 0), cA, voffA); PG8_STAGE(PG8_SA(0, 1), cA + hstepA, voffA);
        if (wr == 1) PG8_BAR;
        PG8_WAIT_V(2); PG8_BAR;
        PG8_STAGE(PG8_SB(1, 0), cB + kstep, voffB); PG8_STAGE(PG8_SA(1, 0), cA + kstep, voffA); PG8_STAGE(PG8_SB(1, 1), cB + hstepB + kstep, voffB);
        PG8_WAIT_V(6); PG8_BAR;
    } else {
        PG8_STAGE(PG8_SB(0, 0), cB, voffB); PG8_STAGE(PG8_SA(0, 0), cA, voffA); PG8_STAGE(PG8_SB(0, 1), cB + hstepB, voffB); PG8_STAGE(PG8_SA(0, 1), cA + hstepA, voffA);
        if (wr == 1) PG8_BAR;
        PG8_WAIT_V(4); PG8_BAR;
        PG8_STAGE(PG8_SB(1, 0), cB + kstep, voffB); PG8_STAGE(PG8_SA(1, 0), cA + kstep, voffA); PG8_STAGE(PG8_SB(1, 1), cB + hstepB + kstep, voffB);
        PG8_WAIT_V(6); PG8_BAR;
    }
    for (;;) {
        const bool has_next = S.next(ui + 1, nxt);
        const char* nA = has_next ? (const char*)g.A + (size_t)nxt.pm * tstepA + a_unit_off(g, nxt) : cA; const char* nB = has_next ? (const char*)g.Bt + (size_t)nxt.pn * tstepB : cB;
        for (int t = 0; t < nt; t += 2) {
            const bool last = (t == nt - 2);
            const char* a1 = cA + (size_t)(t + 1) * kstep;
            const char* a2 = last ? nA : cA + (size_t)(t + 2) * kstep; const char* b2 = last ? nB : cB + (size_t)(t + 2) * kstep;
            const char* a3 = a2 + kstep; const char* b3 = b2 + kstep;
            if (last && has_next) S.a_ready(nxt);
            if constexpr (SP2) {
            PG8_LDB(B0, 0, 0); PG8_LDB(B1, 0, 1); PG8_SCHED; PG8_LDA(At, 0, 0); PG8_STAGE(PG8_SA(1, 1), a1 + hstepA, voffA);
            PG8_WAIT_V(8); PG8_WAIT_L(0); PG8_BAR; PG8_MMA(0, 0, At, B0); PG8_MMA(0, 1, At, B1); PG8_BAR; PG8_SCHED;
            PG8_LDA(At, 0, 1); PG8_STAGE(PG8_SB(0, 0), b2, voffB); PG8_STAGE(PG8_SB(0, 1), b2 + hstepB, voffB); PG8_STAGE(PG8_SA(0, 0), a2, voffA);
            PG8_WAIT_V(8); PG8_WAIT_L(0); PG8_BAR; PG8_MMA(1, 0, At, B0); PG8_MMA(1, 1, At, B1); PG8_BAR; PG8_SCHED;
            PG8_LDB(B0, 1, 0); PG8_LDB(B1, 1, 1); PG8_SCHED; PG8_LDA(At, 1, 0); PG8_STAGE(PG8_SA(0, 1), a2 + hstepA, voffA);
            PG8_WAIT_V(8); PG8_WAIT_L(0); PG8_BAR; PG8_MMA(0, 0, At, B0); PG8_MMA(0, 1, At, B1); PG8_BAR; PG8_SCHED;
            PG8_LDA(At, 1, 1); PG8_STAGE(PG8_SB(1, 0), b3, voffB); PG8_STAGE(PG8_SB(1, 1), b3 + hstepB, voffB); PG8_STAGE(PG8_SA(1, 0), a3, voffA);
            PG8_WAIT_V(8); PG8_WAIT_L(0); PG8_BAR; PG8_MMA(1, 0, At, B0); PG8_MMA(1, 1, At, B1); PG8_BAR; PG8_SCHED;
            } else {
            PG8_LDB(B0, 0, 0); PG8_SCHED; PG8_LDA(At, 0, 0); PG8_STAGE(PG8_SA(1, 1), a1 + hstepA, voffA);
            PG8_WAIT_L(8); PG8_BAR; PG8_WAIT_L(0); PG8_MMA(0, 0, At, B0); PG8_BAR; PG8_SCHED;
            PG8_LDB(B1, 0, 1); PG8_STAGE(PG8_SB(0, 0), b2, voffB);
            PG8_BAR; PG8_WAIT_L(0); PG8_MMA(0, 1, At, B1); PG8_BAR;
            PG8_LDA(At, 0, 1); PG8_STAGE(PG8_SA(0, 0), a2, voffA);
            PG8_BAR; PG8_WAIT_L(0); PG8_MMA(1, 0, At, B0); PG8_BAR; PG8_SCHED;
            PG8_STAGE(PG8_SB(0, 1), b2 + hstepB, voffB);
            PG8_WAIT_V(6); PG8_BAR; PG8_MMA(1, 1, At, B1); PG8_BAR;
            PG8_LDB(B0, 1, 0); PG8_SCHED; PG8_LDA(At, 1, 0); PG8_STAGE(PG8_SA(0, 1), a2 + hstepA, voffA);
            PG8_WAIT_L(8); PG8_BAR; PG8_WAIT_L(0); PG8_MMA(0, 0, At, B0); PG8_BAR; PG8_SCHED;
            PG8_LDB(B1, 1, 1); PG8_STAGE(PG8_SB(1, 0), b3, voffB);
            PG8_BAR; PG8_WAIT_L(0); PG8_MMA(0, 1, At, B1); PG8_BAR;
            PG8_LDA(At, 1, 1); PG8_STAGE(PG8_SA(1, 0), a3, voffA);
            PG8_BAR; PG8_WAIT_L(0); PG8_MMA(1, 0, At, B0); PG8_BAR; PG8_SCHED;
            PG8_STAGE(PG8_SB(1, 1), b3 + hstepB, voffB);
            PG8_WAIT_V(6); PG8_BAR; PG8_MMA(1, 1, At, B1); PG8_BAR;
            }
        }
        if constexpr (ALIGN_EPI) { if (wr == 0) PG8_BAR; }
        if constexpr (!Epi::AFTER_DRAIN) { E(acc, cur, wr, wc, fr, fq); S.done(cur); }
        if (!has_next) break;
#pragma unroll
        for (int a = 0; a < 2; ++a)
#pragma unroll
            for (int b = 0; b < 2; ++b)
#pragma unroll
                for (int m = 0; m < 4; ++m)
#pragma unroll
                    for (int n = 0; n < 2; ++n) acc[a][b][m][n] = (f32x4){0.f, 0.f, 0.f, 0.f};
        cur = nxt; cA = nA; cB = nB; ++ui;
        if constexpr (ALIGN_EPI) { if (wr == 1) PG8_BAR; }
    }
    PG8_WAIT_V(0);
    if constexpr (!ALIGN_EPI) { if (wr == 0) PG8_BAR; }
    PG8_BAR;
    if constexpr (Epi::AFTER_DRAIN) { E.fused(acc, cur, wr, wc, fr, fq, lds, wid, lane); S.done(cur); }
#undef PG8_SA
#undef PG8_SB
#undef PG8_STAGE
#undef PG8_LDA
#undef PG8_LDB
#undef PG8_MMA
#undef PG8_WAIT_V
#undef PG8_WAIT_L
#undef PG8_BAR
#undef PG8_SCHED
}


struct EpiStoreBf16 {
    static constexpr bool PERM = true, AFTER_DRAIN = false;
    bf16_t* O; int ldc;
    __device__ __forceinline__ NOPK void operator()(const f32x4 (&acc)[2][2][4][2], const Unit& u, int wr, int wc, int fr, int fq) const {
        const int row0 = u.pm * BM + wr * 64 + fr, col0 = u.pn * BM + wc * 32 + 8 * fq;
#pragma unroll
        for (int ai = 0; ai < 2; ++ai)
#pragma unroll
            for (int m = 0; m < 4; ++m) { bf16_t* rowp = O + (size_t)(row0 + ai * HALF + m * 16) * ldc + col0;
#pragma unroll
                for (int bj = 0; bj < 2; ++bj) { const f32x4 v0 = acc[ai][bj][m][0], v1 = acc[ai][bj][m][1];
                    u32x4 w; w.x = cvt_pk_bf16(v0[0], v0[1]); w.y = cvt_pk_bf16(v0[2], v0[3]); w.z = cvt_pk_bf16(v1[0], v1[1]); w.w = cvt_pk_bf16(v1[2], v1[3]);
                    *(u32x4*)(rowp + bj * HALF) = w; } }
    }
};
struct EpiPleGate {
    static constexpr bool PERM = true, AFTER_DRAIN = false;
    bf16_t* PP;
    __device__ __forceinline__ NOPK void operator()(const f32x4 (&acc)[2][2][4][2], const Unit& u, int wr, int wc, int fr, int fq) const {
        const int row0 = u.pm * BM + wr * 64 + fr, col0 = u.pn * BM + wc * 32 + 8 * fq;
        u32x4 pp[2][4][2];
#pragma unroll
        for (int ai = 0; ai < 2; ++ai)
#pragma unroll
            for (int m = 0; m < 4; ++m) { const bf16_t* rowp = PP + (size_t)(row0 + ai * HALF + m * 16) * 1024 + col0;
#pragma unroll
                for (int bj = 0; bj < 2; ++bj) pp[ai][m][bj] = *(const u32x4*)(rowp + bj * HALF); }
#pragma unroll
        for (int ai = 0; ai < 2; ++ai)
#pragma unroll
            for (int m = 0; m < 4; ++m) { bf16_t* rowp = PP + (size_t)(row0 + ai * HALF + m * 16) * 1024 + col0;
#pragma unroll
                for (int bj = 0; bj < 2; ++bj) { const f32x4 v0 = acc[ai][bj][m][0], v1 = acc[ai][bj][m][1];
                    const u32x4 p = pp[ai][m][bj];
                    u32x4 w;
                    w.x = cvt_pk_bf16(sigmoid_f(v0[0]) * bf_lo(p.x), sigmoid_f(v0[1]) * bf_hi(p.x));
                    w.y = cvt_pk_bf16(sigmoid_f(v0[2]) * bf_lo(p.y), sigmoid_f(v0[3]) * bf_hi(p.y));
                    w.z = cvt_pk_bf16(sigmoid_f(v1[0]) * bf_lo(p.z), sigmoid_f(v1[1]) * bf_hi(p.z));
                    w.w = cvt_pk_bf16(sigmoid_f(v1[2]) * bf_lo(p.w), sigmoid_f(v1[3]) * bf_hi(p.w));
                    *(u32x4*)(rowp + bj * HALF) = w; } }
    }
};
struct EpiMerge {
    static constexpr bool PERM = false, AFTER_DRAIN = false;
    const bf16_t* P; bf16_t* MG;
    __device__ __forceinline__ NOPK void operator()(const f32x4 (&acc)[2][2][4][2], const Unit& u, int wr, int wc, int fr, int fq) const {
        const int row0 = u.pm * BM + wr * 64 + fr, oc = u.pn * 64 + wc * 16 + fq * 4;
        u32x2 pv[2][4][4];
#pragma unroll
        for (int ai = 0; ai < 2; ++ai)
#pragma unroll
            for (int m = 0; m < 4; ++m) { const bf16_t* prow = P + (size_t)(row0 + ai * HALF + m * 16) * 4096 + oc;
#pragma unroll
                for (int b = 0; b < 4; ++b) pv[ai][m][b] = *(const u32x2*)(prow + b * 1024); }
#pragma unroll
        for (int ai = 0; ai < 2; ++ai)
#pragma unroll
            for (int m = 0; m < 4; ++m) { const size_t row = (size_t)(row0 + ai * HALF + m * 16);
                f32x4 s = (f32x4){0.f, 0.f, 0.f, 0.f};
#pragma unroll
                for (int b = 0; b < 4; ++b) { const u32x2 p = pv[ai][m][b]; const f32x4 g = acc[ai][b >> 1][m][b & 1];
                    s[0] += sigmoid_f(g[0]) * bf_lo(p.x); s[1] += sigmoid_f(g[1]) * bf_hi(p.x); s[2] += sigmoid_f(g[2]) * bf_lo(p.y); s[3] += sigmoid_f(g[3]) * bf_hi(p.y); }
                u32x2 w; w.x = cvt_pk_bf16(s[0], s[1]); w.y = cvt_pk_bf16(s[2], s[3]);
                *(u32x2*)(MG + row * 1024 + oc) = w; }
    }
};
struct EpiResF32 {
    static constexpr bool PERM = false, AFTER_DRAIN = false;
    const bf16_t* X; const bf16_t* PLE; float* V; float alpha;
    __device__ __forceinline__ NOPK void operator()(const f32x4 (&acc)[2][2][4][2], const Unit& u, int wr, int wc, int fr, int fq) const {
        const int row0 = u.pm * BM + wr * 64 + fr, col0 = u.pn * BM + wc * 32 + 4 * fq;
#pragma unroll
        for (int ai = 0; ai < 2; ++ai) {
            u32x2 xv[4][2][2], pv[4][2][2];
#pragma unroll
            for (int m = 0; m < 4; ++m) { const size_t off = (size_t)(row0 + ai * HALF + m * 16) * 1024 + col0;
#pragma unroll
                for (int bj = 0; bj < 2; ++bj)
#pragma unroll
                    for (int n = 0; n < 2; ++n) { const size_t o = off + bj * HALF + n * 16; xv[m][bj][n] = *(const u32x2*)(X + o); if (PLE) pv[m][bj][n] = *(const u32x2*)(PLE + o); else pv[m][bj][n] = (u32x2){0u, 0u}; } }
#pragma unroll
            for (int m = 0; m < 4; ++m) { const size_t off = (size_t)(row0 + ai * HALF + m * 16) * 1024 + col0;
#pragma unroll
                for (int bj = 0; bj < 2; ++bj)
#pragma unroll
                    for (int n = 0; n < 2; ++n) { const size_t o = off + bj * HALF + n * 16; const u32x2 x2 = xv[m][bj][n], p2 = pv[m][bj][n];
                        f32x4 r = acc[ai][bj][m][n];
                        r[0] += alpha * bf_lo(x2.x) + bf_lo(p2.x); r[1] += alpha * bf_hi(x2.x) + bf_hi(p2.x); r[2] += alpha * bf_lo(x2.y) + bf_lo(p2.y); r[3] += alpha * bf_hi(x2.y) + bf_hi(p2.y);
                        *(f32x4*)(V + o) = r; } } }
    }
};
__device__ __forceinline__ NOPK float gelu_tanh_f(float x) {
    const float inner = x * (0.7978845608f + 0.0356774081f * x * x);
    return x * __builtin_amdgcn_rcpf(1.0f + __builtin_amdgcn_exp2f(-2.885390082f * inner));
}
struct EpiFfnUp {
    static constexpr bool PERM = false, AFTER_DRAIN = false;
    bf16_t* ACT; const float* conv; float* uhead; float* vhead; float* utail; PG8_LAS float* xch;
    __device__ __forceinline__ NOPK void operator()(const f32x4 (&acc)[2][2][4][2], const Unit& u, int wr, int wc, int fr, int fq) const {
        const int lane = threadIdx.x & 63;
        const int cc0 = wc * 32 + 4 * fq, colg = u.pn * 128 + cc0;
        if (fr >= 14) {
#pragma unroll
            for (int ai = 0; ai < 2; ++ai)
#pragma unroll
                for (int n = 0; n < 2; ++n) *(PG8_LAS f32x4*)(xch + ((2 * ai + wr) * 2 + (fr - 14)) * 128 + cc0 + 16 * n) = acc[ai][0][3][n];
            if (wr == 1) {
#pragma unroll
                for (int n = 0; n < 2; ++n) *(f32x4*)(utail + ((size_t)u.pm * 2 + (fr - 14)) * 2816 + colg + 16 * n) = acc[1][0][3][n];
            }
        }
        if (wr == 0 && fr < 2) {
#pragma unroll
            for (int n = 0; n < 2; ++n) { *(f32x4*)(uhead + ((size_t)u.pm * 2 + fr) * 2816 + colg + 16 * n) = acc[0][0][0][n];
                                          *(f32x4*)(vhead + ((size_t)u.pm * 2 + fr) * 2816 + colg + 16 * n) = acc[0][1][0][n]; }
        }
        asm volatile("s_waitcnt lgkmcnt(0)" ::: "memory"); __builtin_amdgcn_s_barrier(); asm volatile("" ::: "memory");
        f32x4 c0[2], c1[2], c2[2];
#pragma unroll
        for (int n = 0; n < 2; ++n) { c0[n] = *(const f32x4*)(conv + colg + 16 * n); c1[n] = *(const f32x4*)(conv + 2816 + colg + 16 * n); c2[n] = *(const f32x4*)(conv + 2 * 2816 + colg + 16 * n); }
        const int src1 = (lane & 48) | ((fr + 15) & 15), src2 = (lane & 48) | ((fr + 14) & 15);
#pragma unroll
        for (int ai = 0; ai < 2; ++ai)
#pragma unroll
            for (int m = 0; m < 4; ++m) { const size_t row = (size_t)(u.pm * BM + ai * HALF + wr * 64 + m * 16 + fr);
#pragma unroll
                for (int n = 0; n < 2; ++n) {
                    const f32x4 cur = acc[ai][0][m][n];
                    f32x4 e1, e2, r1, r2;
                    if (m > 0) { const f32x4 pg = acc[ai][0][m > 0 ? m - 1 : 0][n];
#pragma unroll
                        for (int j = 0; j < 4; ++j) { e1[j] = shfl_(pg[j], src1); e2[j] = shfl_(pg[j], src2); } }
                    else { const int rb = 2 * ai + wr;
                        if (rb > 0) { const f32x4 x62 = *(const PG8_LAS f32x4*)(xch + ((rb - 1) * 2 + 0) * 128 + cc0 + 16 * n), x63 = *(const PG8_LAS f32x4*)(xch + ((rb - 1) * 2 + 1) * 128 + cc0 + 16 * n);
                            e1 = x63; e2 = (fr == 0) ? x62 : x63; }
                        else { e1 = (f32x4){0.f, 0.f, 0.f, 0.f}; e2 = e1; } }
#pragma unroll
                    for (int j = 0; j < 4; ++j) { r1[j] = shfl_(cur[j], src1); r2[j] = shfl_(cur[j], src2); }
                    const f32x4 p1 = (fr >= 1) ? r1 : e1, p2 = (fr >= 2) ? r2 : e2;
                    const f32x4 cv = c2[n] * cur + c1[n] * p1 + c0[n] * p2;
                    const f32x4 vv = acc[ai][1][m][n];
                    u32x2 w; w.x = cvt_pk_bf16(gelu_tanh_f(cv[0]) * vv[0], gelu_tanh_f(cv[1]) * vv[1]); w.y = cvt_pk_bf16(gelu_tanh_f(cv[2]) * vv[2], gelu_tanh_f(cv[3]) * vv[3]);
                    *(u32x2*)(ACT + row * 2816 + colg + 16 * n) = w; } }
    }
};
}

constexpr int D = 1024, BATCH = 16, SEQ = 2048, DEPTH = 2, M = BATCH * SEQ;
constexpr int NMIX = 3600, NMIXP = 3840, NIN = 7696, DFF = 2816, PLE = 256, NCHUNK = SEQ / 64;
constexpr float ALPHA = 1.41421356237f;
constexpr float LN_EPS = 1e-5f;
constexpr int NWAVES = 8;
#ifndef ONE_LAUNCH
#define ONE_LAUNCH 1
#endif

constexpr size_t MiB = 1u << 20;
constexpr size_t WS_CTL = 0, CTL_ZERO_BYTES = 1 * MiB;
constexpr size_t WS_W = 1 * MiB, W_LAYER = 39 * MiB;
constexpr size_t WO_IN = 0, WO_G = 15 * MiB / 2, WO_B = 31 * MiB / 2, WO_MIX = 35 * MiB / 2, WO_UP = 39 * MiB / 2, WO_DN = 61 * MiB / 2, WO_PG = 36 * MiB, WO_PP = 38 * MiB;
constexpr size_t WS_PB = 79 * MiB;
constexpr size_t WS_XB = 111 * MiB;
constexpr size_t WS_R2 = 175 * MiB;
constexpr size_t R2_PPLE = 176 * MiB;
constexpr size_t WS_ROPE = 431 * MiB;
constexpr size_t WS_HALO = 432 * MiB, HALO_ONE = (size_t)128 * 2 * DFF * 4;
constexpr size_t WS_RST = 442 * MiB;
constexpr size_t WS_PPLE = 444 * MiB;
constexpr size_t WS_END = 508 * MiB;
static_assert(WS_HALO + 3 * HALO_ONE <= WS_END && WS_R2 + 256 * MiB <= WS_ROPE, "ws map");
constexpr int CW_BAR = 4096;

constexpr int LDS_BYTES = 163840;
constexpr int LDS_XCH = 131072;
constexpr int LDS_MISC = 163840 - 256;

#define LAS __attribute__((address_space(3)))
typedef unsigned short bf16;
typedef float f32x4 __attribute__((ext_vector_type(4)));
typedef unsigned v4u __attribute__((ext_vector_type(4)));
typedef unsigned v2u __attribute__((ext_vector_type(2)));
#define LDS_WAIT() asm volatile("s_waitcnt lgkmcnt(0)" ::: "memory")
using pg8::cvt_pk_bf16; using pg8::bf_lo; using pg8::bf_hi; using pg8::sigmoid_f;

#define XB_TMO      128
#define XB_XCNT(j)  (256  + 64 * (j))
#define XB_XSUB(j)  (1280 + 64 * (j))
#define XB_XGEN(j)  (2304 + 64 * (j))
#define XB_TOP      3328
#define XB_TOPGEN   3392
#define XCD_BAR_WORDS 3456
#define XB_SPIN_CAP (1u << 18)
__device__ __forceinline__ NOPK unsigned xb_ld(unsigned* p)              { return __hip_atomic_load(p, __ATOMIC_RELAXED, __HIP_MEMORY_SCOPE_AGENT); }
__device__ __forceinline__ NOPK unsigned xb_add(unsigned* p, unsigned v) { return __hip_atomic_fetch_add(p, v, __ATOMIC_RELAXED, __HIP_MEMORY_SCOPE_AGENT); }
__device__ __forceinline__ NOPK unsigned xb_xcc_id() { return (unsigned)__builtin_amdgcn_s_getreg((3 << 11) | 20) & 0xFu; }
#define XB_SPIN(cond, bar) do { unsigned _sp = 0; while (cond) { __builtin_amdgcn_s_sleep(1); \
    if ((++_sp & 255u) == 0u) { if (xb_ld(&(bar)[XB_TMO])) break; if (_sp > XB_SPIN_CAP) { (void)xb_add(&(bar)[XB_TMO], 1u); break; } } } } while (0)
struct XcdBarrier { unsigned* bar; unsigned x; volatile LAS unsigned* st; };
__device__ __forceinline__ NOPK XcdBarrier xcd_barrier_post(unsigned* bar, volatile LAS unsigned* st) {
    XcdBarrier b; b.bar = bar; b.x = xb_xcc_id(); b.st = st;
    if (threadIdx.x == 0) (void)xb_add(&bar[XB_XCNT(b.x)], 1u);
    return b;
}
__device__ __forceinline__ NOPK void xcd_barrier_complete(unsigned* bar, unsigned x, unsigned& nloc, unsigned& nx) {
    const unsigned G = gridDim.x * gridDim.y * gridDim.z;
    unsigned sum, cnt, mine, sp = 0u;
    for (;;) {
        sum = 0u; cnt = 0u; mine = 0u;
#pragma unroll
        for (unsigned j = 0; j < 16; ++j) { const unsigned c = xb_ld(&bar[XB_XCNT(j)]); sum += c; cnt += (c > 0u) ? 1u : 0u; mine = (j == x) ? c : mine; }
        if (sum == G) break;
        __builtin_amdgcn_s_sleep(1);
        if ((++sp & 255u) == 0u) { if (xb_ld(&bar[XB_TMO])) break; if (sp > XB_SPIN_CAP) { (void)xb_add(&bar[XB_TMO], 1u); break; } }
    }
    nloc = mine > 0u ? mine : 1u; nx = cnt > 0u ? cnt : 1u;
}
__device__ __forceinline__ NOPK void xcd_barrier(const XcdBarrier& b) {
    asm volatile("s_waitcnt vmcnt(0)" ::: "memory");
    sync_wg();
    if (threadIdx.x == 0) {
        unsigned* bar = b.bar;
        __builtin_amdgcn_s_waitcnt(0);
        unsigned nloc = b.st[0], nx = b.st[1];
        if (nloc == 0u) { xcd_barrier_complete(bar, b.x, nloc, nx); b.st[0] = nloc; b.st[1] = nx; }
        const unsigned old = xb_add(&bar[XB_XSUB(b.x)], 1u);
        const unsigned gen = old / nloc;
        if (old + 1u == (gen + 1u) * nloc) {
            __builtin_amdgcn_fence(__ATOMIC_RELEASE, "agent");
            asm volatile("s_waitcnt vmcnt(0)" ::: "memory");
            const unsigned og = xb_add(&bar[XB_TOP], 1u);
            const unsigned tg = og / nx;
            if (og + 1u == (tg + 1u) * nx) xb_add(&bar[XB_TOPGEN], 1u);
            else XB_SPIN(xb_ld(&bar[XB_TOPGEN]) == tg, bar);
            __builtin_amdgcn_fence(__ATOMIC_ACQUIRE, "agent");
            xb_add(&bar[XB_XGEN(b.x)], 1u);
            asm volatile("s_waitcnt vmcnt(0)" ::: "memory");
        } else {
            XB_SPIN(xb_ld(&bar[XB_XGEN(b.x)]) == gen, bar);
            __builtin_amdgcn_fence(__ATOMIC_ACQUIRE, "agent");
            asm volatile("s_waitcnt vmcnt(0)" ::: "memory");
        }
    }
    sync_wg();
}

struct Params {
    const float* in[32];
    float* out; unsigned char* ws;
    int ph_lo, ph_hi;
};
enum { I_X = 0, I_P, I_LNINW, I_LNINB, I_WIN, I_MU, I_W0, I_W2, I_A0, I_A2, I_G2, I_KK, I_KA, I_RK, I_RLNW, I_RLNB, I_GLAW2, I_GLAB, I_GLANW, I_HLB, I_HNW,
       I_WBR, I_WMIX, I_LNMW, I_LNMB, I_WUP, I_CONV, I_WDN, I_WPG, I_WPP, I_LNFW, I_LNFB };

typedef const __attribute__((address_space(4))) Params* KP;
__device__ __forceinline__ NOPK KP kparams() { KP p = (KP)__builtin_amdgcn_kernarg_segment_ptr(); asm volatile("" : "+s"(p)); return p; }
__device__ __forceinline__ NOPK float wave_sum(float v) {
#pragma unroll
    for (int o = 1; o < 64; o <<= 1) v += shfl_xor_(v, o);
    return v;
}
__device__ __forceinline__ NOPK int opaque_tid() { int t = threadIdx.x; asm volatile("" : "+v"(t)); return t; }
__device__ __forceinline__ NOPK float red8(float v) { v += shfl_xor_(v, 1); v += shfl_xor_(v, 2); v += shfl_xor_(v, 4); return v; }

__constant__ double ROPE_THETA[16] = {1.0, 0.5411695265464637, 0.2928644564625237, 0.15848931924611134, 0.08576958985908942, 0.046415888336127795, 0.025118864315095794, 0.013593563908785255, 0.007356422544596414, 0.003981071705534973, 0.0021544346900318843, 0.0011659144011798323, 0.000630957344480193, 0.0003414548873833601, 0.00018478497974222906, 0.0001};
__device__ __forceinline__ NOPK int map_row(int mode, int c) {
    if (mode == 1) { const int b = c >> 10, of = c & 1023, pn = of >> 6, oc = of & 63; return 256 * pn + 128 * (b >> 1) + 32 * (oc >> 4) + 16 * (b & 1) + (oc & 15); }
    if (mode == 2) { return c < DFF ? 256 * (c >> 7) + (c & 127) : 256 * ((c - DFF) >> 7) + 128 + ((c - DFF) & 127); }
    return c;
}
__device__ __forceinline__ NOPK void cvt_item(const float* W, int K, int srcld, int c0, int cnt, bf16* dst, int mode, LAS float* scr, int item, int lane) {
    const int nblk = (cnt + 31) / 32, kb = item / nblk, nb = item % nblk, k0 = 64 * kb, n0 = 32 * nb;
    const bool okr = (n0 + (lane & 31)) < cnt;
    float xin[32];
#pragma unroll
    for (int i = 0; i < 32; ++i) { const int kk = 2 * i + (lane >> 5); xin[i] = okr ? W[(size_t)(k0 + kk) * srcld + c0 + n0 + (lane & 31)] : 0.f; }
#pragma unroll
    for (int i = 0; i < 32; ++i) { const int kk = 2 * i + (lane >> 5); scr[kk * 33 + (lane & 31)] = xin[i]; }
    LDS_WAIT(); asm volatile("" ::: "memory");
    const int c = lane & 7;
#pragma unroll
    for (int j = 0; j < 4; ++j) { const int n = (lane >> 3) + 8 * j; const LAS float* s = scr + (8 * c) * 33 + n;
        v4u o; o.x = cvt_pk_bf16(s[0 * 33], s[1 * 33]); o.y = cvt_pk_bf16(s[2 * 33], s[3 * 33]); o.z = cvt_pk_bf16(s[4 * 33], s[5 * 33]); o.w = cvt_pk_bf16(s[6 * 33], s[7 * 33]);
        if (n0 + n < cnt) *(v4u*)(dst + (size_t)map_row(mode, n0 + n) * K + k0 + 8 * c) = o; }
    LDS_WAIT(); asm volatile("" ::: "memory");
}
struct CvtJob { const float* W; int K, srcld, c0, cnt, mode; bf16* dst; int items; };
__device__ __forceinline__ NOPK CvtJob get_job(KP P, int j) {
    const int l = j / 11, k = j % 11; unsigned char* wl = P->ws + WS_W + (size_t)l * W_LAYER; CvtJob J;
    if (k == 0)      { J.W = P->in[I_WIN] + (size_t)l * D * NIN; J.K = D; J.srcld = NIN; J.c0 = 0; J.cnt = NMIX; J.mode = 0; J.dst = (bf16*)(wl + WO_IN); }
    else if (k == 1) { J.W = P->in[I_WIN] + (size_t)l * D * NIN; J.K = D; J.srcld = NIN; J.c0 = NMIX; J.cnt = 4096; J.mode = 1; J.dst = (bf16*)(wl + WO_G); }
    else if (k < 6)  { const int b = k - 2; J.W = P->in[I_WBR] + (size_t)(l * 4 + b) * 256 * D; J.K = 256; J.srcld = D; J.c0 = 0; J.cnt = D; J.mode = 0; J.dst = (bf16*)(wl + WO_B) + (size_t)b * D * 256; }
    else if (k == 6) { J.W = P->in[I_WMIX] + (size_t)l * D * D; J.K = D; J.srcld = D; J.c0 = 0; J.cnt = D; J.mode = 0; J.dst = (bf16*)(wl + WO_MIX); }
    else if (k == 7) { J.W = P->in[I_WUP] + (size_t)l * D * 2 * DFF; J.K = D; J.srcld = 2 * DFF; J.c0 = 0; J.cnt = 2 * DFF; J.mode = 2; J.dst = (bf16*)(wl + WO_UP); }
    else if (k == 8) { J.W = P->in[I_WDN] + (size_t)l * DFF * D; J.K = DFF; J.srcld = D; J.c0 = 0; J.cnt = D; J.mode = 0; J.dst = (bf16*)(wl + WO_DN); }
    else if (k == 9) { J.W = P->in[I_WPG] + (size_t)l * D * D; J.K = D; J.srcld = D; J.c0 = 0; J.cnt = D; J.mode = 0; J.dst = (bf16*)(wl + WO_PG); }
    else             { J.W = P->in[I_WPP] + (size_t)l * PLE * D; J.K = PLE; J.srcld = D; J.c0 = 0; J.cnt = D; J.mode = 0; J.dst = (bf16*)(wl + WO_PP); }
    J.items = (J.K / 64) * ((J.cnt + 31) / 32);
    return J;
}
__device__ __forceinline__ NOPK void ln_row2(const float* x0, const float* x1, const float* w, const float* b, bf16* o0, bf16* o1, float* f0, float* f1, int lane) {
    const f32x4* xr0 = (const f32x4*)x0 + lane; const f32x4* xr1 = (const f32x4*)x1 + lane;
    f32x4 v0[4], v1[4]; float s0 = 0.f, s1 = 0.f;
#pragma unroll
    for (int j = 0; j < 4; ++j) { v0[j] = xr0[64 * j]; v1[j] = xr1[64 * j]; }
#pragma unroll
    for (int j = 0; j < 4; ++j) { s0 += (v0[j].x + v0[j].y) + (v0[j].z + v0[j].w); s1 += (v1[j].x + v1[j].y) + (v1[j].z + v1[j].w); }
    const float mean0 = wave_sum(s0) * (1.f / D), mean1 = wave_sum(s1) * (1.f / D); float q0 = 0.f, q1 = 0.f;
#pragma unroll
    for (int j = 0; j < 4; ++j) { v0[j] = v0[j] - mean0; v1[j] = v1[j] - mean1; q0 += (v0[j].x * v0[j].x + v0[j].y * v0[j].y) + (v0[j].z * v0[j].z + v0[j].w * v0[j].w); q1 += (v1[j].x * v1[j].x + v1[j].y * v1[j].y) + (v1[j].z * v1[j].z + v1[j].w * v1[j].w); }
    const float rstd0 = 1.f / sqrtf(wave_sum(q0) * (1.f / D) + LN_EPS), rstd1 = 1.f / sqrtf(wave_sum(q1) * (1.f / D) + LN_EPS);
#pragma unroll
    for (int j = 0; j < 4; ++j) { const f32x4 wv = ((const f32x4*)w)[lane + 64 * j], bv = ((const f32x4*)b)[lane + 64 * j]; const f32x4 a0 = v0[j] * rstd0 * wv + bv, a1 = v1[j] * rstd1 * wv + bv;
        if (o0) { v2u pk; pk.x = cvt_pk_bf16(a0.x, a0.y); pk.y = cvt_pk_bf16(a0.z, a0.w); ((v2u*)o0)[lane + 64 * j] = pk; pk.x = cvt_pk_bf16(a1.x, a1.y); pk.y = cvt_pk_bf16(a1.z, a1.w); ((v2u*)o1)[lane + 64 * j] = pk; }
        if (f0) { ((f32x4*)f0)[lane + 64 * j] = a0; ((f32x4*)f1)[lane + 64 * j] = a1; } }
}
__device__ __forceinline__ NOPK void ln_phase(const float* V, const float* w, const float* b, bf16* XB, float* OUTF) {
    const int tid = opaque_tid(), lane = tid & 63, gw = blockIdx.x * NWAVES + (tid >> 6), NGW = gridDim.x * NWAVES;
    for (int m = 2 * gw; m < M; m += 2 * NGW) ln_row2(V + (size_t)m * D, V + (size_t)(m + 1) * D, w, b, XB ? XB + (size_t)m * D : nullptr, XB ? XB + (size_t)(m + 1) * D : nullptr,
                                                   OUTF ? OUTF + (size_t)m * D : nullptr, OUTF ? OUTF + (size_t)(m + 1) * D : nullptr, lane);
}
__device__ __forceinline__ NOPK void prologue(KP P, LAS unsigned char* lds) {
    const int tid = opaque_tid(), lane = tid & 63, wave = __builtin_amdgcn_readfirstlane(tid >> 6);
    LAS float* scr = (LAS float*)(lds + wave * 16384);
    const int gw = blockIdx.x * NWAVES + wave, NGW = gridDim.x * NWAVES;
    const int gt = blockIdx.x * (NWAVES * 64) + tid, NGT = gridDim.x * NWAVES * 64;
    int total = 0;
    for (int j = 0; j < 22; ++j) total += get_job(P, j).items;
    for (int it = gw; it < total; it += NGW) {
        int r = it, j = 0; CvtJob J = get_job(P, 0);
        while (r >= J.items) { r -= J.items; ++j; J = get_job(P, j); }
        cvt_item(J.W, J.K, J.srcld, J.c0, J.cnt, J.dst, J.mode, scr, r, lane);
    }
    for (int l = 0; l < DEPTH; ++l) { v4u* z = (v4u*)((bf16*)(P->ws + WS_W + (size_t)l * W_LAYER + WO_IN) + (size_t)NMIX * D);
        for (int i = gt; i < (NMIXP - NMIX) * D / 8; i += NGT) z[i] = (v4u){0u, 0u, 0u, 0u}; }
    { const f32x4* ps = (const f32x4*)P->in[I_P]; v2u* pd = (v2u*)(P->ws + WS_PB);
        constexpr size_t NP4 = (size_t)DEPTH * M * PLE / 4;
        for (size_t i = gt; i < NP4; i += (size_t)4 * NGT) { f32x4 v[4];
#pragma unroll
            for (int q = 0; q < 4; ++q) if (i + (size_t)q * NGT < NP4) v[q] = ps[i + (size_t)q * NGT];
#pragma unroll
            for (int q = 0; q < 4; ++q) if (i + (size_t)q * NGT < NP4) { v2u o; o.x = cvt_pk_bf16(v[q].x, v[q].y); o.y = cvt_pk_bf16(v[q].z, v[q].w); pd[i + (size_t)q * NGT] = o; } } }
    { f32x2g* rt = (f32x2g*)(P->ws + WS_ROPE);
        for (int i = gt; i < SEQ * 16; i += NGT) { const int t = i >> 4, k = i & 15; const double a = (double)t * ROPE_THETA[k];
            const double n = __builtin_rint(a * 0.15915494309189535); const double r = a - n * 6.283185307179586, r2 = r * r;
            double ts = r, ss = r, tc = 1.0, sc = 1.0;
            for (int q = 1; q <= 14; ++q) { tc *= -r2 / (double)((2 * q - 1) * (2 * q)); sc += tc; ts *= -r2 / (double)((2 * q) * (2 * q + 1)); ss += ts; }
            rt[i] = (f32x2g){(float)sc, (float)ss}; } }
    ln_phase(P->in[I_X], P->in[I_LNINW], P->in[I_LNINB], (bf16*)(P->ws + WS_XB), nullptr);
}

#ifndef REP_PREP
#define REP_PREP 1
#endif
#ifndef REP_REC
#define REP_REC 1
#endif

__device__ __forceinline__ NOPK void ld8(const bf16* p, float (&o)[8]) { const v4u w = *(const v4u*)p; o[0] = bf_lo(w.x); o[1] = bf_hi(w.x); o[2] = bf_lo(w.y); o[3] = bf_hi(w.y); o[4] = bf_lo(w.z); o[5] = bf_hi(w.z); o[6] = bf_lo(w.w); o[7] = bf_hi(w.w); }
__device__ __forceinline__ NOPK void st8(bf16* p, const float (&o)[8]) { v4u w; w.x = cvt_pk_bf16(o[0], o[1]); w.y = cvt_pk_bf16(o[2], o[3]); w.z = cvt_pk_bf16(o[4], o[5]); w.w = cvt_pk_bf16(o[6], o[7]); *(v4u*)p = w; }
__device__ __forceinline__ NOPK float sigmoid_acc(float x) { return __builtin_amdgcn_rcpf(1.0f + __expf(-x)); }
__device__ __forceinline__ NOPK float tanh_fast(float x) { return 2.0f * __builtin_amdgcn_rcpf(1.0f + __expf(-2.0f * x)) - 1.0f; }

template <int MX>
__device__ __forceinline__ NOPK void linattn_task(LAS float* sm, KP P, int layer, int b, int h) {
    constexpr int DK = (MX == 3) ? 64 : 32;
    const int tid = opaque_tid();
    LAS float* sq = sm;
    LAS float* sk = sm + 4096;
    LAS float* seg = sm + 8192;
    LAS float* sv = sm + 12288;
    LAS float* sg = sm + 16384;
    LAS float* so = sm + 20480;
    LAS float* sx = sm + 24576;
    const bf16* Z = (const bf16*)(P->ws + WS_R2);
    bf16* O = (bf16*)P->out;
    const int t8 = tid >> 3, e0 = (tid & 7) * 8;
    float S[DK];
#pragma unroll
    for (int d = 0; d < DK; ++d) S[d] = 0.f;
    float nw[8];
#pragma unroll
    for (int i = 0; i < 8; ++i) nw[i] = (MX == 2) ? P->in[I_GLANW][layer * 64 + e0 + i] : (MX == 3) ? P->in[I_HNW][layer * 64 + e0 + i] : 1.f;
#pragma unroll 1
    for (int c = 0; c < NCHUNK; ++c) {
        const size_t rowbase = (size_t)b * SEQ + c * 64;
        if (MX == 0) {
            const f32x2g* rope = (const f32x2g*)(P->ws + WS_ROPE);
#pragma unroll
            for (int i = 0; i < 2; ++i) { const int idx = tid + 512 * i, t = idx >> 4, pi = idx & 15; const bf16* zr = Z + (rowbase + t) * NMIXP;
                const unsigned qw = *(const unsigned*)(zr + h * 32 + 2 * pi), kw = *(const unsigned*)(zr + 128 + h * 32 + 2 * pi);
                const f32x2g cs = rope[(c * 64 + t) * 16 + pi];
                const float q1 = bf_lo(qw), q2 = bf_hi(qw), k1 = bf_lo(kw) * 0.17677669529663687f, k2 = bf_hi(kw) * 0.17677669529663687f;
                sq[t * DK + 2 * pi] = q1 * cs.x - q2 * cs.y; sq[t * DK + 2 * pi + 1] = q1 * cs.y + q2 * cs.x;
                sk[t * DK + 2 * pi] = k1 * cs.x - k2 * cs.y; sk[t * DK + 2 * pi + 1] = k1 * cs.y + k2 * cs.x; }
            const float gam = 1.0f - exp2f(-5.0f - (float)h);
#pragma unroll
            for (int i = 0; i < 4; ++i) seg[tid + 512 * i] = gam;
            const bf16* zr = Z + (rowbase + t8) * NMIXP; float a[8];
            ld8(zr + 256 + h * 64 + e0, a);
#pragma unroll
            for (int i = 0; i < 8; ++i) sv[t8 * 64 + e0 + i] = a[i];
            ld8(zr + 512 + h * 64 + e0, a);
#pragma unroll
            for (int i = 0; i < 8; ++i) sg[t8 * 64 + e0 + i] = a[i];
        } else if (MX == 2) {
            LAS float* sgl = sx; LAS float* sw2 = sx + 1024; LAS float* sbb = sx + 1536;
            const bf16* zr = Z + (rowbase + t8) * NMIXP + 1792; const int d0 = (tid & 7) * 4;
            { const v2u qw = *(const v2u*)(zr + h * 32 + d0), kw = *(const v2u*)(zr + 128 + h * 32 + d0);
              sq[t8 * DK + d0] = bf_lo(qw.x) * 0.17677669529663687f; sq[t8 * DK + d0 + 1] = bf_hi(qw.x) * 0.17677669529663687f; sq[t8 * DK + d0 + 2] = bf_lo(qw.y) * 0.17677669529663687f; sq[t8 * DK + d0 + 3] = bf_hi(qw.y) * 0.17677669529663687f;
              sk[t8 * DK + d0] = bf_lo(kw.x); sk[t8 * DK + d0 + 1] = bf_hi(kw.x); sk[t8 * DK + d0 + 2] = bf_lo(kw.y); sk[t8 * DK + d0 + 3] = bf_hi(kw.y); }
            float a[8];
            ld8(zr + 256 + h * 64 + e0, a);
#pragma unroll
            for (int i = 0; i < 8; ++i) sv[t8 * 64 + e0 + i] = a[i];
            ld8(zr + 528 + h * 64 + e0, a);
#pragma unroll
            for (int i = 0; i < 8; ++i) sg[t8 * 64 + e0 + i] = a[i];
            if (tid < 128) { const int t = tid >> 1, j0 = (tid & 1) * 8; ld8(Z + (rowbase + t) * NMIXP + 1792 + 512 + j0, a);
#pragma unroll
                for (int i = 0; i < 8; ++i) sgl[t * 16 + j0 + i] = a[i]; }
            sw2[tid] = P->in[I_GLAW2][(size_t)layer * 16 * 128 + (tid >> 5) * 128 + h * 32 + (tid & 31)];
            if (tid < 32) sbb[tid] = P->in[I_GLAB][layer * 128 + h * 32 + tid];
            sync_wg();
#pragma unroll
            for (int i = 0; i < 4; ++i) { const int idx = tid + 512 * i, t = idx >> 5, d = idx & 31; float acc = sbb[d];
#pragma unroll
                for (int j = 0; j < 16; ++j) acc += sgl[t * 16 + j] * sw2[j * 32 + d];
                const float ls = fminf(acc, 0.f) - log1pf(__expf(-fabsf(acc)));
                seg[t * DK + d] = __expf(ls * 0.0625f); }
        } else {
            const bf16* zr = Z + (rowbase + t8) * NMIXP + 2576; float a[8], f[8];
            ld8(zr + h * 64 + e0, a);
#pragma unroll
            for (int i = 0; i < 8; ++i) sq[t8 * DK + e0 + i] = a[i];
            ld8(zr + 256 + h * 64 + e0, f);
#pragma unroll
            for (int i = 0; i < 8; ++i) { float lb = 0.f;
                if (layer > 0) lb = sigmoid_acc(P->in[I_HLB][256 + h * 64 + e0 + i] - P->in[I_HLB][h * 64 + e0 + i]);
                seg[t8 * DK + e0 + i] = lb + (1.f - lb) * sigmoid_acc(f[i]); sk[t8 * DK + e0 + i] = (1.f - lb) * sigmoid_acc(-f[i]); }
            ld8(zr + 512 + h * 64 + e0, a);
#pragma unroll
            for (int i = 0; i < 8; ++i) sv[t8 * 64 + e0 + i] = a[i];
            ld8(zr + 768 + h * 64 + e0, a);
#pragma unroll
            for (int i = 0; i < 8; ++i) sg[t8 * 64 + e0 + i] = a[i];
        }
        sync_wg();
        if (tid < 64) {
#pragma unroll 1
            for (int t = 0; t < 64; ++t) { const float vv = sv[t * 64 + tid]; float o = 0.f;
#pragma unroll
                for (int d = 0; d < DK; ++d) { S[d] = seg[t * DK + d] * S[d] + sk[t * DK + d] * vv; o += sq[t * DK + d] * S[d]; }
                so[t * 64 + tid] = o; }
        }
        sync_wg();
        { float ov[8], y[8]; float s = 0.f;
#pragma unroll
            for (int i = 0; i < 8; ++i) { ov[i] = so[t8 * 64 + e0 + i]; s += (MX == 0) ? ov[i] : ov[i] * ov[i]; }
            s = red8(s);
            if (MX == 0) { const float mean = s * (1.f / 64.f); float q = 0.f;
#pragma unroll
                for (int i = 0; i < 8; ++i) { ov[i] -= mean; q += ov[i] * ov[i]; }
                q = red8(q); const float rs = 1.0f / sqrtf(q * (1.f / 64.f) + 1e-6f);
#pragma unroll
                for (int i = 0; i < 8; ++i) y[i] = ov[i] * rs;
            } else { const float rs = 1.0f / sqrtf(s * (1.f / 64.f) + 1e-6f);
#pragma unroll
                for (int i = 0; i < 8; ++i) y[i] = ov[i] * rs * nw[i]; }
#pragma unroll
            for (int i = 0; i < 8; ++i) { const float gv = sg[t8 * 64 + e0 + i]; y[i] *= gv * sigmoid_acc(gv); }
            st8(O + (rowbase + t8) * D + MX * 256 + h * 64 + e0, y); }
        sync_wg();
    }
}

typedef short bf16x8v __attribute__((ext_vector_type(8)));
#define SWZ(r, c) ((r) * 64 + ((((c) >> 3) ^ ((r) & 7)) << 3) + ((c) & 7))
__device__ __forceinline__ NOPK bf16x8v frag64(const LAS bf16* arr, int row, int ch) { return *(const LAS bf16x8v*)(arr + row * 64 + ((ch ^ (row & 7)) << 3)); }
template <int MX>
__device__ __forceinline__ NOPK void linattn_fast(LAS unsigned char* lds, KP P, int layer, int b, int h) {
    constexpr int DK = (MX == 3) ? 64 : 32, NDT = DK / 16, NKS = DK / 32, QN = DK / 8;
    asm volatile("" : "+s"(h), "+s"(b));
    const int tid = opaque_tid(), lane = tid & 63, wave = __builtin_amdgcn_readfirstlane(tid >> 6), fr = lane & 15, fq = lane >> 4;
    LAS float* slg = (LAS float*)lds;
    LAS bf16* sQ = (LAS bf16*)(lds + 16384); LAS bf16* sK = (LAS bf16*)(lds + 24576); LAS bf16* sKT = (LAS bf16*)(lds + 32768); LAS bf16* sVT = (LAS bf16*)(lds + 40960);
    LAS bf16* sP = (LAS bf16*)(lds + 49152); LAS bf16* sST = (LAS bf16*)(lds + 57344); LAS bf16* sG = (LAS bf16*)(lds + 65536);
    LAS float* sw2 = (LAS float*)(lds + 73728); LAS float* sbb = sw2 + 512;
    const bf16* Z = (const bf16*)(P->ws + WS_R2);
    bf16* O = (bf16*)P->out;
    const int t8 = tid >> 3, e0 = (tid & 7) * 8, dd0 = (tid & 7) * QN;
    constexpr int zbase = (MX == 0) ? 0 : (MX == 2) ? 1792 : 2576;
    constexpr int qcol = 0, kcol = (MX == 3) ? 256 : 128, vcol = (MX == 3) ? 512 : 256, gcol = (MX == 0) ? 512 : (MX == 2) ? 528 : 768;
    const float lgam = (MX == 0) ? logf(1.0f - exp2f(-5.0f - (float)h)) : 0.f;
    sync_wg();
    if (MX == 2) { sw2[tid] = P->in[I_GLAW2][(size_t)layer * 16 * 128 + (tid >> 5) * 128 + h * 32 + (tid & 31)]; if (tid < 32) sbb[tid] = P->in[I_GLAB][layer * 128 + h * 32 + tid]; sync_wg(); }
    float lbv[8];
#pragma unroll
    for (int i = 0; i < 8; ++i) { lbv[i] = 0.f; if (MX == 3 && layer > 0) lbv[i] = sigmoid_acc(P->in[I_HLB][256 + h * 64 + e0 + i] - P->in[I_HLB][h * 64 + e0 + i]); }
    float nw[16];
#pragma unroll
    for (int i = 0; i < 16; ++i) { const int e = 16 * (i >> 2) + 4 * fq + (i & 3); nw[i] = (MX == 2) ? P->in[I_GLANW][layer * 64 + e] : (MX == 3) ? P->in[I_HNW][layer * 64 + e] : 1.f; }
    f32x4 S[NDT];
#pragma unroll
    for (int i = 0; i < NDT; ++i) S[i] = (f32x4){0.f, 0.f, 0.f, 0.f};
#pragma unroll 1
    for (int c = 0; c < NCHUNK; ++c) {
        const size_t rowbase = (size_t)b * SEQ + c * 64;
        const bf16* zr = Z + (rowbase + t8) * NMIXP + zbase;
        float qr[QN], kr[QN];
        { const v4u vw = *(const v4u*)(zr + vcol + h * 64 + e0);
          const unsigned vv[4] = {vw.x, vw.y, vw.z, vw.w};
#pragma unroll
          for (int i = 0; i < 4; ++i) { sVT[SWZ(e0 + 2 * i, t8)] = (bf16)(vv[i] & 0xffffu); sVT[SWZ(e0 + 2 * i + 1, t8)] = (bf16)(vv[i] >> 16); }
          *(LAS v4u*)(sG + SWZ(t8, e0)) = *(const v4u*)(zr + gcol + h * 64 + e0); }
        if (MX == 3) {
            float a[8], f[8]; ld8(zr + qcol + h * 64 + e0, a); ld8(zr + kcol + h * 64 + e0, f);
#pragma unroll
            for (int i = 0; i < 8; ++i) { qr[i] = a[i]; const float ff = lbv[i] + (1.f - lbv[i]) * sigmoid_acc(f[i]); kr[i] = (1.f - lbv[i]) * sigmoid_acc(-f[i]); slg[t8 * 64 + e0 + i] = logf(ff); }
        } else {
            const v2u qw = *(const v2u*)(zr + qcol + h * 32 + dd0), kw = *(const v2u*)(zr + kcol + h * 32 + dd0);
            float q4[4] = {bf_lo(qw.x), bf_hi(qw.x), bf_lo(qw.y), bf_hi(qw.y)}, k4[4] = {bf_lo(kw.x), bf_hi(kw.x), bf_lo(kw.y), bf_hi(kw.y)};
            if (MX == 0) { const f32x2g* rope = (const f32x2g*)(P->ws + WS_ROPE) + (c * 64 + t8) * 16 + (dd0 >> 1);
#pragma unroll
                for (int p2 = 0; p2 < 2; ++p2) { const f32x2g cs = rope[p2]; const float q1 = q4[2 * p2], q2 = q4[2 * p2 + 1], k1 = k4[2 * p2] * 0.17677669529663687f, k2 = k4[2 * p2 + 1] * 0.17677669529663687f;
                    qr[2 * p2] = q1 * cs.x - q2 * cs.y; qr[2 * p2 + 1] = q1 * cs.y + q2 * cs.x; kr[2 * p2] = k1 * cs.x - k2 * cs.y; kr[2 * p2 + 1] = k1 * cs.y + k2 * cs.x; }
            } else { float gl[16]; { float a[8]; ld8(zr + 512, a);
#pragma unroll
                    for (int i = 0; i < 8; ++i) gl[i] = a[i];
                    ld8(zr + 520, a);
#pragma unroll
                    for (int i = 0; i < 8; ++i) gl[8 + i] = a[i]; }
#pragma unroll
                for (int i = 0; i < 4; ++i) { qr[i] = q4[i] * 0.17677669529663687f; kr[i] = k4[i]; float acc = sbb[dd0 + i];
#pragma unroll
                    for (int j = 0; j < 16; ++j) acc += gl[j] * sw2[j * 32 + dd0 + i];
                    slg[t8 * 64 + dd0 + i] = (fminf(acc, 0.f) - log1pf(__expf(-fabsf(acc)))) * 0.0625f; } }
        }
        if (MX != 0) {
            sync_wg();
            if (tid < DK) { float run = 0.f;
#pragma unroll 1
                for (int tb = 0; tb < 64; tb += 16) { float x[16];
#pragma unroll
                    for (int i = 0; i < 16; ++i) x[i] = slg[(tb + i) * 64 + tid];
#pragma unroll
                    for (int i = 0; i < 16; ++i) { run += x[i]; x[i] = run; }
#pragma unroll
                    for (int i = 0; i < 16; ++i) slg[(tb + i) * 64 + tid] = x[i]; } }
            sync_wg();
        }
        { float qs[QN], ks[QN];
#pragma unroll
          for (int i = 0; i < QN; ++i) { float dq;
              if (MX == 0) dq = (float)(t8 - 31) * lgam; else dq = slg[t8 * 64 + dd0 + i] - slg[31 * 64 + dd0 + i];
              qs[i] = qr[i] * __expf(dq); ks[i] = kr[i] * __expf(-dq); }
          if (QN == 8) { v4u o; o.x = cvt_pk_bf16(qs[0], qs[1]); o.y = cvt_pk_bf16(qs[2], qs[3]); o.z = cvt_pk_bf16(qs[4], qs[5]); o.w = cvt_pk_bf16(qs[6], qs[7]); *(LAS v4u*)(sQ + SWZ(t8, dd0)) = o;
                         v4u p; p.x = cvt_pk_bf16(ks[0], ks[1]); p.y = cvt_pk_bf16(ks[2], ks[3]); p.z = cvt_pk_bf16(ks[4], ks[5]); p.w = cvt_pk_bf16(ks[6], ks[7]); *(LAS v4u*)(sK + SWZ(t8, dd0)) = p; }
          else { v2u o; o.x = cvt_pk_bf16(qs[0], qs[1]); o.y = cvt_pk_bf16(qs[2], qs[3]); *(LAS v2u*)(sQ + SWZ(t8, dd0)) = o;
                 v2u p; p.x = cvt_pk_bf16(ks[0], ks[1]); p.y = cvt_pk_bf16(ks[2], ks[3]); *(LAS v2u*)(sK + SWZ(t8, dd0)) = p; }
#pragma unroll
          for (int i = 0; i < QN; i += 2) { const unsigned w = cvt_pk_bf16(ks[i], ks[i + 1]); sKT[SWZ(dd0 + i, t8)] = (bf16)(w & 0xffffu); sKT[SWZ(dd0 + i + 1, t8)] = (bf16)(w >> 16); } }
        sync_wg();
        bf16x8v bq[NKS];
        if (wave < 4) {
            const int t = 16 * wave + fr;
#pragma unroll
            for (int ks = 0; ks < NKS; ++ks) bq[ks] = frag64(sQ, t, 4 * ks + fq);
#pragma unroll
            for (int j = 0; j < 4; ++j) { f32x4 acc = (f32x4){0.f, 0.f, 0.f, 0.f};
                if (j <= wave) {
#pragma unroll
                    for (int ks = 0; ks < NKS; ++ks) acc = __builtin_amdgcn_mfma_f32_16x16x32_bf16(frag64(sK, 16 * j + fr, 4 * ks + fq), bq[ks], acc, 0, 0, 0); }
                float pv[4];
#pragma unroll
                for (int rg = 0; rg < 4; ++rg) pv[rg] = (j < wave || (j == wave && 4 * fq + rg <= fr)) ? acc[rg] : 0.f;
                v2u o; o.x = cvt_pk_bf16(pv[0], pv[1]); o.y = cvt_pk_bf16(pv[2], pv[3]);
                *(LAS v2u*)(sP + t * 64 + (((2 * j + (fq >> 1)) ^ (t & 7)) << 3) + 4 * (fq & 1)) = o; }
        } else {
            const int e = 16 * (wave - 4) + fr;
#pragma unroll
            for (int i = 0; i < NDT; ++i) { float sc[4];
#pragma unroll
                for (int rg = 0; rg < 4; ++rg) sc[rg] = (MX == 0) ? __expf(32.f * lgam) : __expf(slg[31 * 64 + 16 * i + 4 * fq + rg]);
                v2u o; o.x = cvt_pk_bf16(S[i][0] * sc[0], S[i][1] * sc[1]); o.y = cvt_pk_bf16(S[i][2] * sc[2], S[i][3] * sc[3]);
                *(LAS v2u*)(sST + e * 64 + (((2 * i + (fq >> 1)) ^ (e & 7)) << 3) + 4 * (fq & 1)) = o; }
        }
        sync_wg();
        if (wave < 4) {
            const int t = 16 * wave + fr;
            bf16x8v bp[2];
#pragma unroll
            for (int ks = 0; ks < 2; ++ks) bp[ks] = frag64(sP, t, 4 * ks + fq);
            f32x4 oacc[4];
#pragma unroll
            for (int i = 0; i < 4; ++i) { f32x4 acc = (f32x4){0.f, 0.f, 0.f, 0.f};
                acc = __builtin_amdgcn_mfma_f32_16x16x32_bf16(frag64(sVT, 16 * i + fr, fq), bp[0], acc, 0, 0, 0);
                if (wave >= 2) acc = __builtin_amdgcn_mfma_f32_16x16x32_bf16(frag64(sVT, 16 * i + fr, 4 + fq), bp[1], acc, 0, 0, 0);
#pragma unroll
                for (int ks = 0; ks < NKS; ++ks) acc = __builtin_amdgcn_mfma_f32_16x16x32_bf16(frag64(sST, 16 * i + fr, 4 * ks + fq), bq[ks], acc, 0, 0, 0);
                oacc[i] = acc; }
            float s1 = 0.f;
#pragma unroll
            for (int i = 0; i < 4; ++i)
#pragma unroll
                for (int rg = 0; rg < 4; ++rg) s1 += (MX == 0) ? oacc[i][rg] : oacc[i][rg] * oacc[i][rg];
            s1 += shfl_xor_(s1, 16); s1 += shfl_xor_(s1, 32);
            float rs;
            if (MX == 0) { const float mean = s1 * (1.f / 64.f); float q2 = 0.f;
#pragma unroll
                for (int i = 0; i < 4; ++i)
#pragma unroll
                    for (int rg = 0; rg < 4; ++rg) { oacc[i][rg] -= mean; q2 += oacc[i][rg] * oacc[i][rg]; }
                q2 += shfl_xor_(q2, 16); q2 += shfl_xor_(q2, 32); rs = 1.0f / sqrtf(q2 * (1.f / 64.f) + 1e-6f);
            } else rs = 1.0f / sqrtf(s1 * (1.f / 64.f) + 1e-6f);
#pragma unroll
            for (int i = 0; i < 4; ++i) { const v2u gw = *(const LAS v2u*)(sG + t * 64 + (((2 * i + (fq >> 1)) ^ (t & 7)) << 3) + 4 * (fq & 1));
                const float g4[4] = {bf_lo(gw.x), bf_hi(gw.x), bf_lo(gw.y), bf_hi(gw.y)}; float y[4];
#pragma unroll
                for (int rg = 0; rg < 4; ++rg) y[rg] = oacc[i][rg] * rs * nw[4 * i + rg] * g4[rg] * sigmoid_acc(g4[rg]);
                v2u o; o.x = cvt_pk_bf16(y[0], y[1]); o.y = cvt_pk_bf16(y[2], y[3]);
                *(v2u*)(O + (rowbase + t) * D + MX * 256 + h * 64 + 16 * i + 4 * fq) = o; }
        } else {
            const int e = 16 * (wave - 4) + fr;
            bf16x8v bv[2];
#pragma unroll
            for (int ks = 0; ks < 2; ++ks) bv[ks] = frag64(sVT, e, 4 * ks + fq);
#pragma unroll
            for (int i = 0; i < NDT; ++i) { f32x4 acc = (f32x4){0.f, 0.f, 0.f, 0.f};
#pragma unroll
                for (int ks = 0; ks < 2; ++ks) acc = __builtin_amdgcn_mfma_f32_16x16x32_bf16(frag64(sKT, 16 * i + fr, 4 * ks + fq), bv[ks], acc, 0, 0, 0);
#pragma unroll
                for (int rg = 0; rg < 4; ++rg) { float el, er;
                    if (MX == 0) { el = __expf(64.f * lgam); er = __expf(32.f * lgam); }
                    else { const float bl = slg[63 * 64 + 16 * i + 4 * fq + rg], br = slg[31 * 64 + 16 * i + 4 * fq + rg]; el = __expf(bl); er = __expf(bl - br); }
                    S[i][rg] = el * S[i][rg] + er * acc[rg]; } }
        }
        sync_wg();
    }
}

__device__ __forceinline__ NOPK float dpp_f(float x, const int ctrl_sel) {
    const int xi = __builtin_bit_cast(int, x); int r;
    if (ctrl_sel == 0) r = __builtin_amdgcn_update_dpp(0, xi, 0xB1, 0xf, 0xf, true);
    else if (ctrl_sel == 1) r = __builtin_amdgcn_update_dpp(0, xi, 0x4E, 0xf, 0xf, true);
    else if (ctrl_sel == 2) r = __builtin_amdgcn_update_dpp(0, xi, 0x141, 0xf, 0xf, true);
    else r = __builtin_amdgcn_update_dpp(0, xi, 0x140, 0xf, 0xf, true);
    return __builtin_bit_cast(float, r);
}
__device__ __forceinline__ NOPK float sum16_dpp(float v) { v += dpp_f(v, 0); v += dpp_f(v, 1); v += dpp_f(v, 2); v += dpp_f(v, 3); return v; }
#define DPP_SUM16_2(a_, b_) asm volatile( \
    "s_nop 1\n\t" \
    "v_add_f32_dpp %0, %0, %0 quad_perm:[1,0,3,2] row_mask:0xf bank_mask:0xf bound_ctrl:1\n\t" \
    "v_add_f32_dpp %1, %1, %1 quad_perm:[1,0,3,2] row_mask:0xf bank_mask:0xf bound_ctrl:1\n\t" \
    "s_nop 0\n\t" \
    "v_add_f32_dpp %0, %0, %0 quad_perm:[2,3,0,1] row_mask:0xf bank_mask:0xf bound_ctrl:1\n\t" \
    "v_add_f32_dpp %1, %1, %1 quad_perm:[2,3,0,1] row_mask:0xf bank_mask:0xf bound_ctrl:1\n\t" \
    "s_nop 0\n\t" \
    "v_add_f32_dpp %0, %0, %0 row_half_mirror row_mask:0xf bank_mask:0xf bound_ctrl:1\n\t" \
    "v_add_f32_dpp %1, %1, %1 row_half_mirror row_mask:0xf bank_mask:0xf bound_ctrl:1\n\t" \
    "s_nop 0\n\t" \
    "v_add_f32_dpp %0, %0, %0 row_mirror row_mask:0xf bank_mask:0xf bound_ctrl:1\n\t" \
    "v_add_f32_dpp %1, %1, %1 row_mirror row_mask:0xf bank_mask:0xf bound_ctrl:1\n\t" \
    : "+v"(a_), "+v"(b_));
__device__ __forceinline__ NOPK float sum8_dpp(float v) { v += dpp_f(v, 0); v += dpp_f(v, 1); v += dpp_f(v, 2); return v; }

__device__ __forceinline__ NOPK void rwkv_task(LAS unsigned char* lds, KP P, int layer, int b, int h, int half) {
    asm volatile("" : "+s"(h), "+s"(b), "+s"(half));
    const int tid = opaque_tid(), lane = tid & 63, wave = __builtin_amdgcn_readfirstlane(tid >> 6);
    LAS float* sr = (LAS float*)lds; LAS float* skm = sr + 4096; LAS float* sw = sr + 8192; LAS float* ska = sr + 12288; LAS float* sv = sr + 16384;
    LAS float* skk = sr + 20480; LAS float* sy = sr + 24576;
    LAS bf16* tw = (LAS bf16*)(lds + 81920); LAS bf16* ta = (LAS bf16*)(lds + 90112); LAS bf16* tg = (LAS bf16*)(lds + 98304);
    LAS bf16* w2T = (LAS bf16*)(lds + 114688); LAS bf16* a2T = (LAS bf16*)(lds + 122880); LAS bf16* g2T = (LAS bf16*)(lds + 131072);
    LAS float* sbon = (LAS float*)(lds + 147456);
    LAS float* smu = (LAS float*)(lds + 147712);
    LAS float* spar = smu + 448;
    const bf16* Z = (const bf16*)(P->ws + WS_R2);
    bf16* O = (bf16*)P->out;
    const int t8 = tid >> 3, e0 = (tid & 7) * 8, colh = h * 64;
    sync_wg();
    if (tid < 448) { const int seg = tid >> 6, j = tid & 63; const int col = (seg < 3) ? seg * 256 + colh + j : 768 + (seg - 3) * 64 + j; smu[tid] = P->in[I_MU][layer * 1024 + col]; }
    if (tid < 320) { const int seg = tid >> 6, j = tid & 63; const float* src = (seg == 0) ? P->in[I_KK] + layer * 256 + colh : (seg == 1) ? P->in[I_KA] + layer * 256 + colh : (seg == 2) ? P->in[I_RK] + (layer * 4 + h) * 64
                                                                             : (seg == 3) ? P->in[I_RLNW] + layer * 256 + colh : P->in[I_RLNB] + layer * 256 + colh; spar[tid] = src[j]; }
    sync_wg();
    { const int cc = tid & 63, jb = tid >> 6;
      const float* w2 = P->in[I_W2] + (size_t)layer * 64 * 256 + colh + cc; const float* a2 = P->in[I_A2] + (size_t)layer * 64 * 256 + colh + cc; const float* g2 = P->in[I_G2] + (size_t)layer * 128 * 256 + colh + cc;
      float x[8];
#pragma unroll
      for (int i = 0; i < 8; ++i) x[i] = w2[(8 * jb + i) * 256];
      { v4u o; o.x = cvt_pk_bf16(x[0], x[1]); o.y = cvt_pk_bf16(x[2], x[3]); o.z = cvt_pk_bf16(x[4], x[5]); o.w = cvt_pk_bf16(x[6], x[7]); *(LAS v4u*)(w2T + cc * 64 + ((jb ^ (cc & 7)) << 3)) = o; }
#pragma unroll
      for (int i = 0; i < 8; ++i) x[i] = a2[(8 * jb + i) * 256];
      { v4u o; o.x = cvt_pk_bf16(x[0], x[1]); o.y = cvt_pk_bf16(x[2], x[3]); o.z = cvt_pk_bf16(x[4], x[5]); o.w = cvt_pk_bf16(x[6], x[7]); *(LAS v4u*)(a2T + cc * 64 + ((jb ^ (cc & 7)) << 3)) = o; }
#pragma unroll
      for (int hh = 0; hh < 2; ++hh) { const int ch = jb + 8 * hh;
#pragma unroll
          for (int i = 0; i < 8; ++i) x[i] = g2[(8 * ch + i) * 256];
          v4u o; o.x = cvt_pk_bf16(x[0], x[1]); o.y = cvt_pk_bf16(x[2], x[3]); o.z = cvt_pk_bf16(x[4], x[5]); o.w = cvt_pk_bf16(x[6], x[7]); *(LAS v4u*)(g2T + cc * 128 + ((ch ^ (cc & 7)) << 3)) = o; } }
    const int ti = wave & 3, ci0 = 2 * (wave >> 2), fr = lane & 15, fq = lane >> 4;
    float w0v[2], a0v[2];
#pragma unroll
    for (int q = 0; q < 2; ++q) { w0v[q] = P->in[I_W0][layer * 256 + colh + 16 * (ci0 + q) + fr]; a0v[q] = P->in[I_A0][layer * 256 + colh + 16 * (ci0 + q) + fr]; }
    const int kq = lane & 15, vrow = 32 * half + 2 * (4 * (wave & 3) + (lane >> 4));
    typedef float f32x2 __attribute__((ext_vector_type(2)));
    v4u R[7];
#define RWKV_LOAD(cc_, dst_, back_) { const bf16* zr_ = Z + ((size_t)b * SEQ + (cc_) * 64 + t8) * NMIXP + 768; const bf16* zp_ = ((back_) && !((cc_) == 0 && t8 == 0)) ? zr_ - NMIXP : zr_; \
        const int cols_[7] = {colh + e0, 256 + colh + e0, 512 + colh + e0, 768 + e0, 832 + e0, 896 + e0, 960 + e0}; \
        _Pragma("unroll") for (int q_ = 0; q_ < 7; ++q_) dst_[q_] = *(const v4u*)(zp_ + cols_[q_]); }
    RWKV_LOAD(0, R, 0)
    v4u Rp[7]; RWKV_LOAD(0, Rp, 1)
    f32x2 S2[4];
#pragma unroll
    for (int k = 0; k < 4; ++k) S2[k] = (f32x2){0.f, 0.f};
#pragma unroll 1
    for (int c = 0; c < NCHUNK; ++c) {
        const size_t rowbase = (size_t)b * SEQ + c * 64;
        f32x4 gacc[2];
        for (int rp_ = 0; rp_ < REP_PREP; ++rp_) {
        { const bool first = (c == 0 && t8 == 0);
          float a[8], p[8], z[8];
#define UNPK(vv_, o_) { const v4u u_ = vv_; o_[0] = bf_lo(u_.x); o_[1] = bf_hi(u_.x); o_[2] = bf_lo(u_.y); o_[3] = bf_hi(u_.y); o_[4] = bf_lo(u_.z); o_[5] = bf_hi(u_.z); o_[6] = bf_lo(u_.w); o_[7] = bf_hi(u_.w); }
#define SHIFTED(idx, col) { UNPK(R[idx], a) UNPK(Rp[idx], p) _Pragma("unroll") for (int i = 0; i < 8; ++i) { const float pv = first ? 0.f : p[i]; z[i] = a[i] + (pv - a[i]) * smu[(idx) * 64 + e0 + i]; } }
          SHIFTED(0, colh + e0)
#pragma unroll
          for (int i = 0; i < 8; ++i) sr[t8 * 64 + e0 + i] = z[i];
          SHIFTED(1, 256 + colh + e0)
#pragma unroll
          for (int i = 0; i < 8; ++i) skm[t8 * 64 + e0 + i] = z[i];
          SHIFTED(2, 512 + colh + e0)
#pragma unroll
          for (int i = 0; i < 8; ++i) sv[t8 * 64 + e0 + i] = z[i];
          const int sw8 = ((tid & 7) ^ (t8 & 7)) << 3;
          SHIFTED(3, 768 + e0)
          { v4u o; o.x = cvt_pk_bf16(tanh_fast(z[0]), tanh_fast(z[1])); o.y = cvt_pk_bf16(tanh_fast(z[2]), tanh_fast(z[3])); o.z = cvt_pk_bf16(tanh_fast(z[4]), tanh_fast(z[5])); o.w = cvt_pk_bf16(tanh_fast(z[6]), tanh_fast(z[7])); *(LAS v4u*)(tw + t8 * 64 + sw8) = o; }
          SHIFTED(4, 832 + e0)
          { v4u o; o.x = cvt_pk_bf16(z[0], z[1]); o.y = cvt_pk_bf16(z[2], z[3]); o.z = cvt_pk_bf16(z[4], z[5]); o.w = cvt_pk_bf16(z[6], z[7]); *(LAS v4u*)(ta + t8 * 64 + sw8) = o; }
          SHIFTED(5, 896 + e0)
          { v4u o; o.x = cvt_pk_bf16(sigmoid_acc(z[0]), sigmoid_acc(z[1])); o.y = cvt_pk_bf16(sigmoid_acc(z[2]), sigmoid_acc(z[3])); o.z = cvt_pk_bf16(sigmoid_acc(z[4]), sigmoid_acc(z[5])); o.w = cvt_pk_bf16(sigmoid_acc(z[6]), sigmoid_acc(z[7])); *(LAS v4u*)(tg + t8 * 128 + sw8) = o; }
          SHIFTED(6, 960 + e0)
          { v4u o; o.x = cvt_pk_bf16(sigmoid_acc(z[0]), sigmoid_acc(z[1])); o.y = cvt_pk_bf16(sigmoid_acc(z[2]), sigmoid_acc(z[3])); o.z = cvt_pk_bf16(sigmoid_acc(z[4]), sigmoid_acc(z[5])); o.w = cvt_pk_bf16(sigmoid_acc(z[6]), sigmoid_acc(z[7])); *(LAS v4u*)(tg + t8 * 128 + 64 + sw8) = o; }
#undef UNPK
#undef SHIFTED
        }
        sync_wg();
        { const int ar = 16 * ti + fr;
          f32x4 wacc[2], aacc[2];
#pragma unroll
          for (int q = 0; q < 2; ++q) { wacc[q] = (f32x4){0.f, 0.f, 0.f, 0.f}; aacc[q] = wacc[q]; gacc[q] = wacc[q]; }
#pragma unroll
          for (int ks = 0; ks < 2; ++ks) { const int ch = ks * 4 + fq;
              const bf16x8v Aw = *(const LAS bf16x8v*)(tw + ar * 64 + ((ch ^ (ar & 7)) << 3)), Aa = *(const LAS bf16x8v*)(ta + ar * 64 + ((ch ^ (ar & 7)) << 3));
#pragma unroll
              for (int q = 0; q < 2; ++q) { const int br = 16 * (ci0 + q) + fr;
                  const bf16x8v Bw = *(const LAS bf16x8v*)(w2T + br * 64 + ((ch ^ (br & 7)) << 3)), Ba = *(const LAS bf16x8v*)(a2T + br * 64 + ((ch ^ (br & 7)) << 3));
                  wacc[q] = __builtin_amdgcn_mfma_f32_16x16x32_bf16(Aw, Bw, wacc[q], 0, 0, 0); aacc[q] = __builtin_amdgcn_mfma_f32_16x16x32_bf16(Aa, Ba, aacc[q], 0, 0, 0); } }
#pragma unroll
          for (int ks = 0; ks < 4; ++ks) { const int ch = ks * 4 + fq;
              const bf16x8v Ag = *(const LAS bf16x8v*)(tg + ar * 128 + ((ch ^ (ar & 7)) << 3));
#pragma unroll
              for (int q = 0; q < 2; ++q) { const int br = 16 * (ci0 + q) + fr;
                  const bf16x8v Bg = *(const LAS bf16x8v*)(g2T + br * 128 + ((ch ^ (br & 7)) << 3));
                  gacc[q] = __builtin_amdgcn_mfma_f32_16x16x32_bf16(Ag, Bg, gacc[q], 0, 0, 0); } }
#pragma unroll
          for (int q = 0; q < 2; ++q)
#pragma unroll
              for (int rg = 0; rg < 4; ++rg) { const int t = 16 * ti + 4 * fq + rg, cc = 16 * (ci0 + q) + fr;
                  sw[t * 64 + cc] = __expf(-0.6065306597126334f * sigmoid_acc(w0v[q] + wacc[q][rg])); ska[t * 64 + cc] = sigmoid_acc(a0v[q] + aacc[q][rg]); } }
        sync_wg();
        }
        { float ss = 0.f, bon = 0.f; float kk[8], av[8];
#pragma unroll
            for (int i = 0; i < 8; ++i) { const int cc = e0 + i; const float kv = skm[t8 * 64 + cc]; av[i] = ska[t8 * 64 + cc];
                kk[i] = kv * spar[cc]; ss += kk[i] * kk[i];
                const float km = kv * (1.f + (av[i] - 1.f) * spar[64 + cc]); skm[t8 * 64 + cc] = km;
                bon += sr[t8 * 64 + cc] * km * spar[128 + cc]; }
            ss = red8(ss); bon = red8(bon); const float inv = 1.0f / sqrtf(ss + 1e-12f);
#pragma unroll
            for (int i = 0; i < 8; ++i) { const float kn = kk[i] * inv; skk[t8 * 64 + e0 + i] = kn; ska[t8 * 64 + e0 + i] = kn * av[i]; }
            if ((tid & 7) == 0) sbon[t8] = bon; }
        sync_wg();
        if (c + 1 < NCHUNK) RWKV_LOAD(c + 1, R, 0)
        if (wave < 4) { const LAS f32x4* pw = (const LAS f32x4*)(sw + 4 * kq); const LAS f32x4* pkk = (const LAS f32x4*)(skk + 4 * kq); const LAS f32x4* pka = (const LAS f32x4*)(ska + 4 * kq);
          const LAS f32x4* pkm = (const LAS f32x4*)(skm + 4 * kq); const LAS f32x4* pr = (const LAS f32x4*)(sr + 4 * kq); const LAS f32x2* pv = (const LAS f32x2*)(sv + vrow);
          f32x2 Ssave[4] = {S2[0], S2[1], S2[2], S2[3]};
          for (int rr_ = 0; rr_ < REP_REC; ++rr_) { S2[0] = Ssave[0]; S2[1] = Ssave[1]; S2[2] = Ssave[2]; S2[3] = Ssave[3];
          f32x4 wA = pw[0], kA = pkk[0], aA = pka[0], mA = pkm[0], rA = pr[0]; f32x2 vA = pv[0];
          f32x4 wB, kB, aB, mB, rB; f32x2 vB;
#define RWKV_STEP(tcur, tn, wX, kX, aX, mX, rX, vX, wY, kY, aY, mY, rY, vY) { \
              wY = pw[(tn) * 16]; kY = pkk[(tn) * 16]; aY = pka[(tn) * 16]; mY = pkm[(tn) * 16]; rY = pr[(tn) * 16]; vY = pv[(tn) * 32]; \
              f32x2 sa = S2[0] * kX.x; sa = S2[1] * kX.y + sa; sa = S2[2] * kX.z + sa; sa = S2[3] * kX.w + sa; \
              const f32x2 tm0 = S2[0] * wX.x + vX * mX.x, tm1 = S2[1] * wX.y + vX * mX.y, tm2 = S2[2] * wX.z + vX * mX.z, tm3 = S2[3] * wX.w + vX * mX.w; \
              float s0 = sa.x, s1 = sa.y; DPP_SUM16_2(s0, s1) \
              const f32x2 sar = (f32x2){s0, s1}; \
              S2[0] = tm0 - sar * aX.x; S2[1] = tm1 - sar * aX.y; S2[2] = tm2 - sar * aX.z; S2[3] = tm3 - sar * aX.w; \
              f32x2 yy = S2[0] * rX.x; yy = S2[1] * rX.y + yy; yy = S2[2] * rX.z + yy; yy = S2[3] * rX.w + yy; \
              float y0 = yy.x, y1 = yy.y; DPP_SUM16_2(y0, y1) \
              if (kq == 0) *(LAS f32x2*)(sy + (tcur) * 64 + vrow) = (f32x2){y0, y1}; }
#pragma unroll 1
          for (int t = 0; t < 64; t += 2) {
              RWKV_STEP(t, t + 1, wA, kA, aA, mA, rA, vA, wB, kB, aB, mB, rB, vB)
              RWKV_STEP(t + 1, (t + 2) & 63, wB, kB, aB, mB, rB, vB, wA, kA, aA, mA, rA, vA) }
#undef RWKV_STEP
          } }
        sync_wg();
        if (c + 1 < NCHUNK) RWKV_LOAD(c + 1, Rp, 1)
#pragma unroll
        for (int q = 0; q < 2; ++q)
#pragma unroll
            for (int rg = 0; rg < 4; ++rg) skk[(16 * ti + 4 * fq + rg) * 64 + 16 * (ci0 + q) + fr] = gacc[q][rg];
        sync_wg();
        { const int c4 = 32 * half + (tid & 7) * 4; float yv[4]; float s = 0.f;
#pragma unroll
            for (int i = 0; i < 4; ++i) { yv[i] = sy[t8 * 64 + c4 + i]; s += yv[i]; }
            s = red8(s); const float mean = s * (1.f / 32.f); float q = 0.f;
#pragma unroll
            for (int i = 0; i < 4; ++i) { const float d = yv[i] - mean; q += d * d; }
            q = red8(q); const float bon = sbon[t8];
            const size_t off = (rowbase + t8) * 256 + colh + c4;
            *(f32x4*)((float*)(P->out + (size_t)M * D / 2) + off) = (f32x4){yv[0], yv[1], yv[2], yv[3]};
            v2u ad; ad.x = cvt_pk_bf16(bon * sv[t8 * 64 + c4], bon * sv[t8 * 64 + c4 + 1]); ad.y = cvt_pk_bf16(bon * sv[t8 * 64 + c4 + 2], bon * sv[t8 * 64 + c4 + 3]);
            *(v2u*)((bf16*)(P->out + (size_t)M * D / 2 + (size_t)M * 256) + off) = ad;
            v2u gt; gt.x = cvt_pk_bf16(skk[t8 * 64 + c4], skk[t8 * 64 + c4 + 1]); gt.y = cvt_pk_bf16(skk[t8 * 64 + c4 + 2], skk[t8 * 64 + c4 + 3]);
            *(v2u*)((bf16*)(P->out + (size_t)M * D / 2 + (size_t)M * 256) + (size_t)M * 256 + off) = gt;
            if ((tid & 7) == 0) ((f32x2g*)(P->ws + WS_RST))[((rowbase + t8) * 4 + h) * 2 + half] = (f32x2g){mean, q}; }
        sync_wg();
    }
}

constexpr int RW_SET = 40960;
constexpr int RW_SV = 81920, RW_SY = 90112, RW_SG = 98304, RW_SB = 106496;
constexpr int RW_SCR = 108544;
constexpr int RW_W2T = 124928, RW_A2T = 133120, RW_G2T = 141312;
constexpr int RW_MU = 149504, RW_PAR = 151296;
__device__ __forceinline__ NOPK void rwkv_task2(LAS unsigned char* lds, KP P, int layer, int b, int h, int half) {
    asm volatile("" : "+s"(h), "+s"(b), "+s"(half));
    const int tid = opaque_tid(), lane = tid & 63, wave = __builtin_amdgcn_readfirstlane(tid >> 6);
    LAS bf16* w2T = (LAS bf16*)(lds + RW_W2T); LAS bf16* a2T = (LAS bf16*)(lds + RW_A2T); LAS bf16* g2T = (LAS bf16*)(lds + RW_G2T);
    LAS float* smu = (LAS float*)(lds + RW_MU); LAS float* spar = (LAS float*)(lds + RW_PAR);
    const bf16* Z = (const bf16*)(P->ws + WS_R2);
    const int colh = h * 64;
    constexpr int NC2 = SEQ / 32;
    sync_wg();
    if (tid < 448) { const int seg = tid >> 6, j = tid & 63; const int col = (seg < 3) ? seg * 256 + colh + j : 768 + (seg - 3) * 64 + j; smu[tid] = P->in[I_MU][layer * 1024 + col]; }
    if (tid < 320) { const int seg = tid >> 6, j = tid & 63; const float* src = (seg == 0) ? P->in[I_KK] + layer * 256 + colh : (seg == 1) ? P->in[I_KA] + layer * 256 + colh : (seg == 2) ? P->in[I_RK] + (layer * 4 + h) * 64
                                                                             : (seg == 3) ? P->in[I_RLNW] + layer * 256 + colh : P->in[I_RLNB] + layer * 256 + colh; spar[tid] = src[j]; }
    { const int cc = tid & 63, jb = tid >> 6;
      const float* w2 = P->in[I_W2] + (size_t)layer * 64 * 256 + colh + cc; const float* a2 = P->in[I_A2] + (size_t)layer * 64 * 256 + colh + cc;
      float x[8];
#pragma unroll
      for (int i = 0; i < 8; ++i) x[i] = w2[(8 * jb + i) * 256];
      { v4u o; o.x = cvt_pk_bf16(x[0], x[1]); o.y = cvt_pk_bf16(x[2], x[3]); o.z = cvt_pk_bf16(x[4], x[5]); o.w = cvt_pk_bf16(x[6], x[7]); *(LAS v4u*)(w2T + cc * 64 + ((jb ^ (cc & 7)) << 3)) = o; }
#pragma unroll
      for (int i = 0; i < 8; ++i) x[i] = a2[(8 * jb + i) * 256];
      { v4u o; o.x = cvt_pk_bf16(x[0], x[1]); o.y = cvt_pk_bf16(x[2], x[3]); o.z = cvt_pk_bf16(x[4], x[5]); o.w = cvt_pk_bf16(x[6], x[7]); *(LAS v4u*)(a2T + cc * 64 + ((jb ^ (cc & 7)) << 3)) = o; }
      const int cg = tid & 31, ch = tid >> 5; const float* g2 = P->in[I_G2] + (size_t)layer * 128 * 256 + colh + 32 * half + cg;
#pragma unroll
      for (int i = 0; i < 8; ++i) x[i] = g2[(8 * ch + i) * 256];
      { v4u o; o.x = cvt_pk_bf16(x[0], x[1]); o.y = cvt_pk_bf16(x[2], x[3]); o.z = cvt_pk_bf16(x[4], x[5]); o.w = cvt_pk_bf16(x[6], x[7]); *(LAS v4u*)(g2T + cg * 128 + ((ch ^ (cg & 7)) << 3)) = o; } }
    sync_wg();
    const int wrole = wave >> 2, widx = wave & 3;
    if (wrole) {
        const int pw = widx, tl = lane >> 3, e0 = (lane & 7) * 8, tk = 8 * pw + tl;
        const int fr = lane & 15, fq = lane >> 4;
        LAS bf16* tw = (LAS bf16*)(lds + RW_SCR + pw * 4096); LAS bf16* ta = tw + 512; LAS bf16* tg = tw + 1024;
        float w0v[4], a0v[4];
#pragma unroll
        for (int q = 0; q < 4; ++q) { w0v[q] = P->in[I_W0][layer * 256 + colh + 16 * q + fr]; a0v[q] = P->in[I_A0][layer * 256 + colh + 16 * q + fr]; }
        v4u R[7], Rp[7];
#define RW2_LOAD(cc_) { const size_t row_ = (size_t)b * SEQ + (cc_) * 32 + tk; const bf16* zr_ = Z + row_ * NMIXP + 768; const bf16* zp_ = ((cc_) == 0 && tk == 0) ? zr_ : zr_ - NMIXP; \
        const int cols_[7] = {colh + e0, 256 + colh + e0, 512 + colh + e0, 768 + e0, 832 + e0, 896 + e0, 960 + e0}; \
        _Pragma("unroll") for (int q_ = 0; q_ < 7; ++q_) { R[q_] = *(const v4u*)(zr_ + cols_[q_]); Rp[q_] = *(const v4u*)(zp_ + cols_[q_]); } }
        RW2_LOAD(0)
#pragma unroll 1
        for (int it = -1; it <= NC2; ++it) {
            if (it >= 1) { const int oc = it - 1, ob = oc & 1; const int c4 = (lane & 7) * 4;
                const LAS float* sy = (const LAS float*)(lds + RW_SY + ob * 4096); const LAS float* sv = (const LAS float*)(lds + RW_SV + ob * 4096); const LAS float* sg = (const LAS float*)(lds + RW_SG + ob * 4096);
                const f32x4 yv = *(const LAS f32x4*)(sy + tk * 32 + c4), vv = *(const LAS f32x4*)(sv + tk * 32 + c4), gv = *(const LAS f32x4*)(sg + tk * 32 + c4);
                float s = (yv.x + yv.y) + (yv.z + yv.w); s = red8(s); const float mean = s * (1.f / 32.f);
                const f32x4 d = yv - mean; float q = (d.x * d.x + d.y * d.y) + (d.z * d.z + d.w * d.w); q = red8(q);
                const float bon = ((const LAS float*)(lds + RW_SB + ob * 128))[tk];
                const size_t row = (size_t)b * SEQ + oc * 32 + tk; const size_t off = row * 256 + colh + 32 * half + c4;
                *(f32x4*)((float*)(P->out + (size_t)M * D / 2) + off) = yv;
                v2u ad; ad.x = cvt_pk_bf16(bon * vv.x, bon * vv.y); ad.y = cvt_pk_bf16(bon * vv.z, bon * vv.w);
                *(v2u*)((bf16*)(P->out + (size_t)M * D / 2 + (size_t)M * 256) + off) = ad;
                v2u gt; gt.x = cvt_pk_bf16(gv.x, gv.y); gt.y = cvt_pk_bf16(gv.z, gv.w);
                *(v2u*)((bf16*)(P->out + (size_t)M * D / 2 + (size_t)M * 256) + (size_t)M * 256 + off) = gt;
                if ((lane & 7) == 0) ((f32x2g*)(P->ws + WS_RST))[(row * 4 + h) * 2 + half] = (f32x2g){mean, q}; }
            if (it + 1 < NC2) { const int pc = it + 1, pb = pc & 1;
                LAS float* sr = (LAS float*)(lds + pb * RW_SET); LAS float* skm = sr + 2048; LAS float* sw = sr + 4096; LAS float* skk = sr + 6144; LAS float* ska = sr + 8192;
                LAS float* sv = (LAS float*)(lds + RW_SV + pb * 4096); LAS float* sg = (LAS float*)(lds + RW_SG + pb * 4096); LAS float* sb = (LAS float*)(lds + RW_SB + pb * 128);
                { const bool first = (pc == 0 && tk == 0); float a[8], p[8], z[8];
#define UNPK2(vv_, o_) { const v4u u_ = vv_; o_[0] = bf_lo(u_.x); o_[1] = bf_hi(u_.x); o_[2] = bf_lo(u_.y); o_[3] = bf_hi(u_.y); o_[4] = bf_lo(u_.z); o_[5] = bf_hi(u_.z); o_[6] = bf_lo(u_.w); o_[7] = bf_hi(u_.w); }
#define SHIFT2(idx) { UNPK2(R[idx], a) UNPK2(Rp[idx], p) _Pragma("unroll") for (int i = 0; i < 8; ++i) { const float pv = first ? 0.f : p[i]; z[i] = a[i] + (pv - a[i]) * smu[(idx) * 64 + e0 + i]; } }
                  SHIFT2(0)
                  *(LAS f32x4*)(sr + tk * 64 + e0) = (f32x4){z[0], z[1], z[2], z[3]}; *(LAS f32x4*)(sr + tk * 64 + e0 + 4) = (f32x4){z[4], z[5], z[6], z[7]};
                  SHIFT2(1)
                  *(LAS f32x4*)(skm + tk * 64 + e0) = (f32x4){z[0], z[1], z[2], z[3]}; *(LAS f32x4*)(skm + tk * 64 + e0 + 4) = (f32x4){z[4], z[5], z[6], z[7]};
                  SHIFT2(2)
                  if ((e0 >> 5) == half) { *(LAS f32x4*)(sv + tk * 32 + (e0 & 31)) = (f32x4){z[0], z[1], z[2], z[3]}; *(LAS f32x4*)(sv + tk * 32 + (e0 & 31) + 4) = (f32x4){z[4], z[5], z[6], z[7]}; }
                  const int sw8 = ((lane & 7) ^ (tl & 7)) << 3;
                  SHIFT2(3)
                  { v4u o; o.x = cvt_pk_bf16(tanh_fast(z[0]), tanh_fast(z[1])); o.y = cvt_pk_bf16(tanh_fast(z[2]), tanh_fast(z[3])); o.z = cvt_pk_bf16(tanh_fast(z[4]), tanh_fast(z[5])); o.w = cvt_pk_bf16(tanh_fast(z[6]), tanh_fast(z[7])); *(LAS v4u*)(tw + tl * 64 + sw8) = o; }
                  SHIFT2(4)
                  { v4u o; o.x = cvt_pk_bf16(z[0], z[1]); o.y = cvt_pk_bf16(z[2], z[3]); o.z = cvt_pk_bf16(z[4], z[5]); o.w = cvt_pk_bf16(z[6], z[7]); *(LAS v4u*)(ta + tl * 64 + sw8) = o; }
                  SHIFT2(5)
                  { v4u o; o.x = cvt_pk_bf16(sigmoid_acc(z[0]), sigmoid_acc(z[1])); o.y = cvt_pk_bf16(sigmoid_acc(z[2]), sigmoid_acc(z[3])); o.z = cvt_pk_bf16(sigmoid_acc(z[4]), sigmoid_acc(z[5])); o.w = cvt_pk_bf16(sigmoid_acc(z[6]), sigmoid_acc(z[7])); *(LAS v4u*)(tg + tl * 128 + sw8) = o; }
                  SHIFT2(6)
                  { v4u o; o.x = cvt_pk_bf16(sigmoid_acc(z[0]), sigmoid_acc(z[1])); o.y = cvt_pk_bf16(sigmoid_acc(z[2]), sigmoid_acc(z[3])); o.z = cvt_pk_bf16(sigmoid_acc(z[4]), sigmoid_acc(z[5])); o.w = cvt_pk_bf16(sigmoid_acc(z[6]), sigmoid_acc(z[7])); *(LAS v4u*)(tg + tl * 128 + 64 + sw8) = o; }
#undef SHIFT2
#undef UNPK2
                }
                if (pc + 1 < NC2) RW2_LOAD(pc + 1)
                asm volatile("s_waitcnt lgkmcnt(0)" ::: "memory");
                { const int ar = fr & 7;
                  f32x4 wacc[4], aacc[4], gacc[2];
#pragma unroll
                  for (int q = 0; q < 4; ++q) { wacc[q] = (f32x4){0.f, 0.f, 0.f, 0.f}; aacc[q] = wacc[q]; }
                  gacc[0] = (f32x4){0.f, 0.f, 0.f, 0.f}; gacc[1] = gacc[0];
#pragma unroll
                  for (int ks = 0; ks < 2; ++ks) { const int ch = ks * 4 + fq;
                      const bf16x8v Aw = *(const LAS bf16x8v*)(tw + ar * 64 + ((ch ^ (ar & 7)) << 3)), Aa = *(const LAS bf16x8v*)(ta + ar * 64 + ((ch ^ (ar & 7)) << 3));
#pragma unroll
                      for (int q = 0; q < 4; ++q) { const int br = 16 * q + fr;
                          const bf16x8v Bw = *(const LAS bf16x8v*)(w2T + br * 64 + ((ch ^ (br & 7)) << 3)), Ba = *(const LAS bf16x8v*)(a2T + br * 64 + ((ch ^ (br & 7)) << 3));
                          wacc[q] = __builtin_amdgcn_mfma_f32_16x16x32_bf16(Aw, Bw, wacc[q], 0, 0, 0); aacc[q] = __builtin_amdgcn_mfma_f32_16x16x32_bf16(Aa, Ba, aacc[q], 0, 0, 0); } }
#pragma unroll
                  for (int ks = 0; ks < 4; ++ks) { const int ch = ks * 4 + fq;
                      const bf16x8v Ag = *(const LAS bf16x8v*)(tg + ar * 128 + ((ch ^ (ar & 7)) << 3));
#pragma unroll
                      for (int q = 0; q < 2; ++q) { const int br = 16 * q + fr;
                          const bf16x8v Bg = *(const LAS bf16x8v*)(g2T + br * 128 + ((ch ^ (br & 7)) << 3));
                          gacc[q] = __builtin_amdgcn_mfma_f32_16x16x32_bf16(Ag, Bg, gacc[q], 0, 0, 0); } }
                  if (fq < 2) {
#pragma unroll
                      for (int rg = 0; rg < 4; ++rg) { const int t = 8 * pw + 4 * fq + rg;
#pragma unroll
                          for (int q = 0; q < 4; ++q) { const int cc = 16 * q + fr;
                              sw[t * 64 + cc] = __expf(-0.6065306597126334f * sigmoid_acc(w0v[q] + wacc[q][rg])); ska[t * 64 + cc] = sigmoid_acc(a0v[q] + aacc[q][rg]); }
#pragma unroll
                          for (int q = 0; q < 2; ++q) sg[t * 32 + 16 * q + fr] = gacc[q][rg]; } } }
                asm volatile("s_waitcnt lgkmcnt(0)" ::: "memory");
                { float ss = 0.f, bon = 0.f; float kk[8], av[8];
#pragma unroll
                  for (int i = 0; i < 8; ++i) { const int cc = e0 + i; const float kv = skm[tk * 64 + cc]; av[i] = ska[tk * 64 + cc];
                      kk[i] = kv * spar[cc]; ss += kk[i] * kk[i];
                      const float km = kv * (1.f + (av[i] - 1.f) * spar[64 + cc]); skm[tk * 64 + cc] = km;
                      bon += sr[tk * 64 + cc] * km * spar[128 + cc]; }
                  ss = red8(ss); bon = red8(bon); const float inv = 1.0f / sqrtf(ss + 1e-12f);
#pragma unroll
                  for (int i = 0; i < 8; ++i) { const float kn = kk[i] * inv; skk[tk * 64 + e0 + i] = kn; ska[tk * 64 + e0 + i] = kn * av[i]; }
                  if ((lane & 7) == 0) sb[tk] = bon; }
            }
            sync_wg();
        }
#undef RW2_LOAD
    } else {
        const int kq = lane & 15, vloc = 2 * (4 * widx + (lane >> 4));
        typedef float f32x2 __attribute__((ext_vector_type(2)));
        f32x2 S2[4];
#pragma unroll
        for (int i = 0; i < 4; ++i) S2[i] = (f32x2){0.f, 0.f};
        sync_wg();
#pragma unroll 1
        for (int it = 0; it < NC2; ++it) { const int cb = it & 1;
            const LAS f32x4* pr = (const LAS f32x4*)(lds + cb * RW_SET + 16 * kq); const LAS f32x4* pkm = pr + 512; const LAS f32x4* pw = pr + 1024; const LAS f32x4* pkk = pr + 1536; const LAS f32x4* pka = pr + 2048;
            const LAS f32x2* pv = (const LAS f32x2*)(lds + RW_SV + cb * 4096 + 4 * vloc); LAS float* sy = (LAS float*)(lds + RW_SY + cb * 4096);
            const f32x2 Ssv0 = S2[0], Ssv1 = S2[1], Ssv2 = S2[2], Ssv3 = S2[3];
            for (int rr_ = 0; rr_ < REP_REC; ++rr_) { S2[0] = Ssv0; S2[1] = Ssv1; S2[2] = Ssv2; S2[3] = Ssv3;
            f32x4 wA = pw[0], kA = pkk[0], aA = pka[0], mA = pkm[0], rA = pr[0]; f32x2 vA = pv[0];
            f32x4 wB, kB, aB, mB, rB; f32x2 vB;
#define RWKV_STEP(tcur, tn, wX, kX, aX, mX, rX, vX, wY, kY, aY, mY, rY, vY) { \
              wY = pw[(tn) * 16]; kY = pkk[(tn) * 16]; aY = pka[(tn) * 16]; mY = pkm[(tn) * 16]; rY = pr[(tn) * 16]; vY = pv[(tn) * 16]; \
              f32x2 sa = S2[0] * kX.x; sa = S2[1] * kX.y + sa; sa = S2[2] * kX.z + sa; sa = S2[3] * kX.w + sa; \
              const f32x2 tm0 = S2[0] * wX.x + vX * mX.x, tm1 = S2[1] * wX.y + vX * mX.y, tm2 = S2[2] * wX.z + vX * mX.z, tm3 = S2[3] * wX.w + vX * mX.w; \
              float s0 = sa.x, s1 = sa.y; DPP_SUM16_2(s0, s1) \
              const f32x2 sar = (f32x2){s0, s1}; \
              S2[0] = tm0 - sar * aX.x; S2[1] = tm1 - sar * aX.y; S2[2] = tm2 - sar * aX.z; S2[3] = tm3 - sar * aX.w; \
              f32x2 yy = S2[0] * rX.x; yy = S2[1] * rX.y + yy; yy = S2[2] * rX.z + yy; yy = S2[3] * rX.w + yy; \
              float y0 = yy.x, y1 = yy.y; DPP_SUM16_2(y0, y1) \
              if (kq == 0) *(LAS f32x2*)(sy + (tcur) * 32 + vloc) = (f32x2){y0, y1}; }
#pragma unroll 1
            for (int t = 0; t < 32; t += 2) {
                RWKV_STEP(t, t + 1, wA, kA, aA, mA, rA, vA, wB, kB, aB, mB, rB, vB)
                RWKV_STEP(t + 1, (t + 2) & 31, wB, kB, aB, mB, rB, vB, wA, kA, aA, mA, rA, vA) }
#undef RWKV_STEP
            }
            sync_wg();
        }
        sync_wg();
    }
}

__device__ __forceinline__ NOPK void rwkv_finalize(KP P, int layer) {
    const int gt = blockIdx.x * (NWAVES * 64) + opaque_tid(), NGT = gridDim.x * NWAVES * 64;
    const float* YR = P->out + (size_t)M * D / 2; const bf16* AD = (const bf16*)(YR + (size_t)M * 256); const bf16* GT = AD + (size_t)M * 256;
    const f32x2g* ST = (const f32x2g*)(P->ws + WS_RST); bf16* O = (bf16*)P->out;
    for (int i = gt; i < M * 64; i += NGT) { const int row = i >> 6, c4 = (i & 63) * 4, h = c4 >> 6;
        const f32x2g sa = ST[(row * 4 + h) * 2], sb = ST[(row * 4 + h) * 2 + 1];
        const float mean = 0.5f * (sa.x + sb.x), dm = sa.x - sb.x, m2 = sa.y + sb.y + 16.f * dm * dm, rs = 1.0f / sqrtf(m2 * (1.f / 64.f) + 64e-5f);
        const f32x4 y = *(const f32x4*)(YR + (size_t)row * 256 + c4); const v2u ad = *(const v2u*)(AD + (size_t)row * 256 + c4), g = *(const v2u*)(GT + (size_t)row * 256 + c4);
        const f32x4 lw = *(const f32x4*)(P->in[I_RLNW] + layer * 256 + c4), lb = *(const f32x4*)(P->in[I_RLNB] + layer * 256 + c4);
        v2u o; o.x = cvt_pk_bf16(((y.x - mean) * rs * lw.x + lb.x + bf_lo(ad.x)) * bf_lo(g.x), ((y.y - mean) * rs * lw.y + lb.y + bf_hi(ad.x)) * bf_hi(g.x));
        o.y = cvt_pk_bf16(((y.z - mean) * rs * lw.z + lb.z + bf_lo(ad.y)) * bf_lo(g.y), ((y.w - mean) * rs * lw.w + lb.w + bf_hi(ad.y)) * bf_hi(g.y));
        *(v2u*)(O + (size_t)row * D + 256 + c4) = o; }
}

__device__ __forceinline__ NOPK void ffn_fixup_panel(KP P, int layer, int pm) {
    const int tid = opaque_tid();
    const float* uh = (const float*)(P->ws + WS_HALO); const float* vh = (const float*)(P->ws + WS_HALO + HALO_ONE); const float* ut = (const float*)(P->ws + WS_HALO + 2 * HALO_ONE);
    const float* conv = P->in[I_CONV] + (size_t)layer * 3 * DFF; bf16* ACT = (bf16*)(P->ws + WS_R2);
    for (int i = tid; i < 2 * DFF; i += NWAVES * 64) { const int rr = i / DFF, cc = i % DFF;
        const float u0 = uh[((size_t)pm * 2) * DFF + cc], u1 = uh[((size_t)pm * 2 + 1) * DFF + cc];
        float t0 = 0.f, t1 = 0.f; if (pm & 7) { t0 = ut[((size_t)(pm - 1) * 2) * DFF + cc]; t1 = ut[((size_t)(pm - 1) * 2 + 1) * DFF + cc]; }
        const float c0 = conv[cc], c1 = conv[DFF + cc], c2 = conv[2 * DFF + cc];
        const float cv = rr ? (c2 * u1 + c1 * u0 + c0 * t1) : (c2 * u0 + c1 * t1 + c0 * t0);
        const float a = pg8::gelu_tanh_f(cv) * vh[((size_t)pm * 2 + rr) * DFF + cc];
        ACT[((size_t)pm * 256 + rr) * DFF + cc] = (bf16)(cvt_pk_bf16(a, 0.f) & 0xffffu); }
}

constexpr int NPH = 1 + 10 * DEPTH;
#ifndef REP_MIX
#define REP_MIX -1
#endif
#ifndef REP_PHASE
#define REP_PHASE -1
#endif
#define REPEAT(k) for (int rep_ = 0; rep_ < ((REP_PHASE == (k)) ? 2 : 1); ++rep_)
__global__ void __launch_bounds__(NWAVES * 64, 2) NOPK mega(Params Pk) {
    KP P = kparams();
    extern __shared__ __attribute__((aligned(16))) unsigned char lds_raw[];
    LAS unsigned char* lds = (LAS unsigned char*)lds_raw;
    volatile LAS unsigned* MISC = (volatile LAS unsigned*)(lds + LDS_MISC);
    const int tid = threadIdx.x;
    const int G = gridDim.x, bx = blockIdx.x;
    if (tid < 64) MISC[tid] = 0u;
    sync_wg();
    const int lo = P->ph_lo, hi = P->ph_hi;
    XcdBarrier bar; bar.bar = (unsigned*)(P->ws + WS_CTL) + CW_BAR; bar.x = 0; bar.st = nullptr;
    if (hi - lo > 1) bar = xcd_barrier_post((unsigned*)(P->ws + WS_CTL) + CW_BAR, MISC + 8);
#define IN(k) (lo <= (k) && (k) < hi)
#define SEAM(k) do { if (IN(k) && IN((k) + 1)) xcd_barrier(bar); } while (0)
#define PHASE_PTRS KP P = kparams(); unsigned char* const wl = P->ws + WS_W + (size_t)l * W_LAYER; bf16* const XB = (bf16*)(P->ws + WS_XB); unsigned char* const R2 = P->ws + WS_R2; \
        bf16* const OB = (bf16*)P->out;   bf16* const MG = (bf16*)P->out + (size_t)M * D;   \
        (void)wl; (void)XB; (void)R2; (void)OB; (void)MG;

    REPEAT(100) if (IN(0)) prologue(kparams(), lds);
    SEAM(0);
    for (int l = 0; l < DEPTH; ++l) {
        const int pb = 1 + 10 * l;
        REPEAT(0) if (IN(pb + 0)) {
            PHASE_PTRS
            pg8::Gemm g{XB, (const bf16*)(wl + WO_IN), M, NMIXP, D, D, D, 0, 0}; pg8::StaticOrder S; S.init(M, NMIXP, G, bx);
            pg8::EpiStoreBf16 E{(bf16*)R2, NMIXP};
            pg8::gemm_phase<pg8::EpiStoreBf16, pg8::StaticOrder, true, true>(lds, g, S, E);
        }
        SEAM(pb + 0);
        REPEAT(1) if (IN(pb + 1)) {
            PHASE_PTRS
#ifndef NO_MIX
            for (int slot = bx; slot < 256; slot += G) {
                if (slot < 128) { const int bh = slot >> 1; rwkv_task2(lds, P, l, bh >> 2, bh & 3, slot & 1); }
                else if (slot < 192) { const int bh = slot - 128; linattn_fast<0>(lds, P, l, bh >> 2, bh & 3); linattn_fast<2>(lds, P, l, bh >> 2, bh & 3); }
                else { const int bh = slot - 192; linattn_fast<3>(lds, P, l, bh >> 2, bh & 3);
                    pg8::Gemm g{(const bf16*)(P->ws + WS_PB) + (size_t)l * M * PLE, (const bf16*)(wl + WO_PP), M, D, PLE, PLE, PLE, 0, 0}; pg8::StaticOrder S; S.init(M, D, 64, slot - 192);
                    pg8::EpiStoreBf16 E{(bf16*)(P->ws + WS_PPLE), D};
                    pg8::gemm_phase<pg8::EpiStoreBf16, pg8::StaticOrder, true, true>(lds, g, S, E); } }
#endif
        }
        SEAM(pb + 1);
        REPEAT(2) if (IN(pb + 2)) rwkv_finalize(kparams(), l);
        SEAM(pb + 2);
        REPEAT(3) if (IN(pb + 3)) {
            PHASE_PTRS
            pg8::Gemm g{OB, (const bf16*)(wl + WO_B), M, 4096, 256, D, 256, 4, 256}; pg8::StaticOrder S; S.init(M, 4096, G, bx);
            pg8::EpiStoreBf16 E{(bf16*)R2, 4096};
            pg8::gemm_phase<pg8::EpiStoreBf16, pg8::StaticOrder, true, true>(lds, g, S, E);
        }
        SEAM(pb + 3);
        REPEAT(4) if (IN(pb + 4)) {
            PHASE_PTRS
            pg8::Gemm g{XB, (const bf16*)(wl + WO_G), M, 4096, D, D, D, 0, 0}; pg8::StaticOrder S; S.init(M, 4096, G, bx);
            pg8::EpiMerge E{(const bf16*)R2, MG};
            pg8::gemm_phase<pg8::EpiMerge, pg8::StaticOrder, true, true>(lds, g, S, E);
        }
        SEAM(pb + 4);
        REPEAT(5) if (IN(pb + 5)) {
            PHASE_PTRS
            pg8::Gemm g{MG, (const bf16*)(wl + WO_MIX), M, D, D, D, D, 0, 0}; pg8::StaticOrder S; S.init(M, D, G, bx);
            pg8::EpiResF32 E{XB, nullptr, (float*)R2, ALPHA};
            pg8::gemm_phase<pg8::EpiResF32, pg8::StaticOrder, true, true>(lds, g, S, E);
        }
        SEAM(pb + 5);
        REPEAT(6) if (IN(pb + 6)) { PHASE_PTRS ln_phase((const float*)R2, P->in[I_LNMW] + l * D, P->in[I_LNMB] + l * D, XB, nullptr); }
        SEAM(pb + 6);
        REPEAT(7) if (IN(pb + 7)) {
            PHASE_PTRS
            { pg8::Gemm g{XB, (const bf16*)(wl + WO_UP), M, 2 * DFF, D, D, D, 0, 0}; pg8::StaticOrder S; S.init(M, 2 * DFF, G, bx);
              pg8::EpiFfnUp E{(bf16*)R2, P->in[I_CONV] + (size_t)l * 3 * DFF, (float*)(P->ws + WS_HALO), (float*)(P->ws + WS_HALO + HALO_ONE), (float*)(P->ws + WS_HALO + 2 * HALO_ONE), (LAS float*)(lds + LDS_XCH)};
              pg8::gemm_phase<pg8::EpiFfnUp, pg8::StaticOrder, true, true>(lds, g, S, E); }
            if (rep_ == 0) { pg8::Gemm g{XB, (const bf16*)(wl + WO_PG), M, D, D, D, D, 0, 0}; pg8::StaticOrder S; S.init(M, D, G, bx);
              pg8::EpiPleGate E{(bf16*)(P->ws + WS_PPLE)};
              pg8::gemm_phase<pg8::EpiPleGate, pg8::StaticOrder, true, true>(lds, g, S, E); }
        }
        SEAM(pb + 7);
        REPEAT(8) if (IN(pb + 8)) {
            PHASE_PTRS
            pg8::Gemm g{(const bf16*)R2, (const bf16*)(wl + WO_DN), M, D, DFF, DFF, DFF, 0, 0}; pg8::StaticOrder S; S.init(M, D, G, bx);
            { pg8::Unit u; for (int i = 0; S.next(i, u); ++i) ffn_fixup_panel(P, l, u.pm); }
            asm volatile("s_waitcnt vmcnt(0)" ::: "memory"); sync_wg();
            pg8::EpiResF32 E{XB, (const bf16*)(P->ws + WS_PPLE), P->out, ALPHA};
            pg8::gemm_phase<pg8::EpiResF32, pg8::StaticOrder, true, true>(lds, g, S, E);
        }
        SEAM(pb + 8);
        if (IN(pb + 9)) { PHASE_PTRS ln_phase(P->out, P->in[I_LNFW] + l * D, P->in[I_LNFB] + l * D, (l == DEPTH - 1) ? nullptr : XB, (l == DEPTH - 1) ? P->out : nullptr); }
        SEAM(pb + 9);
    }
#undef IN
#undef SEAM
}

extern "C" void kernel_launch(void* const* d_in, const int* in_sizes, int n_in, void* d_out, int out_size, void* d_ws, size_t ws_size, hipStream_t stream) {
    static int grid = 0;
    if (grid == 0) {
        if (n_in != 32 || out_size != M * D || ws_size < WS_END) { fprintf(stderr, "kernel_launch: unexpected shapes (n_in %d, out %d, ws %zu)\n", n_in, out_size, ws_size); grid = -1; return; }
        int dev = 0, cus = 0, per_cu = 0;
        if (hipGetDevice(&dev) != hipSuccess || hipDeviceGetAttribute(&cus, hipDeviceAttributeMultiprocessorCount, dev) != hipSuccess) { grid = -1; return; }
        if (hipFuncSetAttribute((const void*)mega, hipFuncAttributeMaxDynamicSharedMemorySize, LDS_BYTES) != hipSuccess) { fprintf(stderr, "kernel_launch: hipFuncSetAttribute failed\n"); grid = -1; return; }
        if (hipOccupancyMaxActiveBlocksPerMultiprocessor(&per_cu, (const void*)mega, NWAVES * 64, LDS_BYTES) != hipSuccess || per_cu < 1) fprintf(stderr, "kernel_launch: occupancy query reports %d\n", per_cu);
        (void)hipGetLastError();
        grid = cus;
    }
    if (grid < 0) return;
    (void)hipMemsetAsync((char*)d_ws + WS_CTL, 0, CTL_ZERO_BYTES, stream);
    Params p{};
    for (int i = 0; i < 32; ++i) p.in[i] = (const float*)d_in[i];
    p.out = (float*)d_out; p.ws = (unsigned char*)d_ws;
#if ONE_LAUNCH
    p.ph_lo = 0; p.ph_hi = NPH;
    hipLaunchKernelGGL(mega, dim3(grid), dim3(NWAVES * 64), LDS_BYTES, stream, p);
#else
    for (int ph = 0; ph < NPH; ++ph) { p.ph_lo = ph; p.ph_hi = ph + 1; hipLaunchKernelGGL(mega, dim3(grid), dim3(NWAVES * 64), LDS_BYTES, stream, p); }
#endif
}
```

```cpp
#include <hip/hip_runtime.h>
#include <cstdio>
#include <cstdint>
#if defined(__HIP_DEVICE_COMPILE__)
#define NOPK __attribute__((target("no-packed-fp32-ops")))
#else
#define NOPK
#endif

typedef float f32x2g __attribute__((ext_vector_type(2)));
__device__ __forceinline__ NOPK void sync_wg() { __builtin_amdgcn_fence(__ATOMIC_RELEASE, "workgroup"); __builtin_amdgcn_s_barrier(); __builtin_amdgcn_fence(__ATOMIC_ACQUIRE, "workgroup"); }
__device__ __forceinline__ NOPK float u2f(unsigned u) { return __builtin_bit_cast(float, u); }
__device__ __forceinline__ NOPK float shfl_(float v, int src) { return __builtin_bit_cast(float, __builtin_amdgcn_ds_bpermute(src << 2, __builtin_bit_cast(int, v))); }
__device__ __forceinline__ NOPK float shfl_xor_(float v, int m) { const int lane_ = __builtin_amdgcn_mbcnt_hi(~0u, __builtin_amdgcn_mbcnt_lo(~0u, 0u)); return shfl_(v, lane_ ^ m); }
namespace pg8 {
#define PG8_LAS __attribute__((address_space(3)))
typedef unsigned short bf16_t;
typedef short bf16x8 __attribute__((ext_vector_type(8)));
typedef float f32x4 __attribute__((ext_vector_type(4)));
typedef float f32x2 __attribute__((ext_vector_type(2)));
typedef unsigned u32x4 __attribute__((ext_vector_type(4)));
typedef unsigned u32x2 __attribute__((ext_vector_type(2)));
constexpr int BM = 256, BK = 64, HALF = 128, HTB = HALF * BK * 2  , STAGE_BYTES = 8 * HTB, NXCD = 8, WGM = 8;

__host__ __device__ __forceinline__ NOPK int lds_byte(int r, int c) { const int st = (r >> 4) * 2 + (c >> 5), rr = r & 15, cc = c & 31, ob = rr * 64 + cc * 2; return st * 1024 + (ob ^ (((ob >> 9) & 1) << 5)); }
__host__ __device__ __forceinline__ NOPK void stage_rc(int b, int& R, int& C) { const int st = b / 1024, sb = b % 1024, swz = sb ^ (((sb >> 9) & 1) << 5); R = (st >> 1) * 16 + swz / 64; C = (st & 1) * 32 + (swz % 64) / 2; }
__host__ __device__ __forceinline__ NOPK int perm32(int rho) { const int n = rho >> 4, i = rho & 15; return 8 * (i >> 2) + 4 * n + (i & 3); }

struct Unit { int pm, pn; };
struct Gemm { const bf16_t* A; const bf16_t* Bt; int M, N, K, lda, ldb, a_div, a_coloff; };
__device__ __forceinline__ NOPK size_t a_unit_off(const Gemm& g, const Unit& u) { return g.a_div ? (size_t)((u.pn / g.a_div) * g.a_coloff) * 2u : (size_t)0; }

struct StaticOrder {
    int nM, nN, nwg, G, c;
    __host__ __device__ __forceinline__ NOPK void init(int M, int N, int G_, int c_) { nM = M / BM; nN = N / BM; nwg = nM * nN; G = G_; c = c_; }
    __host__ __device__ __forceinline__ NOPK bool next(int i, Unit& u) const {
        const long L = (long)i * G + c; if (L >= nwg) return false;
        int wgid = (int)L; { const int q = nwg / NXCD, r = nwg % NXCD, xcd = wgid % NXCD, off = wgid / NXCD; wgid = (xcd < r ? xcd * (q + 1) : r * (q + 1) + (xcd - r) * q) + off; }
        const int nig = WGM * nN, gid = wgid / nig, fm = gid * WGM, gsz = (nM - fm) < WGM ? (nM - fm) : WGM;
        u.pm = fm + ((wgid % nig) % gsz); u.pn = (wgid % nig) / gsz; return true;
    }
    __device__ __forceinline__ NOPK void a_ready(const Unit&) const {}
    __device__ __forceinline__ NOPK void done(const Unit&) const {}
};

typedef __bf16 bf16x2_t __attribute__((ext_vector_type(2)));
__device__ __forceinline__ NOPK unsigned cvt_pk_bf16(float lo, float hi) { const f32x2 v = {lo, hi}; const bf16x2_t b = __builtin_convertvector(v, bf16x2_t); return __builtin_bit_cast(unsigned, b); }
__device__ __forceinline__ NOPK float bf_lo(unsigned w) { return u2f(w << 16); }
__device__ __forceinline__ NOPK float bf_hi(unsigned w) { return u2f(w & 0xffff0000u); }
__device__ __forceinline__ NOPK float sigmoid_f(float x) { return __builtin_amdgcn_rcpf(1.0f + __builtin_amdgcn_exp2f(-1.44269504089f * x)); }

template <class Epi, class Sched, bool ALIGN_EPI = false, bool SP2 = false>
__device__ __forceinline__ NOPK void gemm_phase(PG8_LAS unsigned char* lds, const Gemm g, const Sched& S, const Epi& E) {
    int tid_o = threadIdx.x; asm volatile("" : "+v"(tid_o));
    const int tid = tid_o, wid = __builtin_amdgcn_readfirstlane(tid >> 6), lane = tid & 63, wr = wid >> 2, wc = wid & 3, fr = lane & 15, fq = lane >> 4;
    const int K = g.K, nt = K / BK;
    unsigned voffA[2], voffB[2];
#pragma unroll
    for (int i = 0; i < 2; ++i) { int R, C; stage_rc(tid * 16 + i * 8192, R, C); const int Rb = Epi::PERM ? ((R & ~31) + perm32(R & 31)) : R;
        voffA[i] = (unsigned)(R * g.lda + C) * 2u; voffB[i] = (unsigned)(Rb * g.ldb + C) * 2u; }
    const size_t kstep = (size_t)(BK * 2);
    const size_t hstepA = (size_t)HALF * g.lda * 2, hstepB = (size_t)HALF * g.ldb * 2;
    const size_t tstepA = 2 * hstepA, tstepB = 2 * hstepB;
    const unsigned ldsw = (unsigned)wid * 1024u;
    const int aoff = lds_byte(wr * 64 + fr, fq * 8), boff = lds_byte(wc * 32 + fr, fq * 8);
#define PG8_SA(b, h) (((b) * 2 + (h)) * HTB)
#define PG8_SB(b, h) ((4 + (b) * 2 + (h)) * HTB)
#define PG8_STAGE(bufoff, gbase, voff) do { _Pragma("unroll") for (int _i = 0; _i < 2; ++_i) \
        __builtin_amdgcn_global_load_lds((const unsigned*)((const char*)(gbase) + (voff)[_i]), (PG8_LAS unsigned*)(lds + (bufoff) + ldsw + _i * 8192), 16, 0, 0); } while (0)
#define PG8_LDA(dst, b, h) do { _Pragma("unroll") for (int m = 0; m < 4; ++m) _Pragma("unroll") for (int k = 0; k < 2; ++k) dst[m][k] = *(const PG8_LAS bf16x8*)(lds + PG8_SA(b, h) + aoff + m * 2048 + k * 1024); } while (0)
#define PG8_LDB(dst, b, h) do { _Pragma("unroll") for (int n = 0; n < 2; ++n) _Pragma("unroll") for (int k = 0; k < 2; ++k) dst[n][k] = *(const PG8_LAS bf16x8*)(lds + PG8_SB(b, h) + boff + n * 2048 + k * 1024); } while (0)
#define PG8_MMA(ai, bj, At, Bt) do { __builtin_amdgcn_s_setprio(1); _Pragma("unroll") for (int m = 0; m < 4; ++m) _Pragma("unroll") for (int n = 0; n < 2; ++n) _Pragma("unroll") for (int k = 0; k < 2; ++k) \
        acc[ai][bj][m][n] = __builtin_amdgcn_mfma_f32_16x16x32_bf16(Bt[n][k], At[m][k], acc[ai][bj][m][n], 0, 0, 0); __builtin_amdgcn_s_setprio(0); } while (0)
#define PG8_WAIT_V(n) asm volatile("s_waitcnt vmcnt(" #n ")" ::: "memory")
#define PG8_WAIT_L(n) asm volatile("s_waitcnt lgkmcnt(" #n ")" ::: "memory")
#define PG8_BAR __builtin_amdgcn_s_barrier()
#define PG8_SCHED __builtin_amdgcn_sched_barrier(0)
    Unit cur, nxt; int ui = 0;
    if (!S.next(0, cur)) return;
    f32x4 acc[2][2][4][2];
#pragma unroll
    for (int a = 0; a < 2; ++a)
#pragma unroll
        for (int b = 0; b < 2; ++b)
#pragma unroll
            for (int m = 0; m < 4; ++m)
#pragma unroll
                for (int n = 0; n < 2; ++n) acc[a][b][m][n] = (f32x4){0.f, 0.f, 0.f, 0.f};
    bf16x8 At[4][2], B0[2][2], B1[2][2];
    const char* cA = (const char*)g.A + (size_t)cur.pm * tstepA + a_unit_off(g, cur); const char* cB = (const char*)g.Bt + (size_t)cur.pn * tstepB;
    S.a_ready(cur);
    if constexpr (SP2) {
        PG8_STAGE(PG8_SB(0, 0), cB, voffB); PG8_STAGE(PG8_SB(0, 1), cB + hstepB, voffB); PG8_STAGE(PG8_SA(0, 0), cA, voffA); PG8_STAGE(PG8_SA(0, 1), cA + hstepA, voffA);
        if (wr == 1) PG8_BAR;
        PG8_WAIT_V(2); PG8_BAR;
        PG8_STAGE(PG8_SB(1, 0), cB + kstep, voffB); PG8_STAGE(PG8_SA(1, 0), cA + kstep, voffA); PG8_STAGE(PG8_SB(1, 1), cB + hstepB + kstep, voffB);
        PG8_WAIT_V(6); PG8_BAR;
    } else {
        PG8_STAGE(PG8_SB(0, 0), cB, voffB); PG8_STAGE(PG8_SA(0, 0), cA, voffA); PG8_STAGE(PG8_SB(0, 1), cB + hstepB, voffB); PG8_STAGE(PG8_SA(0, 1), cA + hstepA, voffA);
        if (wr == 1) PG8_BAR;
        PG8_WAIT_V(4); PG8_BAR;
        PG8_STAGE(PG8_SB(1, 0), cB + kstep, voffB); PG8_STAGE(PG8_SA(1, 0), cA + kstep, voffA); PG8_STAGE(PG8_SB(1, 1), cB + hstepB + kstep, voffB);
        PG8_WAIT_V(6); PG8_BAR;
    }
    for (;;) {
        const bool has_next = S.next(ui + 1, nxt);
        const char* nA = has_next ? (const char*)g.A + (size_t)nxt.pm * tstepA + a_unit_off(g, nxt) : cA; const char* nB = has_next ? (const char*)g.Bt + (size_t)nxt.pn * tstepB : cB;
        for (int t = 0; t < nt; t += 2) {
            const bool last = (t == nt - 2);
            const char* a1 = cA + (size_t)(t + 1) * kstep;
            const char* a2 = last ? nA : cA + (size_t)(t + 2) * kstep; const char* b2 = last ? nB : cB + (size_t)(t + 2) * kstep;
            const char* a3 = a2 + kstep; const char* b3 = b2 + kstep;
            if (last && has_next) S.a_ready(nxt);
            if constexpr (SP2) {
            PG8_LDB(B0, 0, 0); PG8_LDB(B1, 0, 1); PG8_SCHED; PG8_LDA(At, 0, 0); PG8_STAGE(PG8_SA(1, 1), a1 + hstepA, voffA);
            PG8_WAIT_V(8); PG8_WAIT_L(0); PG8_BAR; PG8_MMA(0, 0, At, B0); PG8_MMA(0, 1, At, B1); PG8_BAR; PG8_SCHED;
            PG8_LDA(At, 0, 1); PG8_STAGE(PG8_SB(0, 0), b2, voffB); PG8_STAGE(PG8_SB(0, 1), b2 + hstepB, voffB); PG8_STAGE(PG8_SA(0, 0), a2, voffA);
            PG8_WAIT_V(8); PG8_WAIT_L(0); PG8_BAR; PG8_MMA(1, 0, At, B0); PG8_MMA(1, 1, At, B1); PG8_BAR; PG8_SCHED;
            PG8_LDB(B0, 1, 0); PG8_LDB(B1, 1, 1); PG8_SCHED; PG8_LDA(At, 1, 0); PG8_STAGE(PG8_SA(0, 1), a2 + hstepA, voffA);
            PG8_WAIT_V(8); PG8_WAIT_L(0); PG8_BAR; PG8_MMA(0, 0, At, B0); PG8_MMA(0, 1, At, B1); PG8_BAR; PG8_SCHED;
            PG8_LDA(At, 1, 1); PG8_STAGE(PG8_SB(1, 0), b3, voffB); PG8_STAGE(PG8_SB(1, 1), b3 + hstepB, voffB); PG8_STAGE(PG8_SA(1, 0), a3, voffA);
            PG8_WAIT_V(8); PG8_WAIT_L(0); PG8_BAR; PG8_MMA(1, 0, At, B0); PG8_MMA(1, 1, At, B1); PG8_BAR; PG8_SCHED;
            } else {
            PG8_LDB(B0, 0, 0); PG8_SCHED; PG8_LDA(At, 0, 0); PG8_STAGE(PG8_SA(1, 1), a1 + hstepA, voffA);
            PG8_WAIT_L(8); PG8_BAR; PG8_WAIT_L(0); PG8_MMA(0, 0, At, B0); PG8_BAR; PG8_SCHED;
            PG8_LDB(B1, 0, 1); PG8_STAGE(PG8_SB(0, 0), b2, voffB);
            PG8_BAR; PG8_WAIT_L(0); PG8_MMA(0, 1, At, B1); PG8_BAR;
            PG8_LDA(At, 0, 1); PG8_STAGE(PG8_SA(0, 0), a2, voffA);
            PG8_BAR; PG8_WAIT_L(0); PG8_MMA(1, 0, At, B0); PG8_BAR; PG8_SCHED;
            PG8_STAGE(PG8_SB(0, 1), b2 + hstepB, voffB);
            PG8_WAIT_V(6); PG8_BAR; PG8_MMA(1, 1, At, B1); PG8_BAR;
            PG8_LDB(B0, 1, 0); PG8_SCHED; PG8_LDA(At, 1, 0); PG8_STAGE(PG8_SA(0, 1), a2 + hstepA, voffA);
            PG8_WAIT_L(8); PG8_BAR; PG8_WAIT_L(0); PG8_MMA(0, 0, At, B0); PG8_BAR; PG8_SCHED;
            PG8_LDB(B1, 1, 1); PG8_STAGE(PG8_SB(1, 0), b3, voffB);
            PG8_BAR; PG8_WAIT_L(0); PG8_MMA(0, 1, At, B1); PG8_BAR;
            PG8_LDA(At, 1, 1); PG8_STAGE(PG8_SA(1, 0), a3, voffA);
            PG8_BAR; PG8_WAIT_L(0); PG8_MMA(1, 0, At, B0); PG8_BAR; PG8_SCHED;
            PG8_STAGE(PG8_SB(1, 1), b3 + hstepB, voffB);
            PG8_WAIT_V(6); PG8_BAR; PG8_MMA(1, 1, At, B1); PG8_BAR;
            }
        }
        if constexpr (ALIGN_EPI) { if (wr == 0) PG8_BAR; }
        if constexpr (!Epi::AFTER_DRAIN) { E(acc, cur, wr, wc, fr, fq); S.done(cur); }
        if (!has_next) break;
#pragma unroll
        for (int a = 0; a < 2; ++a)
#pragma unroll
            for (int b = 0; b < 2; ++b)
#pragma unroll
                for (int m = 0; m < 4; ++m)
#pragma unroll
                    for (int n = 0; n < 2; ++n) acc[a][b][m][n] = (f32x4){0.f, 0.f, 0.f, 0.f};
        cur = nxt; cA = nA; cB = nB; ++ui;
        if constexpr (ALIGN_EPI) { if (wr == 1) PG8_BAR; }
    }
    PG8_WAIT_V(0);
    if constexpr (!ALIGN_EPI) { if (wr == 0) PG8_BAR; }
    PG8_BAR;
    if constexpr (Epi::AFTER_DRAIN) { E.fused(acc, cur, wr, wc, fr, fq, lds, wid, lane); S.done(cur); }
#undef PG8_SA
#undef PG8_SB
#undef PG8_STAGE
#undef PG8_LDA
#undef PG8_LDB
#undef PG8_MMA
#undef PG8_WAIT_V
#undef PG8_WAIT_L
#undef PG8_BAR
#undef PG8_SCHED
}


struct EpiStoreBf16 {
    static constexpr bool PERM = true, AFTER_DRAIN = false;
    bf16_t* O; int ldc;
    __device__ __forceinline__ NOPK void operator()(const f32x4 (&acc)[2][2][4][2], const Unit& u, int wr, int wc, int fr, int fq) const {
        const int row0 = u.pm * BM + wr * 64 + fr, col0 = u.pn * BM + wc * 32 + 8 * fq;
#pragma unroll
        for (int ai = 0; ai < 2; ++ai)
#pragma unroll
            for (int m = 0; m < 4; ++m) { bf16_t* rowp = O + (size_t)(row0 + ai * HALF + m * 16) * ldc + col0;
#pragma unroll
                for (int bj = 0; bj < 2; ++bj) { const f32x4 v0 = acc[ai][bj][m][0], v1 = acc[ai][bj][m][1];
                    u32x4 w; w.x = cvt_pk_bf16(v0[0], v0[1]); w.y = cvt_pk_bf16(v0[2], v0[3]); w.z = cvt_pk_bf16(v1[0], v1[1]); w.w = cvt_pk_bf16(v1[2], v1[3]);
                    *(u32x4*)(rowp + bj * HALF) = w; } }
    }
};
struct EpiPleGate {
    static constexpr bool PERM = true, AFTER_DRAIN = false;
    bf16_t* PP;
    __device__ __forceinline__ NOPK void operator()(const f32x4 (&acc)[2][2][4][2], const Unit& u, int wr, int wc, int fr, int fq) const {
        const int row0 = u.pm * BM + wr * 64 + fr, col0 = u.pn * BM + wc * 32 + 8 * fq;
        u32x4 pp[2][4][2];
#pragma unroll
        for (int ai = 0; ai < 2; ++ai)
#pragma unroll
            for (int m = 0; m < 4; ++m) { const bf16_t* rowp = PP + (size_t)(row0 + ai * HALF + m * 16) * 1024 + col0;
#pragma unroll
                for (int bj = 0; bj < 2; ++bj) pp[ai][m][bj] = *(const u32x4*)(rowp + bj * HALF); }
#pragma unroll
        for (int ai = 0; ai < 2; ++ai)
#pragma unroll
            for (int m = 0; m < 4; ++m) { bf16_t* rowp = PP + (size_t)(row0 + ai * HALF + m * 16) * 1024 + col0;
#pragma unroll
                for (int bj = 0; bj < 2; ++bj) { const f32x4 v0 = acc[ai][bj][m][0], v1 = acc[ai][bj][m][1];
                    const u32x4 p = pp[ai][m][bj];
                    u32x4 w;
                    w.x = cvt_pk_bf16(sigmoid_f(v0[0]) * bf_lo(p.x), sigmoid_f(v0[1]) * bf_hi(p.x));
                    w.y = cvt_pk_bf16(sigmoid_f(v0[2]) * bf_lo(p.y), sigmoid_f(v0[3]) * bf_hi(p.y));
                    w.z = cvt_pk_bf16(sigmoid_f(v1[0]) * bf_lo(p.z), sigmoid_f(v1[1]) * bf_hi(p.z));
                    w.w = cvt_pk_bf16(sigmoid_f(v1[2]) * bf_lo(p.w), sigmoid_f(v1[3]) * bf_hi(p.w));
                    *(u32x4*)(rowp + bj * HALF) = w; } }
    }
};
struct EpiMerge {
    static constexpr bool PERM = false, AFTER_DRAIN = false;
    const bf16_t* P; bf16_t* MG;
    __device__ __forceinline__ NOPK void operator()(const f32x4 (&acc)[2][2][4][2], const Unit& u, int wr, int wc, int fr, int fq) const {
        const int row0 = u.pm * BM + wr * 64 + fr, oc = u.pn * 64 + wc * 16 + fq * 4;
        u32x2 pv[2][4][4];
#pragma unroll
        for (int ai = 0; ai < 2; ++ai)
#pragma unroll
            for (int m = 0; m < 4; ++m) { const bf16_t* prow = P + (size_t)(row0 + ai * HALF + m * 16) * 4096 + oc;
#pragma unroll
                for (int b = 0; b < 4; ++b) pv[ai][m][b] = *(const u32x2*)(prow + b * 1024); }
#pragma unroll
        for (int ai = 0; ai < 2; ++ai)
#pragma unroll
            for (int m = 0; m < 4; ++m) { const size_t row = (size_t)(row0 + ai * HALF + m * 16);
                f32x4 s = (f32x4){0.f, 0.f, 0.f, 0.f};
#pragma unroll
                for (int b = 0; b < 4; ++b) { const u32x2 p = pv[ai][m][b]; const f32x4 g = acc[ai][b >> 1][m][b & 1];
                    s[0] += sigmoid_f(g[0]) * bf_lo(p.x); s[1] += sigmoid_f(g[1]) * bf_hi(p.x); s[2] += sigmoid_f(g[2]) * bf_lo(p.y); s[3] += sigmoid_f(g[3]) * bf_hi(p.y); }
                u32x2 w; w.x = cvt_pk_bf16(s[0], s[1]); w.y = cvt_pk_bf16(s[2], s[3]);
                *(u32x2*)(MG + row * 1024 + oc) = w; }
    }
};
struct EpiResF32 {
    static constexpr bool PERM = false, AFTER_DRAIN = false;
    const bf16_t* X; const bf16_t* PLE; float* V; float alpha;
    __device__ __forceinline__ NOPK void operator()(const f32x4 (&acc)[2][2][4][2], const Unit& u, int wr, int wc, int fr, int fq) const {
        const int row0 = u.pm * BM + wr * 64 + fr, col0 = u.pn * BM + wc * 32 + 4 * fq;
#pragma unroll
        for (int ai = 0; ai < 2; ++ai) {
            u32x2 xv[4][2][2], pv[4][2][2];
#pragma unroll
            for (int m = 0; m < 4; ++m) { const size_t off = (size_t)(row0 + ai * HALF + m * 16) * 1024 + col0;
#pragma unroll
                for (int bj = 0; bj < 2; ++bj)
#pragma unroll
                    for (int n = 0; n < 2; ++n) { const size_t o = off + bj * HALF + n * 16; xv[m][bj][n] = *(const u32x2*)(X + o); if (PLE) pv[m][bj][n] = *(const u32x2*)(PLE + o); else pv[m][bj][n] = (u32x2){0u, 0u}; } }
#pragma unroll
            for (int m = 0; m < 4; ++m) { const size_t off = (size_t)(row0 + ai * HALF + m * 16) * 1024 + col0;
#pragma unroll
                for (int bj = 0; bj < 2; ++bj)
#pragma unroll
                    for (int n = 0; n < 2; ++n) { const size_t o = off + bj * HALF + n * 16; const u32x2 x2 = xv[m][bj][n], p2 = pv[m][bj][n];
                        f32x4 r = acc[ai][bj][m][n];
                        r[0] += alpha * bf_lo(x2.x) + bf_lo(p2.x); r[1] += alpha * bf_hi(x2.x) + bf_hi(p2.x); r[2] += alpha * bf_lo(x2.y) + bf_lo(p2.y); r[3] += alpha * bf_hi(x2.y) + bf_hi(p2.y);
                        *(f32x4*)(V + o) = r; } } }
    }
};
__device__ __forceinline__ NOPK float gelu_tanh_f(float x) {
    const float inner = x * (0.7978845608f + 0.0356774081f * x * x);
    return x * __builtin_amdgcn_rcpf(1.0f + __builtin_amdgcn_exp2f(-2.885390082f * inner));
}
struct EpiFfnUp {
    static constexpr bool PERM = false, AFTER_DRAIN = false;
    bf16_t* ACT; const float* conv; float* uhead; float* vhead; float* utail; PG8_LAS float* xch;
    __device__ __forceinline__ NOPK void operator()(const f32x4 (&acc)[2][2][4][2], const Unit& u, int wr, int wc, int fr, int fq) const {
        const int lane = threadIdx.x & 63;
        const int cc0 = wc * 32 + 4 * fq, colg = u.pn * 128 + cc0;
        f32x4 c0[2], c1[2], c2[2];
#pragma unroll
        for (int n = 0; n < 2; ++n) { c0[n] = *(const f32x4*)(conv + colg + 16 * n); c1[n] = *(const f32x4*)(conv + 2816 + colg + 16 * n); c2[n] = *(const f32x4*)(conv + 2 * 2816 + colg + 16 * n); }
        if (fr >= 14) {
#pragma unroll
            for (int ai = 0; ai < 2; ++ai)
#pragma unroll
                for (int n = 0; n < 2; ++n) *(PG8_LAS f32x4*)(xch + ((2 * ai + wr) * 2 + (fr - 14)) * 128 + cc0 + 16 * n) = acc[ai][0][3][n];
            if (wr == 1) {
#pragma unroll
                for (int n = 0; n < 2; ++n) *(f32x4*)(utail + ((size_t)u.pm * 2 + (fr - 14)) * 2816 + colg + 16 * n) = acc[1][0][3][n];
            }
        }
        if (wr == 0 && fr < 2) {
#pragma unroll
            for (int n = 0; n < 2; ++n) { *(f32x4*)(uhead + ((size_t)u.pm * 2 + fr) * 2816 + colg + 16 * n) = acc[0][0][0][n];
                                          *(f32x4*)(vhead + ((size_t)u.pm * 2 + fr) * 2816 + colg + 16 * n) = acc[0][1][0][n]; }
        }
        asm volatile("s_waitcnt lgkmcnt(0)" ::: "memory"); __builtin_amdgcn_s_barrier(); asm volatile("" ::: "memory");
        const int src1 = (lane & 48) | ((fr + 15) & 15), src2 = (lane & 48) | ((fr + 14) & 15);
#pragma unroll
        for (int ai = 0; ai < 2; ++ai)
#pragma unroll
            for (int m = 0; m < 4; ++m) { const size_t row = (size_t)(u.pm * BM + ai * HALF + wr * 64 + m * 16 + fr);
#pragma unroll
                for (int n = 0; n < 2; ++n) {
                    const f32x4 cur = acc[ai][0][m][n];
                    f32x4 e1, e2, r1, r2;
                    if (m > 0) { const f32x4 pg = acc[ai][0][m > 0 ? m - 1 : 0][n];
#pragma unroll
                        for (int j = 0; j < 4; ++j) { e1[j] = shfl_(pg[j], src1); e2[j] = shfl_(pg[j], src2); } }
                    else { const int rb = 2 * ai + wr;
                        if (rb > 0) { const f32x4 x62 = *(const PG8_LAS f32x4*)(xch + ((rb - 1) * 2 + 0) * 128 + cc0 + 16 * n), x63 = *(const PG8_LAS f32x4*)(xch + ((rb - 1) * 2 + 1) * 128 + cc0 + 16 * n);
                            e1 = x63; e2 = (fr == 0) ? x62 : x63; }
                        else { e1 = (f32x4){0.f, 0.f, 0.f, 0.f}; e2 = e1; } }
#pragma unroll
                    for (int j = 0; j < 4; ++j) { r1[j] = shfl_(cur[j], src1); r2[j] = shfl_(cur[j], src2); }
                    const f32x4 p1 = (fr >= 1) ? r1 : e1, p2 = (fr >= 2) ? r2 : e2;
                    const f32x4 cv = c2[n] * cur + c1[n] * p1 + c0[n] * p2;
                    const f32x4 vv = acc[ai][1][m][n];
                    u32x2 w; w.x = cvt_pk_bf16(gelu_tanh_f(cv[0]) * vv[0], gelu_tanh_f(cv[1]) * vv[1]); w.y = cvt_pk_bf16(gelu_tanh_f(cv[2]) * vv[2], gelu_tanh_f(cv[3]) * vv[3]);
                    *(u32x2*)(ACT + row * 2816 + colg + 16 * n) = w; } }
    }
};
}

constexpr int D = 1024, BATCH = 16, SEQ = 2048, DEPTH = 2, M = BATCH * SEQ;
constexpr int NMIX = 3600, NMIXP = 3840, NIN = 7696, DFF = 2816, PLE = 256, NCHUNK = SEQ / 64;
constexpr float ALPHA = 1.41421356237f;
constexpr float LN_EPS = 1e-5f;
constexpr int NWAVES = 8;
#ifndef ONE_LAUNCH
#define ONE_LAUNCH 1
#endif

constexpr size_t MiB = 1u << 20;
constexpr size_t WS_CTL = 0, CTL_ZERO_BYTES = 1 * MiB;
constexpr size_t WS_W = 1 * MiB, W_LAYER = 39 * MiB;
constexpr size_t WO_IN = 0, WO_G = 15 * MiB / 2, WO_B = 31 * MiB / 2, WO_MIX = 35 * MiB / 2, WO_UP = 39 * MiB / 2, WO_DN = 61 * MiB / 2, WO_PG = 36 * MiB, WO_PP = 38 * MiB;
constexpr size_t WS_PB = 79 * MiB;
constexpr size_t WS_XB = 111 * MiB;
constexpr size_t WS_R2 = 175 * MiB;
constexpr size_t R2_PPLE = 176 * MiB;
constexpr size_t WS_ROPE = 431 * MiB;
constexpr size_t WS_HALO = 432 * MiB, HALO_ONE = (size_t)128 * 2 * DFF * 4;
constexpr size_t WS_RST = 442 * MiB;
constexpr size_t WS_PPLE = 444 * MiB;
constexpr size_t WS_END = 508 * MiB;
static_assert(WS_HALO + 3 * HALO_ONE <= WS_END && WS_R2 + 256 * MiB <= WS_ROPE, "ws map");
constexpr int CW_BAR = 4096;

constexpr int LDS_BYTES = 163840;
constexpr int LDS_XCH = 131072;
constexpr int LDS_MISC = 163840 - 256;

#define LAS __attribute__((address_space(3)))
typedef unsigned short bf16;
typedef float f32x4 __attribute__((ext_vector_type(4)));
typedef unsigned v4u __attribute__((ext_vector_type(4)));
typedef unsigned v2u __attribute__((ext_vector_type(2)));
#define LDS_WAIT() asm volatile("s_waitcnt lgkmcnt(0)" ::: "memory")
using pg8::cvt_pk_bf16; using pg8::bf_lo; using pg8::bf_hi; using pg8::sigmoid_f;

#define XB_TMO      128
#define XB_XCNT(j)  (256  + 64 * (j))
#define XB_XSUB(j)  (1280 + 64 * (j))
#define XB_XGEN(j)  (2304 + 64 * (j))
#define XB_TOP      3328
#define XB_TOPGEN   3392
#define XCD_BAR_WORDS 3456
#define XB_SPIN_CAP (1u << 18)
__device__ __forceinline__ NOPK unsigned xb_ld(unsigned* p)              { return __hip_atomic_load(p, __ATOMIC_RELAXED, __HIP_MEMORY_SCOPE_AGENT); }
__device__ __forceinline__ NOPK unsigned xb_add(unsigned* p, unsigned v) { return __hip_atomic_fetch_add(p, v, __ATOMIC_RELAXED, __HIP_MEMORY_SCOPE_AGENT); }
__device__ __forceinline__ NOPK unsigned xb_xcc_id() { return (unsigned)__builtin_amdgcn_s_getreg((3 << 11) | 20) & 0xFu; }
#define XB_SPIN(cond, bar) do { unsigned _sp = 0; while (cond) { __builtin_amdgcn_s_sleep(1); \
    if ((++_sp & 255u) == 0u) { if (xb_ld(&(bar)[XB_TMO])) break; if (_sp > XB_SPIN_CAP) { (void)xb_add(&(bar)[XB_TMO], 1u); break; } } } } while (0)
struct XcdBarrier { unsigned* bar; unsigned x; volatile LAS unsigned* st; };
__device__ __forceinline__ NOPK XcdBarrier xcd_barrier_post(unsigned* bar, volatile LAS unsigned* st) {
    XcdBarrier b; b.bar = bar; b.x = xb_xcc_id(); b.st = st;
    if (threadIdx.x == 0) (void)xb_add(&bar[XB_XCNT(b.x)], 1u);
    return b;
}
__device__ __forceinline__ NOPK void xcd_barrier_complete(unsigned* bar, unsigned x, unsigned& nloc, unsigned& nx) {
    const unsigned G = gridDim.x * gridDim.y * gridDim.z;
    unsigned sum, cnt, mine, sp = 0u;
    for (;;) {
        sum = 0u; cnt = 0u; mine = 0u;
#pragma unroll
        for (unsigned j = 0; j < 16; ++j) { const unsigned c = xb_ld(&bar[XB_XCNT(j)]); sum += c; cnt += (c > 0u) ? 1u : 0u; mine = (j == x) ? c : mine; }
        if (sum == G) break;
        __builtin_amdgcn_s_sleep(1);
        if ((++sp & 255u) == 0u) { if (xb_ld(&bar[XB_TMO])) break; if (sp > XB_SPIN_CAP) { (void)xb_add(&bar[XB_TMO], 1u); break; } }
    }
    nloc = mine > 0u ? mine : 1u; nx = cnt > 0u ? cnt : 1u;
}
__device__ __forceinline__ NOPK void xcd_barrier(const XcdBarrier& b) {
    asm volatile("s_waitcnt vmcnt(0)" ::: "memory");
    sync_wg();
    if (threadIdx.x == 0) {
        unsigned* bar = b.bar;
        __builtin_amdgcn_s_waitcnt(0);
        unsigned nloc = b.st[0], nx = b.st[1];
        if (nloc == 0u) { xcd_barrier_complete(bar, b.x, nloc, nx); b.st[0] = nloc; b.st[1] = nx; }
        const unsigned old = xb_add(&bar[XB_XSUB(b.x)], 1u);
        const unsigned gen = old / nloc;
        if (old + 1u == (gen + 1u) * nloc) {
            __builtin_amdgcn_fence(__ATOMIC_RELEASE, "agent");
            asm volatile("s_waitcnt vmcnt(0)" ::: "memory");
            const unsigned og = xb_add(&bar[XB_TOP], 1u);
            const unsigned tg = og / nx;
            if (og + 1u == (tg + 1u) * nx) xb_add(&bar[XB_TOPGEN], 1u);
            else XB_SPIN(xb_ld(&bar[XB_TOPGEN]) == tg, bar);
            __builtin_amdgcn_fence(__ATOMIC_ACQUIRE, "agent");
            xb_add(&bar[XB_XGEN(b.x)], 1u);
            asm volatile("s_waitcnt vmcnt(0)" ::: "memory");
        } else {
            XB_SPIN(xb_ld(&bar[XB_XGEN(b.x)]) == gen, bar);
            __builtin_amdgcn_fence(__ATOMIC_ACQUIRE, "agent");
            asm volatile("s_waitcnt vmcnt(0)" ::: "memory");
        }
    }
    sync_wg();
}

struct Params {
    const float* in[32];
    float* out; unsigned char* ws;
    int ph_lo, ph_hi;
};
enum { I_X = 0, I_P, I_LNINW, I_LNINB, I_WIN, I_MU, I_W0, I_W2, I_A0, I_A2, I_G2, I_KK, I_KA, I_RK, I_RLNW, I_RLNB, I_GLAW2, I_GLAB, I_GLANW, I_HLB, I_HNW,
       I_WBR, I_WMIX, I_LNMW, I_LNMB, I_WUP, I_CONV, I_WDN, I_WPG, I_WPP, I_LNFW, I_LNFB };

typedef const __attribute__((address_space(4))) Params* KP;
__device__ __forceinline__ NOPK KP kparams() { KP p = (KP)__builtin_amdgcn_kernarg_segment_ptr(); asm volatile("" : "+s"(p)); return p; }
__device__ __forceinline__ NOPK float wave_sum(float v) {
#pragma unroll
    for (int o = 1; o < 64; o <<= 1) v += shfl_xor_(v, o);
    return v;
}
__device__ __forceinline__ NOPK int opaque_tid() { int t = threadIdx.x; asm volatile("" : "+v"(t)); return t; }
__device__ __forceinline__ NOPK float red8(float v) { v += shfl_xor_(v, 1); v += shfl_xor_(v, 2); v += shfl_xor_(v, 4); return v; }

__constant__ double ROPE_THETA[16] = {1.0, 0.5411695265464637, 0.2928644564625237, 0.15848931924611134, 0.08576958985908942, 0.046415888336127795, 0.025118864315095794, 0.013593563908785255, 0.007356422544596414, 0.003981071705534973, 0.0021544346900318843, 0.0011659144011798323, 0.000630957344480193, 0.0003414548873833601, 0.00018478497974222906, 0.0001};
__device__ __forceinline__ NOPK int map_row(int mode, int c) {
    if (mode == 1) { const int b = c >> 10, of = c & 1023, pn = of >> 6, oc = of & 63; return 256 * pn + 128 * (b >> 1) + 32 * (oc >> 4) + 16 * (b & 1) + (oc & 15); }
    if (mode == 2) { return c < DFF ? 256 * (c >> 7) + (c & 127) : 256 * ((c - DFF) >> 7) + 128 + ((c - DFF) & 127); }
    return c;
}
__device__ __forceinline__ NOPK void cvt_item(const float* W, int K, int srcld, int c0, int cnt, bf16* dst, int mode, LAS float* scr, int item, int lane) {
    const int nblk = (cnt + 31) / 32, kb = item / nblk, nb = item % nblk, k0 = 64 * kb, n0 = 32 * nb;
    const bool okr = (n0 + (lane & 31)) < cnt;
    float xin[32];
#pragma unroll
    for (int i = 0; i < 32; ++i) { const int kk = 2 * i + (lane >> 5); xin[i] = okr ? W[(size_t)(k0 + kk) * srcld + c0 + n0 + (lane & 31)] : 0.f; }
#pragma unroll
    for (int i = 0; i < 32; ++i) { const int kk = 2 * i + (lane >> 5); scr[kk * 33 + (lane & 31)] = xin[i]; }
    LDS_WAIT(); asm volatile("" ::: "memory");
    const int c = lane & 7;
#pragma unroll
    for (int j = 0; j < 4; ++j) { const int n = (lane >> 3) + 8 * j; const LAS float* s = scr + (8 * c) * 33 + n;
        v4u o; o.x = cvt_pk_bf16(s[0 * 33], s[1 * 33]); o.y = cvt_pk_bf16(s[2 * 33], s[3 * 33]); o.z = cvt_pk_bf16(s[4 * 33], s[5 * 33]); o.w = cvt_pk_bf16(s[6 * 33], s[7 * 33]);
        if (n0 + n < cnt) *(v4u*)(dst + (size_t)map_row(mode, n0 + n) * K + k0 + 8 * c) = o; }
    LDS_WAIT(); asm volatile("" ::: "memory");
}
struct CvtJob { const float* W; int K, srcld, c0, cnt, mode; bf16* dst; int items; };
__device__ __forceinline__ NOPK CvtJob get_job(KP P, int j) {
    const int l = j / 11, k = j % 11; unsigned char* wl = P->ws + WS_W + (size_t)l * W_LAYER; CvtJob J;
    if (k == 0)      { J.W = P->in[I_WIN] + (size_t)l * D * NIN; J.K = D; J.srcld = NIN; J.c0 = 0; J.cnt = NMIX; J.mode = 0; J.dst = (bf16*)(wl + WO_IN); }
    else if (k == 1) { J.W = P->in[I_WIN] + (size_t)l * D * NIN; J.K = D; J.srcld = NIN; J.c0 = NMIX; J.cnt = 4096; J.mode = 1; J.dst = (bf16*)(wl + WO_G); }
    else if (k < 6)  { const int b = k - 2; J.W = P->in[I_WBR] + (size_t)(l * 4 + b) * 256 * D; J.K = 256; J.srcld = D; J.c0 = 0; J.cnt = D; J.mode = 0; J.dst = (bf16*)(wl + WO_B) + (size_t)b * D * 256; }
    else if (k == 6) { J.W = P->in[I_WMIX] + (size_t)l * D * D; J.K = D; J.srcld = D; J.c0 = 0; J.cnt = D; J.mode = 0; J.dst = (bf16*)(wl + WO_MIX); }
    else if (k == 7) { J.W = P->in[I_WUP] + (size_t)l * D * 2 * DFF; J.K = D; J.srcld = 2 * DFF; J.c0 = 0; J.cnt = 2 * DFF; J.mode = 2; J.dst = (bf16*)(wl + WO_UP); }
    else if (k == 8) { J.W = P->in[I_WDN] + (size_t)l * DFF * D; J.K = DFF; J.srcld = D; J.c0 = 0; J.cnt = D; J.mode = 0; J.dst = (bf16*)(wl + WO_DN); }
    else if (k == 9) { J.W = P->in[I_WPG] + (size_t)l * D * D; J.K = D; J.srcld = D; J.c0 = 0; J.cnt = D; J.mode = 0; J.dst = (bf16*)(wl + WO_PG); }
    else             { J.W = P->in[I_WPP] + (size_t)l * PLE * D; J.K = PLE; J.srcld = D; J.c0 = 0; J.cnt = D; J.mode = 0; J.dst = (bf16*)(wl + WO_PP); }
    J.items = (J.K / 64) * ((J.cnt + 31) / 32);
    return J;
}
template <int NR>
__device__ __forceinline__ NOPK void ln_rows(const float* x0, const float* w, const float* b, bf16* o0, float* f0, int lane) {
    f32x4 v[NR][4];
#pragma unroll
    for (int r = 0; r < NR; ++r)
#pragma unroll
        for (int j = 0; j < 4; ++j) v[r][j] = ((const f32x4*)(x0 + (size_t)r * D))[lane + 64 * j];
    f32x4 wv[4], bv[4];
#pragma unroll
    for (int j = 0; j < 4; ++j) { wv[j] = ((const f32x4*)w)[lane + 64 * j]; bv[j] = ((const f32x4*)b)[lane + 64 * j]; }
#pragma unroll
    for (int r = 0; r < NR; ++r) { float s = 0.f;
#pragma unroll
        for (int j = 0; j < 4; ++j) s += (v[r][j].x + v[r][j].y) + (v[r][j].z + v[r][j].w);
        const float mean = wave_sum(s) * (1.f / D); float q = 0.f;
#pragma unroll
        for (int j = 0; j < 4; ++j) { v[r][j] = v[r][j] - mean; q += (v[r][j].x * v[r][j].x + v[r][j].y * v[r][j].y) + (v[r][j].z * v[r][j].z + v[r][j].w * v[r][j].w); }
        const float rstd = 1.f / sqrtf(wave_sum(q) * (1.f / D) + LN_EPS);
#pragma unroll
        for (int j = 0; j < 4; ++j) { const f32x4 a = v[r][j] * rstd * wv[j] + bv[j];
            if (o0) { v2u pk; pk.x = cvt_pk_bf16(a.x, a.y); pk.y = cvt_pk_bf16(a.z, a.w); ((v2u*)(o0 + (size_t)r * D))[lane + 64 * j] = pk; }
            if (f0) ((f32x4*)(f0 + (size_t)r * D))[lane + 64 * j] = a; } }
}
__device__ __forceinline__ NOPK void ln_phase(const float* V, const float* w, const float* b, bf16* XB, float* OUTF) {
    const int tid = opaque_tid(), lane = tid & 63, gw = blockIdx.x * NWAVES + (tid >> 6), NGW = gridDim.x * NWAVES;
    for (int m = 4 * gw; m < M; m += 4 * NGW) ln_rows<4>(V + (size_t)m * D, w, b, XB ? XB + (size_t)m * D : nullptr, OUTF ? OUTF + (size_t)m * D : nullptr, lane);
}
__device__ __forceinline__ NOPK void prologue(KP P, LAS unsigned char* lds) {
    const int tid = opaque_tid(), lane = tid & 63, wave = __builtin_amdgcn_readfirstlane(tid >> 6);
    LAS float* scr = (LAS float*)(lds + wave * 16384);
    const int gw = blockIdx.x * NWAVES + wave, NGW = gridDim.x * NWAVES;
    const int gt = blockIdx.x * (NWAVES * 64) + tid, NGT = gridDim.x * NWAVES * 64;
    int total = 0;
    for (int j = 0; j < 22; ++j) total += get_job(P, j).items;
    for (int it = gw; it < total; it += NGW) {
        int r = it, j = 0; CvtJob J = get_job(P, 0);
        while (r >= J.items) { r -= J.items; ++j; J = get_job(P, j); }
        cvt_item(J.W, J.K, J.srcld, J.c0, J.cnt, J.dst, J.mode, scr, r, lane);
    }
    for (int l = 0; l < DEPTH; ++l) { v4u* z = (v4u*)((bf16*)(P->ws + WS_W + (size_t)l * W_LAYER + WO_IN) + (size_t)NMIX * D);
        for (int i = gt; i < (NMIXP - NMIX) * D / 8; i += NGT) z[i] = (v4u){0u, 0u, 0u, 0u}; }
    { const f32x4* ps = (const f32x4*)P->in[I_P]; v2u* pd = (v2u*)(P->ws + WS_PB);
        constexpr size_t NP4 = (size_t)DEPTH * M * PLE / 4;
        for (size_t i = gt; i < NP4; i += (size_t)4 * NGT) { f32x4 v[4];
#pragma unroll
            for (int q = 0; q < 4; ++q) if (i + (size_t)q * NGT < NP4) v[q] = ps[i + (size_t)q * NGT];
#pragma unroll
            for (int q = 0; q < 4; ++q) if (i + (size_t)q * NGT < NP4) { v2u o; o.x = cvt_pk_bf16(v[q].x, v[q].y); o.y = cvt_pk_bf16(v[q].z, v[q].w); pd[i + (size_t)q * NGT] = o; } } }
    { f32x2g* rt = (f32x2g*)(P->ws + WS_ROPE);
        for (int i = gt; i < SEQ * 16; i += NGT) { const int t = i >> 4, k = i & 15; const double a = (double)t * ROPE_THETA[k];
            const double n = __builtin_rint(a * 0.15915494309189535); const double r = a - n * 6.283185307179586, r2 = r * r;
            double ts = r, ss = r, tc = 1.0, sc = 1.0;
            for (int q = 1; q <= 14; ++q) { tc *= -r2 / (double)((2 * q - 1) * (2 * q)); sc += tc; ts *= -r2 / (double)((2 * q) * (2 * q + 1)); ss += ts; }
            rt[i] = (f32x2g){(float)sc, (float)ss}; } }
    ln_phase(P->in[I_X], P->in[I_LNINW], P->in[I_LNINB], (bf16*)(P->ws + WS_XB), nullptr);
}

#ifndef REP_PREP
#define REP_PREP 1
#endif
#ifndef REP_REC
#define REP_REC 1
#endif

__device__ __forceinline__ NOPK void ld8(const bf16* p, float (&o)[8]) { const v4u w = *(const v4u*)p; o[0] = bf_lo(w.x); o[1] = bf_hi(w.x); o[2] = bf_lo(w.y); o[3] = bf_hi(w.y); o[4] = bf_lo(w.z); o[5] = bf_hi(w.z); o[6] = bf_lo(w.w); o[7] = bf_hi(w.w); }
__device__ __forceinline__ NOPK void st8(bf16* p, const float (&o)[8]) { v4u w; w.x = cvt_pk_bf16(o[0], o[1]); w.y = cvt_pk_bf16(o[2], o[3]); w.z = cvt_pk_bf16(o[4], o[5]); w.w = cvt_pk_bf16(o[6], o[7]); *(v4u*)p = w; }
__device__ __forceinline__ NOPK float sigmoid_acc(float x) { return __builtin_amdgcn_rcpf(1.0f + __expf(-x)); }
__device__ __forceinline__ NOPK float tanh_fast(float x) { return 2.0f * __builtin_amdgcn_rcpf(1.0f + __expf(-2.0f * x)) - 1.0f; }

typedef short bf16x8v __attribute__((ext_vector_type(8)));
#define SWZ(r, c) ((r) * 64 + ((((c) >> 3) ^ ((r) & 7)) << 3) + ((c) & 7))
__device__ __forceinline__ NOPK bf16x8v frag64(const LAS bf16* arr, int row, int ch) { return *(const LAS bf16x8v*)(arr + row * 64 + ((ch ^ (row & 7)) << 3)); }
template <int MX>
__device__ __forceinline__ NOPK void linattn_fast(LAS unsigned char* lds, KP P, int layer, int b, int h) {
    constexpr int DK = (MX == 3) ? 64 : 32, NDT = DK / 16, NKS = DK / 32, QN = DK / 8;
    asm volatile("" : "+s"(h), "+s"(b));
    const int tid = opaque_tid(), lane = tid & 63, wave = __builtin_amdgcn_readfirstlane(tid >> 6), fr = lane & 15, fq = lane >> 4;
    LAS float* slg = (LAS float*)lds;
    LAS bf16* sQ = (LAS bf16*)(lds + 16384); LAS bf16* sK = (LAS bf16*)(lds + 24576); LAS bf16* sKT = (LAS bf16*)(lds + 32768); LAS bf16* sVT = (LAS bf16*)(lds + 40960);
    LAS bf16* sP = (LAS bf16*)(lds + 49152); LAS bf16* sST = (LAS bf16*)(lds + 57344); LAS bf16* sG = (LAS bf16*)(lds + 65536);
    LAS float* sw2 = (LAS float*)(lds + 73728); LAS float* sbb = sw2 + 512;
    const bf16* Z = (const bf16*)(P->ws + WS_R2);
    bf16* O = (bf16*)P->out;
    const int t8 = tid >> 3, e0 = (tid & 7) * 8, dd0 = (tid & 7) * QN;
    constexpr int zbase = (MX == 0) ? 0 : (MX == 2) ? 1792 : 2576;
    constexpr int qcol = 0, kcol = (MX == 3) ? 256 : 128, vcol = (MX == 3) ? 512 : 256, gcol = (MX == 0) ? 512 : (MX == 2) ? 528 : 768;
    const float lgam = (MX == 0) ? logf(1.0f - exp2f(-5.0f - (float)h)) : 0.f;
    sync_wg();
    if (MX == 2) { sw2[tid] = P->in[I_GLAW2][(size_t)layer * 16 * 128 + (tid >> 5) * 128 + h * 32 + (tid & 31)]; if (tid < 32) sbb[tid] = P->in[I_GLAB][layer * 128 + h * 32 + tid]; sync_wg(); }
    float lbv[8];
#pragma unroll
    for (int i = 0; i < 8; ++i) { lbv[i] = 0.f; if (MX == 3 && layer > 0) lbv[i] = sigmoid_acc(P->in[I_HLB][256 + h * 64 + e0 + i] - P->in[I_HLB][h * 64 + e0 + i]); }
    float nw[16];
#pragma unroll
    for (int i = 0; i < 16; ++i) { const int e = 16 * (i >> 2) + 4 * fq + (i & 3); nw[i] = (MX == 2) ? P->in[I_GLANW][layer * 64 + e] : (MX == 3) ? P->in[I_HNW][layer * 64 + e] : 1.f; }
    f32x4 S[NDT];
#pragma unroll
    for (int i = 0; i < NDT; ++i) S[i] = (f32x4){0.f, 0.f, 0.f, 0.f};
#pragma unroll 1
    for (int c = 0; c < NCHUNK; ++c) {
        const size_t rowbase = (size_t)b * SEQ + c * 64;
        const bf16* zr = Z + (rowbase + t8) * NMIXP + zbase;
        float qr[QN], kr[QN];
        { const v4u vw = *(const v4u*)(zr + vcol + h * 64 + e0);
          const unsigned vv[4] = {vw.x, vw.y, vw.z, vw.w};
#pragma unroll
          for (int i = 0; i < 4; ++i) { sVT[SWZ(e0 + 2 * i, t8)] = (bf16)(vv[i] & 0xffffu); sVT[SWZ(e0 + 2 * i + 1, t8)] = (bf16)(vv[i] >> 16); }
          *(LAS v4u*)(sG + SWZ(t8, e0)) = *(const v4u*)(zr + gcol + h * 64 + e0); }
        if (MX == 3) {
            float a[8], f[8]; ld8(zr + qcol + h * 64 + e0, a); ld8(zr + kcol + h * 64 + e0, f);
#pragma unroll
            for (int i = 0; i < 8; ++i) { qr[i] = a[i]; const float ff = lbv[i] + (1.f - lbv[i]) * sigmoid_acc(f[i]); kr[i] = (1.f - lbv[i]) * sigmoid_acc(-f[i]); slg[t8 * 64 + e0 + i] = logf(ff); }
        } else {
            const v2u qw = *(const v2u*)(zr + qcol + h * 32 + dd0), kw = *(const v2u*)(zr + kcol + h * 32 + dd0);
            float q4[4] = {bf_lo(qw.x), bf_hi(qw.x), bf_lo(qw.y), bf_hi(qw.y)}, k4[4] = {bf_lo(kw.x), bf_hi(kw.x), bf_lo(kw.y), bf_hi(kw.y)};
            if (MX == 0) { const f32x2g* rope = (const f32x2g*)(P->ws + WS_ROPE) + (c * 64 + t8) * 16 + (dd0 >> 1);
#pragma unroll
                for (int p2 = 0; p2 < 2; ++p2) { const f32x2g cs = rope[p2]; const float q1 = q4[2 * p2], q2 = q4[2 * p2 + 1], k1 = k4[2 * p2] * 0.17677669529663687f, k2 = k4[2 * p2 + 1] * 0.17677669529663687f;
                    qr[2 * p2] = q1 * cs.x - q2 * cs.y; qr[2 * p2 + 1] = q1 * cs.y + q2 * cs.x; kr[2 * p2] = k1 * cs.x - k2 * cs.y; kr[2 * p2 + 1] = k1 * cs.y + k2 * cs.x; }
            } else { float gl[16]; { float a[8]; ld8(zr + 512, a);
#pragma unroll
                    for (int i = 0; i < 8; ++i) gl[i] = a[i];
                    ld8(zr + 520, a);
#pragma unroll
                    for (int i = 0; i < 8; ++i) gl[8 + i] = a[i]; }
#pragma unroll
                for (int i = 0; i < 4; ++i) { qr[i] = q4[i] * 0.17677669529663687f; kr[i] = k4[i]; float acc = sbb[dd0 + i];
#pragma unroll
                    for (int j = 0; j < 16; ++j) acc += gl[j] * sw2[j * 32 + dd0 + i];
                    slg[t8 * 64 + dd0 + i] = (fminf(acc, 0.f) - log1pf(__expf(-fabsf(acc)))) * 0.0625f; } }
        }
        if (MX != 0) {
            sync_wg();
            if (tid < DK) { float run = 0.f;
#pragma unroll 1
                for (int tb = 0; tb < 64; tb += 16) { float x[16];
#pragma unroll
                    for (int i = 0; i < 16; ++i) x[i] = slg[(tb + i) * 64 + tid];
#pragma unroll
                    for (int i = 0; i < 16; ++i) { run += x[i]; x[i] = run; }
#pragma unroll
                    for (int i = 0; i < 16; ++i) slg[(tb + i) * 64 + tid] = x[i]; } }
            sync_wg();
        }
        { float qs[QN], ks[QN];
#pragma unroll
          for (int i = 0; i < QN; ++i) { float dq;
              if (MX == 0) dq = (float)(t8 - 31) * lgam; else dq = slg[t8 * 64 + dd0 + i] - slg[31 * 64 + dd0 + i];
              qs[i] = qr[i] * __expf(dq); ks[i] = kr[i] * __expf(-dq); }
          if (QN == 8) { v4u o; o.x = cvt_pk_bf16(qs[0], qs[1]); o.y = cvt_pk_bf16(qs[2], qs[3]); o.z = cvt_pk_bf16(qs[4], qs[5]); o.w = cvt_pk_bf16(qs[6], qs[7]); *(LAS v4u*)(sQ + SWZ(t8, dd0)) = o;
                         v4u p; p.x = cvt_pk_bf16(ks[0], ks[1]); p.y = cvt_pk_bf16(ks[2], ks[3]); p.z = cvt_pk_bf16(ks[4], ks[5]); p.w = cvt_pk_bf16(ks[6], ks[7]); *(LAS v4u*)(sK + SWZ(t8, dd0)) = p; }
          else { v2u o; o.x = cvt_pk_bf16(qs[0], qs[1]); o.y = cvt_pk_bf16(qs[2], qs[3]); *(LAS v2u*)(sQ + SWZ(t8, dd0)) = o;
                 v2u p; p.x = cvt_pk_bf16(ks[0], ks[1]); p.y = cvt_pk_bf16(ks[2], ks[3]); *(LAS v2u*)(sK + SWZ(t8, dd0)) = p; }
#pragma unroll
          for (int i = 0; i < QN; i += 2) { const unsigned w = cvt_pk_bf16(ks[i], ks[i + 1]); sKT[SWZ(dd0 + i, t8)] = (bf16)(w & 0xffffu); sKT[SWZ(dd0 + i + 1, t8)] = (bf16)(w >> 16); } }
        sync_wg();
        bf16x8v bq[NKS];
        if (wave < 4) {
            const int t = 16 * wave + fr;
#pragma unroll
            for (int ks = 0; ks < NKS; ++ks) bq[ks] = frag64(sQ, t, 4 * ks + fq);
#pragma unroll
            for (int j = 0; j < 4; ++j) { f32x4 acc = (f32x4){0.f, 0.f, 0.f, 0.f};
                if (j <= wave) {
#pragma unroll
                    for (int ks = 0; ks < NKS; ++ks) acc = __builtin_amdgcn_mfma_f32_16x16x32_bf16(frag64(sK, 16 * j + fr, 4 * ks + fq), bq[ks], acc, 0, 0, 0); }
                float pv[4];
#pragma unroll
                for (int rg = 0; rg < 4; ++rg) pv[rg] = (j < wave || (j == wave && 4 * fq + rg <= fr)) ? acc[rg] : 0.f;
                v2u o; o.x = cvt_pk_bf16(pv[0], pv[1]); o.y = cvt_pk_bf16(pv[2], pv[3]);
                *(LAS v2u*)(sP + t * 64 + (((2 * j + (fq >> 1)) ^ (t & 7)) << 3) + 4 * (fq & 1)) = o; }
        } else {
            const int e = 16 * (wave - 4) + fr;
#pragma unroll
            for (int i = 0; i < NDT; ++i) { float sc[4];
#pragma unroll
                for (int rg = 0; rg < 4; ++rg) sc[rg] = (MX == 0) ? __expf(32.f * lgam) : __expf(slg[31 * 64 + 16 * i + 4 * fq + rg]);
                v2u o; o.x = cvt_pk_bf16(S[i][0] * sc[0], S[i][1] * sc[1]); o.y = cvt_pk_bf16(S[i][2] * sc[2], S[i][3] * sc[3]);
                *(LAS v2u*)(sST + e * 64 + (((2 * i + (fq >> 1)) ^ (e & 7)) << 3) + 4 * (fq & 1)) = o; }
        }
        sync_wg();
        if (wave < 4) {
            const int t = 16 * wave + fr;
            bf16x8v bp[2];
#pragma unroll
            for (int ks = 0; ks < 2; ++ks) bp[ks] = frag64(sP, t, 4 * ks + fq);
            f32x4 oacc[4];
#pragma unroll
            for (int i = 0; i < 4; ++i) { f32x4 acc = (f32x4){0.f, 0.f, 0.f, 0.f};
                acc = __builtin_amdgcn_mfma_f32_16x16x32_bf16(frag64(sVT, 16 * i + fr, fq), bp[0], acc, 0, 0, 0);
                if (wave >= 2) acc = __builtin_amdgcn_mfma_f32_16x16x32_bf16(frag64(sVT, 16 * i + fr, 4 + fq), bp[1], acc, 0, 0, 0);
#pragma unroll
                for (int ks = 0; ks < NKS; ++ks) acc = __builtin_amdgcn_mfma_f32_16x16x32_bf16(frag64(sST, 16 * i + fr, 4 * ks + fq), bq[ks], acc, 0, 0, 0);
                oacc[i] = acc; }
            float s1 = 0.f;
#pragma unroll
            for (int i = 0; i < 4; ++i)
#pragma unroll
                for (int rg = 0; rg < 4; ++rg) s1 += (MX == 0) ? oacc[i][rg] : oacc[i][rg] * oacc[i][rg];
            s1 += shfl_xor_(s1, 16); s1 += shfl_xor_(s1, 32);
            float rs;
            if (MX == 0) { const float mean = s1 * (1.f / 64.f); float q2 = 0.f;
#pragma unroll
                for (int i = 0; i < 4; ++i)
#pragma unroll
                    for (int rg = 0; rg < 4; ++rg) { oacc[i][rg] -= mean; q2 += oacc[i][rg] * oacc[i][rg]; }
                q2 += shfl_xor_(q2, 16); q2 += shfl_xor_(q2, 32); rs = 1.0f / sqrtf(q2 * (1.f / 64.f) + 1e-6f);
            } else rs = 1.0f / sqrtf(s1 * (1.f / 64.f) + 1e-6f);
#pragma unroll
            for (int i = 0; i < 4; ++i) { const v2u gw = *(const LAS v2u*)(sG + t * 64 + (((2 * i + (fq >> 1)) ^ (t & 7)) << 3) + 4 * (fq & 1));
                const float g4[4] = {bf_lo(gw.x), bf_hi(gw.x), bf_lo(gw.y), bf_hi(gw.y)}; float y[4];
#pragma unroll
                for (int rg = 0; rg < 4; ++rg) y[rg] = oacc[i][rg] * rs * nw[4 * i + rg] * g4[rg] * sigmoid_acc(g4[rg]);
                v2u o; o.x = cvt_pk_bf16(y[0], y[1]); o.y = cvt_pk_bf16(y[2], y[3]);
                *(v2u*)(O + (rowbase + t) * D + MX * 256 + h * 64 + 16 * i + 4 * fq) = o; }
        } else {
            const int e = 16 * (wave - 4) + fr;
            bf16x8v bv[2];
#pragma unroll
            for (int ks = 0; ks < 2; ++ks) bv[ks] = frag64(sVT, e, 4 * ks + fq);
#pragma unroll
            for (int i = 0; i < NDT; ++i) { f32x4 acc = (f32x4){0.f, 0.f, 0.f, 0.f};
#pragma unroll
                for (int ks = 0; ks < 2; ++ks) acc = __builtin_amdgcn_mfma_f32_16x16x32_bf16(frag64(sKT, 16 * i + fr, 4 * ks + fq), bv[ks], acc, 0, 0, 0);
#pragma unroll
                for (int rg = 0; rg < 4; ++rg) { float el, er;
                    if (MX == 0) { el = __expf(64.f * lgam); er = __expf(32.f * lgam); }
                    else { const float bl = slg[63 * 64 + 16 * i + 4 * fq + rg], br = slg[31 * 64 + 16 * i + 4 * fq + rg]; el = __expf(bl); er = __expf(bl - br); }
                    S[i][rg] = el * S[i][rg] + er * acc[rg]; } }
        }
        sync_wg();
    }
}

__device__ __forceinline__ NOPK float dpp_f(float x, const int ctrl_sel) {
    const int xi = __builtin_bit_cast(int, x); int r;
    if (ctrl_sel == 0) r = __builtin_amdgcn_update_dpp(0, xi, 0xB1, 0xf, 0xf, true);
    else if (ctrl_sel == 1) r = __builtin_amdgcn_update_dpp(0, xi, 0x4E, 0xf, 0xf, true);
    else if (ctrl_sel == 2) r = __builtin_amdgcn_update_dpp(0, xi, 0x141, 0xf, 0xf, true);
    else r = __builtin_amdgcn_update_dpp(0, xi, 0x140, 0xf, 0xf, true);
    return __builtin_bit_cast(float, r);
}
__device__ __forceinline__ NOPK float sum16_dpp(float v) { v += dpp_f(v, 0); v += dpp_f(v, 1); v += dpp_f(v, 2); v += dpp_f(v, 3); return v; }
#define DPP_SUM16_2(a_, b_) asm volatile( \
    "s_nop 1\n\t" \
    "v_add_f32_dpp %0, %0, %0 quad_perm:[1,0,3,2] row_mask:0xf bank_mask:0xf bound_ctrl:1\n\t" \
    "v_add_f32_dpp %1, %1, %1 quad_perm:[1,0,3,2] row_mask:0xf bank_mask:0xf bound_ctrl:1\n\t" \
    "s_nop 0\n\t" \
    "v_add_f32_dpp %0, %0, %0 quad_perm:[2,3,0,1] row_mask:0xf bank_mask:0xf bound_ctrl:1\n\t" \
    "v_add_f32_dpp %1, %1, %1 quad_perm:[2,3,0,1] row_mask:0xf bank_mask:0xf bound_ctrl:1\n\t" \
    "s_nop 0\n\t" \
    "v_add_f32_dpp %0, %0, %0 row_half_mirror row_mask:0xf bank_mask:0xf bound_ctrl:1\n\t" \
    "v_add_f32_dpp %1, %1, %1 row_half_mirror row_mask:0xf bank_mask:0xf bound_ctrl:1\n\t" \
    "s_nop 0\n\t" \
    "v_add_f32_dpp %0, %0, %0 row_mirror row_mask:0xf bank_mask:0xf bound_ctrl:1\n\t" \
    "v_add_f32_dpp %1, %1, %1 row_mirror row_mask:0xf bank_mask:0xf bound_ctrl:1\n\t" \
    : "+v"(a_), "+v"(b_));
__device__ __forceinline__ NOPK float sum8_dpp(float v) { v += dpp_f(v, 0); v += dpp_f(v, 1); v += dpp_f(v, 2); return v; }

constexpr int RW_SET = 40960;
constexpr int RW_SV = 81920, RW_SY = 90112, RW_SG = 98304, RW_SB = 106496;
constexpr int RW_SCR = 108544;
constexpr int RW_W2T = 124928, RW_A2T = 133120, RW_G2T = 141312;
constexpr int RW_MU = 149504, RW_PAR = 151296;
__device__ __forceinline__ NOPK void rwkv_task2(LAS unsigned char* lds, KP P, int layer, int b, int h, int half) {
    asm volatile("" : "+s"(h), "+s"(b), "+s"(half));
    const int tid = opaque_tid(), lane = tid & 63, wave = __builtin_amdgcn_readfirstlane(tid >> 6);
    LAS bf16* w2T = (LAS bf16*)(lds + RW_W2T); LAS bf16* a2T = (LAS bf16*)(lds + RW_A2T); LAS bf16* g2T = (LAS bf16*)(lds + RW_G2T);
    LAS float* smu = (LAS float*)(lds + RW_MU); LAS float* spar = (LAS float*)(lds + RW_PAR);
    const bf16* Z = (const bf16*)(P->ws + WS_R2);
    const int colh = h * 64;
    constexpr int NC2 = SEQ / 32;
    sync_wg();
    if (tid < 448) { const int seg = tid >> 6, j = tid & 63; const int col = (seg < 3) ? seg * 256 + colh + j : 768 + (seg - 3) * 64 + j; smu[tid] = P->in[I_MU][layer * 1024 + col]; }
    if (tid < 320) { const int seg = tid >> 6, j = tid & 63; const float* src = (seg == 0) ? P->in[I_KK] + layer * 256 + colh : (seg == 1) ? P->in[I_KA] + layer * 256 + colh : (seg == 2) ? P->in[I_RK] + (layer * 4 + h) * 64
                                                                             : (seg == 3) ? P->in[I_RLNW] + layer * 256 + colh : P->in[I_RLNB] + layer * 256 + colh; spar[tid] = src[j]; }
    { const int cc = tid & 63, jb = tid >> 6;
      const float* w2 = P->in[I_W2] + (size_t)layer * 64 * 256 + colh + cc; const float* a2 = P->in[I_A2] + (size_t)layer * 64 * 256 + colh + cc;
      float x[8];
#pragma unroll
      for (int i = 0; i < 8; ++i) x[i] = w2[(8 * jb + i) * 256];
      { v4u o; o.x = cvt_pk_bf16(x[0], x[1]); o.y = cvt_pk_bf16(x[2], x[3]); o.z = cvt_pk_bf16(x[4], x[5]); o.w = cvt_pk_bf16(x[6], x[7]); *(LAS v4u*)(w2T + cc * 64 + ((jb ^ (cc & 7)) << 3)) = o; }
#pragma unroll
      for (int i = 0; i < 8; ++i) x[i] = a2[(8 * jb + i) * 256];
      { v4u o; o.x = cvt_pk_bf16(x[0], x[1]); o.y = cvt_pk_bf16(x[2], x[3]); o.z = cvt_pk_bf16(x[4], x[5]); o.w = cvt_pk_bf16(x[6], x[7]); *(LAS v4u*)(a2T + cc * 64 + ((jb ^ (cc & 7)) << 3)) = o; }
      const int cg = tid & 31, ch = tid >> 5; const float* g2 = P->in[I_G2] + (size_t)layer * 128 * 256 + colh + 32 * half + cg;
#pragma unroll
      for (int i = 0; i < 8; ++i) x[i] = g2[(8 * ch + i) * 256];
      { v4u o; o.x = cvt_pk_bf16(x[0], x[1]); o.y = cvt_pk_bf16(x[2], x[3]); o.z = cvt_pk_bf16(x[4], x[5]); o.w = cvt_pk_bf16(x[6], x[7]); *(LAS v4u*)(g2T + cg * 128 + ((ch ^ (cg & 7)) << 3)) = o; } }
    sync_wg();
    const int wrole = wave >> 2, widx = wave & 3;
    if (wrole) {
        const int pw = widx, tl = lane >> 3, e0 = (lane & 7) * 8, tk = 8 * pw + tl;
        const int fr = lane & 15, fq = lane >> 4;
        LAS bf16* tw = (LAS bf16*)(lds + RW_SCR + pw * 4096); LAS bf16* ta = tw + 512; LAS bf16* tg = tw + 1024;
        float w0v[4], a0v[4];
#pragma unroll
        for (int q = 0; q < 4; ++q) { w0v[q] = P->in[I_W0][layer * 256 + colh + 16 * q + fr]; a0v[q] = P->in[I_A0][layer * 256 + colh + 16 * q + fr]; }
        v4u R[7], Rp[7];
#define RW2_LOAD(cc_) { const size_t row_ = (size_t)b * SEQ + (cc_) * 32 + tk; const bf16* zr_ = Z + row_ * NMIXP + 768; const bf16* zp_ = ((cc_) == 0 && tk == 0) ? zr_ : zr_ - NMIXP; \
        const int cols_[7] = {colh + e0, 256 + colh + e0, 512 + colh + e0, 768 + e0, 832 + e0, 896 + e0, 960 + e0}; \
        _Pragma("unroll") for (int q_ = 0; q_ < 7; ++q_) { R[q_] = *(const v4u*)(zr_ + cols_[q_]); Rp[q_] = *(const v4u*)(zp_ + cols_[q_]); } }
        RW2_LOAD(0)
#pragma unroll 1
        for (int it = -1; it <= NC2; ++it) {
            if (it >= 1) { const int oc = it - 1, ob = oc & 1; const int c4 = (lane & 7) * 4;
                const LAS float* sy = (const LAS float*)(lds + RW_SY + ob * 4096); const LAS float* sv = (const LAS float*)(lds + RW_SV + ob * 4096); const LAS float* sg = (const LAS float*)(lds + RW_SG + ob * 4096);
                const f32x4 yv = *(const LAS f32x4*)(sy + tk * 32 + c4), vv = *(const LAS f32x4*)(sv + tk * 32 + c4), gv = *(const LAS f32x4*)(sg + tk * 32 + c4);
                float s = (yv.x + yv.y) + (yv.z + yv.w); s = red8(s); const float mean = s * (1.f / 32.f);
                const f32x4 d = yv - mean; float q = (d.x * d.x + d.y * d.y) + (d.z * d.z + d.w * d.w); q = red8(q);
                const float bon = ((const LAS float*)(lds + RW_SB + ob * 128))[tk];
                const size_t row = (size_t)b * SEQ + oc * 32 + tk; const size_t off = row * 256 + colh + 32 * half + c4;
                *(f32x4*)((float*)(P->out + (size_t)M * D / 2) + off) = yv;
                v2u ad; ad.x = cvt_pk_bf16(bon * vv.x, bon * vv.y); ad.y = cvt_pk_bf16(bon * vv.z, bon * vv.w);
                *(v2u*)((bf16*)(P->out + (size_t)M * D / 2 + (size_t)M * 256) + off) = ad;
                v2u gt; gt.x = cvt_pk_bf16(gv.x, gv.y); gt.y = cvt_pk_bf16(gv.z, gv.w);
                *(v2u*)((bf16*)(P->out + (size_t)M * D / 2 + (size_t)M * 256) + (size_t)M * 256 + off) = gt;
                if ((lane & 7) == 0) ((f32x2g*)(P->ws + WS_RST))[(row * 4 + h) * 2 + half] = (f32x2g){mean, q}; }
            if (it + 1 < NC2) { const int pc = it + 1, pb = pc & 1;
                LAS float* sr = (LAS float*)(lds + pb * RW_SET); LAS float* skm = sr + 2048; LAS float* sw = sr + 4096; LAS float* skk = sr + 6144; LAS float* ska = sr + 8192;
                LAS float* sv = (LAS float*)(lds + RW_SV + pb * 4096); LAS float* sg = (LAS float*)(lds + RW_SG + pb * 4096); LAS float* sb = (LAS float*)(lds + RW_SB + pb * 128);
                { const bool first = (pc == 0 && tk == 0); float a[8], p[8], z[8];
#define UNPK2(vv_, o_) { const v4u u_ = vv_; o_[0] = bf_lo(u_.x); o_[1] = bf_hi(u_.x); o_[2] = bf_lo(u_.y); o_[3] = bf_hi(u_.y); o_[4] = bf_lo(u_.z); o_[5] = bf_hi(u_.z); o_[6] = bf_lo(u_.w); o_[7] = bf_hi(u_.w); }
#define SHIFT2(idx) { UNPK2(R[idx], a) UNPK2(Rp[idx], p) _Pragma("unroll") for (int i = 0; i < 8; ++i) { const float pv = first ? 0.f : p[i]; z[i] = a[i] + (pv - a[i]) * smu[(idx) * 64 + e0 + i]; } }
                  SHIFT2(0)
                  *(LAS f32x4*)(sr + tk * 64 + e0) = (f32x4){z[0], z[1], z[2], z[3]}; *(LAS f32x4*)(sr + tk * 64 + e0 + 4) = (f32x4){z[4], z[5], z[6], z[7]};
                  SHIFT2(1)
                  *(LAS f32x4*)(skm + tk * 64 + e0) = (f32x4){z[0], z[1], z[2], z[3]}; *(LAS f32x4*)(skm + tk * 64 + e0 + 4) = (f32x4){z[4], z[5], z[6], z[7]};
                  SHIFT2(2)
                  if ((e0 >> 5) == half) { *(LAS f32x4*)(sv + tk * 32 + (e0 & 31)) = (f32x4){z[0], z[1], z[2], z[3]}; *(LAS f32x4*)(sv + tk * 32 + (e0 & 31) + 4) = (f32x4){z[4], z[5], z[6], z[7]}; }
                  const int sw8 = ((lane & 7) ^ (tl & 7)) << 3;
                  SHIFT2(3)
                  { v4u o; o.x = cvt_pk_bf16(tanh_fast(z[0]), tanh_fast(z[1])); o.y = cvt_pk_bf16(tanh_fast(z[2]), tanh_fast(z[3])); o.z = cvt_pk_bf16(tanh_fast(z[4]), tanh_fast(z[5])); o.w = cvt_pk_bf16(tanh_fast(z[6]), tanh_fast(z[7])); *(LAS v4u*)(tw + tl * 64 + sw8) = o; }
                  SHIFT2(4)
                  { v4u o; o.x = cvt_pk_bf16(z[0], z[1]); o.y = cvt_pk_bf16(z[2], z[3]); o.z = cvt_pk_bf16(z[4], z[5]); o.w = cvt_pk_bf16(z[6], z[7]); *(LAS v4u*)(ta + tl * 64 + sw8) = o; }
                  SHIFT2(5)
                  { v4u o; o.x = cvt_pk_bf16(sigmoid_acc(z[0]), sigmoid_acc(z[1])); o.y = cvt_pk_bf16(sigmoid_acc(z[2]), sigmoid_acc(z[3])); o.z = cvt_pk_bf16(sigmoid_acc(z[4]), sigmoid_acc(z[5])); o.w = cvt_pk_bf16(sigmoid_acc(z[6]), sigmoid_acc(z[7])); *(LAS v4u*)(tg + tl * 128 + sw8) = o; }
                  SHIFT2(6)
                  { v4u o; o.x = cvt_pk_bf16(sigmoid_acc(z[0]), sigmoid_acc(z[1])); o.y = cvt_pk_bf16(sigmoid_acc(z[2]), sigmoid_acc(z[3])); o.z = cvt_pk_bf16(sigmoid_acc(z[4]), sigmoid_acc(z[5])); o.w = cvt_pk_bf16(sigmoid_acc(z[6]), sigmoid_acc(z[7])); *(LAS v4u*)(tg + tl * 128 + 64 + sw8) = o; }
#undef SHIFT2
#undef UNPK2
                }
                if (pc + 1 < NC2) RW2_LOAD(pc + 1)
                asm volatile("s_waitcnt lgkmcnt(0)" ::: "memory");
                { const int ar = fr & 7;
                  f32x4 wacc[4], aacc[4], gacc[2];
#pragma unroll
                  for (int q = 0; q < 4; ++q) { wacc[q] = (f32x4){0.f, 0.f, 0.f, 0.f}; aacc[q] = wacc[q]; }
                  gacc[0] = (f32x4){0.f, 0.f, 0.f, 0.f}; gacc[1] = gacc[0];
#pragma unroll
                  for (int ks = 0; ks < 2; ++ks) { const int ch = ks * 4 + fq;
                      const bf16x8v Aw = *(const LAS bf16x8v*)(tw + ar * 64 + ((ch ^ (ar & 7)) << 3)), Aa = *(const LAS bf16x8v*)(ta + ar * 64 + ((ch ^ (ar & 7)) << 3));
#pragma unroll
                      for (int q = 0; q < 4; ++q) { const int br = 16 * q + fr;
                          const bf16x8v Bw = *(const LAS bf16x8v*)(w2T + br * 64 + ((ch ^ (br & 7)) << 3)), Ba = *(const LAS bf16x8v*)(a2T + br * 64 + ((ch ^ (br & 7)) << 3));
                          wacc[q] = __builtin_amdgcn_mfma_f32_16x16x32_bf16(Aw, Bw, wacc[q], 0, 0, 0); aacc[q] = __builtin_amdgcn_mfma_f32_16x16x32_bf16(Aa, Ba, aacc[q], 0, 0, 0); } }
#pragma unroll
                  for (int ks = 0; ks < 4; ++ks) { const int ch = ks * 4 + fq;
                      const bf16x8v Ag = *(const LAS bf16x8v*)(tg + ar * 128 + ((ch ^ (ar & 7)) << 3));
#pragma unroll
                      for (int q = 0; q < 2; ++q) { const int br = 16 * q + fr;
                          const bf16x8v Bg = *(const LAS bf16x8v*)(g2T + br * 128 + ((ch ^ (br & 7)) << 3));
                          gacc[q] = __builtin_amdgcn_mfma_f32_16x16x32_bf16(Ag, Bg, gacc[q], 0, 0, 0); } }
                  if (fq < 2) {
#pragma unroll
                      for (int rg = 0; rg < 4; ++rg) { const int t = 8 * pw + 4 * fq + rg;
#pragma unroll
                          for (int q = 0; q < 4; ++q) { const int cc = 16 * q + fr;
                              sw[t * 64 + cc] = __expf(-0.6065306597126334f * sigmoid_acc(w0v[q] + wacc[q][rg])); ska[t * 64 + cc] = sigmoid_acc(a0v[q] + aacc[q][rg]); }
#pragma unroll
                          for (int q = 0; q < 2; ++q) sg[t * 32 + 16 * q + fr] = gacc[q][rg]; } } }
                asm volatile("s_waitcnt lgkmcnt(0)" ::: "memory");
                { float ss = 0.f, bon = 0.f; float kk[8], av[8];
#pragma unroll
                  for (int i = 0; i < 8; ++i) { const int cc = e0 + i; const float kv = skm[tk * 64 + cc]; av[i] = ska[tk * 64 + cc];
                      kk[i] = kv * spar[cc]; ss += kk[i] * kk[i];
                      const float km = kv * (1.f + (av[i] - 1.f) * spar[64 + cc]); skm[tk * 64 + cc] = km;
                      bon += sr[tk * 64 + cc] * km * spar[128 + cc]; }
                  ss = red8(ss); bon = red8(bon); const float inv = 1.0f / sqrtf(ss + 1e-12f);
#pragma unroll
                  for (int i = 0; i < 8; ++i) { const float kn = kk[i] * inv; skk[tk * 64 + e0 + i] = kn; ska[tk * 64 + e0 + i] = kn * av[i]; }
                  if ((lane & 7) == 0) sb[tk] = bon; }
            }
            sync_wg();
        }
#undef RW2_LOAD
    } else {
        const int kq = lane & 15, vloc = 2 * (4 * widx + (lane >> 4));
        typedef float f32x2 __attribute__((ext_vector_type(2)));
        f32x2 S2[4];
#pragma unroll
        for (int i = 0; i < 4; ++i) S2[i] = (f32x2){0.f, 0.f};
        sync_wg();
#pragma unroll 1
        for (int it = 0; it < NC2; ++it) { const int cb = it & 1;
            const LAS f32x4* pr = (const LAS f32x4*)(lds + cb * RW_SET + 16 * kq); const LAS f32x4* pkm = pr + 512; const LAS f32x4* pw = pr + 1024; const LAS f32x4* pkk = pr + 1536; const LAS f32x4* pka = pr + 2048;
            const LAS f32x2* pv = (const LAS f32x2*)(lds + RW_SV + cb * 4096 + 4 * vloc); LAS float* sy = (LAS float*)(lds + RW_SY + cb * 4096);
            const f32x2 Ssv0 = S2[0], Ssv1 = S2[1], Ssv2 = S2[2], Ssv3 = S2[3];
            for (int rr_ = 0; rr_ < REP_REC; ++rr_) { S2[0] = Ssv0; S2[1] = Ssv1; S2[2] = Ssv2; S2[3] = Ssv3;
            f32x4 wA = pw[0], kA = pkk[0], aA = pka[0], mA = pkm[0], rA = pr[0]; f32x2 vA = pv[0];
            f32x4 wB, kB, aB, mB, rB; f32x2 vB;
#define RWKV_STEP(tcur, tn, wX, kX, aX, mX, rX, vX, wY, kY, aY, mY, rY, vY) { \
              wY = pw[(tn) * 16]; kY = pkk[(tn) * 16]; aY = pka[(tn) * 16]; mY = pkm[(tn) * 16]; rY = pr[(tn) * 16]; vY = pv[(tn) * 16]; \
              f32x2 sa = S2[0] * kX.x; sa = S2[1] * kX.y + sa; sa = S2[2] * kX.z + sa; sa = S2[3] * kX.w + sa; \
              const f32x2 tm0 = S2[0] * wX.x + vX * mX.x, tm1 = S2[1] * wX.y + vX * mX.y, tm2 = S2[2] * wX.z + vX * mX.z, tm3 = S2[3] * wX.w + vX * mX.w; \
              float s0 = sa.x, s1 = sa.y; DPP_SUM16_2(s0, s1) \
              const f32x2 sar = (f32x2){s0, s1}; \
              S2[0] = tm0 - sar * aX.x; S2[1] = tm1 - sar * aX.y; S2[2] = tm2 - sar * aX.z; S2[3] = tm3 - sar * aX.w; \
              f32x2 yy = S2[0] * rX.x; yy = S2[1] * rX.y + yy; yy = S2[2] * rX.z + yy; yy = S2[3] * rX.w + yy; \
              float y0 = yy.x, y1 = yy.y; DPP_SUM16_2(y0, y1) \
              if (kq == 0) *(LAS f32x2*)(sy + (tcur) * 32 + vloc) = (f32x2){y0, y1}; }
#pragma unroll 1
            for (int t = 0; t < 32; t += 2) {
                RWKV_STEP(t, t + 1, wA, kA, aA, mA, rA, vA, wB, kB, aB, mB, rB, vB)
                RWKV_STEP(t + 1, (t + 2) & 31, wB, kB, aB, mB, rB, vB, wA, kA, aA, mA, rA, vA) }
#undef RWKV_STEP
            }
            sync_wg();
        }
        sync_wg();
    }
}

__device__ __forceinline__ NOPK void rwkv_finalize(KP P, int layer) {
    const int gt = blockIdx.x * (NWAVES * 64) + opaque_tid(), NGT = gridDim.x * NWAVES * 64;
    const float* YR = P->out + (size_t)M * D / 2; const bf16* AD = (const bf16*)(YR + (size_t)M * 256); const bf16* GT = AD + (size_t)M * 256;
    const f32x2g* ST = (const f32x2g*)(P->ws + WS_RST); bf16* O = (bf16*)P->out;
    for (int i = gt; i < M * 64; i += NGT) { const int row = i >> 6, c4 = (i & 63) * 4, h = c4 >> 6;
        const f32x2g sa = ST[(row * 4 + h) * 2], sb = ST[(row * 4 + h) * 2 + 1];
        const float mean = 0.5f * (sa.x + sb.x), dm = sa.x - sb.x, m2 = sa.y + sb.y + 16.f * dm * dm, rs = 1.0f / sqrtf(m2 * (1.f / 64.f) + 64e-5f);
        const f32x4 y = *(const f32x4*)(YR + (size_t)row * 256 + c4); const v2u ad = *(const v2u*)(AD + (size_t)row * 256 + c4), g = *(const v2u*)(GT + (size_t)row * 256 + c4);
        const f32x4 lw = *(const f32x4*)(P->in[I_RLNW] + layer * 256 + c4), lb = *(const f32x4*)(P->in[I_RLNB] + layer * 256 + c4);
        v2u o; o.x = cvt_pk_bf16(((y.x - mean) * rs * lw.x + lb.x + bf_lo(ad.x)) * bf_lo(g.x), ((y.y - mean) * rs * lw.y + lb.y + bf_hi(ad.x)) * bf_hi(g.x));
        o.y = cvt_pk_bf16(((y.z - mean) * rs * lw.z + lb.z + bf_lo(ad.y)) * bf_lo(g.y), ((y.w - mean) * rs * lw.w + lb.w + bf_hi(ad.y)) * bf_hi(g.y));
        *(v2u*)(O + (size_t)row * D + 256 + c4) = o; }
}

__device__ __forceinline__ NOPK void ffn_fixup_panel(KP P, int layer, int pm) {
    const int tid = opaque_tid();
    const float* uh = (const float*)(P->ws + WS_HALO); const float* vh = (const float*)(P->ws + WS_HALO + HALO_ONE); const float* ut = (const float*)(P->ws + WS_HALO + 2 * HALO_ONE);
    const float* conv = P->in[I_CONV] + (size_t)layer * 3 * DFF; bf16* ACT = (bf16*)(P->ws + WS_R2);
    for (int i = tid; i < 2 * DFF; i += NWAVES * 64) { const int rr = i / DFF, cc = i % DFF;
        const float u0 = uh[((size_t)pm * 2) * DFF + cc], u1 = uh[((size_t)pm * 2 + 1) * DFF + cc];
        float t0 = 0.f, t1 = 0.f; if (pm & 7) { t0 = ut[((size_t)(pm - 1) * 2) * DFF + cc]; t1 = ut[((size_t)(pm - 1) * 2 + 1) * DFF + cc]; }
        const float c0 = conv[cc], c1 = conv[DFF + cc], c2 = conv[2 * DFF + cc];
        const float cv = rr ? (c2 * u1 + c1 * u0 + c0 * t1) : (c2 * u0 + c1 * t1 + c0 * t0);
        const float a = pg8::gelu_tanh_f(cv) * vh[((size_t)pm * 2 + rr) * DFF + cc];
        ACT[((size_t)pm * 256 + rr) * DFF + cc] = (bf16)(cvt_pk_bf16(a, 0.f) & 0xffffu); }
}

constexpr int NPH = 1 + 10 * DEPTH;
#ifndef REP_MIX
#define REP_MIX -1
#endif
#ifndef REP_PHASE
#define REP_PHASE -1
#endif
#define REPEAT(k) for (int rep_ = 0; rep_ < ((REP_PHASE == (k)) ? 2 : 1); ++rep_)
__global__ void __launch_bounds__(NWAVES * 64, 2) NOPK mega(Params Pk) {
    KP P = kparams();
    extern __shared__ __attribute__((aligned(16))) unsigned char lds_raw[];
    LAS unsigned char* lds = (LAS unsigned char*)lds_raw;
    volatile LAS unsigned* MISC = (volatile LAS unsigned*)(lds + LDS_MISC);
    const int tid = threadIdx.x;
    const int G = gridDim.x, bx = blockIdx.x;
    if (tid < 64) MISC[tid] = 0u;
    sync_wg();
    const int lo = P->ph_lo, hi = P->ph_hi;
    XcdBarrier bar; bar.bar = (unsigned*)(P->ws + WS_CTL) + CW_BAR; bar.x = 0; bar.st = nullptr;
    if (hi - lo > 1) bar = xcd_barrier_post((unsigned*)(P->ws + WS_CTL) + CW_BAR, MISC + 8);
#define IN(k) (lo <= (k) && (k) < hi)
#define SEAM(k) do { if (IN(k) && IN((k) + 1)) xcd_barrier(bar); } while (0)
#define PHASE_PTRS KP P = kparams(); unsigned char* const wl = P->ws + WS_W + (size_t)l * W_LAYER; bf16* const XB = (bf16*)(P->ws + WS_XB); unsigned char* const R2 = P->ws + WS_R2; \
        bf16* const OB = (bf16*)P->out;   bf16* const MG = (bf16*)P->out + (size_t)M * D;   \
        (void)wl; (void)XB; (void)R2; (void)OB; (void)MG;

    REPEAT(100) if (IN(0)) prologue(kparams(), lds);
    SEAM(0);
    for (int l = 0; l < DEPTH; ++l) {
        const int pb = 1 + 10 * l;
        REPEAT(0) if (IN(pb + 0)) {
            PHASE_PTRS
            pg8::Gemm g{XB, (const bf16*)(wl + WO_IN), M, NMIXP, D, D, D, 0, 0}; pg8::StaticOrder S; S.init(M, NMIXP, G, bx);
            pg8::EpiStoreBf16 E{(bf16*)R2, NMIXP};
            pg8::gemm_phase<pg8::EpiStoreBf16, pg8::StaticOrder, true, true>(lds, g, S, E);
        }
        SEAM(pb + 0);
        REPEAT(1) if (IN(pb + 1)) {
            PHASE_PTRS
#ifndef NO_MIX
            for (int slot = bx; slot < 256; slot += G) {
                if (slot < 128) { const int bh = slot >> 1; rwkv_task2(lds, P, l, bh >> 2, bh & 3, slot & 1); }
                else if (slot < 192) { const int bh = slot - 128; linattn_fast<0>(lds, P, l, bh >> 2, bh & 3); linattn_fast<2>(lds, P, l, bh >> 2, bh & 3); }
                else { const int bh = slot - 192; linattn_fast<3>(lds, P, l, bh >> 2, bh & 3);
                    pg8::Gemm g{(const bf16*)(P->ws + WS_PB) + (size_t)l * M * PLE, (const bf16*)(wl + WO_PP), M, D, PLE, PLE, PLE, 0, 0}; pg8::StaticOrder S; S.init(M, D, 64, slot - 192);
                    pg8::EpiStoreBf16 E{(bf16*)(P->ws + WS_PPLE), D};
                    pg8::gemm_phase<pg8::EpiStoreBf16, pg8::StaticOrder, true, true>(lds, g, S, E); } }
#endif
        }
        SEAM(pb + 1);
        REPEAT(2) if (IN(pb + 2)) rwkv_finalize(kparams(), l);
        SEAM(pb + 2);
        REPEAT(3) if (IN(pb + 3)) {
            PHASE_PTRS
            pg8::Gemm g{OB, (const bf16*)(wl + WO_B), M, 4096, 256, D, 256, 4, 256}; pg8::StaticOrder S; S.init(M, 4096, G, bx);
            pg8::EpiStoreBf16 E{(bf16*)R2, 4096};
            pg8::gemm_phase<pg8::EpiStoreBf16, pg8::StaticOrder, true, true>(lds, g, S, E);
        }
        SEAM(pb + 3);
        REPEAT(4) if (IN(pb + 4)) {
            PHASE_PTRS
            pg8::Gemm g{XB, (const bf16*)(wl + WO_G), M, 4096, D, D, D, 0, 0}; pg8::StaticOrder S; S.init(M, 4096, G, bx);
            pg8::EpiMerge E{(const bf16*)R2, MG};
            pg8::gemm_phase<pg8::EpiMerge, pg8::StaticOrder, true, true>(lds, g, S, E);
        }
        SEAM(pb + 4);
        REPEAT(5) if (IN(pb + 5)) {
            PHASE_PTRS
            pg8::Gemm g{MG, (const bf16*)(wl + WO_MIX), M, D, D, D, D, 0, 0}; pg8::StaticOrder S; S.init(M, D, G, bx);
            pg8::EpiResF32 E{XB, nullptr, (float*)R2, ALPHA};
            pg8::gemm_phase<pg8::EpiResF32, pg8::StaticOrder, true, true>(lds, g, S, E);
        }
        SEAM(pb + 5);
        REPEAT(6) if (IN(pb + 6)) { PHASE_PTRS ln_phase((const float*)R2, P->in[I_LNMW] + l * D, P->in[I_LNMB] + l * D, XB, nullptr); }
        SEAM(pb + 6);
        REPEAT(7) if (IN(pb + 7)) {
            PHASE_PTRS
            { pg8::Gemm g{XB, (const bf16*)(wl + WO_UP), M, 2 * DFF, D, D, D, 0, 0}; pg8::StaticOrder S; S.init(M, 2 * DFF, G, bx);
              pg8::EpiFfnUp E{(bf16*)R2, P->in[I_CONV] + (size_t)l * 3 * DFF, (float*)(P->ws + WS_HALO), (float*)(P->ws + WS_HALO + HALO_ONE), (float*)(P->ws + WS_HALO + 2 * HALO_ONE), (LAS float*)(lds + LDS_XCH)};
              pg8::gemm_phase<pg8::EpiFfnUp, pg8::StaticOrder, true, true>(lds, g, S, E); }
            if (rep_ == 0) { pg8::Gemm g{XB, (const bf16*)(wl + WO_PG), M, D, D, D, D, 0, 0}; pg8::StaticOrder S; S.init(M, D, G, bx);
              pg8::EpiPleGate E{(bf16*)(P->ws + WS_PPLE)};
              pg8::gemm_phase<pg8::EpiPleGate, pg8::StaticOrder, true, true>(lds, g, S, E); }
        }
        SEAM(pb + 7);
        REPEAT(8) if (IN(pb + 8)) {
            PHASE_PTRS
            pg8::Gemm g{(const bf16*)R2, (const bf16*)(wl + WO_DN), M, D, DFF, DFF, DFF, 0, 0}; pg8::StaticOrder S; S.init(M, D, G, bx);
            { pg8::Unit u; for (int i = 0; S.next(i, u); ++i) ffn_fixup_panel(P, l, u.pm); }
            asm volatile("s_waitcnt vmcnt(0)" ::: "memory"); sync_wg();
            pg8::EpiResF32 E{XB, (const bf16*)(P->ws + WS_PPLE), P->out, ALPHA};
            pg8::gemm_phase<pg8::EpiResF32, pg8::StaticOrder, true, true>(lds, g, S, E);
        }
        SEAM(pb + 8);
        if (IN(pb + 9)) { PHASE_PTRS ln_phase(P->out, P->in[I_LNFW] + l * D, P->in[I_LNFB] + l * D, (l == DEPTH - 1) ? nullptr : XB, (l == DEPTH - 1) ? P->out : nullptr); }
        SEAM(pb + 9);
    }
#undef IN
#undef SEAM
}

extern "C" void kernel_launch(void* const* d_in, const int* in_sizes, int n_in, void* d_out, int out_size, void* d_ws, size_t ws_size, hipStream_t stream) {
    static int grid = 0;
    if (grid == 0) {
        if (n_in != 32 || out_size != M * D || ws_size < WS_END) { fprintf(stderr, "kernel_launch: unexpected shapes (n_in %d, out %d, ws %zu)\n", n_in, out_size, ws_size); grid = -1; return; }
        int dev = 0, cus = 0, per_cu = 0;
        if (hipGetDevice(&dev) != hipSuccess || hipDeviceGetAttribute(&cus, hipDeviceAttributeMultiprocessorCount, dev) != hipSuccess) { grid = -1; return; }
        if (hipFuncSetAttribute((const void*)mega, hipFuncAttributeMaxDynamicSharedMemorySize, LDS_BYTES) != hipSuccess) { fprintf(stderr, "kernel_launch: hipFuncSetAttribute failed\n"); grid = -1; return; }
        if (hipOccupancyMaxActiveBlocksPerMultiprocessor(&per_cu, (const void*)mega, NWAVES * 64, LDS_BYTES) != hipSuccess || per_cu < 1) fprintf(stderr, "kernel_launch: occupancy query reports %d\n", per_cu);
        (void)hipGetLastError();
        grid = cus;
    }
    if (grid < 0) return;
    (void)hipMemsetAsync((char*)d_ws + WS_CTL, 0, CTL_ZERO_BYTES, stream);
    Params p{};
    for (int i = 0; i < 32; ++i) p.in[i] = (const float*)d_in[i];
    p.out = (float*)d_out; p.ws = (unsigned char*)d_ws;
#if ONE_LAUNCH
    p.ph_lo = 0; p.ph_hi = NPH;
    hipLaunchKernelGGL(mega, dim3(grid), dim3(NWAVES * 64), LDS_BYTES, stream, p);
#else
    for (int ph = 0; ph < NPH; ++ph) { p.ph_lo = ph; p.ph_hi = ph + 1; hipLaunchKernelGGL(mega, dim3(grid), dim3(NWAVES * 64), LDS_BYTES, stream, p); }
#endif
}
```

```cpp
#include <hip/hip_runtime.h>
#include <cstdio>
#include <cstdint>
#if defined(__HIP_DEVICE_COMPILE__)
#define NOPK __attribute__((target("no-packed-fp32-ops")))
#else
#define NOPK
#endif

typedef float f32x2g __attribute__((ext_vector_type(2)));
__device__ __forceinline__ NOPK void sync_wg() { __builtin_amdgcn_fence(__ATOMIC_RELEASE, "workgroup"); __builtin_amdgcn_s_barrier(); __builtin_amdgcn_fence(__ATOMIC_ACQUIRE, "workgroup"); }
__device__ __forceinline__ NOPK float u2f(unsigned u) { return __builtin_bit_cast(float, u); }
__device__ __forceinline__ NOPK float shfl_(float v, int src) { return __builtin_bit_cast(float, __builtin_amdgcn_ds_bpermute(src << 2, __builtin_bit_cast(int, v))); }
__device__ __forceinline__ NOPK float shfl_xor_(float v, int m) { const int lane_ = __builtin_amdgcn_mbcnt_hi(~0u, __builtin_amdgcn_mbcnt_lo(~0u, 0u)); return shfl_(v, lane_ ^ m); }
namespace pg8 {
#define PG8_LAS __attribute__((address_space(3)))
typedef unsigned short bf16_t;
typedef short bf16x8 __attribute__((ext_vector_type(8)));
typedef float f32x4 __attribute__((ext_vector_type(4)));
typedef float f32x2 __attribute__((ext_vector_type(2)));
typedef unsigned u32x4 __attribute__((ext_vector_type(4)));
typedef unsigned u32x2 __attribute__((ext_vector_type(2)));
constexpr int BM = 256, BK = 64, HALF = 128, HTB = HALF * BK * 2  , STAGE_BYTES = 8 * HTB, NXCD = 8, WGM = 8;

__host__ __device__ __forceinline__ NOPK int lds_byte(int r, int c) { const int st = (r >> 4) * 2 + (c >> 5), rr = r & 15, cc = c & 31, ob = rr * 64 + cc * 2; return st * 1024 + (ob ^ (((ob >> 9) & 1) << 5)); }
__host__ __device__ __forceinline__ NOPK void stage_rc(int b, int& R, int& C) { const int st = b / 1024, sb = b % 1024, swz = sb ^ (((sb >> 9) & 1) << 5); R = (st >> 1) * 16 + swz / 64; C = (st & 1) * 32 + (swz % 64) / 2; }
__host__ __device__ __forceinline__ NOPK int perm32(int rho) { const int n = rho >> 4, i = rho & 15; return 8 * (i >> 2) + 4 * n + (i & 3); }

struct Unit { int pm, pn; };
struct Gemm { const bf16_t* A; const bf16_t* Bt; int M, N, K, lda, ldb, a_div, a_coloff; };
__device__ __forceinline__ NOPK size_t a_unit_off(const Gemm& g, const Unit& u) { return g.a_div ? (size_t)((u.pn / g.a_div) * g.a_coloff) * 2u : (size_t)0; }

struct StaticOrder {
    int nM, nN, nwg, G, c;
    __host__ __device__ __forceinline__ NOPK void init(int M, int N, int G_, int c_) { nM = M / BM; nN = N / BM; nwg = nM * nN; G = G_; c = c_; }
    __host__ __device__ __forceinline__ NOPK bool next(int i, Unit& u) const {
        const long L = (long)i * G + c; if (L >= nwg) return false;
        int wgid = (int)L; { const int q = nwg / NXCD, r = nwg % NXCD, xcd = wgid % NXCD, off = wgid / NXCD; wgid = (xcd < r ? xcd * (q + 1) : r * (q + 1) + (xcd - r) * q) + off; }
        const int nig = WGM * nN, gid = wgid / nig, fm = gid * WGM, gsz = (nM - fm) < WGM ? (nM - fm) : WGM;
        u.pm = fm + ((wgid % nig) % gsz); u.pn = (wgid % nig) / gsz; return true;
    }
    __device__ __forceinline__ NOPK void a_ready(const Unit&) const {}
    __device__ __forceinline__ NOPK void done(const Unit&) const {}
};

typedef __bf16 bf16x2_t __attribute__((ext_vector_type(2)));
__device__ __forceinline__ NOPK unsigned cvt_pk_bf16(float lo, float hi) { const f32x2 v = {lo, hi}; const bf16x2_t b = __builtin_convertvector(v, bf16x2_t); return __builtin_bit_cast(unsigned, b); }
__device__ __forceinline__ NOPK float bf_lo(unsigned w) { return u2f(w << 16); }
__device__ __forceinline__ NOPK float bf_hi(unsigned w) { return u2f(w & 0xffff0000u); }
__device__ __forceinline__ NOPK float sigmoid_f(float x) { return __builtin_amdgcn_rcpf(1.0f + __builtin_amdgcn_exp2f(-1.44269504089f * x)); }

template <class Epi, class Sched, bool ALIGN_EPI = false, bool SP2 = false>
__device__ __forceinline__ NOPK void gemm_phase(PG8_LAS unsigned char* lds, const Gemm g, const Sched& S, const Epi& E) {
    int tid_o = threadIdx.x; asm volatile("" : "+v"(tid_o));
    const int tid = tid_o, wid = __builtin_amdgcn_readfirstlane(tid >> 6), lane = tid & 63, wr = wid >> 2, wc = wid & 3, fr = lane & 15, fq = lane >> 4;
    const int K = g.K, nt = K / BK;
    unsigned voffA[2], voffB[2];
#pragma unroll
    for (int i = 0; i < 2; ++i) { int R, C; stage_rc(tid * 16 + i * 8192, R, C); const int Rb = Epi::PERM ? ((R & ~31) + perm32(R & 31)) : R;
        voffA[i] = (unsigned)(R * g.lda + C) * 2u; voffB[i] = (unsigned)(Rb * g.ldb + C) * 2u; }
    const size_t kstep = (size_t)(BK * 2);
    const size_t hstepA = (size_t)HALF * g.lda * 2, hstepB = (size_t)HALF * g.ldb * 2;
    const size_t tstepA = 2 * hstepA, tstepB = 2 * hstepB;
    const unsigned ldsw = (unsigned)wid * 1024u;
    const int aoff = lds_byte(wr * 64 + fr, fq * 8), boff = lds_byte(wc * 32 + fr, fq * 8);
#define PG8_SA(b, h) (((b) * 2 + (h)) * HTB)
#define PG8_SB(b, h) ((4 + (b) * 2 + (h)) * HTB)
#define PG8_STAGE(bufoff, gbase, voff) do { _Pragma("unroll") for (int _i = 0; _i < 2; ++_i) \
        __builtin_amdgcn_global_load_lds((const unsigned*)((const char*)(gbase) + (voff)[_i]), (PG8_LAS unsigned*)(lds + (bufoff) + ldsw + _i * 8192), 16, 0, 0); } while (0)
#define PG8_LDA(dst, b, h) do { _Pragma("unroll") for (int m = 0; m < 4; ++m) _Pragma("unroll") for (int k = 0; k < 2; ++k) dst[m][k] = *(const PG8_LAS bf16x8*)(lds + PG8_SA(b, h) + aoff + m * 2048 + k * 1024); } while (0)
#define PG8_LDB(dst, b, h) do { _Pragma("unroll") for (int n = 0; n < 2; ++n) _Pragma("unroll") for (int k = 0; k < 2; ++k) dst[n][k] = *(const PG8_LAS bf16x8*)(lds + PG8_SB(b, h) + boff + n * 2048 + k * 1024); } while (0)
#define PG8_MMA(ai, bj, At, Bt) do { __builtin_amdgcn_s_setprio(1); _Pragma("unroll") for (int m = 0; m < 4; ++m) _Pragma("unroll") for (int n = 0; n < 2; ++n) _Pragma("unroll") for (int k = 0; k < 2; ++k) \
        acc[ai][bj][m][n] = __builtin_amdgcn_mfma_f32_16x16x32_bf16(Bt[n][k], At[m][k], acc[ai][bj][m][n], 0, 0, 0); __builtin_amdgcn_s_setprio(0); } while (0)
#define PG8_WAIT_V(n) asm volatile("s_waitcnt vmcnt(" #n ")" ::: "memory")
#define PG8_WAIT_L(n) asm volatile("s_waitcnt lgkmcnt(" #n ")" ::: "memory")
#define PG8_BAR __builtin_amdgcn_s_barrier()
#define PG8_SCHED __builtin_amdgcn_sched_barrier(0)
    Unit cur, nxt; int ui = 0;
    if (!S.next(0, cur)) return;
    f32x4 acc[2][2][4][2];
#pragma unroll
    for (int a = 0; a < 2; ++a)
#pragma unroll
        for (int b = 0; b < 2; ++b)
#pragma unroll
            for (int m = 0; m < 4; ++m)
#pragma unroll
                for (int n = 0; n < 2; ++n) acc[a][b][m][n] = (f32x4){0.f, 0.f, 0.f, 0.f};
    bf16x8 At[4][2], B0[2][2], B1[2][2];
    const char* cA = (const char*)g.A + (size_t)cur.pm * tstepA + a_unit_off(g, cur); const char* cB = (const char*)g.Bt + (size_t)cur.pn * tstepB;
    S.a_ready(cur);
    if constexpr (SP2) {
        PG8_STAGE(PG8_SB(0, 0), cB, voffB); PG8_STAGE(PG8_SB(0, 1), cB + hstepB, voffB); PG8_STAGE(PG8_SA(0, 0), cA, voffA); PG8_STAGE(PG8_SA(0, 1), cA + hstepA, voffA);
        if (wr == 1) PG8_BAR;
        PG8_WAIT_V(2); PG8_BAR;
        PG8_STAGE(PG8_SB(1, 0), cB + kstep, voffB); PG8_STAGE(PG8_SA(1, 0), cA + kstep, voffA); PG8_STAGE(PG8_SB(1, 1), cB + hstepB + kstep, voffB);
        PG8_WAIT_V(6); PG8_BAR;
    } else {
        PG8_STAGE(PG8_SB(0, 0), cB, voffB); PG8_STAGE(PG8_SA(0, 0), cA, voffA); PG8_STAGE(PG8_SB(0, 1), cB + hstepB, voffB); PG8_STAGE(PG8_SA(0, 1), cA + hstepA, voffA);
        if (wr == 1) PG8_BAR;
        PG8_WAIT_V(4); PG8_BAR;
        PG8_STAGE(PG8_SB(1, 0), cB + kstep, voffB); PG8_STAGE(PG8_SA(1, 0), cA + kstep, voffA); PG8_STAGE(PG8_SB(1, 1), cB + hstepB + kstep, voffB);
        PG8_WAIT_V(6); PG8_BAR;
    }
    for (;;) {
        const bool has_next = S.next(ui + 1, nxt);
        const char* nA = has_next ? (const char*)g.A + (size_t)nxt.pm * tstepA + a_unit_off(g, nxt) : cA; const char* nB = has_next ? (const char*)g.Bt + (size_t)nxt.pn * tstepB : cB;
        for (int t = 0; t < nt; t += 2) {
            const bool last = (t == nt - 2);
            const char* a1 = cA + (size_t)(t + 1) * kstep;
            const char* a2 = last ? nA : cA + (size_t)(t + 2) * kstep; const char* b2 = last ? nB : cB + (size_t)(t + 2) * kstep;
            const char* a3 = a2 + kstep; const char* b3 = b2 + kstep;
            if (last && has_next) S.a_ready(nxt);
            if constexpr (SP2) {
            PG8_LDB(B0, 0, 0); PG8_LDB(B1, 0, 1); PG8_SCHED; PG8_LDA(At, 0, 0); PG8_STAGE(PG8_SA(1, 1), a1 + hstepA, voffA);
            PG8_WAIT_V(8); PG8_WAIT_L(0); PG8_BAR; PG8_MMA(0, 0, At, B0); PG8_MMA(0, 1, At, B1); PG8_BAR; PG8_SCHED;
            PG8_LDA(At, 0, 1); PG8_STAGE(PG8_SB(0, 0), b2, voffB); PG8_STAGE(PG8_SB(0, 1), b2 + hstepB, voffB); PG8_STAGE(PG8_SA(0, 0), a2, voffA);
            PG8_WAIT_V(8); PG8_WAIT_L(0); PG8_BAR; PG8_MMA(1, 0, At, B0); PG8_MMA(1, 1, At, B1); PG8_BAR; PG8_SCHED;
            PG8_LDB(B0, 1, 0); PG8_LDB(B1, 1, 1); PG8_SCHED; PG8_LDA(At, 1, 0); PG8_STAGE(PG8_SA(0, 1), a2 + hstepA, voffA);
            PG8_WAIT_V(8); PG8_WAIT_L(0); PG8_BAR; PG8_MMA(0, 0, At, B0); PG8_MMA(0, 1, At, B1); PG8_BAR; PG8_SCHED;
            PG8_LDA(At, 1, 1); PG8_STAGE(PG8_SB(1, 0), b3, voffB); PG8_STAGE(PG8_SB(1, 1), b3 + hstepB, voffB); PG8_STAGE(PG8_SA(1, 0), a3, voffA);
            PG8_WAIT_V(8); PG8_WAIT_L(0); PG8_BAR; PG8_MMA(1, 0, At, B0); PG8_MMA(1, 1, At, B1); PG8_BAR; PG8_SCHED;
            } else {
            PG8_LDB(B0, 0, 0); PG8_SCHED; PG8_LDA(At, 0, 0); PG8_STAGE(PG8_SA(1, 1), a1 + hstepA, voffA);
            PG8_WAIT_L(8); PG8_BAR; PG8_WAIT_L(0); PG8_MMA(0, 0, At, B0); PG8_BAR; PG8_SCHED;
            PG8_LDB(B1, 0, 1); PG8_STAGE(PG8_SB(0, 0), b2, voffB);
            PG8_BAR; PG8_WAIT_L(0); PG8_MMA(0, 1, At, B1); PG8_BAR;
            PG8_LDA(At, 0, 1); PG8_STAGE(PG8_SA(0, 0), a2, voffA);
            PG8_BAR; PG8_WAIT_L(0); PG8_MMA(1, 0, At, B0); PG8_BAR; PG8_SCHED;
            PG8_STAGE(PG8_SB(0, 1), b2 + hstepB, voffB);
            PG8_WAIT_V(6); PG8_BAR; PG8_MMA(1, 1, At, B1); PG8_BAR;
            PG8_LDB(B0, 1, 0); PG8_SCHED; PG8_LDA(At, 1, 0); PG8_STAGE(PG8_SA(0, 1), a2 + hstepA, voffA);
            PG8_WAIT_L(8); PG8_BAR; PG8_WAIT_L(0); PG8_MMA(0, 0, At, B0); PG8_BAR; PG8_SCHED;
            PG8_LDB(B1, 1, 1); PG8_STAGE(PG8_SB(1, 0), b3, voffB);
            PG8_BAR; PG8_WAIT_L(0); PG8_MMA(0, 1, At, B1); PG8_BAR;
            PG8_LDA(At, 1, 1); PG8_STAGE(PG8_SA(1, 0), a3, voffA);
            PG8_BAR; PG8_WAIT_L(0); PG8_MMA(1, 0, At, B0); PG8_BAR; PG8_SCHED;
            PG8_STAGE(PG8_SB(1, 1), b3 + hstepB, voffB);
            PG8_WAIT_V(6); PG8_BAR; PG8_MMA(1, 1, At, B1); PG8_BAR;
            }
        }
        if constexpr (ALIGN_EPI) { if (wr == 0) PG8_BAR; }
        if constexpr (!Epi::AFTER_DRAIN) { E(acc, cur, wr, wc, fr, fq); S.done(cur); }
        if (!has_next) break;
#pragma unroll
        for (int a = 0; a < 2; ++a)
#pragma unroll
            for (int b = 0; b < 2; ++b)
#pragma unroll
                for (int m = 0; m < 4; ++m)
#pragma unroll
                    for (int n = 0; n < 2; ++n) acc[a][b][m][n] = (f32x4){0.f, 0.f, 0.f, 0.f};
        cur = nxt; cA = nA; cB = nB; ++ui;
        if constexpr (ALIGN_EPI) { if (wr == 1) PG8_BAR; }
    }
    PG8_WAIT_V(0);
    if constexpr (!ALIGN_EPI) { if (wr == 0) PG8_BAR; }
    PG8_BAR;
    if constexpr (Epi::AFTER_DRAIN) { E.fused(acc, cur, wr, wc, fr, fq, lds, wid, lane); S.done(cur); }
#undef PG8_SA
#undef PG8_SB
#undef PG8_STAGE
#undef PG8_LDA
#undef PG8_LDB
#undef PG8_MMA
#undef PG8_WAIT_V
#undef PG8_WAIT_L
#undef PG8_BAR
#undef PG8_SCHED
}


struct EpiStoreBf16 {
    static constexpr bool PERM = true, AFTER_DRAIN = false;
    bf16_t* O; int ldc;
    __device__ __forceinline__ NOPK void operator()(const f32x4 (&acc)[2][2][4][2], const Unit& u, int wr, int wc, int fr, int fq) const {
        const int row0 = u.pm * BM + wr * 64 + fr, col0 = u.pn * BM + wc * 32 + 8 * fq;
#pragma unroll
        for (int ai = 0; ai < 2; ++ai)
#pragma unroll
            for (int m = 0; m < 4; ++m) { bf16_t* rowp = O + (size_t)(row0 + ai * HALF + m * 16) * ldc + col0;
#pragma unroll
                for (int bj = 0; bj < 2; ++bj) { const f32x4 v0 = acc[ai][bj][m][0], v1 = acc[ai][bj][m][1];
                    u32x4 w; w.x = cvt_pk_bf16(v0[0], v0[1]); w.y = cvt_pk_bf16(v0[2], v0[3]); w.z = cvt_pk_bf16(v1[0], v1[1]); w.w = cvt_pk_bf16(v1[2], v1[3]);
                    *(u32x4*)(rowp + bj * HALF) = w; } }
    }
};
struct EpiPleGate {
    static constexpr bool PERM = true, AFTER_DRAIN = false;
    bf16_t* PP;
    __device__ __forceinline__ NOPK void operator()(const f32x4 (&acc)[2][2][4][2], const Unit& u, int wr, int wc, int fr, int fq) const {
        const int row0 = u.pm * BM + wr * 64 + fr, col0 = u.pn * BM + wc * 32 + 8 * fq;
        u32x4 pp[2][4][2];
#pragma unroll
        for (int ai = 0; ai < 2; ++ai)
#pragma unroll
            for (int m = 0; m < 4; ++m) { const bf16_t* rowp = PP + (size_t)(row0 + ai * HALF + m * 16) * 1024 + col0;
#pragma unroll
                for (int bj = 0; bj < 2; ++bj) pp[ai][m][bj] = *(const u32x4*)(rowp + bj * HALF); }
#pragma unroll
        for (int ai = 0; ai < 2; ++ai)
#pragma unroll
            for (int m = 0; m < 4; ++m) { bf16_t* rowp = PP + (size_t)(row0 + ai * HALF + m * 16) * 1024 + col0;
#pragma unroll
                for (int bj = 0; bj < 2; ++bj) { const f32x4 v0 = acc[ai][bj][m][0], v1 = acc[ai][bj][m][1];
                    const u32x4 p = pp[ai][m][bj];
                    u32x4 w;
                    w.x = cvt_pk_bf16(sigmoid_f(v0[0]) * bf_lo(p.x), sigmoid_f(v0[1]) * bf_hi(p.x));
                    w.y = cvt_pk_bf16(sigmoid_f(v0[2]) * bf_lo(p.y), sigmoid_f(v0[3]) * bf_hi(p.y));
                    w.z = cvt_pk_bf16(sigmoid_f(v1[0]) * bf_lo(p.z), sigmoid_f(v1[1]) * bf_hi(p.z));
                    w.w = cvt_pk_bf16(sigmoid_f(v1[2]) * bf_lo(p.w), sigmoid_f(v1[3]) * bf_hi(p.w));
                    *(u32x4*)(rowp + bj * HALF) = w; } }
    }
};
struct EpiMerge {
    static constexpr bool PERM = false, AFTER_DRAIN = false;
    const bf16_t* P; bf16_t* MG;
    __device__ __forceinline__ NOPK void operator()(const f32x4 (&acc)[2][2][4][2], const Unit& u, int wr, int wc, int fr, int fq) const {
        const int row0 = u.pm * BM + wr * 64 + fr, oc = u.pn * 64 + wc * 16 + fq * 4;
        u32x2 pv[2][4][4];
#pragma unroll
        for (int ai = 0; ai < 2; ++ai)
#pragma unroll
            for (int m = 0; m < 4; ++m) { const bf16_t* prow = P + (size_t)(row0 + ai * HALF + m * 16) * 4096 + oc;
#pragma unroll
                for (int b = 0; b < 4; ++b) pv[ai][m][b] = *(const u32x2*)(prow + b * 1024); }
#pragma unroll
        for (int ai = 0; ai < 2; ++ai)
#pragma unroll
            for (int m = 0; m < 4; ++m) { const size_t row = (size_t)(row0 + ai * HALF + m * 16);
                f32x4 s = (f32x4){0.f, 0.f, 0.f, 0.f};
#pragma unroll
                for (int b = 0; b < 4; ++b) { const u32x2 p = pv[ai][m][b]; const f32x4 g = acc[ai][b >> 1][m][b & 1];
                    s[0] += sigmoid_f(g[0]) * bf_lo(p.x); s[1] += sigmoid_f(g[1]) * bf_hi(p.x); s[2] += sigmoid_f(g[2]) * bf_lo(p.y); s[3] += sigmoid_f(g[3]) * bf_hi(p.y); }
                u32x2 w; w.x = cvt_pk_bf16(s[0], s[1]); w.y = cvt_pk_bf16(s[2], s[3]);
                *(u32x2*)(MG + row * 1024 + oc) = w; }
    }
};
struct EpiResF32 {
    static constexpr bool PERM = false, AFTER_DRAIN = false;
    const bf16_t* X; const bf16_t* PLE; float* V; float alpha;
    __device__ __forceinline__ NOPK void operator()(const f32x4 (&acc)[2][2][4][2], const Unit& u, int wr, int wc, int fr, int fq) const {
        const int row0 = u.pm * BM + wr * 64 + fr, col0 = u.pn * BM + wc * 32 + 4 * fq;
#pragma unroll
        for (int ai = 0; ai < 2; ++ai) {
            u32x2 xv[4][2][2], pv[4][2][2];
#pragma unroll
            for (int m = 0; m < 4; ++m) { const size_t off = (size_t)(row0 + ai * HALF + m * 16) * 1024 + col0;
#pragma unroll
                for (int bj = 0; bj < 2; ++bj)
#pragma unroll
                    for (int n = 0; n < 2; ++n) { const size_t o = off + bj * HALF + n * 16; xv[m][bj][n] = *(const u32x2*)(X + o); if (PLE) pv[m][bj][n] = *(const u32x2*)(PLE + o); else pv[m][bj][n] = (u32x2){0u, 0u}; } }
#pragma unroll
            for (int m = 0; m < 4; ++m) { const size_t off = (size_t)(row0 + ai * HALF + m * 16) * 1024 + col0;
#pragma unroll
                for (int bj = 0; bj < 2; ++bj)
#pragma unroll
                    for (int n = 0; n < 2; ++n) { const size_t o = off + bj * HALF + n * 16; const u32x2 x2 = xv[m][bj][n], p2 = pv[m][bj][n];
                        f32x4 r = acc[ai][bj][m][n];
                        r[0] += alpha * bf_lo(x2.x) + bf_lo(p2.x); r[1] += alpha * bf_hi(x2.x) + bf_hi(p2.x); r[2] += alpha * bf_lo(x2.y) + bf_lo(p2.y); r[3] += alpha * bf_hi(x2.y) + bf_hi(p2.y);
                        *(f32x4*)(V + o) = r; } } }
    }
};
struct EpiResBf16 {
    static constexpr bool PERM = true, AFTER_DRAIN = false;
    bf16_t* X; const bf16_t* PLE; float alpha;
    __device__ __forceinline__ NOPK void operator()(const f32x4 (&acc)[2][2][4][2], const Unit& u, int wr, int wc, int fr, int fq) const {
        const int row0 = u.pm * BM + wr * 64 + fr, col0 = u.pn * BM + wc * 32 + 8 * fq;
#pragma unroll
        for (int ai = 0; ai < 2; ++ai) {
            u32x4 xv[4][2], pv[4][2];
#pragma unroll
            for (int m = 0; m < 4; ++m) { const size_t off = (size_t)(row0 + ai * HALF + m * 16) * 1024 + col0;
#pragma unroll
                for (int bj = 0; bj < 2; ++bj) { xv[m][bj] = *(const u32x4*)(X + off + bj * HALF); if (PLE) pv[m][bj] = *(const u32x4*)(PLE + off + bj * HALF); else pv[m][bj] = (u32x4){0u, 0u, 0u, 0u}; } }
#pragma unroll
            for (int m = 0; m < 4; ++m) { const size_t off = (size_t)(row0 + ai * HALF + m * 16) * 1024 + col0;
#pragma unroll
                for (int bj = 0; bj < 2; ++bj) { const f32x4 v0 = acc[ai][bj][m][0], v1 = acc[ai][bj][m][1]; const u32x4 x4 = xv[m][bj], p4 = pv[m][bj];
                    u32x4 w;
                    w.x = cvt_pk_bf16(v0[0] + alpha * bf_lo(x4.x) + bf_lo(p4.x), v0[1] + alpha * bf_hi(x4.x) + bf_hi(p4.x));
                    w.y = cvt_pk_bf16(v0[2] + alpha * bf_lo(x4.y) + bf_lo(p4.y), v0[3] + alpha * bf_hi(x4.y) + bf_hi(p4.y));
                    w.z = cvt_pk_bf16(v1[0] + alpha * bf_lo(x4.z) + bf_lo(p4.z), v1[1] + alpha * bf_hi(x4.z) + bf_hi(p4.z));
                    w.w = cvt_pk_bf16(v1[2] + alpha * bf_lo(x4.w) + bf_lo(p4.w), v1[3] + alpha * bf_hi(x4.w) + bf_hi(p4.w));
                    *(u32x4*)(X + off + bj * HALF) = w; } } }
    }
};
__device__ __forceinline__ NOPK float gelu_tanh_f(float x) {
    const float inner = x * (0.7978845608f + 0.0356774081f * x * x);
    return x * __builtin_amdgcn_rcpf(1.0f + __builtin_amdgcn_exp2f(-2.885390082f * inner));
}
struct EpiFfnUp {
    static constexpr bool PERM = false, AFTER_DRAIN = false;
    bf16_t* ACT; const float* conv; float* uhead; float* vhead; float* utail; PG8_LAS float* xch;
    __device__ __forceinline__ NOPK void operator()(const f32x4 (&acc)[2][2][4][2], const Unit& u, int wr, int wc, int fr, int fq) const {
        const int lane = threadIdx.x & 63;
        const int cc0 = wc * 32 + 4 * fq, colg = u.pn * 128 + cc0;
        f32x4 c0[2], c1[2], c2[2];
#pragma unroll
        for (int n = 0; n < 2; ++n) { c0[n] = *(const f32x4*)(conv + colg + 16 * n); c1[n] = *(const f32x4*)(conv + 2816 + colg + 16 * n); c2[n] = *(const f32x4*)(conv + 2 * 2816 + colg + 16 * n); }
        if (fr >= 14) {
#pragma unroll
            for (int ai = 0; ai < 2; ++ai)
#pragma unroll
                for (int n = 0; n < 2; ++n) *(PG8_LAS f32x4*)(xch + ((2 * ai + wr) * 2 + (fr - 14)) * 128 + cc0 + 16 * n) = acc[ai][0][3][n];
            if (wr == 1) {
#pragma unroll
                for (int n = 0; n < 2; ++n) *(f32x4*)(utail + ((size_t)u.pm * 2 + (fr - 14)) * 2816 + colg + 16 * n) = acc[1][0][3][n];
            }
        }
        if (wr == 0 && fr < 2) {
#pragma unroll
            for (int n = 0; n < 2; ++n) { *(f32x4*)(uhead + ((size_t)u.pm * 2 + fr) * 2816 + colg + 16 * n) = acc[0][0][0][n];
                                          *(f32x4*)(vhead + ((size_t)u.pm * 2 + fr) * 2816 + colg + 16 * n) = acc[0][1][0][n]; }
        }
        asm volatile("s_waitcnt lgkmcnt(0)" ::: "memory"); __builtin_amdgcn_s_barrier(); asm volatile("" ::: "memory");
        const int src1 = (lane & 48) | ((fr + 15) & 15), src2 = (lane & 48) | ((fr + 14) & 15);
#pragma unroll
        for (int ai = 0; ai < 2; ++ai)
#pragma unroll
            for (int m = 0; m < 4; ++m) { const size_t row = (size_t)(u.pm * BM + ai * HALF + wr * 64 + m * 16 + fr);
#pragma unroll
                for (int n = 0; n < 2; ++n) {
                    const f32x4 cur = acc[ai][0][m][n];
                    f32x4 e1, e2, r1, r2;
                    if (m > 0) { const f32x4 pg = acc[ai][0][m > 0 ? m - 1 : 0][n];
#pragma unroll
                        for (int j = 0; j < 4; ++j) { e1[j] = shfl_(pg[j], src1); e2[j] = shfl_(pg[j], src2); } }
                    else { const int rb = 2 * ai + wr;
                        if (rb > 0) { const f32x4 x62 = *(const PG8_LAS f32x4*)(xch + ((rb - 1) * 2 + 0) * 128 + cc0 + 16 * n), x63 = *(const PG8_LAS f32x4*)(xch + ((rb - 1) * 2 + 1) * 128 + cc0 + 16 * n);
                            e1 = x63; e2 = (fr == 0) ? x62 : x63; }
                        else { e1 = (f32x4){0.f, 0.f, 0.f, 0.f}; e2 = e1; } }
#pragma unroll
                    for (int j = 0; j < 4; ++j) { r1[j] = shfl_(cur[j], src1); r2[j] = shfl_(cur[j], src2); }
                    const f32x4 p1 = (fr >= 1) ? r1 : e1, p2 = (fr >= 2) ? r2 : e2;
                    const f32x4 cv = c2[n] * cur + c1[n] * p1 + c0[n] * p2;
                    const f32x4 vv = acc[ai][1][m][n];
                    u32x2 w; w.x = cvt_pk_bf16(gelu_tanh_f(cv[0]) * vv[0], gelu_tanh_f(cv[1]) * vv[1]); w.y = cvt_pk_bf16(gelu_tanh_f(cv[2]) * vv[2], gelu_tanh_f(cv[3]) * vv[3]);
                    *(u32x2*)(ACT + row * 2816 + colg + 16 * n) = w; } }
    }
};
}

constexpr int D = 1024, BATCH = 16, SEQ = 2048, DEPTH = 2, M = BATCH * SEQ;
constexpr int NMIX = 3600, NMIXP = 3840, NIN = 7696, DFF = 2816, PLE = 256, NCHUNK = SEQ / 64;
constexpr float ALPHA = 1.41421356237f;
constexpr float LN_EPS = 1e-5f;
constexpr int NWAVES = 8;
#ifndef ONE_LAUNCH
#define ONE_LAUNCH 1
#endif

constexpr size_t MiB = 1u << 20;
constexpr size_t WS_CTL = 0, CTL_ZERO_BYTES = 1 * MiB;
constexpr size_t WS_W = 1 * MiB, W_LAYER = 39 * MiB;
constexpr size_t WO_IN = 0, WO_G = 15 * MiB / 2, WO_B = 31 * MiB / 2, WO_MIX = 35 * MiB / 2, WO_UP = 39 * MiB / 2, WO_DN = 61 * MiB / 2, WO_PG = 36 * MiB, WO_PP = 38 * MiB;
constexpr size_t WS_PB = 79 * MiB;
constexpr size_t WS_XB = 111 * MiB;
constexpr size_t WS_R2 = 175 * MiB;
constexpr size_t R2_PPLE = 176 * MiB;
constexpr size_t WS_ROPE = 431 * MiB;
constexpr size_t WS_HALO = 432 * MiB, HALO_ONE = (size_t)128 * 2 * DFF * 4;
constexpr size_t WS_RST = 442 * MiB;
constexpr size_t WS_PPLE = 444 * MiB;
constexpr size_t WS_END = 508 * MiB;
static_assert(WS_HALO + 3 * HALO_ONE <= WS_END && WS_R2 + 256 * MiB <= WS_ROPE, "ws map");
constexpr int CW_BAR = 4096;

constexpr int LDS_BYTES = 163840;
constexpr int LDS_XCH = 131072;
constexpr int LDS_MISC = 163840 - 256;

#define LAS __attribute__((address_space(3)))
typedef unsigned short bf16;
typedef float f32x4 __attribute__((ext_vector_type(4)));
typedef unsigned v4u __attribute__((ext_vector_type(4)));
typedef unsigned v2u __attribute__((ext_vector_type(2)));
#define LDS_WAIT() asm volatile("s_waitcnt lgkmcnt(0)" ::: "memory")
using pg8::cvt_pk_bf16; using pg8::bf_lo; using pg8::bf_hi; using pg8::sigmoid_f;

#define XB_TMO      128
#define XB_XCNT(j)  (256  + 64 * (j))
#define XB_XSUB(j)  (1280 + 64 * (j))
#define XB_XGEN(j)  (2304 + 64 * (j))
#define XB_TOP      3328
#define XB_TOPGEN   3392
#define XCD_BAR_WORDS 3456
#define XB_SPIN_CAP (1u << 18)
__device__ __forceinline__ NOPK unsigned xb_ld(unsigned* p)              { return __hip_atomic_load(p, __ATOMIC_RELAXED, __HIP_MEMORY_SCOPE_AGENT); }
__device__ __forceinline__ NOPK unsigned xb_add(unsigned* p, unsigned v) { return __hip_atomic_fetch_add(p, v, __ATOMIC_RELAXED, __HIP_MEMORY_SCOPE_AGENT); }
__device__ __forceinline__ NOPK unsigned xb_xcc_id() { return (unsigned)__builtin_amdgcn_s_getreg((3 << 11) | 20) & 0xFu; }
#define XB_SPIN(cond, bar) do { unsigned _sp = 0; while (cond) { __builtin_amdgcn_s_sleep(1); \
    if ((++_sp & 255u) == 0u) { if (xb_ld(&(bar)[XB_TMO])) break; if (_sp > XB_SPIN_CAP) { (void)xb_add(&(bar)[XB_TMO], 1u); break; } } } } while (0)
struct XcdBarrier { unsigned* bar; unsigned x; volatile LAS unsigned* st; };
__device__ __forceinline__ NOPK XcdBarrier xcd_barrier_post(unsigned* bar, volatile LAS unsigned* st) {
    XcdBarrier b; b.bar = bar; b.x = xb_xcc_id(); b.st = st;
    if (threadIdx.x == 0) (void)xb_add(&bar[XB_XCNT(b.x)], 1u);
    return b;
}
__device__ __forceinline__ NOPK void xcd_barrier_complete(unsigned* bar, unsigned x, unsigned& nloc, unsigned& nx) {
    const unsigned G = gridDim.x * gridDim.y * gridDim.z;
    unsigned sum, cnt, mine, sp = 0u;
    for (;;) {
        sum = 0u; cnt = 0u; mine = 0u;
#pragma unroll
        for (unsigned j = 0; j < 16; ++j) { const unsigned c = xb_ld(&bar[XB_XCNT(j)]); sum += c; cnt += (c > 0u) ? 1u : 0u; mine = (j == x) ? c : mine; }
        if (sum == G) break;
        __builtin_amdgcn_s_sleep(1);
        if ((++sp & 255u) == 0u) { if (xb_ld(&bar[XB_TMO])) break; if (sp > XB_SPIN_CAP) { (void)xb_add(&bar[XB_TMO], 1u); break; } }
    }
    nloc = mine > 0u ? mine : 1u; nx = cnt > 0u ? cnt : 1u;
}
__device__ __forceinline__ NOPK void xcd_barrier(const XcdBarrier& b) {
    asm volatile("s_waitcnt vmcnt(0)" ::: "memory");
    sync_wg();
    if (threadIdx.x == 0) {
        unsigned* bar = b.bar;
        __builtin_amdgcn_s_waitcnt(0);
        unsigned nloc = b.st[0], nx = b.st[1];
        if (nloc == 0u) { xcd_barrier_complete(bar, b.x, nloc, nx); b.st[0] = nloc; b.st[1] = nx; }
        const unsigned old = xb_add(&bar[XB_XSUB(b.x)], 1u);
        const unsigned gen = old / nloc;
        if (old + 1u == (gen + 1u) * nloc) {
            __builtin_amdgcn_fence(__ATOMIC_RELEASE, "agent");
            asm volatile("s_waitcnt vmcnt(0)" ::: "memory");
            const unsigned og = xb_add(&bar[XB_TOP], 1u);
            const unsigned tg = og / nx;
            if (og + 1u == (tg + 1u) * nx) xb_add(&bar[XB_TOPGEN], 1u);
            else XB_SPIN(xb_ld(&bar[XB_TOPGEN]) == tg, bar);
            __builtin_amdgcn_fence(__ATOMIC_ACQUIRE, "agent");
            xb_add(&bar[XB_XGEN(b.x)], 1u);
            asm volatile("s_waitcnt vmcnt(0)" ::: "memory");
        } else {
            XB_SPIN(xb_ld(&bar[XB_XGEN(b.x)]) == gen, bar);
            __builtin_amdgcn_fence(__ATOMIC_ACQUIRE, "agent");
            asm volatile("s_waitcnt vmcnt(0)" ::: "memory");
        }
    }
    sync_wg();
}

struct Params {
    const float* in[32];
    float* out; unsigned char* ws;
    int ph_lo, ph_hi;
};
enum { I_X = 0, I_P, I_LNINW, I_LNINB, I_WIN, I_MU, I_W0, I_W2, I_A0, I_A2, I_G2, I_KK, I_KA, I_RK, I_RLNW, I_RLNB, I_GLAW2, I_GLAB, I_GLANW, I_HLB, I_HNW,
       I_WBR, I_WMIX, I_LNMW, I_LNMB, I_WUP, I_CONV, I_WDN, I_WPG, I_WPP, I_LNFW, I_LNFB };

typedef const __attribute__((address_space(4))) Params* KP;
__device__ __forceinline__ NOPK KP kparams() { KP p = (KP)__builtin_amdgcn_kernarg_segment_ptr(); asm volatile("" : "+s"(p)); return p; }
__device__ __forceinline__ NOPK float wave_sum(float v) {
#pragma unroll
    for (int o = 1; o < 64; o <<= 1) v += shfl_xor_(v, o);
    return v;
}
__device__ __forceinline__ NOPK int opaque_tid() { int t = threadIdx.x; asm volatile("" : "+v"(t)); return t; }
__device__ __forceinline__ NOPK float red8(float v) { v += shfl_xor_(v, 1); v += shfl_xor_(v, 2); v += shfl_xor_(v, 4); return v; }

__constant__ double ROPE_THETA[16] = {1.0, 0.5411695265464637, 0.2928644564625237, 0.15848931924611134, 0.08576958985908942, 0.046415888336127795, 0.025118864315095794, 0.013593563908785255, 0.007356422544596414, 0.003981071705534973, 0.0021544346900318843, 0.0011659144011798323, 0.000630957344480193, 0.0003414548873833601, 0.00018478497974222906, 0.0001};
__device__ __forceinline__ NOPK int map_row(int mode, int c) {
    if (mode == 1) { const int b = c >> 10, of = c & 1023, pn = of >> 6, oc = of & 63; return 256 * pn + 128 * (b >> 1) + 32 * (oc >> 4) + 16 * (b & 1) + (oc & 15); }
    if (mode == 2) { return c < DFF ? 256 * (c >> 7) + (c & 127) : 256 * ((c - DFF) >> 7) + 128 + ((c - DFF) & 127); }
    return c;
}
__device__ __forceinline__ NOPK void cvt_item(const float* W, int K, int srcld, int c0, int cnt, bf16* dst, int mode, LAS float* scr, int item, int lane) {
    const int nblk = (cnt + 31) / 32, kb = item / nblk, nb = item % nblk, k0 = 64 * kb, n0 = 32 * nb;
    const bool okr = (n0 + (lane & 31)) < cnt;
    float xin[32];
#pragma unroll
    for (int i = 0; i < 32; ++i) { const int kk = 2 * i + (lane >> 5); xin[i] = okr ? W[(size_t)(k0 + kk) * srcld + c0 + n0 + (lane & 31)] : 0.f; }
#pragma unroll
    for (int i = 0; i < 32; ++i) { const int kk = 2 * i + (lane >> 5); scr[kk * 33 + (lane & 31)] = xin[i]; }
    LDS_WAIT(); asm volatile("" ::: "memory");
    const int c = lane & 7;
#pragma unroll
    for (int j = 0; j < 4; ++j) { const int n = (lane >> 3) + 8 * j; const LAS float* s = scr + (8 * c) * 33 + n;
        v4u o; o.x = cvt_pk_bf16(s[0 * 33], s[1 * 33]); o.y = cvt_pk_bf16(s[2 * 33], s[3 * 33]); o.z = cvt_pk_bf16(s[4 * 33], s[5 * 33]); o.w = cvt_pk_bf16(s[6 * 33], s[7 * 33]);
        if (n0 + n < cnt) *(v4u*)(dst + (size_t)map_row(mode, n0 + n) * K + k0 + 8 * c) = o; }
    LDS_WAIT(); asm volatile("" ::: "memory");
}
struct CvtJob { const float* W; int K, srcld, c0, cnt, mode; bf16* dst; int items; };
__device__ __forceinline__ NOPK CvtJob get_job(KP P, int j) {
    const int l = j / 11, k = j % 11; unsigned char* wl = P->ws + WS_W + (size_t)l * W_LAYER; CvtJob J;
    if (k == 0)      { J.W = P->in[I_WIN] + (size_t)l * D * NIN; J.K = D; J.srcld = NIN; J.c0 = 0; J.cnt = NMIX; J.mode = 0; J.dst = (bf16*)(wl + WO_IN); }
    else if (k == 1) { J.W = P->in[I_WIN] + (size_t)l * D * NIN; J.K = D; J.srcld = NIN; J.c0 = NMIX; J.cnt = 4096; J.mode = 1; J.dst = (bf16*)(wl + WO_G); }
    else if (k < 6)  { const int b = k - 2; J.W = P->in[I_WBR] + (size_t)(l * 4 + b) * 256 * D; J.K = 256; J.srcld = D; J.c0 = 0; J.cnt = D; J.mode = 0; J.dst = (bf16*)(wl + WO_B) + (size_t)b * D * 256; }
    else if (k == 6) { J.W = P->in[I_WMIX] + (size_t)l * D * D; J.K = D; J.srcld = D; J.c0 = 0; J.cnt = D; J.mode = 0; J.dst = (bf16*)(wl + WO_MIX); }
    else if (k == 7) { J.W = P->in[I_WUP] + (size_t)l * D * 2 * DFF; J.K = D; J.srcld = 2 * DFF; J.c0 = 0; J.cnt = 2 * DFF; J.mode = 2; J.dst = (bf16*)(wl + WO_UP); }
    else if (k == 8) { J.W = P->in[I_WDN] + (size_t)l * DFF * D; J.K = DFF; J.srcld = D; J.c0 = 0; J.cnt = D; J.mode = 0; J.dst = (bf16*)(wl + WO_DN); }
    else if (k == 9) { J.W = P->in[I_WPG] + (size_t)l * D * D; J.K = D; J.srcld = D; J.c0 = 0; J.cnt = D; J.mode = 0; J.dst = (bf16*)(wl + WO_PG); }
    else             { J.W = P->in[I_WPP] + (size_t)l * PLE * D; J.K = PLE; J.srcld = D; J.c0 = 0; J.cnt = D; J.mode = 0; J.dst = (bf16*)(wl + WO_PP); }
    J.items = (J.K / 64) * ((J.cnt + 31) / 32);
    return J;
}
template <int NR, bool SRCBF>
__device__ __forceinline__ NOPK void ln_rows(const void* xsrc, const float* w, const float* b, bf16* o0, float* f0, int lane) {
    f32x4 v[NR][4];
    if (SRCBF) { v2u t[NR][4];
#pragma unroll
        for (int r = 0; r < NR; ++r)
#pragma unroll
            for (int j = 0; j < 4; ++j) t[r][j] = ((const v2u*)((const bf16*)xsrc + (size_t)r * D))[lane + 64 * j];
#pragma unroll
        for (int r = 0; r < NR; ++r)
#pragma unroll
            for (int j = 0; j < 4; ++j) v[r][j] = (f32x4){u2f(t[r][j].x << 16), u2f(t[r][j].x & 0xffff0000u), u2f(t[r][j].y << 16), u2f(t[r][j].y & 0xffff0000u)};
    } else {
#pragma unroll
        for (int r = 0; r < NR; ++r)
#pragma unroll
            for (int j = 0; j < 4; ++j) v[r][j] = ((const f32x4*)((const float*)xsrc + (size_t)r * D))[lane + 64 * j];
    }
    f32x4 wv[4], bv[4];
#pragma unroll
    for (int j = 0; j < 4; ++j) { wv[j] = ((const f32x4*)w)[lane + 64 * j]; bv[j] = ((const f32x4*)b)[lane + 64 * j]; }
#pragma unroll
    for (int r = 0; r < NR; ++r) { float s = 0.f;
#pragma unroll
        for (int j = 0; j < 4; ++j) s += (v[r][j].x + v[r][j].y) + (v[r][j].z + v[r][j].w);
        const float mean = wave_sum(s) * (1.f / D); float q = 0.f;
#pragma unroll
        for (int j = 0; j < 4; ++j) { v[r][j] = v[r][j] - mean; q += (v[r][j].x * v[r][j].x + v[r][j].y * v[r][j].y) + (v[r][j].z * v[r][j].z + v[r][j].w * v[r][j].w); }
        const float rstd = 1.f / sqrtf(wave_sum(q) * (1.f / D) + LN_EPS);
#pragma unroll
        for (int j = 0; j < 4; ++j) { const f32x4 a = v[r][j] * rstd * wv[j] + bv[j];
            if (o0) { v2u pk; pk.x = cvt_pk_bf16(a.x, a.y); pk.y = cvt_pk_bf16(a.z, a.w); ((v2u*)(o0 + (size_t)r * D))[lane + 64 * j] = pk; }
            if (f0) ((f32x4*)(f0 + (size_t)r * D))[lane + 64 * j] = a; } }
}
template <bool SRCBF>
__device__ __forceinline__ NOPK void ln_phase(const void* V, const float* w, const float* b, bf16* XB, float* OUTF) {
    const int tid = opaque_tid(), lane = tid & 63, gw = blockIdx.x * NWAVES + (tid >> 6), NGW = gridDim.x * NWAVES;
    for (int m = 4 * gw; m < M; m += 4 * NGW)
        ln_rows<4, SRCBF>(SRCBF ? (const void*)((const bf16*)V + (size_t)m * D) : (const void*)((const float*)V + (size_t)m * D), w, b, XB ? XB + (size_t)m * D : nullptr, OUTF ? OUTF + (size_t)m * D : nullptr, lane);
}
__device__ __forceinline__ NOPK void prologue(KP P, LAS unsigned char* lds) {
    const int tid = opaque_tid(), lane = tid & 63, wave = __builtin_amdgcn_readfirstlane(tid >> 6);
    LAS float* scr = (LAS float*)(lds + wave * 16384);
    const int gw = blockIdx.x * NWAVES + wave, NGW = gridDim.x * NWAVES;
    const int gt = blockIdx.x * (NWAVES * 64) + tid, NGT = gridDim.x * NWAVES * 64;
    int total = 0;
    for (int j = 0; j < 22; ++j) total += get_job(P, j).items;
    for (int it = gw; it < total; it += NGW) {
        int r = it, j = 0; CvtJob J = get_job(P, 0);
        while (r >= J.items) { r -= J.items; ++j; J = get_job(P, j); }
        cvt_item(J.W, J.K, J.srcld, J.c0, J.cnt, J.dst, J.mode, scr, r, lane);
    }
    for (int l = 0; l < DEPTH; ++l) { v4u* z = (v4u*)((bf16*)(P->ws + WS_W + (size_t)l * W_LAYER + WO_IN) + (size_t)NMIX * D);
        for (int i = gt; i < (NMIXP - NMIX) * D / 8; i += NGT) z[i] = (v4u){0u, 0u, 0u, 0u}; }
    { const f32x4* ps = (const f32x4*)P->in[I_P]; v2u* pd = (v2u*)(P->ws + WS_PB);
        constexpr size_t NP4 = (size_t)DEPTH * M * PLE / 4;
        for (size_t i = gt; i < NP4; i += (size_t)4 * NGT) { f32x4 v[4];
#pragma unroll
            for (int q = 0; q < 4; ++q) if (i + (size_t)q * NGT < NP4) v[q] = ps[i + (size_t)q * NGT];
#pragma unroll
            for (int q = 0; q < 4; ++q) if (i + (size_t)q * NGT < NP4) { v2u o; o.x = cvt_pk_bf16(v[q].x, v[q].y); o.y = cvt_pk_bf16(v[q].z, v[q].w); pd[i + (size_t)q * NGT] = o; } } }
    { f32x2g* rt = (f32x2g*)(P->ws + WS_ROPE);
        for (int i = gt; i < SEQ * 16; i += NGT) { const int t = i >> 4, k = i & 15; const double a = (double)t * ROPE_THETA[k];
            const double n = __builtin_rint(a * 0.15915494309189535); const double r = a - n * 6.283185307179586, r2 = r * r;
            double ts = r, ss = r, tc = 1.0, sc = 1.0;
            for (int q = 1; q <= 14; ++q) { tc *= -r2 / (double)((2 * q - 1) * (2 * q)); sc += tc; ts *= -r2 / (double)((2 * q) * (2 * q + 1)); ss += ts; }
            rt[i] = (f32x2g){(float)sc, (float)ss}; } }
    ln_phase<false>(P->in[I_X], P->in[I_LNINW], P->in[I_LNINB], (bf16*)(P->ws + WS_XB), nullptr);
}

#ifndef REP_PREP
#define REP_PREP 1
#endif
#ifndef REP_REC
#define REP_REC 1
#endif

__device__ __forceinline__ NOPK void ld8(const bf16* p, float (&o)[8]) { const v4u w = *(const v4u*)p; o[0] = bf_lo(w.x); o[1] = bf_hi(w.x); o[2] = bf_lo(w.y); o[3] = bf_hi(w.y); o[4] = bf_lo(w.z); o[5] = bf_hi(w.z); o[6] = bf_lo(w.w); o[7] = bf_hi(w.w); }
__device__ __forceinline__ NOPK void st8(bf16* p, const float (&o)[8]) { v4u w; w.x = cvt_pk_bf16(o[0], o[1]); w.y = cvt_pk_bf16(o[2], o[3]); w.z = cvt_pk_bf16(o[4], o[5]); w.w = cvt_pk_bf16(o[6], o[7]); *(v4u*)p = w; }
__device__ __forceinline__ NOPK float sigmoid_acc(float x) { return __builtin_amdgcn_rcpf(1.0f + __expf(-x)); }
__device__ __forceinline__ NOPK float tanh_fast(float x) { return 2.0f * __builtin_amdgcn_rcpf(1.0f + __expf(-2.0f * x)) - 1.0f; }

typedef short bf16x8v __attribute__((ext_vector_type(8)));
#define SWZ(r, c) ((r) * 64 + ((((c) >> 3) ^ ((r) & 7)) << 3) + ((c) & 7))
__device__ __forceinline__ NOPK bf16x8v frag64(const LAS bf16* arr, int row, int ch) { return *(const LAS bf16x8v*)(arr + row * 64 + ((ch ^ (row & 7)) << 3)); }
template <int MX>
__device__ __forceinline__ NOPK void linattn_fast(LAS unsigned char* lds, KP P, int layer, int b, int h) {
    constexpr int DK = (MX == 3) ? 64 : 32, NDT = DK / 16, NKS = DK / 32, QN = DK / 8;
    asm volatile("" : "+s"(h), "+s"(b));
    const int tid = opaque_tid(), lane = tid & 63, wave = __builtin_amdgcn_readfirstlane(tid >> 6), fr = lane & 15, fq = lane >> 4;
    LAS float* slg = (LAS float*)lds;
    LAS bf16* sQ = (LAS bf16*)(lds + 16384); LAS bf16* sK = (LAS bf16*)(lds + 24576); LAS bf16* sKT = (LAS bf16*)(lds + 32768); LAS bf16* sVT = (LAS bf16*)(lds + 40960);
    LAS bf16* sP = (LAS bf16*)(lds + 49152); LAS bf16* sST = (LAS bf16*)(lds + 57344); LAS bf16* sG = (LAS bf16*)(lds + 65536);
    LAS float* sw2 = (LAS float*)(lds + 73728); LAS float* sbb = sw2 + 512;
    const bf16* Z = (const bf16*)(P->ws + WS_R2);
    bf16* O = (bf16*)P->out;
    const int t8 = tid >> 3, e0 = (tid & 7) * 8, dd0 = (tid & 7) * QN;
    constexpr int zbase = (MX == 0) ? 0 : (MX == 2) ? 1792 : 2576;
    constexpr int qcol = 0, kcol = (MX == 3) ? 256 : 128, vcol = (MX == 3) ? 512 : 256, gcol = (MX == 0) ? 512 : (MX == 2) ? 528 : 768;
    const float lgam = (MX == 0) ? logf(1.0f - exp2f(-5.0f - (float)h)) : 0.f;
    sync_wg();
    if (MX == 2) { sw2[tid] = P->in[I_GLAW2][(size_t)layer * 16 * 128 + (tid >> 5) * 128 + h * 32 + (tid & 31)]; if (tid < 32) sbb[tid] = P->in[I_GLAB][layer * 128 + h * 32 + tid]; sync_wg(); }
    float lbv[8];
#pragma unroll
    for (int i = 0; i < 8; ++i) { lbv[i] = 0.f; if (MX == 3 && layer > 0) lbv[i] = sigmoid_acc(P->in[I_HLB][256 + h * 64 + e0 + i] - P->in[I_HLB][h * 64 + e0 + i]); }
    float nw[16];
#pragma unroll
    for (int i = 0; i < 16; ++i) { const int e = 16 * (i >> 2) + 4 * fq + (i & 3); nw[i] = (MX == 2) ? P->in[I_GLANW][layer * 64 + e] : (MX == 3) ? P->in[I_HNW][layer * 64 + e] : 1.f; }
    f32x4 S[NDT];
#pragma unroll
    for (int i = 0; i < NDT; ++i) S[i] = (f32x4){0.f, 0.f, 0.f, 0.f};
#pragma unroll 1
    for (int c = 0; c < NCHUNK; ++c) {
        const size_t rowbase = (size_t)b * SEQ + c * 64;
        const bf16* zr = Z + (rowbase + t8) * NMIXP + zbase;
        float qr[QN], kr[QN];
        { const v4u vw = *(const v4u*)(zr + vcol + h * 64 + e0);
          const unsigned vv[4] = {vw.x, vw.y, vw.z, vw.w};
#pragma unroll
          for (int i = 0; i < 4; ++i) { sVT[SWZ(e0 + 2 * i, t8)] = (bf16)(vv[i] & 0xffffu); sVT[SWZ(e0 + 2 * i + 1, t8)] = (bf16)(vv[i] >> 16); }
          *(LAS v4u*)(sG + SWZ(t8, e0)) = *(const v4u*)(zr + gcol + h * 64 + e0); }
        if (MX == 3) {
            float a[8], f[8]; ld8(zr + qcol + h * 64 + e0, a); ld8(zr + kcol + h * 64 + e0, f);
#pragma unroll
            for (int i = 0; i < 8; ++i) { qr[i] = a[i]; const float ff = lbv[i] + (1.f - lbv[i]) * sigmoid_acc(f[i]); kr[i] = (1.f - lbv[i]) * sigmoid_acc(-f[i]); slg[t8 * 64 + e0 + i] = logf(ff); }
        } else {
            const v2u qw = *(const v2u*)(zr + qcol + h * 32 + dd0), kw = *(const v2u*)(zr + kcol + h * 32 + dd0);
            float q4[4] = {bf_lo(qw.x), bf_hi(qw.x), bf_lo(qw.y), bf_hi(qw.y)}, k4[4] = {bf_lo(kw.x), bf_hi(kw.x), bf_lo(kw.y), bf_hi(kw.y)};
            if (MX == 0) { const f32x2g* rope = (const f32x2g*)(P->ws + WS_ROPE) + (c * 64 + t8) * 16 + (dd0 >> 1);
#pragma unroll
                for (int p2 = 0; p2 < 2; ++p2) { const f32x2g cs = rope[p2]; const float q1 = q4[2 * p2], q2 = q4[2 * p2 + 1], k1 = k4[2 * p2] * 0.17677669529663687f, k2 = k4[2 * p2 + 1] * 0.17677669529663687f;
                    qr[2 * p2] = q1 * cs.x - q2 * cs.y; qr[2 * p2 + 1] = q1 * cs.y + q2 * cs.x; kr[2 * p2] = k1 * cs.x - k2 * cs.y; kr[2 * p2 + 1] = k1 * cs.y + k2 * cs.x; }
            } else { float gl[16]; { float a[8]; ld8(zr + 512, a);
#pragma unroll
                    for (int i = 0; i < 8; ++i) gl[i] = a[i];
                    ld8(zr + 520, a);
#pragma unroll
                    for (int i = 0; i < 8; ++i) gl[8 + i] = a[i]; }
#pragma unroll
                for (int i = 0; i < 4; ++i) { qr[i] = q4[i] * 0.17677669529663687f; kr[i] = k4[i]; float acc = sbb[dd0 + i];
#pragma unroll
                    for (int j = 0; j < 16; ++j) acc += gl[j] * sw2[j * 32 + dd0 + i];
                    slg[t8 * 64 + dd0 + i] = (fminf(acc, 0.f) - log1pf(__expf(-fabsf(acc)))) * 0.0625f; } }
        }
        if (MX != 0) {
            sync_wg();
            if (tid < DK) { float run = 0.f;
#pragma unroll 1
                for (int tb = 0; tb < 64; tb += 16) { float x[16];
#pragma unroll
                    for (int i = 0; i < 16; ++i) x[i] = slg[(tb + i) * 64 + tid];
#pragma unroll
                    for (int i = 0; i < 16; ++i) { run += x[i]; x[i] = run; }
#pragma unroll
                    for (int i = 0; i < 16; ++i) slg[(tb + i) * 64 + tid] = x[i]; } }
            sync_wg();
        }
        { float qs[QN], ks[QN];
#pragma unroll
          for (int i = 0; i < QN; ++i) { float dq;
              if (MX == 0) dq = (float)(t8 - 31) * lgam; else dq = slg[t8 * 64 + dd0 + i] - slg[31 * 64 + dd0 + i];
              qs[i] = qr[i] * __expf(dq); ks[i] = kr[i] * __expf(-dq); }
          if (QN == 8) { v4u o; o.x = cvt_pk_bf16(qs[0], qs[1]); o.y = cvt_pk_bf16(qs[2], qs[3]); o.z = cvt_pk_bf16(qs[4], qs[5]); o.w = cvt_pk_bf16(qs[6], qs[7]); *(LAS v4u*)(sQ + SWZ(t8, dd0)) = o;
                         v4u p; p.x = cvt_pk_bf16(ks[0], ks[1]); p.y = cvt_pk_bf16(ks[2], ks[3]); p.z = cvt_pk_bf16(ks[4], ks[5]); p.w = cvt_pk_bf16(ks[6], ks[7]); *(LAS v4u*)(sK + SWZ(t8, dd0)) = p; }
          else { v2u o; o.x = cvt_pk_bf16(qs[0], qs[1]); o.y = cvt_pk_bf16(qs[2], qs[3]); *(LAS v2u*)(sQ + SWZ(t8, dd0)) = o;
                 v2u p; p.x = cvt_pk_bf16(ks[0], ks[1]); p.y = cvt_pk_bf16(ks[2], ks[3]); *(LAS v2u*)(sK + SWZ(t8, dd0)) = p; }
#pragma unroll
          for (int i = 0; i < QN; i += 2) { const unsigned w = cvt_pk_bf16(ks[i], ks[i + 1]); sKT[SWZ(dd0 + i, t8)] = (bf16)(w & 0xffffu); sKT[SWZ(dd0 + i + 1, t8)] = (bf16)(w >> 16); } }
        sync_wg();
        bf16x8v bq[NKS];
        if (wave < 4) {
            const int t = 16 * wave + fr;
#pragma unroll
            for (int ks = 0; ks < NKS; ++ks) bq[ks] = frag64(sQ, t, 4 * ks + fq);
#pragma unroll
            for (int j = 0; j < 4; ++j) { f32x4 acc = (f32x4){0.f, 0.f, 0.f, 0.f};
                if (j <= wave) {
#pragma unroll
                    for (int ks = 0; ks < NKS; ++ks) acc = __builtin_amdgcn_mfma_f32_16x16x32_bf16(frag64(sK, 16 * j + fr, 4 * ks + fq), bq[ks], acc, 0, 0, 0); }
                float pv[4];
#pragma unroll
                for (int rg = 0; rg < 4; ++rg) pv[rg] = (j < wave || (j == wave && 4 * fq + rg <= fr)) ? acc[rg] : 0.f;
                v2u o; o.x = cvt_pk_bf16(pv[0], pv[1]); o.y = cvt_pk_bf16(pv[2], pv[3]);
                *(LAS v2u*)(sP + t * 64 + (((2 * j + (fq >> 1)) ^ (t & 7)) << 3) + 4 * (fq & 1)) = o; }
        } else {
            const int e = 16 * (wave - 4) + fr;
#pragma unroll
            for (int i = 0; i < NDT; ++i) { float sc[4];
#pragma unroll
                for (int rg = 0; rg < 4; ++rg) sc[rg] = (MX == 0) ? __expf(32.f * lgam) : __expf(slg[31 * 64 + 16 * i + 4 * fq + rg]);
                v2u o; o.x = cvt_pk_bf16(S[i][0] * sc[0], S[i][1] * sc[1]); o.y = cvt_pk_bf16(S[i][2] * sc[2], S[i][3] * sc[3]);
                *(LAS v2u*)(sST + e * 64 + (((2 * i + (fq >> 1)) ^ (e & 7)) << 3) + 4 * (fq & 1)) = o; }
        }
        sync_wg();
        if (wave < 4) {
            const int t = 16 * wave + fr;
            bf16x8v bp[2];
#pragma unroll
            for (int ks = 0; ks < 2; ++ks) bp[ks] = frag64(sP, t, 4 * ks + fq);
            f32x4 oacc[4];
#pragma unroll
            for (int i = 0; i < 4; ++i) { f32x4 acc = (f32x4){0.f, 0.f, 0.f, 0.f};
                acc = __builtin_amdgcn_mfma_f32_16x16x32_bf16(frag64(sVT, 16 * i + fr, fq), bp[0], acc, 0, 0, 0);
                if (wave >= 2) acc = __builtin_amdgcn_mfma_f32_16x16x32_bf16(frag64(sVT, 16 * i + fr, 4 + fq), bp[1], acc, 0, 0, 0);
#pragma unroll
                for (int ks = 0; ks < NKS; ++ks) acc = __builtin_amdgcn_mfma_f32_16x16x32_bf16(frag64(sST, 16 * i + fr, 4 * ks + fq), bq[ks], acc, 0, 0, 0);
                oacc[i] = acc; }
            float s1 = 0.f;
#pragma unroll
            for (int i = 0; i < 4; ++i)
#pragma unroll
                for (int rg = 0; rg < 4; ++rg) s1 += (MX == 0) ? oacc[i][rg] : oacc[i][rg] * oacc[i][rg];
            s1 += shfl_xor_(s1, 16); s1 += shfl_xor_(s1, 32);
            float rs;
            if (MX == 0) { const float mean = s1 * (1.f / 64.f); float q2 = 0.f;
#pragma unroll
                for (int i = 0; i < 4; ++i)
#pragma unroll
                    for (int rg = 0; rg < 4; ++rg) { oacc[i][rg] -= mean; q2 += oacc[i][rg] * oacc[i][rg]; }
                q2 += shfl_xor_(q2, 16); q2 += shfl_xor_(q2, 32); rs = 1.0f / sqrtf(q2 * (1.f / 64.f) + 1e-6f);
            } else rs = 1.0f / sqrtf(s1 * (1.f / 64.f) + 1e-6f);
#pragma unroll
            for (int i = 0; i < 4; ++i) { const v2u gw = *(const LAS v2u*)(sG + t * 64 + (((2 * i + (fq >> 1)) ^ (t & 7)) << 3) + 4 * (fq & 1));
                const float g4[4] = {bf_lo(gw.x), bf_hi(gw.x), bf_lo(gw.y), bf_hi(gw.y)}; float y[4];
#pragma unroll
                for (int rg = 0; rg < 4; ++rg) y[rg] = oacc[i][rg] * rs * nw[4 * i + rg] * g4[rg] * sigmoid_acc(g4[rg]);
                v2u o; o.x = cvt_pk_bf16(y[0], y[1]); o.y = cvt_pk_bf16(y[2], y[3]);
                *(v2u*)(O + (rowbase + t) * D + MX * 256 + h * 64 + 16 * i + 4 * fq) = o; }
        } else {
            const int e = 16 * (wave - 4) + fr;
            bf16x8v bv[2];
#pragma unroll
            for (int ks = 0; ks < 2; ++ks) bv[ks] = frag64(sVT, e, 4 * ks + fq);
#pragma unroll
            for (int i = 0; i < NDT; ++i) { f32x4 acc = (f32x4){0.f, 0.f, 0.f, 0.f};
#pragma unroll
                for (int ks = 0; ks < 2; ++ks) acc = __builtin_amdgcn_mfma_f32_16x16x32_bf16(frag64(sKT, 16 * i + fr, 4 * ks + fq), bv[ks], acc, 0, 0, 0);
#pragma unroll
                for (int rg = 0; rg < 4; ++rg) { float el, er;
                    if (MX == 0) { el = __expf(64.f * lgam); er = __expf(32.f * lgam); }
                    else { const float bl = slg[63 * 64 + 16 * i + 4 * fq + rg], br = slg[31 * 64 + 16 * i + 4 * fq + rg]; el = __expf(bl); er = __expf(bl - br); }
                    S[i][rg] = el * S[i][rg] + er * acc[rg]; } }
        }
        sync_wg();
    }
}

__device__ __forceinline__ NOPK float dpp_f(float x, const int ctrl_sel) {
    const int xi = __builtin_bit_cast(int, x); int r;
    if (ctrl_sel == 0) r = __builtin_amdgcn_update_dpp(0, xi, 0xB1, 0xf, 0xf, true);
    else if (ctrl_sel == 1) r = __builtin_amdgcn_update_dpp(0, xi, 0x4E, 0xf, 0xf, true);
    else if (ctrl_sel == 2) r = __builtin_amdgcn_update_dpp(0, xi, 0x141, 0xf, 0xf, true);
    else r = __builtin_amdgcn_update_dpp(0, xi, 0x140, 0xf, 0xf, true);
    return __builtin_bit_cast(float, r);
}
__device__ __forceinline__ NOPK float sum16_dpp(float v) { v += dpp_f(v, 0); v += dpp_f(v, 1); v += dpp_f(v, 2); v += dpp_f(v, 3); return v; }
#define DPP_SUM16_2(a_, b_) asm volatile( \
    "s_nop 1\n\t" \
    "v_add_f32_dpp %0, %0, %0 quad_perm:[1,0,3,2] row_mask:0xf bank_mask:0xf bound_ctrl:1\n\t" \
    "v_add_f32_dpp %1, %1, %1 quad_perm:[1,0,3,2] row_mask:0xf bank_mask:0xf bound_ctrl:1\n\t" \
    "s_nop 0\n\t" \
    "v_add_f32_dpp %0, %0, %0 quad_perm:[2,3,0,1] row_mask:0xf bank_mask:0xf bound_ctrl:1\n\t" \
    "v_add_f32_dpp %1, %1, %1 quad_perm:[2,3,0,1] row_mask:0xf bank_mask:0xf bound_ctrl:1\n\t" \
    "s_nop 0\n\t" \
    "v_add_f32_dpp %0, %0, %0 row_half_mirror row_mask:0xf bank_mask:0xf bound_ctrl:1\n\t" \
    "v_add_f32_dpp %1, %1, %1 row_half_mirror row_mask:0xf bank_mask:0xf bound_ctrl:1\n\t" \
    "s_nop 0\n\t" \
    "v_add_f32_dpp %0, %0, %0 row_mirror row_mask:0xf bank_mask:0xf bound_ctrl:1\n\t" \
    "v_add_f32_dpp %1, %1, %1 row_mirror row_mask:0xf bank_mask:0xf bound_ctrl:1\n\t" \
    : "+v"(a_), "+v"(b_));
__device__ __forceinline__ NOPK float sum8_dpp(float v) { v += dpp_f(v, 0); v += dpp_f(v, 1); v += dpp_f(v, 2); return v; }

constexpr int RW_SET = 40960;
constexpr int RW_SV = 81920, RW_SY = 90112, RW_SG = 98304, RW_SB = 106496;
constexpr int RW_SCR = 108544;
constexpr int RW_W2T = 124928, RW_A2T = 133120, RW_G2T = 141312;
constexpr int RW_MU = 149504, RW_PAR = 151296;
__device__ __forceinline__ NOPK void rwkv_task2(LAS unsigned char* lds, KP P, int layer, int b, int h, int half) {
    asm volatile("" : "+s"(h), "+s"(b), "+s"(half));
    const int tid = opaque_tid(), lane = tid & 63, wave = __builtin_amdgcn_readfirstlane(tid >> 6);
    LAS bf16* w2T = (LAS bf16*)(lds + RW_W2T); LAS bf16* a2T = (LAS bf16*)(lds + RW_A2T); LAS bf16* g2T = (LAS bf16*)(lds + RW_G2T);
    LAS float* smu = (LAS float*)(lds + RW_MU); LAS float* spar = (LAS float*)(lds + RW_PAR);
    const bf16* Z = (const bf16*)(P->ws + WS_R2);
    const int colh = h * 64;
    constexpr int NC2 = SEQ / 32;
    sync_wg();
    if (tid < 448) { const int seg = tid >> 6, j = tid & 63; const int col = (seg < 3) ? seg * 256 + colh + j : 768 + (seg - 3) * 64 + j; smu[tid] = P->in[I_MU][layer * 1024 + col]; }
    if (tid < 320) { const int seg = tid >> 6, j = tid & 63; const float* src = (seg == 0) ? P->in[I_KK] + layer * 256 + colh : (seg == 1) ? P->in[I_KA] + layer * 256 + colh : (seg == 2) ? P->in[I_RK] + (layer * 4 + h) * 64
                                                                             : (seg == 3) ? P->in[I_RLNW] + layer * 256 + colh : P->in[I_RLNB] + layer * 256 + colh; spar[tid] = src[j]; }
    { const int cc = tid & 63, jb = tid >> 6;
      const float* w2 = P->in[I_W2] + (size_t)layer * 64 * 256 + colh + cc; const float* a2 = P->in[I_A2] + (size_t)layer * 64 * 256 + colh + cc;
      float x[8];
#pragma unroll
      for (int i = 0; i < 8; ++i) x[i] = w2[(8 * jb + i) * 256];
      { v4u o; o.x = cvt_pk_bf16(x[0], x[1]); o.y = cvt_pk_bf16(x[2], x[3]); o.z = cvt_pk_bf16(x[4], x[5]); o.w = cvt_pk_bf16(x[6], x[7]); *(LAS v4u*)(w2T + cc * 64 + ((jb ^ (cc & 7)) << 3)) = o; }
#pragma unroll
      for (int i = 0; i < 8; ++i) x[i] = a2[(8 * jb + i) * 256];
      { v4u o; o.x = cvt_pk_bf16(x[0], x[1]); o.y = cvt_pk_bf16(x[2], x[3]); o.z = cvt_pk_bf16(x[4], x[5]); o.w = cvt_pk_bf16(x[6], x[7]); *(LAS v4u*)(a2T + cc * 64 + ((jb ^ (cc & 7)) << 3)) = o; }
      const int cg = tid & 31, ch = tid >> 5; const float* g2 = P->in[I_G2] + (size_t)layer * 128 * 256 + colh + 32 * half + cg;
#pragma unroll
      for (int i = 0; i < 8; ++i) x[i] = g2[(8 * ch + i) * 256];
      { v4u o; o.x = cvt_pk_bf16(x[0], x[1]); o.y = cvt_pk_bf16(x[2], x[3]); o.z = cvt_pk_bf16(x[4], x[5]); o.w = cvt_pk_bf16(x[6], x[7]); *(LAS v4u*)(g2T + cg * 128 + ((ch ^ (cg & 7)) << 3)) = o; } }
    sync_wg();
    const int wrole = wave >> 2, widx = wave & 3;
    if (wrole) {
        const int pw = widx, tl = lane >> 3, e0 = (lane & 7) * 8, tk = 8 * pw + tl;
        const int fr = lane & 15, fq = lane >> 4;
        LAS bf16* tw = (LAS bf16*)(lds + RW_SCR + pw * 4096); LAS bf16* ta = tw + 512; LAS bf16* tg = tw + 1024;
        float w0v[4], a0v[4];
#pragma unroll
        for (int q = 0; q < 4; ++q) { w0v[q] = P->in[I_W0][layer * 256 + colh + 16 * q + fr]; a0v[q] = P->in[I_A0][layer * 256 + colh + 16 * q + fr]; }
        v4u R[7], Rp[7];
#define RW2_LOAD(cc_) { const size_t row_ = (size_t)b * SEQ + (cc_) * 32 + tk; const bf16* zr_ = Z + row_ * NMIXP + 768; const bf16* zp_ = ((cc_) == 0 && tk == 0) ? zr_ : zr_ - NMIXP; \
        const int cols_[7] = {colh + e0, 256 + colh + e0, 512 + colh + e0, 768 + e0, 832 + e0, 896 + e0, 960 + e0}; \
        _Pragma("unroll") for (int q_ = 0; q_ < 7; ++q_) { R[q_] = *(const v4u*)(zr_ + cols_[q_]); Rp[q_] = *(const v4u*)(zp_ + cols_[q_]); } }
        RW2_LOAD(0)
#pragma unroll 1
        for (int it = -1; it <= NC2; ++it) {
            if (it >= 1) { const int oc = it - 1, ob = oc & 1; const int c4 = (lane & 7) * 4;
                const LAS float* sy = (const LAS float*)(lds + RW_SY + ob * 4096); const LAS float* sv = (const LAS float*)(lds + RW_SV + ob * 4096); const LAS float* sg = (const LAS float*)(lds + RW_SG + ob * 4096);
                const f32x4 yv = *(const LAS f32x4*)(sy + tk * 32 + c4), vv = *(const LAS f32x4*)(sv + tk * 32 + c4), gv = *(const LAS f32x4*)(sg + tk * 32 + c4);
                float s = (yv.x + yv.y) + (yv.z + yv.w); s = red8(s); const float mean = s * (1.f / 32.f);
                const f32x4 d = yv - mean; float q = (d.x * d.x + d.y * d.y) + (d.z * d.z + d.w * d.w); q = red8(q);
                const float bon = ((const LAS float*)(lds + RW_SB + ob * 128))[tk];
                const size_t row = (size_t)b * SEQ + oc * 32 + tk; const size_t off = row * 256 + colh + 32 * half + c4;
                *(f32x4*)((float*)(P->out + (size_t)M * D / 2) + off) = yv;
                v2u ad; ad.x = cvt_pk_bf16(bon * vv.x, bon * vv.y); ad.y = cvt_pk_bf16(bon * vv.z, bon * vv.w);
                *(v2u*)((bf16*)(P->out + (size_t)M * D / 2 + (size_t)M * 256) + off) = ad;
                v2u gt; gt.x = cvt_pk_bf16(gv.x, gv.y); gt.y = cvt_pk_bf16(gv.z, gv.w);
                *(v2u*)((bf16*)(P->out + (size_t)M * D / 2 + (size_t)M * 256) + (size_t)M * 256 + off) = gt;
                if ((lane & 7) == 0) ((f32x2g*)(P->ws + WS_RST))[(row * 4 + h) * 2 + half] = (f32x2g){mean, q}; }
            if (it + 1 < NC2) { const int pc = it + 1, pb = pc & 1;
                LAS float* sr = (LAS float*)(lds + pb * RW_SET); LAS float* skm = sr + 2048; LAS float* sw = sr + 4096; LAS float* skk = sr + 6144; LAS float* ska = sr + 8192;
                LAS float* sv = (LAS float*)(lds + RW_SV + pb * 4096); LAS float* sg = (LAS float*)(lds + RW_SG + pb * 4096); LAS float* sb = (LAS float*)(lds + RW_SB + pb * 128);
                { const bool first = (pc == 0 && tk == 0); float a[8], p[8], z[8];
#define UNPK2(vv_, o_) { const v4u u_ = vv_; o_[0] = bf_lo(u_.x); o_[1] = bf_hi(u_.x); o_[2] = bf_lo(u_.y); o_[3] = bf_hi(u_.y); o_[4] = bf_lo(u_.z); o_[5] = bf_hi(u_.z); o_[6] = bf_lo(u_.w); o_[7] = bf_hi(u_.w); }
#define SHIFT2(idx) { UNPK2(R[idx], a) UNPK2(Rp[idx], p) _Pragma("unroll") for (int i = 0; i < 8; ++i) { const float pv = first ? 0.f : p[i]; z[i] = a[i] + (pv - a[i]) * smu[(idx) * 64 + e0 + i]; } }
                  SHIFT2(0)
                  *(LAS f32x4*)(sr + tk * 64 + e0) = (f32x4){z[0], z[1], z[2], z[3]}; *(LAS f32x4*)(sr + tk * 64 + e0 + 4) = (f32x4){z[4], z[5], z[6], z[7]};
                  SHIFT2(1)
                  *(LAS f32x4*)(skm + tk * 64 + e0) = (f32x4){z[0], z[1], z[2], z[3]}; *(LAS f32x4*)(skm + tk * 64 + e0 + 4) = (f32x4){z[4], z[5], z[6], z[7]};
                  SHIFT2(2)
                  if ((e0 >> 5) == half) { *(LAS f32x4*)(sv + tk * 32 + (e0 & 31)) = (f32x4){z[0], z[1], z[2], z[3]}; *(LAS f32x4*)(sv + tk * 32 + (e0 & 31) + 4) = (f32x4){z[4], z[5], z[6], z[7]}; }
                  const int sw8 = ((lane & 7) ^ (tl & 7)) << 3;
                  SHIFT2(3)
                  { v4u o; o.x = cvt_pk_bf16(tanh_fast(z[0]), tanh_fast(z[1])); o.y = cvt_pk_bf16(tanh_fast(z[2]), tanh_fast(z[3])); o.z = cvt_pk_bf16(tanh_fast(z[4]), tanh_fast(z[5])); o.w = cvt_pk_bf16(tanh_fast(z[6]), tanh_fast(z[7])); *(LAS v4u*)(tw + tl * 64 + sw8) = o; }
                  SHIFT2(4)
                  { v4u o; o.x = cvt_pk_bf16(z[0], z[1]); o.y = cvt_pk_bf16(z[2], z[3]); o.z = cvt_pk_bf16(z[4], z[5]); o.w = cvt_pk_bf16(z[6], z[7]); *(LAS v4u*)(ta + tl * 64 + sw8) = o; }
                  SHIFT2(5)
                  { v4u o; o.x = cvt_pk_bf16(sigmoid_acc(z[0]), sigmoid_acc(z[1])); o.y = cvt_pk_bf16(sigmoid_acc(z[2]), sigmoid_acc(z[3])); o.z = cvt_pk_bf16(sigmoid_acc(z[4]), sigmoid_acc(z[5])); o.w = cvt_pk_bf16(sigmoid_acc(z[6]), sigmoid_acc(z[7])); *(LAS v4u*)(tg + tl * 128 + sw8) = o; }
                  SHIFT2(6)
                  { v4u o; o.x = cvt_pk_bf16(sigmoid_acc(z[0]), sigmoid_acc(z[1])); o.y = cvt_pk_bf16(sigmoid_acc(z[2]), sigmoid_acc(z[3])); o.z = cvt_pk_bf16(sigmoid_acc(z[4]), sigmoid_acc(z[5])); o.w = cvt_pk_bf16(sigmoid_acc(z[6]), sigmoid_acc(z[7])); *(LAS v4u*)(tg + tl * 128 + 64 + sw8) = o; }
#undef SHIFT2
#undef UNPK2
                }
                if (pc + 1 < NC2) RW2_LOAD(pc + 1)
                asm volatile("s_waitcnt lgkmcnt(0)" ::: "memory");
                { const int ar = fr & 7;
                  f32x4 wacc[4], aacc[4], gacc[2];
#pragma unroll
                  for (int q = 0; q < 4; ++q) { wacc[q] = (f32x4){0.f, 0.f, 0.f, 0.f}; aacc[q] = wacc[q]; }
                  gacc[0] = (f32x4){0.f, 0.f, 0.f, 0.f}; gacc[1] = gacc[0];
#pragma unroll
                  for (int ks = 0; ks < 2; ++ks) { const int ch = ks * 4 + fq;
                      const bf16x8v Aw = *(const LAS bf16x8v*)(tw + ar * 64 + ((ch ^ (ar & 7)) << 3)), Aa = *(const LAS bf16x8v*)(ta + ar * 64 + ((ch ^ (ar & 7)) << 3));
#pragma unroll
                      for (int q = 0; q < 4; ++q) { const int br = 16 * q + fr;
                          const bf16x8v Bw = *(const LAS bf16x8v*)(w2T + br * 64 + ((ch ^ (br & 7)) << 3)), Ba = *(const LAS bf16x8v*)(a2T + br * 64 + ((ch ^ (br & 7)) << 3));
                          wacc[q] = __builtin_amdgcn_mfma_f32_16x16x32_bf16(Aw, Bw, wacc[q], 0, 0, 0); aacc[q] = __builtin_amdgcn_mfma_f32_16x16x32_bf16(Aa, Ba, aacc[q], 0, 0, 0); } }
#pragma unroll
                  for (int ks = 0; ks < 4; ++ks) { const int ch = ks * 4 + fq;
                      const bf16x8v Ag = *(const LAS bf16x8v*)(tg + ar * 128 + ((ch ^ (ar & 7)) << 3));
#pragma unroll
                      for (int q = 0; q < 2; ++q) { const int br = 16 * q + fr;
                          const bf16x8v Bg = *(const LAS bf16x8v*)(g2T + br * 128 + ((ch ^ (br & 7)) << 3));
                          gacc[q] = __builtin_amdgcn_mfma_f32_16x16x32_bf16(Ag, Bg, gacc[q], 0, 0, 0); } }
                  if (fq < 2) {
#pragma unroll
                      for (int rg = 0; rg < 4; ++rg) { const int t = 8 * pw + 4 * fq + rg;
#pragma unroll
                          for (int q = 0; q < 4; ++q) { const int cc = 16 * q + fr;
                              sw[t * 64 + cc] = __expf(-0.6065306597126334f * sigmoid_acc(w0v[q] + wacc[q][rg])); ska[t * 64 + cc] = sigmoid_acc(a0v[q] + aacc[q][rg]); }
#pragma unroll
                          for (int q = 0; q < 2; ++q) sg[t * 32 + 16 * q + fr] = gacc[q][rg]; } } }
                asm volatile("s_waitcnt lgkmcnt(0)" ::: "memory");
                { float ss = 0.f, bon = 0.f; float kk[8], av[8];
#pragma unroll
                  for (int i = 0; i < 8; ++i) { const int cc = e0 + i; const float kv = skm[tk * 64 + cc]; av[i] = ska[tk * 64 + cc];
                      kk[i] = kv * spar[cc]; ss += kk[i] * kk[i];
                      const float km = kv * (1.f + (av[i] - 1.f) * spar[64 + cc]); skm[tk * 64 + cc] = km;
                      bon += sr[tk * 64 + cc] * km * spar[128 + cc]; }
                  ss = red8(ss); bon = red8(bon); const float inv = 1.0f / sqrtf(ss + 1e-12f);
#pragma unroll
                  for (int i = 0; i < 8; ++i) { const float kn = kk[i] * inv; skk[tk * 64 + e0 + i] = kn; ska[tk * 64 + e0 + i] = kn * av[i]; }
                  if ((lane & 7) == 0) sb[tk] = bon; }
            }
            sync_wg();
        }
#undef RW2_LOAD
    } else {
        const int kq = lane & 15, vloc = 2 * (4 * widx + (lane >> 4));
        typedef float f32x2 __attribute__((ext_vector_type(2)));
        f32x2 S2[4];
#pragma unroll
        for (int i = 0; i < 4; ++i) S2[i] = (f32x2){0.f, 0.f};
        sync_wg();
#pragma unroll 1
        for (int it = 0; it < NC2; ++it) { const int cb = it & 1;
            const LAS f32x4* pr = (const LAS f32x4*)(lds + cb * RW_SET + 16 * kq); const LAS f32x4* pkm = pr + 512; const LAS f32x4* pw = pr + 1024; const LAS f32x4* pkk = pr + 1536; const LAS f32x4* pka = pr + 2048;
            const LAS f32x2* pv = (const LAS f32x2*)(lds + RW_SV + cb * 4096 + 4 * vloc); LAS float* sy = (LAS float*)(lds + RW_SY + cb * 4096);
            const f32x2 Ssv0 = S2[0], Ssv1 = S2[1], Ssv2 = S2[2], Ssv3 = S2[3];
            for (int rr_ = 0; rr_ < REP_REC; ++rr_) { S2[0] = Ssv0; S2[1] = Ssv1; S2[2] = Ssv2; S2[3] = Ssv3;
            f32x4 wA = pw[0], kA = pkk[0], aA = pka[0], mA = pkm[0], rA = pr[0]; f32x2 vA = pv[0];
            f32x4 wB, kB, aB, mB, rB; f32x2 vB;
#define RWKV_STEP(tcur, tn, wX, kX, aX, mX, rX, vX, wY, kY, aY, mY, rY, vY) { \
              wY = pw[(tn) * 16]; kY = pkk[(tn) * 16]; aY = pka[(tn) * 16]; mY = pkm[(tn) * 16]; rY = pr[(tn) * 16]; vY = pv[(tn) * 16]; \
              f32x2 sa = S2[0] * kX.x; sa = S2[1] * kX.y + sa; sa = S2[2] * kX.z + sa; sa = S2[3] * kX.w + sa; \
              const f32x2 tm0 = S2[0] * wX.x + vX * mX.x, tm1 = S2[1] * wX.y + vX * mX.y, tm2 = S2[2] * wX.z + vX * mX.z, tm3 = S2[3] * wX.w + vX * mX.w; \
              float s0 = sa.x, s1 = sa.y; DPP_SUM16_2(s0, s1) \
              const f32x2 sar = (f32x2){s0, s1}; \
              S2[0] = tm0 - sar * aX.x; S2[1] = tm1 - sar * aX.y; S2[2] = tm2 - sar * aX.z; S2[3] = tm3 - sar * aX.w; \
              f32x2 yy = S2[0] * rX.x; yy = S2[1] * rX.y + yy; yy = S2[2] * rX.z + yy; yy = S2[3] * rX.w + yy; \
              float y0 = yy.x, y1 = yy.y; DPP_SUM16_2(y0, y1) \
              if (kq == 0) *(LAS f32x2*)(sy + (tcur) * 32 + vloc) = (f32x2){y0, y1}; }
#pragma unroll 1
            for (int t = 0; t < 32; t += 2) {
                RWKV_STEP(t, t + 1, wA, kA, aA, mA, rA, vA, wB, kB, aB, mB, rB, vB)
                RWKV_STEP(t + 1, (t + 2) & 31, wB, kB, aB, mB, rB, vB, wA, kA, aA, mA, rA, vA) }
#undef RWKV_STEP
            }
            sync_wg();
        }
        sync_wg();
    }
}

__device__ __forceinline__ NOPK void rwkv_finalize(KP P, int layer) {
    const int gt = blockIdx.x * (NWAVES * 64) + opaque_tid(), NGT = gridDim.x * NWAVES * 64;
    const float* YR = P->out + (size_t)M * D / 2; const bf16* AD = (const bf16*)(YR + (size_t)M * 256); const bf16* GT = AD + (size_t)M * 256;
    const f32x2g* ST = (const f32x2g*)(P->ws + WS_RST); bf16* O = (bf16*)P->out;
    for (int i = gt; i < M * 64; i += NGT) { const int row = i >> 6, c4 = (i & 63) * 4, h = c4 >> 6;
        const f32x2g sa = ST[(row * 4 + h) * 2], sb = ST[(row * 4 + h) * 2 + 1];
        const float mean = 0.5f * (sa.x + sb.x), dm = sa.x - sb.x, m2 = sa.y + sb.y + 16.f * dm * dm, rs = 1.0f / sqrtf(m2 * (1.f / 64.f) + 64e-5f);
        const f32x4 y = *(const f32x4*)(YR + (size_t)row * 256 + c4); const v2u ad = *(const v2u*)(AD + (size_t)row * 256 + c4), g = *(const v2u*)(GT + (size_t)row * 256 + c4);
        const f32x4 lw = *(const f32x4*)(P->in[I_RLNW] + layer * 256 + c4), lb = *(const f32x4*)(P->in[I_RLNB] + layer * 256 + c4);
        v2u o; o.x = cvt_pk_bf16(((y.x - mean) * rs * lw.x + lb.x + bf_lo(ad.x)) * bf_lo(g.x), ((y.y - mean) * rs * lw.y + lb.y + bf_hi(ad.x)) * bf_hi(g.x));
        o.y = cvt_pk_bf16(((y.z - mean) * rs * lw.z + lb.z + bf_lo(ad.y)) * bf_lo(g.y), ((y.w - mean) * rs * lw.w + lb.w + bf_hi(ad.y)) * bf_hi(g.y));
        *(v2u*)(O + (size_t)row * D + 256 + c4) = o; }
}

__device__ __forceinline__ NOPK void ffn_fixup_panel(KP P, int layer, int pm) {
    const int tid = opaque_tid();
    const float* uh = (const float*)(P->ws + WS_HALO); const float* vh = (const float*)(P->ws + WS_HALO + HALO_ONE); const float* ut = (const float*)(P->ws + WS_HALO + 2 * HALO_ONE);
    const float* conv = P->in[I_CONV] + (size_t)layer * 3 * DFF; bf16* ACT = (bf16*)(P->ws + WS_R2);
    for (int i = tid; i < 2 * DFF; i += NWAVES * 64) { const int rr = i / DFF, cc = i % DFF;
        const float u0 = uh[((size_t)pm * 2) * DFF + cc], u1 = uh[((size_t)pm * 2 + 1) * DFF + cc];
        float t0 = 0.f, t1 = 0.f; if (pm & 7) { t0 = ut[((size_t)(pm - 1) * 2) * DFF + cc]; t1 = ut[((size_t)(pm - 1) * 2 + 1) * DFF + cc]; }
        const float c0 = conv[cc], c1 = conv[DFF + cc], c2 = conv[2 * DFF + cc];
        const float cv = rr ? (c2 * u1 + c1 * u0 + c0 * t1) : (c2 * u0 + c1 * t1 + c0 * t0);
        const float a = pg8::gelu_tanh_f(cv) * vh[((size_t)pm * 2 + rr) * DFF + cc];
        ACT[((size_t)pm * 256 + rr) * DFF + cc] = (bf16)(cvt_pk_bf16(a, 0.f) & 0xffffu); }
}

constexpr int NPH = 1 + 10 * DEPTH;
#ifndef REP_MIX
#define REP_MIX -1
#endif
#ifndef REP_PHASE
#define REP_PHASE -1
#endif
#define REPEAT(k) for (int rep_ = 0; rep_ < ((REP_PHASE == (k)) ? 2 : 1); ++rep_)
__global__ void __launch_bounds__(NWAVES * 64, 2) NOPK mega(Params Pk) {
    KP P = kparams();
    extern __shared__ __attribute__((aligned(16))) unsigned char lds_raw[];
    LAS unsigned char* lds = (LAS unsigned char*)lds_raw;
    volatile LAS unsigned* MISC = (volatile LAS unsigned*)(lds + LDS_MISC);
    const int tid = threadIdx.x;
    const int G = gridDim.x, bx = blockIdx.x;
    if (tid < 64) MISC[tid] = 0u;
    sync_wg();
    const int lo = P->ph_lo, hi = P->ph_hi;
    XcdBarrier bar; bar.bar = (unsigned*)(P->ws + WS_CTL) + CW_BAR; bar.x = 0; bar.st = nullptr;
    if (hi - lo > 1) bar = xcd_barrier_post((unsigned*)(P->ws + WS_CTL) + CW_BAR, MISC + 8);
#define IN(k) (lo <= (k) && (k) < hi)
#define SEAM(k) do { if (IN(k) && IN((k) + 1)) xcd_barrier(bar); } while (0)
#define PHASE_PTRS KP P = kparams(); unsigned char* const wl = P->ws + WS_W + (size_t)l * W_LAYER; bf16* const XB = (bf16*)(P->ws + WS_XB); unsigned char* const R2 = P->ws + WS_R2; \
        bf16* const OB = (bf16*)P->out;   bf16* const MG = (bf16*)P->out + (size_t)M * D;   \
        (void)wl; (void)XB; (void)R2; (void)OB; (void)MG;

    REPEAT(100) if (IN(0)) prologue(kparams(), lds);
    SEAM(0);
    for (int l = 0; l < DEPTH; ++l) {
        const int pb = 1 + 10 * l;
        REPEAT(0) if (IN(pb + 0)) {
            PHASE_PTRS
            pg8::Gemm g{XB, (const bf16*)(wl + WO_IN), M, NMIXP, D, D, D, 0, 0}; pg8::StaticOrder S; S.init(M, NMIXP, G, bx);
            pg8::EpiStoreBf16 E{(bf16*)R2, NMIXP};
            pg8::gemm_phase<pg8::EpiStoreBf16, pg8::StaticOrder, true, true>(lds, g, S, E);
        }
        SEAM(pb + 0);
        REPEAT(1) if (IN(pb + 1)) {
            PHASE_PTRS
#ifndef NO_MIX
            for (int slot = bx; slot < 256; slot += G) {
                if (slot < 128) { const int bh = slot >> 1; rwkv_task2(lds, P, l, bh >> 2, bh & 3, slot & 1); }
                else if (slot < 192) { const int bh = slot - 128; linattn_fast<0>(lds, P, l, bh >> 2, bh & 3); linattn_fast<2>(lds, P, l, bh >> 2, bh & 3); }
                else { const int bh = slot - 192; linattn_fast<3>(lds, P, l, bh >> 2, bh & 3);
                    pg8::Gemm g{(const bf16*)(P->ws + WS_PB) + (size_t)l * M * PLE, (const bf16*)(wl + WO_PP), M, D, PLE, PLE, PLE, 0, 0}; pg8::StaticOrder S; S.init(M, D, 64, slot - 192);
                    pg8::EpiStoreBf16 E{(bf16*)(P->ws + WS_PPLE), D};
                    pg8::gemm_phase<pg8::EpiStoreBf16, pg8::StaticOrder, true, true>(lds, g, S, E); } }
#endif
        }
        SEAM(pb + 1);
        REPEAT(2) if (IN(pb + 2)) rwkv_finalize(kparams(), l);
        SEAM(pb + 2);
        REPEAT(3) if (IN(pb + 3)) {
            PHASE_PTRS
            pg8::Gemm g{OB, (const bf16*)(wl + WO_B), M, 4096, 256, D, 256, 4, 256}; pg8::StaticOrder S; S.init(M, 4096, G, bx);
            pg8::EpiStoreBf16 E{(bf16*)R2, 4096};
            pg8::gemm_phase<pg8::EpiStoreBf16, pg8::StaticOrder, true, true>(lds, g, S, E);
        }
        SEAM(pb + 3);
        REPEAT(4) if (IN(pb + 4)) {
            PHASE_PTRS
            pg8::Gemm g{XB, (const bf16*)(wl + WO_G), M, 4096, D, D, D, 0, 0}; pg8::StaticOrder S; S.init(M, 4096, G, bx);
            pg8::EpiMerge E{(const bf16*)R2, MG};
            pg8::gemm_phase<pg8::EpiMerge, pg8::StaticOrder, true, true>(lds, g, S, E);
        }
        SEAM(pb + 4);
        REPEAT(5) if (IN(pb + 5)) {
            PHASE_PTRS
            pg8::Gemm g{MG, (const bf16*)(wl + WO_MIX), M, D, D, D, D, 0, 0}; pg8::StaticOrder S; S.init(M, D, G, bx);
            pg8::EpiResBf16 E{XB, nullptr, ALPHA};
            pg8::gemm_phase<pg8::EpiResBf16, pg8::StaticOrder, true, true>(lds, g, S, E);
        }
        SEAM(pb + 5);
        REPEAT(6) if (IN(pb + 6)) { PHASE_PTRS ln_phase<true>(XB, P->in[I_LNMW] + l * D, P->in[I_LNMB] + l * D, XB, nullptr); }
        SEAM(pb + 6);
        REPEAT(7) if (IN(pb + 7)) {
            PHASE_PTRS
            { pg8::Gemm g{XB, (const bf16*)(wl + WO_UP), M, 2 * DFF, D, D, D, 0, 0}; pg8::StaticOrder S; S.init(M, 2 * DFF, G, bx);
              pg8::EpiFfnUp E{(bf16*)R2, P->in[I_CONV] + (size_t)l * 3 * DFF, (float*)(P->ws + WS_HALO), (float*)(P->ws + WS_HALO + HALO_ONE), (float*)(P->ws + WS_HALO + 2 * HALO_ONE), (LAS float*)(lds + LDS_XCH)};
              pg8::gemm_phase<pg8::EpiFfnUp, pg8::StaticOrder, true, true>(lds, g, S, E); }
            if (rep_ == 0) { pg8::Gemm g{XB, (const bf16*)(wl + WO_PG), M, D, D, D, D, 0, 0}; pg8::StaticOrder S; S.init(M, D, G, bx);
              pg8::EpiPleGate E{(bf16*)(P->ws + WS_PPLE)};
              pg8::gemm_phase<pg8::EpiPleGate, pg8::StaticOrder, true, true>(lds, g, S, E); }
        }
        SEAM(pb + 7);
        REPEAT(8) if (IN(pb + 8)) {
            PHASE_PTRS
            pg8::Gemm g{(const bf16*)R2, (const bf16*)(wl + WO_DN), M, D, DFF, DFF, DFF, 0, 0}; pg8::StaticOrder S; S.init(M, D, G, bx);
            { pg8::Unit u; for (int i = 0; S.next(i, u); ++i) ffn_fixup_panel(P, l, u.pm); }
            asm volatile("s_waitcnt vmcnt(0)" ::: "memory"); sync_wg();
            pg8::EpiResBf16 E{XB, (const bf16*)(P->ws + WS_PPLE), ALPHA};
            pg8::gemm_phase<pg8::EpiResBf16, pg8::StaticOrder, true, true>(lds, g, S, E);
        }
        SEAM(pb + 8);
        if (IN(pb + 9)) { PHASE_PTRS ln_phase<true>(XB, P->in[I_LNFW] + l * D, P->in[I_LNFB] + l * D, (l == DEPTH - 1) ? nullptr : XB, (l == DEPTH - 1) ? P->out : nullptr); }
        SEAM(pb + 9);
    }
#undef IN
#undef SEAM
}

extern "C" void kernel_launch(void* const* d_in, const int* in_sizes, int n_in, void* d_out, int out_size, void* d_ws, size_t ws_size, hipStream_t stream) {
    static int grid = 0;
    if (grid == 0) {
        if (n_in != 32 || out_size != M * D || ws_size < WS_END) { fprintf(stderr, "kernel_launch: unexpected shapes (n_in %d, out %d, ws %zu)\n", n_in, out_size, ws_size); grid = -1; return; }
        int dev = 0, cus = 0, per_cu = 0;
        if (hipGetDevice(&dev) != hipSuccess || hipDeviceGetAttribute(&cus, hipDeviceAttributeMultiprocessorCount, dev) != hipSuccess) { grid = -1; return; }
        if (hipFuncSetAttribute((const void*)mega, hipFuncAttributeMaxDynamicSharedMemorySize, LDS_BYTES) != hipSuccess) { fprintf(stderr, "kernel_launch: hipFuncSetAttribute failed\n"); grid = -1; return; }
        if (hipOccupancyMaxActiveBlocksPerMultiprocessor(&per_cu, (const void*)mega, NWAVES * 64, LDS_BYTES) != hipSuccess || per_cu < 1) fprintf(stderr, "kernel_launch: occupancy query reports %d\n", per_cu);
        (void)hipGetLastError();
        grid = cus;
    }
    if (grid < 0) return;
    (void)hipMemsetAsync((char*)d_ws + WS_CTL, 0, CTL_ZERO_BYTES, stream);
    Params p{};
    for (int i = 0; i < 32; ++i) p.in[i] = (const float*)d_in[i];
    p.out = (float*)d_out; p.ws = (unsigned char*)d_ws;
#if ONE_LAUNCH
    p.ph_lo = 0; p.ph_hi = NPH;
    hipLaunchKernelGGL(mega, dim3(grid), dim3(NWAVES * 64), LDS_BYTES, stream, p);
#else
    for (int ph = 0; ph < NPH; ++ph) { p.ph_lo = ph; p.ph_hi = ph + 1; hipLaunchKernelGGL(mega, dim3(grid), dim3(NWAVES * 64), LDS_BYTES, stream, p); }
#endif
}
```

```cpp
#include <hip/hip_runtime.h>
#include <cstdio>
#include <cstdint>
#if defined(__HIP_DEVICE_COMPILE__)
#define NOPK __attribute__((target("no-packed-fp32-ops")))
#else
#define NOPK
#endif

typedef float f32x2g __attribute__((ext_vector_type(2)));
__device__ __forceinline__ NOPK void sync_wg() { __builtin_amdgcn_fence(__ATOMIC_RELEASE, "workgroup"); __builtin_amdgcn_s_barrier(); __builtin_amdgcn_fence(__ATOMIC_ACQUIRE, "workgroup"); }
__device__ __forceinline__ NOPK float u2f(unsigned u) { return __builtin_bit_cast(float, u); }
__device__ __forceinline__ NOPK float shfl_(float v, int src) { return __builtin_bit_cast(float, __builtin_amdgcn_ds_bpermute(src << 2, __builtin_bit_cast(int, v))); }
__device__ __forceinline__ NOPK float shfl_xor_(float v, int m) { const int lane_ = __builtin_amdgcn_mbcnt_hi(~0u, __builtin_amdgcn_mbcnt_lo(~0u, 0u)); return shfl_(v, lane_ ^ m); }
namespace pg8 {
#define PG8_LAS __attribute__((address_space(3)))
typedef unsigned short bf16_t;
typedef short bf16x8 __attribute__((ext_vector_type(8)));
typedef float f32x4 __attribute__((ext_vector_type(4)));
typedef float f32x2 __attribute__((ext_vector_type(2)));
typedef unsigned u32x4 __attribute__((ext_vector_type(4)));
typedef unsigned u32x2 __attribute__((ext_vector_type(2)));
constexpr int BM = 256, BK = 64, HALF = 128, HTB = HALF * BK * 2  , STAGE_BYTES = 8 * HTB, NXCD = 8, WGM = 8;

__host__ __device__ __forceinline__ NOPK int lds_byte(int r, int c) { const int st = (r >> 4) * 2 + (c >> 5), rr = r & 15, cc = c & 31, ob = rr * 64 + cc * 2; return st * 1024 + (ob ^ (((ob >> 9) & 1) << 5)); }
__host__ __device__ __forceinline__ NOPK void stage_rc(int b, int& R, int& C) { const int st = b / 1024, sb = b % 1024, swz = sb ^ (((sb >> 9) & 1) << 5); R = (st >> 1) * 16 + swz / 64; C = (st & 1) * 32 + (swz % 64) / 2; }
__host__ __device__ __forceinline__ NOPK int perm32(int rho) { const int n = rho >> 4, i = rho & 15; return 8 * (i >> 2) + 4 * n + (i & 3); }

struct Unit { int pm, pn; };
struct Gemm { const bf16_t* A; const bf16_t* Bt; int M, N, K, lda, ldb, a_div, a_coloff; };
__device__ __forceinline__ NOPK size_t a_unit_off(const Gemm& g, const Unit& u) { return g.a_div ? (size_t)((u.pn / g.a_div) * g.a_coloff) * 2u : (size_t)0; }

struct StaticOrder {
    int nM, nN, nwg, G, c;
    __host__ __device__ __forceinline__ NOPK void init(int M, int N, int G_, int c_) { nM = M / BM; nN = N / BM; nwg = nM * nN; G = G_; c = c_; }
    __host__ __device__ __forceinline__ NOPK bool next(int i, Unit& u) const {
        const long L = (long)i * G + c; if (L >= nwg) return false;
        int wgid = (int)L; { const int q = nwg / NXCD, r = nwg % NXCD, xcd = wgid % NXCD, off = wgid / NXCD; wgid = (xcd < r ? xcd * (q + 1) : r * (q + 1) + (xcd - r) * q) + off; }
        const int nig = WGM * nN, gid = wgid / nig, fm = gid * WGM, gsz = (nM - fm) < WGM ? (nM - fm) : WGM;
        u.pm = fm + ((wgid % nig) % gsz); u.pn = (wgid % nig) / gsz; return true;
    }
    __device__ __forceinline__ NOPK void a_ready(const Unit&) const {}
    __device__ __forceinline__ NOPK void done(const Unit&) const {}
};

typedef __bf16 bf16x2_t __attribute__((ext_vector_type(2)));
__device__ __forceinline__ NOPK unsigned cvt_pk_bf16(float lo, float hi) { const f32x2 v = {lo, hi}; const bf16x2_t b = __builtin_convertvector(v, bf16x2_t); return __builtin_bit_cast(unsigned, b); }
__device__ __forceinline__ NOPK float bf_lo(unsigned w) { return u2f(w << 16); }
__device__ __forceinline__ NOPK float bf_hi(unsigned w) { return u2f(w & 0xffff0000u); }
__device__ __forceinline__ NOPK float sigmoid_f(float x) { return __builtin_amdgcn_rcpf(1.0f + __builtin_amdgcn_exp2f(-1.44269504089f * x)); }

template <class Epi, class Sched, bool ALIGN_EPI = false, bool SP2 = false>
__device__ __forceinline__ NOPK void gemm_phase(PG8_LAS unsigned char* lds, const Gemm g, const Sched& S, const Epi& E) {
    int tid_o = threadIdx.x; asm volatile("" : "+v"(tid_o));
    const int tid = tid_o, wid = __builtin_amdgcn_readfirstlane(tid >> 6), lane = tid & 63, wr = wid >> 2, wc = wid & 3, fr = lane & 15, fq = lane >> 4;
    const int K = g.K, nt = K / BK;
    unsigned voffA[2], voffB[2];
#pragma unroll
    for (int i = 0; i < 2; ++i) { int R, C; stage_rc(tid * 16 + i * 8192, R, C); const int Rb = Epi::PERM ? ((R & ~31) + perm32(R & 31)) : R;
        voffA[i] = (unsigned)(R * g.lda + C) * 2u; voffB[i] = (unsigned)(Rb * g.ldb + C) * 2u; }
    const size_t kstep = (size_t)(BK * 2);
    const size_t hstepA = (size_t)HALF * g.lda * 2, hstepB = (size_t)HALF * g.ldb * 2;
    const size_t tstepA = 2 * hstepA, tstepB = 2 * hstepB;
    const unsigned ldsw = (unsigned)wid * 1024u;
    const int aoff = lds_byte(wr * 64 + fr, fq * 8), boff = lds_byte(wc * 32 + fr, fq * 8);
#define PG8_SA(b, h) (((b) * 2 + (h)) * HTB)
#define PG8_SB(b, h) ((4 + (b) * 2 + (h)) * HTB)
#define PG8_STAGE(bufoff, gbase, voff) do { _Pragma("unroll") for (int _i = 0; _i < 2; ++_i) \
        __builtin_amdgcn_global_load_lds((const unsigned*)((const char*)(gbase) + (voff)[_i]), (PG8_LAS unsigned*)(lds + (bufoff) + ldsw + _i * 8192), 16, 0, 0); } while (0)
#define PG8_LDA(dst, b, h) do { _Pragma("unroll") for (int m = 0; m < 4; ++m) _Pragma("unroll") for (int k = 0; k < 2; ++k) dst[m][k] = *(const PG8_LAS bf16x8*)(lds + PG8_SA(b, h) + aoff + m * 2048 + k * 1024); } while (0)
#define PG8_LDB(dst, b, h) do { _Pragma("unroll") for (int n = 0; n < 2; ++n) _Pragma("unroll") for (int k = 0; k < 2; ++k) dst[n][k] = *(const PG8_LAS bf16x8*)(lds + PG8_SB(b, h) + boff + n * 2048 + k * 1024); } while (0)
#define PG8_MMA(ai, bj, At, Bt) do { __builtin_amdgcn_s_setprio(1); _Pragma("unroll") for (int m = 0; m < 4; ++m) _Pragma("unroll") for (int n = 0; n < 2; ++n) _Pragma("unroll") for (int k = 0; k < 2; ++k) \
        acc[ai][bj][m][n] = __builtin_amdgcn_mfma_f32_16x16x32_bf16(Bt[n][k], At[m][k], acc[ai][bj][m][n], 0, 0, 0); __builtin_amdgcn_s_setprio(0); } while (0)
#define PG8_WAIT_V(n) asm volatile("s_waitcnt vmcnt(" #n ")" ::: "memory")
#define PG8_WAIT_L(n) asm volatile("s_waitcnt lgkmcnt(" #n ")" ::: "memory")
#define PG8_BAR __builtin_amdgcn_s_barrier()
#define PG8_SCHED __builtin_amdgcn_sched_barrier(0)
    Unit cur, nxt; int ui = 0;
    if (!S.next(0, cur)) return;
    f32x4 acc[2][2][4][2];
#pragma unroll
    for (int a = 0; a < 2; ++a)
#pragma unroll
        for (int b = 0; b < 2; ++b)
#pragma unroll
            for (int m = 0; m < 4; ++m)
#pragma unroll
                for (int n = 0; n < 2; ++n) acc[a][b][m][n] = (f32x4){0.f, 0.f, 0.f, 0.f};
    bf16x8 At[4][2], B0[2][2], B1[2][2];
    const char* cA = (const char*)g.A + (size_t)cur.pm * tstepA + a_unit_off(g, cur); const char* cB = (const char*)g.Bt + (size_t)cur.pn * tstepB;
    S.a_ready(cur);
    if constexpr (SP2) {
        PG8_STAGE(PG8_SB(0, 0), cB, voffB); PG8_STAGE(PG8_SB(0, 1), cB + hstepB, voffB); PG8_STAGE(PG8_SA(0, 0), cA, voffA); PG8_STAGE(PG8_SA(0, 1), cA + hstepA, voffA);
        if (wr == 1) PG8_BAR;
        PG8_WAIT_V(2); PG8_BAR;
        PG8_STAGE(PG8_SB(1, 0), cB + kstep, voffB); PG8_STAGE(PG8_SA(1, 0), cA + kstep, voffA); PG8_STAGE(PG8_SB(1, 1), cB + hstepB + kstep, voffB);
        PG8_WAIT_V(6); PG8_BAR;
    } else {
        PG8_STAGE(PG8_SB(0, 0), cB, voffB); PG8_STAGE(PG8_SA(0, 0), cA, voffA); PG8_STAGE(PG8_SB(0, 1), cB + hstepB, voffB); PG8_STAGE(PG8_SA(0, 1), cA + hstepA, voffA);
        if (wr == 1) PG8_BAR;
        PG8_WAIT_V(4); PG8_BAR;
        PG8_STAGE(PG8_SB(1, 0), cB + kstep, voffB); PG8_STAGE(PG8_SA(1, 0), cA + kstep, voffA); PG8_STAGE(PG8_SB(1, 1), cB + hstepB + kstep, voffB);
        PG8_WAIT_V(6); PG8_BAR;
    }
    for (;;) {
        const bool has_next = S.next(ui + 1, nxt);
        const char* nA = has_next ? (const char*)g.A + (size_t)nxt.pm * tstepA + a_unit_off(g, nxt) : cA; const char* nB = has_next ? (const char*)g.Bt + (size_t)nxt.pn * tstepB : cB;
        for (int t = 0; t < nt; t += 2) {
            const bool last = (t == nt - 2);
            const char* a1 = cA + (size_t)(t + 1) * kstep;
            const char* a2 = last ? nA : cA + (size_t)(t + 2) * kstep; const char* b2 = last ? nB : cB + (size_t)(t + 2) * kstep;
            const char* a3 = a2 + kstep; const char* b3 = b2 + kstep;
            if (last && has_next) S.a_ready(nxt);
            if constexpr (SP2) {
            PG8_LDB(B0, 0, 0); PG8_LDB(B1, 0, 1); PG8_SCHED; PG8_LDA(At, 0, 0); PG8_STAGE(PG8_SA(1, 1), a1 + hstepA, voffA);
            PG8_WAIT_V(8); PG8_WAIT_L(0); PG8_BAR; PG8_MMA(0, 0, At, B0); PG8_MMA(0, 1, At, B1); PG8_BAR; PG8_SCHED;
            PG8_LDA(At, 0, 1); PG8_STAGE(PG8_SB(0, 0), b2, voffB); PG8_STAGE(PG8_SB(0, 1), b2 + hstepB, voffB); PG8_STAGE(PG8_SA(0, 0), a2, voffA);
            PG8_WAIT_V(8); PG8_WAIT_L(0); PG8_BAR; PG8_MMA(1, 0, At, B0); PG8_MMA(1, 1, At, B1); PG8_BAR; PG8_SCHED;
            PG8_LDB(B0, 1, 0); PG8_LDB(B1, 1, 1); PG8_SCHED; PG8_LDA(At, 1, 0); PG8_STAGE(PG8_SA(0, 1), a2 + hstepA, voffA);
            PG8_WAIT_V(8); PG8_WAIT_L(0); PG8_BAR; PG8_MMA(0, 0, At, B0); PG8_MMA(0, 1, At, B1); PG8_BAR; PG8_SCHED;
            PG8_LDA(At, 1, 1); PG8_STAGE(PG8_SB(1, 0), b3, voffB); PG8_STAGE(PG8_SB(1, 1), b3 + hstepB, voffB); PG8_STAGE(PG8_SA(1, 0), a3, voffA);
            PG8_WAIT_V(8); PG8_WAIT_L(0); PG8_BAR; PG8_MMA(1, 0, At, B0); PG8_MMA(1, 1, At, B1); PG8_BAR; PG8_SCHED;
            } else {
            PG8_LDB(B0, 0, 0); PG8_SCHED; PG8_LDA(At, 0, 0); PG8_STAGE(PG8_SA(1, 1), a1 + hstepA, voffA);
            PG8_WAIT_L(8); PG8_BAR; PG8_WAIT_L(0); PG8_MMA(0, 0, At, B0); PG8_BAR; PG8_SCHED;
            PG8_LDB(B1, 0, 1); PG8_STAGE(PG8_SB(0, 0), b2, voffB);
            PG8_BAR; PG8_WAIT_L(0); PG8_MMA(0, 1, At, B1); PG8_BAR;
            PG8_LDA(At, 0, 1); PG8_STAGE(PG8_SA(0, 0), a2, voffA);
            PG8_BAR; PG8_WAIT_L(0); PG8_MMA(1, 0, At, B0); PG8_BAR; PG8_SCHED;
            PG8_STAGE(PG8_SB(0, 1), b2 + hstepB, voffB);
            PG8_WAIT_V(6); PG8_BAR; PG8_MMA(1, 1, At, B1); PG8_BAR;
            PG8_LDB(B0, 1, 0); PG8_SCHED; PG8_LDA(At, 1, 0); PG8_STAGE(PG8_SA(0, 1), a2 + hstepA, voffA);
            PG8_WAIT_L(8); PG8_BAR; PG8_WAIT_L(0); PG8_MMA(0, 0, At, B0); PG8_BAR; PG8_SCHED;
            PG8_LDB(B1, 1, 1); PG8_STAGE(PG8_SB(1, 0), b3, voffB);
            PG8_BAR; PG8_WAIT_L(0); PG8_MMA(0, 1, At, B1); PG8_BAR;
            PG8_LDA(At, 1, 1); PG8_STAGE(PG8_SA(1, 0), a3, voffA);
            PG8_BAR; PG8_WAIT_L(0); PG8_MMA(1, 0, At, B0); PG8_BAR; PG8_SCHED;
            PG8_STAGE(PG8_SB(1, 1), b3 + hstepB, voffB);
            PG8_WAIT_V(6); PG8_BAR; PG8_MMA(1, 1, At, B1); PG8_BAR;
            }
        }
        if constexpr (ALIGN_EPI) { if (wr == 0) PG8_BAR; }
        if constexpr (!Epi::AFTER_DRAIN) { E(acc, cur, wr, wc, fr, fq); S.done(cur); }
        if (!has_next) break;
#pragma unroll
        for (int a = 0; a < 2; ++a)
#pragma unroll
            for (int b = 0; b < 2; ++b)
#pragma unroll
                for (int m = 0; m < 4; ++m)
#pragma unroll
                    for (int n = 0; n < 2; ++n) acc[a][b][m][n] = (f32x4){0.f, 0.f, 0.f, 0.f};
        cur = nxt; cA = nA; cB = nB; ++ui;
        if constexpr (ALIGN_EPI) { if (wr == 1) PG8_BAR; }
    }
    PG8_WAIT_V(0);
    if constexpr (!ALIGN_EPI) { if (wr == 0) PG8_BAR; }
    PG8_BAR;
    if constexpr (Epi::AFTER_DRAIN) { E.fused(acc, cur, wr, wc, fr, fq, lds, wid, lane); S.done(cur); }
#undef PG8_SA
#undef PG8_SB
#undef PG8_STAGE
#undef PG8_LDA
#undef PG8_LDB
#undef PG8_MMA
#undef PG8_WAIT_V
#undef PG8_WAIT_L
#undef PG8_BAR
#undef PG8_SCHED
}


struct EpiStoreBf16 {
    static constexpr bool PERM = true, AFTER_DRAIN = false;
    bf16_t* O; int ldc;
    __device__ __forceinline__ NOPK void operator()(const f32x4 (&acc)[2][2][4][2], const Unit& u, int wr, int wc, int fr, int fq) const {
        const int row0 = u.pm * BM + wr * 64 + fr, col0 = u.pn * BM + wc * 32 + 8 * fq;
#pragma unroll
        for (int ai = 0; ai < 2; ++ai)
#pragma unroll
            for (int m = 0; m < 4; ++m) { bf16_t* rowp = O + (size_t)(row0 + ai * HALF + m * 16) * ldc + col0;
#pragma unroll
                for (int bj = 0; bj < 2; ++bj) { const f32x4 v0 = acc[ai][bj][m][0], v1 = acc[ai][bj][m][1];
                    u32x4 w; w.x = cvt_pk_bf16(v0[0], v0[1]); w.y = cvt_pk_bf16(v0[2], v0[3]); w.z = cvt_pk_bf16(v1[0], v1[1]); w.w = cvt_pk_bf16(v1[2], v1[3]);
                    *(u32x4*)(rowp + bj * HALF) = w; } }
    }
};
struct EpiPleGate {
    static constexpr bool PERM = true, AFTER_DRAIN = false;
    bf16_t* PP;
    __device__ __forceinline__ NOPK void operator()(const f32x4 (&acc)[2][2][4][2], const Unit& u, int wr, int wc, int fr, int fq) const {
        const int row0 = u.pm * BM + wr * 64 + fr, col0 = u.pn * BM + wc * 32 + 8 * fq;
        u32x4 pp[2][4][2];
#pragma unroll
        for (int ai = 0; ai < 2; ++ai)
#pragma unroll
            for (int m = 0; m < 4; ++m) { const bf16_t* rowp = PP + (size_t)(row0 + ai * HALF + m * 16) * 1024 + col0;
#pragma unroll
                for (int bj = 0; bj < 2; ++bj) pp[ai][m][bj] = *(const u32x4*)(rowp + bj * HALF); }
#pragma unroll
        for (int ai = 0; ai < 2; ++ai)
#pragma unroll
            for (int m = 0; m < 4; ++m) { bf16_t* rowp = PP + (size_t)(row0 + ai * HALF + m * 16) * 1024 + col0;
#pragma unroll
                for (int bj = 0; bj < 2; ++bj) { const f32x4 v0 = acc[ai][bj][m][0], v1 = acc[ai][bj][m][1];
                    const u32x4 p = pp[ai][m][bj];
                    u32x4 w;
                    w.x = cvt_pk_bf16(sigmoid_f(v0[0]) * bf_lo(p.x), sigmoid_f(v0[1]) * bf_hi(p.x));
                    w.y = cvt_pk_bf16(sigmoid_f(v0[2]) * bf_lo(p.y), sigmoid_f(v0[3]) * bf_hi(p.y));
                    w.z = cvt_pk_bf16(sigmoid_f(v1[0]) * bf_lo(p.z), sigmoid_f(v1[1]) * bf_hi(p.z));
                    w.w = cvt_pk_bf16(sigmoid_f(v1[2]) * bf_lo(p.w), sigmoid_f(v1[3]) * bf_hi(p.w));
                    *(u32x4*)(rowp + bj * HALF) = w; } }
    }
};
struct EpiMerge {
    static constexpr bool PERM = false, AFTER_DRAIN = false;
    const bf16_t* P; bf16_t* MG;
    __device__ __forceinline__ NOPK void operator()(const f32x4 (&acc)[2][2][4][2], const Unit& u, int wr, int wc, int fr, int fq) const {
        const int row0 = u.pm * BM + wr * 64 + fr, oc = u.pn * 64 + wc * 16 + fq * 4;
        u32x2 pv[2][4][4];
#pragma unroll
        for (int ai = 0; ai < 2; ++ai)
#pragma unroll
            for (int m = 0; m < 4; ++m) { const bf16_t* prow = P + (size_t)(row0 + ai * HALF + m * 16) * 4096 + oc;
#pragma unroll
                for (int b = 0; b < 4; ++b) pv[ai][m][b] = *(const u32x2*)(prow + b * 1024); }
#pragma unroll
        for (int ai = 0; ai < 2; ++ai)
#pragma unroll
            for (int m = 0; m < 4; ++m) { const size_t row = (size_t)(row0 + ai * HALF + m * 16);
                f32x4 s = (f32x4){0.f, 0.f, 0.f, 0.f};
#pragma unroll
                for (int b = 0; b < 4; ++b) { const u32x2 p = pv[ai][m][b]; const f32x4 g = acc[ai][b >> 1][m][b & 1];
                    s[0] += sigmoid_f(g[0]) * bf_lo(p.x); s[1] += sigmoid_f(g[1]) * bf_hi(p.x); s[2] += sigmoid_f(g[2]) * bf_lo(p.y); s[3] += sigmoid_f(g[3]) * bf_hi(p.y); }
                u32x2 w; w.x = cvt_pk_bf16(s[0], s[1]); w.y = cvt_pk_bf16(s[2], s[3]);
                *(u32x2*)(MG + row * 1024 + oc) = w; }
    }
};
struct EpiResF32 {
    static constexpr bool PERM = false, AFTER_DRAIN = false;
    const bf16_t* X; const bf16_t* PLE; float* V; float alpha;
    __device__ __forceinline__ NOPK void operator()(const f32x4 (&acc)[2][2][4][2], const Unit& u, int wr, int wc, int fr, int fq) const {
        const int row0 = u.pm * BM + wr * 64 + fr, col0 = u.pn * BM + wc * 32 + 4 * fq;
#pragma unroll
        for (int ai = 0; ai < 2; ++ai) {
            u32x2 xv[4][2][2], pv[4][2][2];
#pragma unroll
            for (int m = 0; m < 4; ++m) { const size_t off = (size_t)(row0 + ai * HALF + m * 16) * 1024 + col0;
#pragma unroll
                for (int bj = 0; bj < 2; ++bj)
#pragma unroll
                    for (int n = 0; n < 2; ++n) { const size_t o = off + bj * HALF + n * 16; xv[m][bj][n] = *(const u32x2*)(X + o); if (PLE) pv[m][bj][n] = *(const u32x2*)(PLE + o); else pv[m][bj][n] = (u32x2){0u, 0u}; } }
#pragma unroll
            for (int m = 0; m < 4; ++m) { const size_t off = (size_t)(row0 + ai * HALF + m * 16) * 1024 + col0;
#pragma unroll
                for (int bj = 0; bj < 2; ++bj)
#pragma unroll
                    for (int n = 0; n < 2; ++n) { const size_t o = off + bj * HALF + n * 16; const u32x2 x2 = xv[m][bj][n], p2 = pv[m][bj][n];
                        f32x4 r = acc[ai][bj][m][n];
                        r[0] += alpha * bf_lo(x2.x) + bf_lo(p2.x); r[1] += alpha * bf_hi(x2.x) + bf_hi(p2.x); r[2] += alpha * bf_lo(x2.y) + bf_lo(p2.y); r[3] += alpha * bf_hi(x2.y) + bf_hi(p2.y);
                        *(f32x4*)(V + o) = r; } } }
    }
};
struct EpiResBf16 {
    static constexpr bool PERM = true, AFTER_DRAIN = false;
    bf16_t* X; const bf16_t* PLE; float alpha;
    __device__ __forceinline__ NOPK void operator()(const f32x4 (&acc)[2][2][4][2], const Unit& u, int wr, int wc, int fr, int fq) const {
        const int row0 = u.pm * BM + wr * 64 + fr, col0 = u.pn * BM + wc * 32 + 8 * fq;
#pragma unroll
        for (int ai = 0; ai < 2; ++ai) {
            u32x4 xv[4][2], pv[4][2];
#pragma unroll
            for (int m = 0; m < 4; ++m) { const size_t off = (size_t)(row0 + ai * HALF + m * 16) * 1024 + col0;
#pragma unroll
                for (int bj = 0; bj < 2; ++bj) { xv[m][bj] = *(const u32x4*)(X + off + bj * HALF); if (PLE) pv[m][bj] = *(const u32x4*)(PLE + off + bj * HALF); else pv[m][bj] = (u32x4){0u, 0u, 0u, 0u}; } }
#pragma unroll
            for (int m = 0; m < 4; ++m) { const size_t off = (size_t)(row0 + ai * HALF + m * 16) * 1024 + col0;
#pragma unroll
                for (int bj = 0; bj < 2; ++bj) { const f32x4 v0 = acc[ai][bj][m][0], v1 = acc[ai][bj][m][1]; const u32x4 x4 = xv[m][bj], p4 = pv[m][bj];
                    u32x4 w;
                    w.x = cvt_pk_bf16(v0[0] + alpha * bf_lo(x4.x) + bf_lo(p4.x), v0[1] + alpha * bf_hi(x4.x) + bf_hi(p4.x));
                    w.y = cvt_pk_bf16(v0[2] + alpha * bf_lo(x4.y) + bf_lo(p4.y), v0[3] + alpha * bf_hi(x4.y) + bf_hi(p4.y));
                    w.z = cvt_pk_bf16(v1[0] + alpha * bf_lo(x4.z) + bf_lo(p4.z), v1[1] + alpha * bf_hi(x4.z) + bf_hi(p4.z));
                    w.w = cvt_pk_bf16(v1[2] + alpha * bf_lo(x4.w) + bf_lo(p4.w), v1[3] + alpha * bf_hi(x4.w) + bf_hi(p4.w));
                    *(u32x4*)(X + off + bj * HALF) = w; } } }
    }
};
__device__ __forceinline__ NOPK float gelu_tanh_f(float x) {
    const float inner = x * (0.7978845608f + 0.0356774081f * x * x);
    return x * __builtin_amdgcn_rcpf(1.0f + __builtin_amdgcn_exp2f(-2.885390082f * inner));
}
struct EpiFfnUp {
    static constexpr bool PERM = false, AFTER_DRAIN = false;
    bf16_t* ACT; const float* conv; float* uhead; float* vhead; float* utail; PG8_LAS float* xch;
    __device__ __forceinline__ NOPK void operator()(const f32x4 (&acc)[2][2][4][2], const Unit& u, int wr, int wc, int fr, int fq) const {
        const int lane = threadIdx.x & 63;
        const int cc0 = wc * 32 + 4 * fq, colg = u.pn * 128 + cc0;
        f32x4 c0[2], c1[2], c2[2];
#pragma unroll
        for (int n = 0; n < 2; ++n) { c0[n] = *(const f32x4*)(conv + colg + 16 * n); c1[n] = *(const f32x4*)(conv + 2816 + colg + 16 * n); c2[n] = *(const f32x4*)(conv + 2 * 2816 + colg + 16 * n); }
        if (fr >= 14) {
#pragma unroll
            for (int ai = 0; ai < 2; ++ai)
#pragma unroll
                for (int n = 0; n < 2; ++n) *(PG8_LAS f32x4*)(xch + ((2 * ai + wr) * 2 + (fr - 14)) * 128 + cc0 + 16 * n) = acc[ai][0][3][n];
            if (wr == 1) {
#pragma unroll
                for (int n = 0; n < 2; ++n) *(f32x4*)(utail + ((size_t)u.pm * 2 + (fr - 14)) * 2816 + colg + 16 * n) = acc[1][0][3][n];
            }
        }
        if (wr == 0 && fr < 2) {
#pragma unroll
            for (int n = 0; n < 2; ++n) { *(f32x4*)(uhead + ((size_t)u.pm * 2 + fr) * 2816 + colg + 16 * n) = acc[0][0][0][n];
                                          *(f32x4*)(vhead + ((size_t)u.pm * 2 + fr) * 2816 + colg + 16 * n) = acc[0][1][0][n]; }
        }
        asm volatile("s_waitcnt lgkmcnt(0)" ::: "memory"); __builtin_amdgcn_s_barrier(); asm volatile("" ::: "memory");
        const int src1 = (lane & 48) | ((fr + 15) & 15), src2 = (lane & 48) | ((fr + 14) & 15);
#pragma unroll
        for (int ai = 0; ai < 2; ++ai)
#pragma unroll
            for (int m = 0; m < 4; ++m) { const size_t row = (size_t)(u.pm * BM + ai * HALF + wr * 64 + m * 16 + fr);
#pragma unroll
                for (int n = 0; n < 2; ++n) {
                    const f32x4 cur = acc[ai][0][m][n];
                    f32x4 e1, e2, r1, r2;
                    if (m > 0) { const f32x4 pg = acc[ai][0][m > 0 ? m - 1 : 0][n];
#pragma unroll
                        for (int j = 0; j < 4; ++j) { e1[j] = shfl_(pg[j], src1); e2[j] = shfl_(pg[j], src2); } }
                    else { const int rb = 2 * ai + wr;
                        if (rb > 0) { const f32x4 x62 = *(const PG8_LAS f32x4*)(xch + ((rb - 1) * 2 + 0) * 128 + cc0 + 16 * n), x63 = *(const PG8_LAS f32x4*)(xch + ((rb - 1) * 2 + 1) * 128 + cc0 + 16 * n);
                            e1 = x63; e2 = (fr == 0) ? x62 : x63; }
                        else { e1 = (f32x4){0.f, 0.f, 0.f, 0.f}; e2 = e1; } }
#pragma unroll
                    for (int j = 0; j < 4; ++j) { r1[j] = shfl_(cur[j], src1); r2[j] = shfl_(cur[j], src2); }
                    const f32x4 p1 = (fr >= 1) ? r1 : e1, p2 = (fr >= 2) ? r2 : e2;
                    const f32x4 cv = c2[n] * cur + c1[n] * p1 + c0[n] * p2;
                    const f32x4 vv = acc[ai][1][m][n];
                    u32x2 w; w.x = cvt_pk_bf16(gelu_tanh_f(cv[0]) * vv[0], gelu_tanh_f(cv[1]) * vv[1]); w.y = cvt_pk_bf16(gelu_tanh_f(cv[2]) * vv[2], gelu_tanh_f(cv[3]) * vv[3]);
                    *(u32x2*)(ACT + row * 2816 + colg + 16 * n) = w; } }
    }
};
}

constexpr int D = 1024, BATCH = 16, SEQ = 2048, DEPTH = 2, M = BATCH * SEQ;
constexpr int NMIX = 3600, NMIXP = 3840, NMIXG = 3584  , NIN = 7696, DFF = 2816, PLE = 256, NCHUNK = SEQ / 64;
constexpr float ALPHA = 1.41421356237f;
constexpr float LN_EPS = 1e-5f;
constexpr int NWAVES = 8;
#ifndef ONE_LAUNCH
#define ONE_LAUNCH 1
#endif

constexpr size_t MiB = 1u << 20;
constexpr size_t WS_CTL = 0, CTL_ZERO_BYTES = 1 * MiB;
constexpr size_t WS_W = 1 * MiB, W_LAYER = 39 * MiB;
constexpr size_t WO_IN = 0, WO_G = 15 * MiB / 2, WO_B = 31 * MiB / 2, WO_MIX = 35 * MiB / 2, WO_UP = 39 * MiB / 2, WO_DN = 61 * MiB / 2, WO_PG = 36 * MiB, WO_PP = 38 * MiB;
constexpr size_t WS_PB = 79 * MiB;
constexpr size_t WS_XB = 111 * MiB;
constexpr size_t WS_R2 = 175 * MiB;
constexpr size_t R2_PPLE = 176 * MiB;
constexpr size_t WS_ROPE = 431 * MiB;
constexpr size_t WS_HALO = 432 * MiB, HALO_ONE = (size_t)128 * 2 * DFF * 4;
constexpr size_t WS_RST = 442 * MiB;
constexpr size_t WS_PPLE = 444 * MiB;
constexpr size_t WS_END = 508 * MiB;
static_assert(WS_HALO + 3 * HALO_ONE <= WS_END && WS_R2 + 256 * MiB <= WS_ROPE, "ws map");
constexpr int CW_BAR = 4096;

constexpr int LDS_BYTES = 163840;
constexpr int LDS_XCH = 131072;
constexpr int LDS_MISC = 163840 - 256;

#define LAS __attribute__((address_space(3)))
typedef unsigned short bf16;
typedef float f32x4 __attribute__((ext_vector_type(4)));
typedef unsigned v4u __attribute__((ext_vector_type(4)));
typedef unsigned v2u __attribute__((ext_vector_type(2)));
#define LDS_WAIT() asm volatile("s_waitcnt lgkmcnt(0)" ::: "memory")
using pg8::cvt_pk_bf16; using pg8::bf_lo; using pg8::bf_hi; using pg8::sigmoid_f;

#define XB_TMO      128
#define XB_XCNT(j)  (256  + 64 * (j))
#define XB_XSUB(j)  (1280 + 64 * (j))
#define XB_XGEN(j)  (2304 + 64 * (j))
#define XB_TOP      3328
#define XB_TOPGEN   3392
#define XCD_BAR_WORDS 3456
#define XB_SPIN_CAP (1u << 18)
__device__ __forceinline__ NOPK unsigned xb_ld(unsigned* p)              { return __hip_atomic_load(p, __ATOMIC_RELAXED, __HIP_MEMORY_SCOPE_AGENT); }
__device__ __forceinline__ NOPK unsigned xb_add(unsigned* p, unsigned v) { return __hip_atomic_fetch_add(p, v, __ATOMIC_RELAXED, __HIP_MEMORY_SCOPE_AGENT); }
__device__ __forceinline__ NOPK unsigned xb_xcc_id() { return (unsigned)__builtin_amdgcn_s_getreg((3 << 11) | 20) & 0xFu; }
#define XB_SPIN(cond, bar) do { unsigned _sp = 0; while (cond) { __builtin_amdgcn_s_sleep(1); \
    if ((++_sp & 255u) == 0u) { if (xb_ld(&(bar)[XB_TMO])) break; if (_sp > XB_SPIN_CAP) { (void)xb_add(&(bar)[XB_TMO], 1u); break; } } } } while (0)
struct XcdBarrier { unsigned* bar; unsigned x; volatile LAS unsigned* st; };
__device__ __forceinline__ NOPK XcdBarrier xcd_barrier_post(unsigned* bar, volatile LAS unsigned* st) {
    XcdBarrier b; b.bar = bar; b.x = xb_xcc_id(); b.st = st;
    if (threadIdx.x == 0) (void)xb_add(&bar[XB_XCNT(b.x)], 1u);
    return b;
}
__device__ __forceinline__ NOPK void xcd_barrier_complete(unsigned* bar, unsigned x, unsigned& nloc, unsigned& nx) {
    const unsigned G = gridDim.x * gridDim.y * gridDim.z;
    unsigned sum, cnt, mine, sp = 0u;
    for (;;) {
        sum = 0u; cnt = 0u; mine = 0u;
#pragma unroll
        for (unsigned j = 0; j < 16; ++j) { const unsigned c = xb_ld(&bar[XB_XCNT(j)]); sum += c; cnt += (c > 0u) ? 1u : 0u; mine = (j == x) ? c : mine; }
        if (sum == G) break;
        __builtin_amdgcn_s_sleep(1);
        if ((++sp & 255u) == 0u) { if (xb_ld(&bar[XB_TMO])) break; if (sp > XB_SPIN_CAP) { (void)xb_add(&bar[XB_TMO], 1u); break; } }
    }
    nloc = mine > 0u ? mine : 1u; nx = cnt > 0u ? cnt : 1u;
}
__device__ __forceinline__ NOPK void xcd_barrier(const XcdBarrier& b) {
    asm volatile("s_waitcnt vmcnt(0)" ::: "memory");
    sync_wg();
    if (threadIdx.x == 0) {
        unsigned* bar = b.bar;
        __builtin_amdgcn_s_waitcnt(0);
        unsigned nloc = b.st[0], nx = b.st[1];
        if (nloc == 0u) { xcd_barrier_complete(bar, b.x, nloc, nx); b.st[0] = nloc; b.st[1] = nx; }
        const unsigned old = xb_add(&bar[XB_XSUB(b.x)], 1u);
        const unsigned gen = old / nloc;
        if (old + 1u == (gen + 1u) * nloc) {
            __builtin_amdgcn_fence(__ATOMIC_RELEASE, "agent");
            asm volatile("s_waitcnt vmcnt(0)" ::: "memory");
            const unsigned og = xb_add(&bar[XB_TOP], 1u);
            const unsigned tg = og / nx;
            if (og + 1u == (tg + 1u) * nx) xb_add(&bar[XB_TOPGEN], 1u);
            else XB_SPIN(xb_ld(&bar[XB_TOPGEN]) == tg, bar);
            __builtin_amdgcn_fence(__ATOMIC_ACQUIRE, "agent");
            xb_add(&bar[XB_XGEN(b.x)], 1u);
            asm volatile("s_waitcnt vmcnt(0)" ::: "memory");
        } else {
            XB_SPIN(xb_ld(&bar[XB_XGEN(b.x)]) == gen, bar);
            __builtin_amdgcn_fence(__ATOMIC_ACQUIRE, "agent");
            asm volatile("s_waitcnt vmcnt(0)" ::: "memory");
        }
    }
    sync_wg();
}

struct Params {
    const float* in[32];
    float* out; unsigned char* ws;
    int ph_lo, ph_hi;
};
enum { I_X = 0, I_P, I_LNINW, I_LNINB, I_WIN, I_MU, I_W0, I_W2, I_A0, I_A2, I_G2, I_KK, I_KA, I_RK, I_RLNW, I_RLNB, I_GLAW2, I_GLAB, I_GLANW, I_HLB, I_HNW,
       I_WBR, I_WMIX, I_LNMW, I_LNMB, I_WUP, I_CONV, I_WDN, I_WPG, I_WPP, I_LNFW, I_LNFB };

typedef const __attribute__((address_space(4))) Params* KP;
__device__ __forceinline__ NOPK KP kparams() { KP p = (KP)__builtin_amdgcn_kernarg_segment_ptr(); asm volatile("" : "+s"(p)); return p; }
__device__ __forceinline__ NOPK float wave_sum(float v) {
#pragma unroll
    for (int o = 1; o < 64; o <<= 1) v += shfl_xor_(v, o);
    return v;
}
__device__ __forceinline__ NOPK int opaque_tid() { int t = threadIdx.x; asm volatile("" : "+v"(t)); return t; }
__device__ __forceinline__ NOPK float red8(float v) { v += shfl_xor_(v, 1); v += shfl_xor_(v, 2); v += shfl_xor_(v, 4); return v; }

__constant__ double ROPE_THETA[16] = {1.0, 0.5411695265464637, 0.2928644564625237, 0.15848931924611134, 0.08576958985908942, 0.046415888336127795, 0.025118864315095794, 0.013593563908785255, 0.007356422544596414, 0.003981071705534973, 0.0021544346900318843, 0.0011659144011798323, 0.000630957344480193, 0.0003414548873833601, 0.00018478497974222906, 0.0001};
__device__ __forceinline__ NOPK int map_row(int mode, int c) {
    if (mode == 1) { const int b = c >> 10, of = c & 1023, pn = of >> 6, oc = of & 63; return 256 * pn + 128 * (b >> 1) + 32 * (oc >> 4) + 16 * (b & 1) + (oc & 15); }
    if (mode == 2) { return c < DFF ? 256 * (c >> 7) + (c & 127) : 256 * ((c - DFF) >> 7) + 128 + ((c - DFF) & 127); }
    return c;
}
__device__ __forceinline__ NOPK void cvt_item(const float* W, int K, int srcld, int c0, int cnt, bf16* dst, int mode, LAS float* scr, int item, int lane) {
    const int nblk = (cnt + 31) / 32, kb = item / nblk, nb = item % nblk, k0 = 64 * kb, n0 = 32 * nb;
    const bool okr = (n0 + (lane & 31)) < cnt;
    float xin[32];
#pragma unroll
    for (int i = 0; i < 32; ++i) { const int kk = 2 * i + (lane >> 5); xin[i] = okr ? W[(size_t)(k0 + kk) * srcld + c0 + n0 + (lane & 31)] : 0.f; }
#pragma unroll
    for (int i = 0; i < 32; ++i) { const int kk = 2 * i + (lane >> 5); scr[kk * 33 + (lane & 31)] = xin[i]; }
    LDS_WAIT(); asm volatile("" ::: "memory");
    const int c = lane & 7;
#pragma unroll
    for (int j = 0; j < 4; ++j) { const int n = (lane >> 3) + 8 * j; const LAS float* s = scr + (8 * c) * 33 + n;
        v4u o; o.x = cvt_pk_bf16(s[0 * 33], s[1 * 33]); o.y = cvt_pk_bf16(s[2 * 33], s[3 * 33]); o.z = cvt_pk_bf16(s[4 * 33], s[5 * 33]); o.w = cvt_pk_bf16(s[6 * 33], s[7 * 33]);
        if (n0 + n < cnt) *(v4u*)(dst + (size_t)map_row(mode, n0 + n) * K + k0 + 8 * c) = o; }
    LDS_WAIT(); asm volatile("" ::: "memory");
}
struct CvtJob { const float* W; int K, srcld, c0, cnt, mode; bf16* dst; int items; };
__device__ __forceinline__ NOPK CvtJob get_job(KP P, int j) {
    const int l = j / 11, k = j % 11; unsigned char* wl = P->ws + WS_W + (size_t)l * W_LAYER; CvtJob J;
    if (k == 0)      { J.W = P->in[I_WIN] + (size_t)l * D * NIN; J.K = D; J.srcld = NIN; J.c0 = 0; J.cnt = NMIX; J.mode = 0; J.dst = (bf16*)(wl + WO_IN); }
    else if (k == 1) { J.W = P->in[I_WIN] + (size_t)l * D * NIN; J.K = D; J.srcld = NIN; J.c0 = NMIX; J.cnt = 4096; J.mode = 1; J.dst = (bf16*)(wl + WO_G); }
    else if (k < 6)  { const int b = k - 2; J.W = P->in[I_WBR] + (size_t)(l * 4 + b) * 256 * D; J.K = 256; J.srcld = D; J.c0 = 0; J.cnt = D; J.mode = 0; J.dst = (bf16*)(wl + WO_B) + (size_t)b * D * 256; }
    else if (k == 6) { J.W = P->in[I_WMIX] + (size_t)l * D * D; J.K = D; J.srcld = D; J.c0 = 0; J.cnt = D; J.mode = 0; J.dst = (bf16*)(wl + WO_MIX); }
    else if (k == 7) { J.W = P->in[I_WUP] + (size_t)l * D * 2 * DFF; J.K = D; J.srcld = 2 * DFF; J.c0 = 0; J.cnt = 2 * DFF; J.mode = 2; J.dst = (bf16*)(wl + WO_UP); }
    else if (k == 8) { J.W = P->in[I_WDN] + (size_t)l * DFF * D; J.K = DFF; J.srcld = D; J.c0 = 0; J.cnt = D; J.mode = 0; J.dst = (bf16*)(wl + WO_DN); }
    else if (k == 9) { J.W = P->in[I_WPG] + (size_t)l * D * D; J.K = D; J.srcld = D; J.c0 = 0; J.cnt = D; J.mode = 0; J.dst = (bf16*)(wl + WO_PG); }
    else             { J.W = P->in[I_WPP] + (size_t)l * PLE * D; J.K = PLE; J.srcld = D; J.c0 = 0; J.cnt = D; J.mode = 0; J.dst = (bf16*)(wl + WO_PP); }
    J.items = (J.K / 64) * ((J.cnt + 31) / 32);
    return J;
}
template <int NR, bool SRCBF>
__device__ __forceinline__ NOPK void ln_rows(const void* xsrc, const float* w, const float* b, bf16* o0, float* f0, int lane) {
    f32x4 v[NR][4];
    if (SRCBF) { v2u t[NR][4];
#pragma unroll
        for (int r = 0; r < NR; ++r)
#pragma unroll
            for (int j = 0; j < 4; ++j) t[r][j] = ((const v2u*)((const bf16*)xsrc + (size_t)r * D))[lane + 64 * j];
#pragma unroll
        for (int r = 0; r < NR; ++r)
#pragma unroll
            for (int j = 0; j < 4; ++j) v[r][j] = (f32x4){u2f(t[r][j].x << 16), u2f(t[r][j].x & 0xffff0000u), u2f(t[r][j].y << 16), u2f(t[r][j].y & 0xffff0000u)};
    } else {
#pragma unroll
        for (int r = 0; r < NR; ++r)
#pragma unroll
            for (int j = 0; j < 4; ++j) v[r][j] = ((const f32x4*)((const float*)xsrc + (size_t)r * D))[lane + 64 * j];
    }
    f32x4 wv[4], bv[4];
#pragma unroll
    for (int j = 0; j < 4; ++j) { wv[j] = ((const f32x4*)w)[lane + 64 * j]; bv[j] = ((const f32x4*)b)[lane + 64 * j]; }
#pragma unroll
    for (int r = 0; r < NR; ++r) { float s = 0.f;
#pragma unroll
        for (int j = 0; j < 4; ++j) s += (v[r][j].x + v[r][j].y) + (v[r][j].z + v[r][j].w);
        const float mean = wave_sum(s) * (1.f / D); float q = 0.f;
#pragma unroll
        for (int j = 0; j < 4; ++j) { v[r][j] = v[r][j] - mean; q += (v[r][j].x * v[r][j].x + v[r][j].y * v[r][j].y) + (v[r][j].z * v[r][j].z + v[r][j].w * v[r][j].w); }
        const float rstd = 1.f / sqrtf(wave_sum(q) * (1.f / D) + LN_EPS);
#pragma unroll
        for (int j = 0; j < 4; ++j) { const f32x4 a = v[r][j] * rstd * wv[j] + bv[j];
            if (o0) { v2u pk; pk.x = cvt_pk_bf16(a.x, a.y); pk.y = cvt_pk_bf16(a.z, a.w); ((v2u*)(o0 + (size_t)r * D))[lane + 64 * j] = pk; }
            if (f0) ((f32x4*)(f0 + (size_t)r * D))[lane + 64 * j] = a; } }
}
template <bool SRCBF>
__device__ __forceinline__ NOPK void ln_phase(const void* V, const float* w, const float* b, bf16* XB, float* OUTF) {
    const int tid = opaque_tid(), lane = tid & 63, gw = blockIdx.x * NWAVES + (tid >> 6), NGW = gridDim.x * NWAVES;
    for (int m = 4 * gw; m < M; m += 4 * NGW)
        ln_rows<4, SRCBF>(SRCBF ? (const void*)((const bf16*)V + (size_t)m * D) : (const void*)((const float*)V + (size_t)m * D), w, b, XB ? XB + (size_t)m * D : nullptr, OUTF ? OUTF + (size_t)m * D : nullptr, lane);
}
__device__ __forceinline__ NOPK void prologue(KP P, LAS unsigned char* lds) {
    const int tid = opaque_tid(), lane = tid & 63, wave = __builtin_amdgcn_readfirstlane(tid >> 6);
    LAS float* scr = (LAS float*)(lds + wave * 16384);
    const int gw = blockIdx.x * NWAVES + wave, NGW = gridDim.x * NWAVES;
    const int gt = blockIdx.x * (NWAVES * 64) + tid, NGT = gridDim.x * NWAVES * 64;
    int total = 0;
    for (int j = 0; j < 22; ++j) total += get_job(P, j).items;
    for (int it = gw; it < total; it += NGW) {
        int r = it, j = 0; CvtJob J = get_job(P, 0);
        while (r >= J.items) { r -= J.items; ++j; J = get_job(P, j); }
        cvt_item(J.W, J.K, J.srcld, J.c0, J.cnt, J.dst, J.mode, scr, r, lane);
    }
    for (int l = 0; l < DEPTH; ++l) { v4u* z = (v4u*)((bf16*)(P->ws + WS_W + (size_t)l * W_LAYER + WO_IN) + (size_t)NMIX * D);
        for (int i = gt; i < (NMIXP - NMIX) * D / 8; i += NGT) z[i] = (v4u){0u, 0u, 0u, 0u}; }
    { const f32x4* ps = (const f32x4*)P->in[I_P]; v2u* pd = (v2u*)(P->ws + WS_PB);
        constexpr size_t NP4 = (size_t)DEPTH * M * PLE / 4;
        for (size_t i = gt; i < NP4; i += (size_t)4 * NGT) { f32x4 v[4];
#pragma unroll
            for (int q = 0; q < 4; ++q) if (i + (size_t)q * NGT < NP4) v[q] = ps[i + (size_t)q * NGT];
#pragma unroll
            for (int q = 0; q < 4; ++q) if (i + (size_t)q * NGT < NP4) { v2u o; o.x = cvt_pk_bf16(v[q].x, v[q].y); o.y = cvt_pk_bf16(v[q].z, v[q].w); pd[i + (size_t)q * NGT] = o; } } }
    { f32x2g* rt = (f32x2g*)(P->ws + WS_ROPE);
        for (int i = gt; i < SEQ * 16; i += NGT) { const int t = i >> 4, k = i & 15; const double a = (double)t * ROPE_THETA[k];
            const double n = __builtin_rint(a * 0.15915494309189535); const double r = a - n * 6.283185307179586, r2 = r * r;
            double ts = r, ss = r, tc = 1.0, sc = 1.0;
            for (int q = 1; q <= 14; ++q) { tc *= -r2 / (double)((2 * q - 1) * (2 * q)); sc += tc; ts *= -r2 / (double)((2 * q) * (2 * q + 1)); ss += ts; }
            rt[i] = (f32x2g){(float)sc, (float)ss}; } }
    ln_phase<false>(P->in[I_X], P->in[I_LNINW], P->in[I_LNINB], (bf16*)(P->ws + WS_XB), nullptr);
}

#ifndef REP_PREP
#define REP_PREP 1
#endif
#ifndef REP_REC
#define REP_REC 1
#endif

__device__ __forceinline__ NOPK void ld8(const bf16* p, float (&o)[8]) { const v4u w = *(const v4u*)p; o[0] = bf_lo(w.x); o[1] = bf_hi(w.x); o[2] = bf_lo(w.y); o[3] = bf_hi(w.y); o[4] = bf_lo(w.z); o[5] = bf_hi(w.z); o[6] = bf_lo(w.w); o[7] = bf_hi(w.w); }
__device__ __forceinline__ NOPK void st8(bf16* p, const float (&o)[8]) { v4u w; w.x = cvt_pk_bf16(o[0], o[1]); w.y = cvt_pk_bf16(o[2], o[3]); w.z = cvt_pk_bf16(o[4], o[5]); w.w = cvt_pk_bf16(o[6], o[7]); *(v4u*)p = w; }
__device__ __forceinline__ NOPK float sigmoid_acc(float x) { return __builtin_amdgcn_rcpf(1.0f + __expf(-x)); }
__device__ __forceinline__ NOPK float tanh_fast(float x) { return 2.0f * __builtin_amdgcn_rcpf(1.0f + __expf(-2.0f * x)) - 1.0f; }

typedef short bf16x8v __attribute__((ext_vector_type(8)));
#define SWZ(r, c) ((r) * 64 + ((((c) >> 3) ^ ((r) & 7)) << 3) + ((c) & 7))
__device__ __forceinline__ NOPK bf16x8v frag64(const LAS bf16* arr, int row, int ch) { return *(const LAS bf16x8v*)(arr + row * 64 + ((ch ^ (row & 7)) << 3)); }
template <int MX>
__device__ __forceinline__ NOPK void linattn_fast(LAS unsigned char* lds, KP P, int layer, int b, int h) {
    constexpr int DK = (MX == 3) ? 64 : 32, NDT = DK / 16, NKS = DK / 32, QN = DK / 8;
    asm volatile("" : "+s"(h), "+s"(b));
    const int tid = opaque_tid(), lane = tid & 63, wave = __builtin_amdgcn_readfirstlane(tid >> 6), fr = lane & 15, fq = lane >> 4;
    LAS float* slg = (LAS float*)lds;
    LAS bf16* sQ = (LAS bf16*)(lds + 16384); LAS bf16* sK = (LAS bf16*)(lds + 24576); LAS bf16* sKT = (LAS bf16*)(lds + 32768); LAS bf16* sVT = (LAS bf16*)(lds + 40960);
    LAS bf16* sP = (LAS bf16*)(lds + 49152); LAS bf16* sST = (LAS bf16*)(lds + 57344); LAS bf16* sG = (LAS bf16*)(lds + 65536);
    LAS float* sw2 = (LAS float*)(lds + 73728); LAS float* sbb = sw2 + 512;
    const bf16* Z = (const bf16*)(P->ws + WS_R2);
    bf16* O = (bf16*)P->out;
    const int t8 = tid >> 3, e0 = (tid & 7) * 8, dd0 = (tid & 7) * QN;
    constexpr int zbase = (MX == 0) ? 0 : (MX == 2) ? 1792 : 2576;
    constexpr int qcol = 0, kcol = (MX == 3) ? 256 : 128, vcol = (MX == 3) ? 512 : 256, gcol = (MX == 0) ? 512 : (MX == 2) ? 528 : 768;
    const float lgam = (MX == 0) ? logf(1.0f - exp2f(-5.0f - (float)h)) : 0.f;
    sync_wg();
    if (MX == 2) { sw2[tid] = P->in[I_GLAW2][(size_t)layer * 16 * 128 + (tid >> 5) * 128 + h * 32 + (tid & 31)]; if (tid < 32) sbb[tid] = P->in[I_GLAB][layer * 128 + h * 32 + tid]; sync_wg(); }
    float lbv[8];
#pragma unroll
    for (int i = 0; i < 8; ++i) { lbv[i] = 0.f; if (MX == 3 && layer > 0) lbv[i] = sigmoid_acc(P->in[I_HLB][256 + h * 64 + e0 + i] - P->in[I_HLB][h * 64 + e0 + i]); }
    float nw[16];
#pragma unroll
    for (int i = 0; i < 16; ++i) { const int e = 16 * (i >> 2) + 4 * fq + (i & 3); nw[i] = (MX == 2) ? P->in[I_GLANW][layer * 64 + e] : (MX == 3) ? P->in[I_HNW][layer * 64 + e] : 1.f; }
    f32x4 S[NDT];
#pragma unroll
    for (int i = 0; i < NDT; ++i) S[i] = (f32x4){0.f, 0.f, 0.f, 0.f};
#pragma unroll 1
    for (int c = 0; c < NCHUNK; ++c) {
        const size_t rowbase = (size_t)b * SEQ + c * 64;
        const bf16* zr = Z + (rowbase + t8) * NMIXP + zbase;
        float qr[QN], kr[QN];
        { const v4u vw = *(const v4u*)(zr + vcol + h * 64 + e0);
          const unsigned vv[4] = {vw.x, vw.y, vw.z, vw.w};
#pragma unroll
          for (int i = 0; i < 4; ++i) { sVT[SWZ(e0 + 2 * i, t8)] = (bf16)(vv[i] & 0xffffu); sVT[SWZ(e0 + 2 * i + 1, t8)] = (bf16)(vv[i] >> 16); }
          *(LAS v4u*)(sG + SWZ(t8, e0)) = *(const v4u*)(zr + gcol + h * 64 + e0); }
        if (MX == 3) {
            float a[8], f[8]; ld8(zr + qcol + h * 64 + e0, a); ld8(zr + kcol + h * 64 + e0, f);
#pragma unroll
            for (int i = 0; i < 8; ++i) { qr[i] = a[i]; const float ff = lbv[i] + (1.f - lbv[i]) * sigmoid_acc(f[i]); kr[i] = (1.f - lbv[i]) * sigmoid_acc(-f[i]); slg[t8 * 64 + e0 + i] = logf(ff); }
        } else {
            const v2u qw = *(const v2u*)(zr + qcol + h * 32 + dd0), kw = *(const v2u*)(zr + kcol + h * 32 + dd0);
            float q4[4] = {bf_lo(qw.x), bf_hi(qw.x), bf_lo(qw.y), bf_hi(qw.y)}, k4[4] = {bf_lo(kw.x), bf_hi(kw.x), bf_lo(kw.y), bf_hi(kw.y)};
            if (MX == 0) { const f32x2g* rope = (const f32x2g*)(P->ws + WS_ROPE) + (c * 64 + t8) * 16 + (dd0 >> 1);
#pragma unroll
                for (int p2 = 0; p2 < 2; ++p2) { const f32x2g cs = rope[p2]; const float q1 = q4[2 * p2], q2 = q4[2 * p2 + 1], k1 = k4[2 * p2] * 0.17677669529663687f, k2 = k4[2 * p2 + 1] * 0.17677669529663687f;
                    qr[2 * p2] = q1 * cs.x - q2 * cs.y; qr[2 * p2 + 1] = q1 * cs.y + q2 * cs.x; kr[2 * p2] = k1 * cs.x - k2 * cs.y; kr[2 * p2 + 1] = k1 * cs.y + k2 * cs.x; }
            } else { float gl[16]; { float a[8]; ld8(zr + 512, a);
#pragma unroll
                    for (int i = 0; i < 8; ++i) gl[i] = a[i];
                    ld8(zr + 520, a);
#pragma unroll
                    for (int i = 0; i < 8; ++i) gl[8 + i] = a[i]; }
#pragma unroll
                for (int i = 0; i < 4; ++i) { qr[i] = q4[i] * 0.17677669529663687f; kr[i] = k4[i]; float acc = sbb[dd0 + i];
#pragma unroll
                    for (int j = 0; j < 16; ++j) acc += gl[j] * sw2[j * 32 + dd0 + i];
                    slg[t8 * 64 + dd0 + i] = (fminf(acc, 0.f) - log1pf(__expf(-fabsf(acc)))) * 0.0625f; } }
        }
        if (MX != 0) {
            sync_wg();
            if (tid < DK) { float run = 0.f;
#pragma unroll 1
                for (int tb = 0; tb < 64; tb += 16) { float x[16];
#pragma unroll
                    for (int i = 0; i < 16; ++i) x[i] = slg[(tb + i) * 64 + tid];
#pragma unroll
                    for (int i = 0; i < 16; ++i) { run += x[i]; x[i] = run; }
#pragma unroll
                    for (int i = 0; i < 16; ++i) slg[(tb + i) * 64 + tid] = x[i]; } }
            sync_wg();
        }
        { float qs[QN], ks[QN];
#pragma unroll
          for (int i = 0; i < QN; ++i) { float dq;
              if (MX == 0) dq = (float)(t8 - 31) * lgam; else dq = slg[t8 * 64 + dd0 + i] - slg[31 * 64 + dd0 + i];
              qs[i] = qr[i] * __expf(dq); ks[i] = kr[i] * __expf(-dq); }
          if (QN == 8) { v4u o; o.x = cvt_pk_bf16(qs[0], qs[1]); o.y = cvt_pk_bf16(qs[2], qs[3]); o.z = cvt_pk_bf16(qs[4], qs[5]); o.w = cvt_pk_bf16(qs[6], qs[7]); *(LAS v4u*)(sQ + SWZ(t8, dd0)) = o;
                         v4u p; p.x = cvt_pk_bf16(ks[0], ks[1]); p.y = cvt_pk_bf16(ks[2], ks[3]); p.z = cvt_pk_bf16(ks[4], ks[5]); p.w = cvt_pk_bf16(ks[6], ks[7]); *(LAS v4u*)(sK + SWZ(t8, dd0)) = p; }
          else { v2u o; o.x = cvt_pk_bf16(qs[0], qs[1]); o.y = cvt_pk_bf16(qs[2], qs[3]); *(LAS v2u*)(sQ + SWZ(t8, dd0)) = o;
                 v2u p; p.x = cvt_pk_bf16(ks[0], ks[1]); p.y = cvt_pk_bf16(ks[2], ks[3]); *(LAS v2u*)(sK + SWZ(t8, dd0)) = p; }
#pragma unroll
          for (int i = 0; i < QN; i += 2) { const unsigned w = cvt_pk_bf16(ks[i], ks[i + 1]); sKT[SWZ(dd0 + i, t8)] = (bf16)(w & 0xffffu); sKT[SWZ(dd0 + i + 1, t8)] = (bf16)(w >> 16); } }
        sync_wg();
        bf16x8v bq[NKS];
        if (wave < 4) {
            const int t = 16 * wave + fr;
#pragma unroll
            for (int ks = 0; ks < NKS; ++ks) bq[ks] = frag64(sQ, t, 4 * ks + fq);
#pragma unroll
            for (int j = 0; j < 4; ++j) { f32x4 acc = (f32x4){0.f, 0.f, 0.f, 0.f};
                if (j <= wave) {
#pragma unroll
                    for (int ks = 0; ks < NKS; ++ks) acc = __builtin_amdgcn_mfma_f32_16x16x32_bf16(frag64(sK, 16 * j + fr, 4 * ks + fq), bq[ks], acc, 0, 0, 0); }
                float pv[4];
#pragma unroll
                for (int rg = 0; rg < 4; ++rg) pv[rg] = (j < wave || (j == wave && 4 * fq + rg <= fr)) ? acc[rg] : 0.f;
                v2u o; o.x = cvt_pk_bf16(pv[0], pv[1]); o.y = cvt_pk_bf16(pv[2], pv[3]);
                *(LAS v2u*)(sP + t * 64 + (((2 * j + (fq >> 1)) ^ (t & 7)) << 3) + 4 * (fq & 1)) = o; }
        } else {
            const int e = 16 * (wave - 4) + fr;
#pragma unroll
            for (int i = 0; i < NDT; ++i) { float sc[4];
#pragma unroll
                for (int rg = 0; rg < 4; ++rg) sc[rg] = (MX == 0) ? __expf(32.f * lgam) : __expf(slg[31 * 64 + 16 * i + 4 * fq + rg]);
                v2u o; o.x = cvt_pk_bf16(S[i][0] * sc[0], S[i][1] * sc[1]); o.y = cvt_pk_bf16(S[i][2] * sc[2], S[i][3] * sc[3]);
                *(LAS v2u*)(sST + e * 64 + (((2 * i + (fq >> 1)) ^ (e & 7)) << 3) + 4 * (fq & 1)) = o; }
        }
        sync_wg();
        if (wave < 4) {
            const int t = 16 * wave + fr;
            bf16x8v bp[2];
#pragma unroll
            for (int ks = 0; ks < 2; ++ks) bp[ks] = frag64(sP, t, 4 * ks + fq);
            f32x4 oacc[4];
#pragma unroll
            for (int i = 0; i < 4; ++i) { f32x4 acc = (f32x4){0.f, 0.f, 0.f, 0.f};
                acc = __builtin_amdgcn_mfma_f32_16x16x32_bf16(frag64(sVT, 16 * i + fr, fq), bp[0], acc, 0, 0, 0);
                if (wave >= 2) acc = __builtin_amdgcn_mfma_f32_16x16x32_bf16(frag64(sVT, 16 * i + fr, 4 + fq), bp[1], acc, 0, 0, 0);
#pragma unroll
                for (int ks = 0; ks < NKS; ++ks) acc = __builtin_amdgcn_mfma_f32_16x16x32_bf16(frag64(sST, 16 * i + fr, 4 * ks + fq), bq[ks], acc, 0, 0, 0);
                oacc[i] = acc; }
            float s1 = 0.f;
#pragma unroll
            for (int i = 0; i < 4; ++i)
#pragma unroll
                for (int rg = 0; rg < 4; ++rg) s1 += (MX == 0) ? oacc[i][rg] : oacc[i][rg] * oacc[i][rg];
            s1 += shfl_xor_(s1, 16); s1 += shfl_xor_(s1, 32);
            float rs;
            if (MX == 0) { const float mean = s1 * (1.f / 64.f); float q2 = 0.f;
#pragma unroll
                for (int i = 0; i < 4; ++i)
#pragma unroll
                    for (int rg = 0; rg < 4; ++rg) { oacc[i][rg] -= mean; q2 += oacc[i][rg] * oacc[i][rg]; }
                q2 += shfl_xor_(q2, 16); q2 += shfl_xor_(q2, 32); rs = 1.0f / sqrtf(q2 * (1.f / 64.f) + 1e-6f);
            } else rs = 1.0f / sqrtf(s1 * (1.f / 64.f) + 1e-6f);
#pragma unroll
            for (int i = 0; i < 4; ++i) { const v2u gw = *(const LAS v2u*)(sG + t * 64 + (((2 * i + (fq >> 1)) ^ (t & 7)) << 3) + 4 * (fq & 1));
                const float g4[4] = {bf_lo(gw.x), bf_hi(gw.x), bf_lo(gw.y), bf_hi(gw.y)}; float y[4];
#pragma unroll
                for (int rg = 0; rg < 4; ++rg) y[rg] = oacc[i][rg] * rs * nw[4 * i + rg] * g4[rg] * sigmoid_acc(g4[rg]);
                v2u o; o.x = cvt_pk_bf16(y[0], y[1]); o.y = cvt_pk_bf16(y[2], y[3]);
                *(v2u*)(O + (rowbase + t) * D + MX * 256 + h * 64 + 16 * i + 4 * fq) = o; }
        } else {
            const int e = 16 * (wave - 4) + fr;
            bf16x8v bv[2];
#pragma unroll
            for (int ks = 0; ks < 2; ++ks) bv[ks] = frag64(sVT, e, 4 * ks + fq);
#pragma unroll
            for (int i = 0; i < NDT; ++i) { f32x4 acc = (f32x4){0.f, 0.f, 0.f, 0.f};
#pragma unroll
                for (int ks = 0; ks < 2; ++ks) acc = __builtin_amdgcn_mfma_f32_16x16x32_bf16(frag64(sKT, 16 * i + fr, 4 * ks + fq), bv[ks], acc, 0, 0, 0);
#pragma unroll
                for (int rg = 0; rg < 4; ++rg) { float el, er;
                    if (MX == 0) { el = __expf(64.f * lgam); er = __expf(32.f * lgam); }
                    else { const float bl = slg[63 * 64 + 16 * i + 4 * fq + rg], br = slg[31 * 64 + 16 * i + 4 * fq + rg]; el = __expf(bl); er = __expf(bl - br); }
                    S[i][rg] = el * S[i][rg] + er * acc[rg]; } }
        }
        sync_wg();
    }
}

__device__ __forceinline__ NOPK float dpp_f(float x, const int ctrl_sel) {
    const int xi = __builtin_bit_cast(int, x); int r;
    if (ctrl_sel == 0) r = __builtin_amdgcn_update_dpp(0, xi, 0xB1, 0xf, 0xf, true);
    else if (ctrl_sel == 1) r = __builtin_amdgcn_update_dpp(0, xi, 0x4E, 0xf, 0xf, true);
    else if (ctrl_sel == 2) r = __builtin_amdgcn_update_dpp(0, xi, 0x141, 0xf, 0xf, true);
    else r = __builtin_amdgcn_update_dpp(0, xi, 0x140, 0xf, 0xf, true);
    return __builtin_bit_cast(float, r);
}
__device__ __forceinline__ NOPK float sum16_dpp(float v) { v += dpp_f(v, 0); v += dpp_f(v, 1); v += dpp_f(v, 2); v += dpp_f(v, 3); return v; }
#define DPP_SUM16_2(a_, b_) asm volatile( \
    "s_nop 1\n\t" \
    "v_add_f32_dpp %0, %0, %0 quad_perm:[1,0,3,2] row_mask:0xf bank_mask:0xf bound_ctrl:1\n\t" \
    "v_add_f32_dpp %1, %1, %1 quad_perm:[1,0,3,2] row_mask:0xf bank_mask:0xf bound_ctrl:1\n\t" \
    "s_nop 0\n\t" \
    "v_add_f32_dpp %0, %0, %0 quad_perm:[2,3,0,1] row_mask:0xf bank_mask:0xf bound_ctrl:1\n\t" \
    "v_add_f32_dpp %1, %1, %1 quad_perm:[2,3,0,1] row_mask:0xf bank_mask:0xf bound_ctrl:1\n\t" \
    "s_nop 0\n\t" \
    "v_add_f32_dpp %0, %0, %0 row_half_mirror row_mask:0xf bank_mask:0xf bound_ctrl:1\n\t" \
    "v_add_f32_dpp %1, %1, %1 row_half_mirror row_mask:0xf bank_mask:0xf bound_ctrl:1\n\t" \
    "s_nop 0\n\t" \
    "v_add_f32_dpp %0, %0, %0 row_mirror row_mask:0xf bank_mask:0xf bound_ctrl:1\n\t" \
    "v_add_f32_dpp %1, %1, %1 row_mirror row_mask:0xf bank_mask:0xf bound_ctrl:1\n\t" \
    : "+v"(a_), "+v"(b_));
__device__ __forceinline__ NOPK float sum8_dpp(float v) { v += dpp_f(v, 0); v += dpp_f(v, 1); v += dpp_f(v, 2); return v; }

constexpr int RW_SET = 40960;
constexpr int RW_SV = 81920, RW_SY = 90112, RW_SG = 98304, RW_SB = 106496;
constexpr int RW_SCR = 108544;
constexpr int RW_W2T = 124928, RW_A2T = 133120, RW_G2T = 141312;
constexpr int RW_MU = 149504, RW_PAR = 151296;
__device__ __forceinline__ NOPK void rwkv_task2(LAS unsigned char* lds, KP P, int layer, int b, int h, int half) {
    asm volatile("" : "+s"(h), "+s"(b), "+s"(half));
    const int tid = opaque_tid(), lane = tid & 63, wave = __builtin_amdgcn_readfirstlane(tid >> 6);
    LAS bf16* w2T = (LAS bf16*)(lds + RW_W2T); LAS bf16* a2T = (LAS bf16*)(lds + RW_A2T); LAS bf16* g2T = (LAS bf16*)(lds + RW_G2T);
    LAS float* smu = (LAS float*)(lds + RW_MU); LAS float* spar = (LAS float*)(lds + RW_PAR);
    const bf16* Z = (const bf16*)(P->ws + WS_R2);
    const int colh = h * 64;
    constexpr int NC2 = SEQ / 32;
    sync_wg();
    if (tid < 448) { const int seg = tid >> 6, j = tid & 63; const int col = (seg < 3) ? seg * 256 + colh + j : 768 + (seg - 3) * 64 + j; smu[tid] = P->in[I_MU][layer * 1024 + col]; }
    if (tid < 320) { const int seg = tid >> 6, j = tid & 63; const float* src = (seg == 0) ? P->in[I_KK] + layer * 256 + colh : (seg == 1) ? P->in[I_KA] + layer * 256 + colh : (seg == 2) ? P->in[I_RK] + (layer * 4 + h) * 64
                                                                             : (seg == 3) ? P->in[I_RLNW] + layer * 256 + colh : P->in[I_RLNB] + layer * 256 + colh; spar[tid] = src[j]; }
    { const int cc = tid & 63, jb = tid >> 6;
      const float* w2 = P->in[I_W2] + (size_t)layer * 64 * 256 + colh + cc; const float* a2 = P->in[I_A2] + (size_t)layer * 64 * 256 + colh + cc;
      float x[8];
#pragma unroll
      for (int i = 0; i < 8; ++i) x[i] = w2[(8 * jb + i) * 256];
      { v4u o; o.x = cvt_pk_bf16(x[0], x[1]); o.y = cvt_pk_bf16(x[2], x[3]); o.z = cvt_pk_bf16(x[4], x[5]); o.w = cvt_pk_bf16(x[6], x[7]); *(LAS v4u*)(w2T + cc * 64 + ((jb ^ (cc & 7)) << 3)) = o; }
#pragma unroll
      for (int i = 0; i < 8; ++i) x[i] = a2[(8 * jb + i) * 256];
      { v4u o; o.x = cvt_pk_bf16(x[0], x[1]); o.y = cvt_pk_bf16(x[2], x[3]); o.z = cvt_pk_bf16(x[4], x[5]); o.w = cvt_pk_bf16(x[6], x[7]); *(LAS v4u*)(a2T + cc * 64 + ((jb ^ (cc & 7)) << 3)) = o; }
      const int cg = tid & 31, ch = tid >> 5; const float* g2 = P->in[I_G2] + (size_t)layer * 128 * 256 + colh + 32 * half + cg;
#pragma unroll
      for (int i = 0; i < 8; ++i) x[i] = g2[(8 * ch + i) * 256];
      { v4u o; o.x = cvt_pk_bf16(x[0], x[1]); o.y = cvt_pk_bf16(x[2], x[3]); o.z = cvt_pk_bf16(x[4], x[5]); o.w = cvt_pk_bf16(x[6], x[7]); *(LAS v4u*)(g2T + cg * 128 + ((ch ^ (cg & 7)) << 3)) = o; } }
    sync_wg();
    const int wrole = wave >> 2, widx = wave & 3;
    if (wrole) {
        const int pw = widx, tl = lane >> 3, e0 = (lane & 7) * 8, tk = 8 * pw + tl;
        const int fr = lane & 15, fq = lane >> 4;
        LAS bf16* tw = (LAS bf16*)(lds + RW_SCR + pw * 4096); LAS bf16* ta = tw + 512; LAS bf16* tg = tw + 1024;
        float w0v[4], a0v[4];
#pragma unroll
        for (int q = 0; q < 4; ++q) { w0v[q] = P->in[I_W0][layer * 256 + colh + 16 * q + fr]; a0v[q] = P->in[I_A0][layer * 256 + colh + 16 * q + fr]; }
        v4u R[7], Rp[7];
#define RW2_LOAD(cc_) { const size_t row_ = (size_t)b * SEQ + (cc_) * 32 + tk; const bf16* zr_ = Z + row_ * NMIXP + 768; const bf16* zp_ = ((cc_) == 0 && tk == 0) ? zr_ : zr_ - NMIXP; \
        const int cols_[7] = {colh + e0, 256 + colh + e0, 512 + colh + e0, 768 + e0, 832 + e0, 896 + e0, 960 + e0}; \
        _Pragma("unroll") for (int q_ = 0; q_ < 7; ++q_) { R[q_] = *(const v4u*)(zr_ + cols_[q_]); Rp[q_] = *(const v4u*)(zp_ + cols_[q_]); } }
        RW2_LOAD(0)
#pragma unroll 1
        for (int it = -1; it <= NC2; ++it) {
            if (it >= 1) { const int oc = it - 1, ob = oc & 1; const int c4 = (lane & 7) * 4;
                const LAS float* sy = (const LAS float*)(lds + RW_SY + ob * 4096); const LAS float* sv = (const LAS float*)(lds + RW_SV + ob * 4096); const LAS float* sg = (const LAS float*)(lds + RW_SG + ob * 4096);
                const f32x4 yv = *(const LAS f32x4*)(sy + tk * 32 + c4), vv = *(const LAS f32x4*)(sv + tk * 32 + c4), gv = *(const LAS f32x4*)(sg + tk * 32 + c4);
                float s = (yv.x + yv.y) + (yv.z + yv.w); s = red8(s); const float mean = s * (1.f / 32.f);
                const f32x4 d = yv - mean; float q = (d.x * d.x + d.y * d.y) + (d.z * d.z + d.w * d.w); q = red8(q);
                const float bon = ((const LAS float*)(lds + RW_SB + ob * 128))[tk];
                const size_t row = (size_t)b * SEQ + oc * 32 + tk; const size_t off = row * 256 + colh + 32 * half + c4;
                *(f32x4*)((float*)(P->out + (size_t)M * D / 2) + off) = yv;
                v2u ad; ad.x = cvt_pk_bf16(bon * vv.x, bon * vv.y); ad.y = cvt_pk_bf16(bon * vv.z, bon * vv.w);
                *(v2u*)((bf16*)(P->out + (size_t)M * D / 2 + (size_t)M * 256) + off) = ad;
                v2u gt; gt.x = cvt_pk_bf16(gv.x, gv.y); gt.y = cvt_pk_bf16(gv.z, gv.w);
                *(v2u*)((bf16*)(P->out + (size_t)M * D / 2 + (size_t)M * 256) + (size_t)M * 256 + off) = gt;
                if ((lane & 7) == 0) ((f32x2g*)(P->ws + WS_RST))[(row * 4 + h) * 2 + half] = (f32x2g){mean, q}; }
            if (it + 1 < NC2) { const int pc = it + 1, pb = pc & 1;
                LAS float* sr = (LAS float*)(lds + pb * RW_SET); LAS float* skm = sr + 2048; LAS float* sw = sr + 4096; LAS float* skk = sr + 6144; LAS float* ska = sr + 8192;
                LAS float* sv = (LAS float*)(lds + RW_SV + pb * 4096); LAS float* sg = (LAS float*)(lds + RW_SG + pb * 4096); LAS float* sb = (LAS float*)(lds + RW_SB + pb * 128);
                { const bool first = (pc == 0 && tk == 0); float a[8], p[8], z[8];
#define UNPK2(vv_, o_) { const v4u u_ = vv_; o_[0] = bf_lo(u_.x); o_[1] = bf_hi(u_.x); o_[2] = bf_lo(u_.y); o_[3] = bf_hi(u_.y); o_[4] = bf_lo(u_.z); o_[5] = bf_hi(u_.z); o_[6] = bf_lo(u_.w); o_[7] = bf_hi(u_.w); }
#define SHIFT2(idx) { UNPK2(R[idx], a) UNPK2(Rp[idx], p) _Pragma("unroll") for (int i = 0; i < 8; ++i) { const float pv = first ? 0.f : p[i]; z[i] = a[i] + (pv - a[i]) * smu[(idx) * 64 + e0 + i]; } }
                  SHIFT2(0)
                  *(LAS f32x4*)(sr + tk * 64 + e0) = (f32x4){z[0], z[1], z[2], z[3]}; *(LAS f32x4*)(sr + tk * 64 + e0 + 4) = (f32x4){z[4], z[5], z[6], z[7]};
                  SHIFT2(1)
                  *(LAS f32x4*)(skm + tk * 64 + e0) = (f32x4){z[0], z[1], z[2], z[3]}; *(LAS f32x4*)(skm + tk * 64 + e0 + 4) = (f32x4){z[4], z[5], z[6], z[7]};
                  SHIFT2(2)
                  if ((e0 >> 5) == half) { *(LAS f32x4*)(sv + tk * 32 + (e0 & 31)) = (f32x4){z[0], z[1], z[2], z[3]}; *(LAS f32x4*)(sv + tk * 32 + (e0 & 31) + 4) = (f32x4){z[4], z[5], z[6], z[7]}; }
                  const int sw8 = ((lane & 7) ^ (tl & 7)) << 3;
                  SHIFT2(3)
                  { v4u o; o.x = cvt_pk_bf16(tanh_fast(z[0]), tanh_fast(z[1])); o.y = cvt_pk_bf16(tanh_fast(z[2]), tanh_fast(z[3])); o.z = cvt_pk_bf16(tanh_fast(z[4]), tanh_fast(z[5])); o.w = cvt_pk_bf16(tanh_fast(z[6]), tanh_fast(z[7])); *(LAS v4u*)(tw + tl * 64 + sw8) = o; }
                  SHIFT2(4)
                  { v4u o; o.x = cvt_pk_bf16(z[0], z[1]); o.y = cvt_pk_bf16(z[2], z[3]); o.z = cvt_pk_bf16(z[4], z[5]); o.w = cvt_pk_bf16(z[6], z[7]); *(LAS v4u*)(ta + tl * 64 + sw8) = o; }
                  SHIFT2(5)
                  { v4u o; o.x = cvt_pk_bf16(sigmoid_acc(z[0]), sigmoid_acc(z[1])); o.y = cvt_pk_bf16(sigmoid_acc(z[2]), sigmoid_acc(z[3])); o.z = cvt_pk_bf16(sigmoid_acc(z[4]), sigmoid_acc(z[5])); o.w = cvt_pk_bf16(sigmoid_acc(z[6]), sigmoid_acc(z[7])); *(LAS v4u*)(tg + tl * 128 + sw8) = o; }
                  SHIFT2(6)
                  { v4u o; o.x = cvt_pk_bf16(sigmoid_acc(z[0]), sigmoid_acc(z[1])); o.y = cvt_pk_bf16(sigmoid_acc(z[2]), sigmoid_acc(z[3])); o.z = cvt_pk_bf16(sigmoid_acc(z[4]), sigmoid_acc(z[5])); o.w = cvt_pk_bf16(sigmoid_acc(z[6]), sigmoid_acc(z[7])); *(LAS v4u*)(tg + tl * 128 + 64 + sw8) = o; }
#undef SHIFT2
#undef UNPK2
                }
                if (pc + 1 < NC2) RW2_LOAD(pc + 1)
                asm volatile("s_waitcnt lgkmcnt(0)" ::: "memory");
                { const int ar = fr & 7;
                  f32x4 wacc[4], aacc[4], gacc[2];
#pragma unroll
                  for (int q = 0; q < 4; ++q) { wacc[q] = (f32x4){0.f, 0.f, 0.f, 0.f}; aacc[q] = wacc[q]; }
                  gacc[0] = (f32x4){0.f, 0.f, 0.f, 0.f}; gacc[1] = gacc[0];
#pragma unroll
                  for (int ks = 0; ks < 2; ++ks) { const int ch = ks * 4 + fq;
                      const bf16x8v Aw = *(const LAS bf16x8v*)(tw + ar * 64 + ((ch ^ (ar & 7)) << 3)), Aa = *(const LAS bf16x8v*)(ta + ar * 64 + ((ch ^ (ar & 7)) << 3));
#pragma unroll
                      for (int q = 0; q < 4; ++q) { const int br = 16 * q + fr;
                          const bf16x8v Bw = *(const LAS bf16x8v*)(w2T + br * 64 + ((ch ^ (br & 7)) << 3)), Ba = *(const LAS bf16x8v*)(a2T + br * 64 + ((ch ^ (br & 7)) << 3));
                          wacc[q] = __builtin_amdgcn_mfma_f32_16x16x32_bf16(Aw, Bw, wacc[q], 0, 0, 0); aacc[q] = __builtin_amdgcn_mfma_f32_16x16x32_bf16(Aa, Ba, aacc[q], 0, 0, 0); } }
#pragma unroll
                  for (int ks = 0; ks < 4; ++ks) { const int ch = ks * 4 + fq;
                      const bf16x8v Ag = *(const LAS bf16x8v*)(tg + ar * 128 + ((ch ^ (ar & 7)) << 3));
#pragma unroll
                      for (int q = 0; q < 2; ++q) { const int br = 16 * q + fr;
                          const bf16x8v Bg = *(const LAS bf16x8v*)(g2T + br * 128 + ((ch ^ (br & 7)) << 3));
                          gacc[q] = __builtin_amdgcn_mfma_f32_16x16x32_bf16(Ag, Bg, gacc[q], 0, 0, 0); } }
                  if (fq < 2) {
#pragma unroll
                      for (int rg = 0; rg < 4; ++rg) { const int t = 8 * pw + 4 * fq + rg;
#pragma unroll
                          for (int q = 0; q < 4; ++q) { const int cc = 16 * q + fr;
                              sw[t * 64 + cc] = __expf(-0.6065306597126334f * sigmoid_acc(w0v[q] + wacc[q][rg])); ska[t * 64 + cc] = sigmoid_acc(a0v[q] + aacc[q][rg]); }
#pragma unroll
                          for (int q = 0; q < 2; ++q) sg[t * 32 + 16 * q + fr] = gacc[q][rg]; } } }
                asm volatile("s_waitcnt lgkmcnt(0)" ::: "memory");
                { float ss = 0.f, bon = 0.f; float kk[8], av[8];
#pragma unroll
                  for (int i = 0; i < 8; ++i) { const int cc = e0 + i; const float kv = skm[tk * 64 + cc]; av[i] = ska[tk * 64 + cc];
                      kk[i] = kv * spar[cc]; ss += kk[i] * kk[i];
                      const float km = kv * (1.f + (av[i] - 1.f) * spar[64 + cc]); skm[tk * 64 + cc] = km;
                      bon += sr[tk * 64 + cc] * km * spar[128 + cc]; }
                  ss = red8(ss); bon = red8(bon); const float inv = 1.0f / sqrtf(ss + 1e-12f);
#pragma unroll
                  for (int i = 0; i < 8; ++i) { const float kn = kk[i] * inv; skk[tk * 64 + e0 + i] = kn; ska[tk * 64 + e0 + i] = kn * av[i]; }
                  if ((lane & 7) == 0) sb[tk] = bon; }
            }
            sync_wg();
        }
#undef RW2_LOAD
    } else {
        const int kq = lane & 15, vloc = 2 * (4 * widx + (lane >> 4));
        typedef float f32x2 __attribute__((ext_vector_type(2)));
        f32x2 S2[4];
#pragma unroll
        for (int i = 0; i < 4; ++i) S2[i] = (f32x2){0.f, 0.f};
        sync_wg();
#pragma unroll 1
        for (int it = 0; it < NC2; ++it) { const int cb = it & 1;
            const LAS f32x4* pr = (const LAS f32x4*)(lds + cb * RW_SET + 16 * kq); const LAS f32x4* pkm = pr + 512; const LAS f32x4* pw = pr + 1024; const LAS f32x4* pkk = pr + 1536; const LAS f32x4* pka = pr + 2048;
            const LAS f32x2* pv = (const LAS f32x2*)(lds + RW_SV + cb * 4096 + 4 * vloc); LAS float* sy = (LAS float*)(lds + RW_SY + cb * 4096);
            const f32x2 Ssv0 = S2[0], Ssv1 = S2[1], Ssv2 = S2[2], Ssv3 = S2[3];
            for (int rr_ = 0; rr_ < REP_REC; ++rr_) { S2[0] = Ssv0; S2[1] = Ssv1; S2[2] = Ssv2; S2[3] = Ssv3;
            f32x4 wA = pw[0], kA = pkk[0], aA = pka[0], mA = pkm[0], rA = pr[0]; f32x2 vA = pv[0];
            f32x4 wB, kB, aB, mB, rB; f32x2 vB;
#define RWKV_STEP(tcur, tn, wX, kX, aX, mX, rX, vX, wY, kY, aY, mY, rY, vY) { \
              wY = pw[(tn) * 16]; kY = pkk[(tn) * 16]; aY = pka[(tn) * 16]; mY = pkm[(tn) * 16]; rY = pr[(tn) * 16]; vY = pv[(tn) * 16]; \
              f32x2 sa = S2[0] * kX.x; sa = S2[1] * kX.y + sa; sa = S2[2] * kX.z + sa; sa = S2[3] * kX.w + sa; \
              const f32x2 tm0 = S2[0] * wX.x + vX * mX.x, tm1 = S2[1] * wX.y + vX * mX.y, tm2 = S2[2] * wX.z + vX * mX.z, tm3 = S2[3] * wX.w + vX * mX.w; \
              float s0 = sa.x, s1 = sa.y; DPP_SUM16_2(s0, s1) \
              const f32x2 sar = (f32x2){s0, s1}; \
              S2[0] = tm0 - sar * aX.x; S2[1] = tm1 - sar * aX.y; S2[2] = tm2 - sar * aX.z; S2[3] = tm3 - sar * aX.w; \
              f32x2 yy = S2[0] * rX.x; yy = S2[1] * rX.y + yy; yy = S2[2] * rX.z + yy; yy = S2[3] * rX.w + yy; \
              float y0 = yy.x, y1 = yy.y; DPP_SUM16_2(y0, y1) \
              if (kq == 0) *(LAS f32x2*)(sy + (tcur) * 32 + vloc) = (f32x2){y0, y1}; }
#pragma unroll 1
            for (int t = 0; t < 32; t += 2) {
                RWKV_STEP(t, t + 1, wA, kA, aA, mA, rA, vA, wB, kB, aB, mB, rB, vB)
                RWKV_STEP(t + 1, (t + 2) & 31, wB, kB, aB, mB, rB, vB, wA, kA, aA, mA, rA, vA) }
#undef RWKV_STEP
            }
            sync_wg();
        }
        sync_wg();
    }
}

__device__ __forceinline__ NOPK void rwkv_finalize(KP P, int layer) {
    const int gt = blockIdx.x * (NWAVES * 64) + opaque_tid(), NGT = gridDim.x * NWAVES * 64;
    const float* YR = P->out + (size_t)M * D / 2; const bf16* AD = (const bf16*)(YR + (size_t)M * 256); const bf16* GT = AD + (size_t)M * 256;
    const f32x2g* ST = (const f32x2g*)(P->ws + WS_RST); bf16* O = (bf16*)P->out;
    for (int i = gt; i < M * 64; i += NGT) { const int row = i >> 6, c4 = (i & 63) * 4, h = c4 >> 6;
        const f32x2g sa = ST[(row * 4 + h) * 2], sb = ST[(row * 4 + h) * 2 + 1];
        const float mean = 0.5f * (sa.x + sb.x), dm = sa.x - sb.x, m2 = sa.y + sb.y + 16.f * dm * dm, rs = 1.0f / sqrtf(m2 * (1.f / 64.f) + 64e-5f);
        const f32x4 y = *(const f32x4*)(YR + (size_t)row * 256 + c4); const v2u ad = *(const v2u*)(AD + (size_t)row * 256 + c4), g = *(const v2u*)(GT + (size_t)row * 256 + c4);
        const f32x4 lw = *(const f32x4*)(P->in[I_RLNW] + layer * 256 + c4), lb = *(const f32x4*)(P->in[I_RLNB] + layer * 256 + c4);
        v2u o; o.x = cvt_pk_bf16(((y.x - mean) * rs * lw.x + lb.x + bf_lo(ad.x)) * bf_lo(g.x), ((y.y - mean) * rs * lw.y + lb.y + bf_hi(ad.x)) * bf_hi(g.x));
        o.y = cvt_pk_bf16(((y.z - mean) * rs * lw.z + lb.z + bf_lo(ad.y)) * bf_lo(g.y), ((y.w - mean) * rs * lw.w + lb.w + bf_hi(ad.y)) * bf_hi(g.y));
        *(v2u*)(O + (size_t)row * D + 256 + c4) = o; }
}

__device__ __forceinline__ NOPK void ffn_fixup_panel(KP P, int layer, int pm) {
    const int tid = opaque_tid();
    const float* uh = (const float*)(P->ws + WS_HALO); const float* vh = (const float*)(P->ws + WS_HALO + HALO_ONE); const float* ut = (const float*)(P->ws + WS_HALO + 2 * HALO_ONE);
    const float* conv = P->in[I_CONV] + (size_t)layer * 3 * DFF; bf16* ACT = (bf16*)(P->ws + WS_R2);
    for (int i = tid; i < 2 * DFF; i += NWAVES * 64) { const int rr = i / DFF, cc = i % DFF;
        const float u0 = uh[((size_t)pm * 2) * DFF + cc], u1 = uh[((size_t)pm * 2 + 1) * DFF + cc];
        float t0 = 0.f, t1 = 0.f; if (pm & 7) { t0 = ut[((size_t)(pm - 1) * 2) * DFF + cc]; t1 = ut[((size_t)(pm - 1) * 2 + 1) * DFF + cc]; }
        const float c0 = conv[cc], c1 = conv[DFF + cc], c2 = conv[2 * DFF + cc];
        const float cv = rr ? (c2 * u1 + c1 * u0 + c0 * t1) : (c2 * u0 + c1 * t1 + c0 * t0);
        const float a = pg8::gelu_tanh_f(cv) * vh[((size_t)pm * 2 + rr) * DFF + cc];
        ACT[((size_t)pm * 256 + rr) * DFF + cc] = (bf16)(cvt_pk_bf16(a, 0.f) & 0xffffu); }
}

__device__ __forceinline__ NOPK void z_tail16(const bf16* XB, const bf16* Wt, bf16* Z) {
    const int tid = opaque_tid(), lane = tid & 63, wave = __builtin_amdgcn_readfirstlane(tid >> 6), fr = lane & 15, fq = lane >> 4;
    for (int rb = blockIdx.x * NWAVES + wave; rb < M / 16; rb += gridDim.x * NWAVES) {
        const bf16* xr = XB + (size_t)(rb * 16 + fr) * D + 8 * fq;
        const bf16* wr = Wt + (size_t)(NMIXG + fr) * D + 8 * fq;
        f32x4 acc = (f32x4){0.f, 0.f, 0.f, 0.f};
#pragma unroll 1
        for (int h = 0; h < 2; ++h) {
            bf16x8v a[16], b[16];
#pragma unroll
            for (int s = 0; s < 16; ++s) { a[s] = *(const bf16x8v*)(xr + (h * 16 + s) * 32); b[s] = *(const bf16x8v*)(wr + (h * 16 + s) * 32); }
#pragma unroll
            for (int s = 0; s < 16; ++s) acc = __builtin_amdgcn_mfma_f32_16x16x32_bf16(b[s], a[s], acc, 0, 0, 0);
        }
        v2u pk; pk.x = cvt_pk_bf16(acc[0], acc[1]); pk.y = cvt_pk_bf16(acc[2], acc[3]);
        *(v2u*)(Z + (size_t)(rb * 16 + fr) * NMIXP + NMIXG + 4 * fq) = pk;
    }
}
constexpr int NPH = 1 + 10 * DEPTH;
#ifndef REP_MIX
#define REP_MIX -1
#endif
#ifndef REP_PHASE
#define REP_PHASE -1
#endif
#define REPEAT(k) for (int rep_ = 0; rep_ < ((REP_PHASE == (k)) ? 2 : 1); ++rep_)
__global__ void __launch_bounds__(NWAVES * 64, 2) NOPK mega(Params Pk) {
    KP P = kparams();
    extern __shared__ __attribute__((aligned(16))) unsigned char lds_raw[];
    LAS unsigned char* lds = (LAS unsigned char*)lds_raw;
    volatile LAS unsigned* MISC = (volatile LAS unsigned*)(lds + LDS_MISC);
    const int tid = threadIdx.x;
    const int G = gridDim.x, bx = blockIdx.x;
    if (tid < 64) MISC[tid] = 0u;
    sync_wg();
    const int lo = P->ph_lo, hi = P->ph_hi;
    XcdBarrier bar; bar.bar = (unsigned*)(P->ws + WS_CTL) + CW_BAR; bar.x = 0; bar.st = nullptr;
    if (hi - lo > 1) bar = xcd_barrier_post((unsigned*)(P->ws + WS_CTL) + CW_BAR, MISC + 8);
#define IN(k) (lo <= (k) && (k) < hi)
#define STAGGER(n) for (int d_ = ((bx >> 3) & 7) * (n); d_ > 0; --d_) __builtin_amdgcn_s_sleep(32);
#define SEAM(k) do { if (IN(k) && IN((k) + 1)) xcd_barrier(bar); } while (0)
#define PHASE_PTRS KP P = kparams(); unsigned char* const wl = P->ws + WS_W + (size_t)l * W_LAYER; bf16* const XB = (bf16*)(P->ws + WS_XB); unsigned char* const R2 = P->ws + WS_R2; \
        bf16* const OB = (bf16*)P->out;   bf16* const MG = (bf16*)P->out + (size_t)M * D;   \
        (void)wl; (void)XB; (void)R2; (void)OB; (void)MG;

    REPEAT(100) if (IN(0)) prologue(kparams(), lds);
    SEAM(0);
    for (int l = 0; l < DEPTH; ++l) {
        const int pb = 1 + 10 * l;
        REPEAT(0) if (IN(pb + 0)) {
            PHASE_PTRS
            z_tail16(XB, (const bf16*)(wl + WO_IN), (bf16*)R2);
            pg8::Gemm g{XB, (const bf16*)(wl + WO_IN), M, NMIXG, D, D, D, 0, 0}; pg8::StaticOrder S; S.init(M, NMIXG, G, bx);
            pg8::EpiStoreBf16 E{(bf16*)R2, NMIXP};
            pg8::gemm_phase<pg8::EpiStoreBf16, pg8::StaticOrder, true, true>(lds, g, S, E);
        }
        SEAM(pb + 0);
        REPEAT(1) if (IN(pb + 1)) {
            PHASE_PTRS
#ifndef NO_MIX
            for (int slot = bx; slot < 256; slot += G) {
                if (slot < 128) { const int bh = slot >> 1; rwkv_task2(lds, P, l, bh >> 2, bh & 3, slot & 1); }
                else if (slot < 192) { const int bh = slot - 128; linattn_fast<0>(lds, P, l, bh >> 2, bh & 3); linattn_fast<2>(lds, P, l, bh >> 2, bh & 3); }
                else { const int bh = slot - 192; linattn_fast<3>(lds, P, l, bh >> 2, bh & 3);
                    pg8::Gemm g{(const bf16*)(P->ws + WS_PB) + (size_t)l * M * PLE, (const bf16*)(wl + WO_PP), M, D, PLE, PLE, PLE, 0, 0}; pg8::StaticOrder S; S.init(M, D, 64, slot - 192);
                    pg8::EpiStoreBf16 E{(bf16*)(P->ws + WS_PPLE), D};
                    pg8::gemm_phase<pg8::EpiStoreBf16, pg8::StaticOrder, true, true>(lds, g, S, E); } }
#endif
        }
        SEAM(pb + 1);
        REPEAT(2) if (IN(pb + 2)) rwkv_finalize(kparams(), l);
        SEAM(pb + 2);
        REPEAT(3) if (IN(pb + 3)) {
            PHASE_PTRS
            pg8::Gemm g{OB, (const bf16*)(wl + WO_B), M, 4096, 256, D, 256, 4, 256}; pg8::StaticOrder S; S.init(M, 4096, G, bx);
            pg8::EpiStoreBf16 E{(bf16*)R2, 4096};
            STAGGER(1)
            pg8::gemm_phase<pg8::EpiStoreBf16, pg8::StaticOrder, true, true>(lds, g, S, E);
        }
        SEAM(pb + 3);
        REPEAT(4) if (IN(pb + 4)) {
            PHASE_PTRS
            pg8::Gemm g{XB, (const bf16*)(wl + WO_G), M, 4096, D, D, D, 0, 0}; pg8::StaticOrder S; S.init(M, 4096, G, bx);
            pg8::EpiMerge E{(const bf16*)R2, MG};
            pg8::gemm_phase<pg8::EpiMerge, pg8::StaticOrder, true, true>(lds, g, S, E);
        }
        SEAM(pb + 4);
        REPEAT(5) if (IN(pb + 5)) {
            PHASE_PTRS
            pg8::Gemm g{MG, (const bf16*)(wl + WO_MIX), M, D, D, D, D, 0, 0}; pg8::StaticOrder S; S.init(M, D, G, bx);
            pg8::EpiResBf16 E{XB, nullptr, ALPHA};
            pg8::gemm_phase<pg8::EpiResBf16, pg8::StaticOrder, true, true>(lds, g, S, E);
        }
        SEAM(pb + 5);
        REPEAT(6) if (IN(pb + 6)) { PHASE_PTRS ln_phase<true>(XB, P->in[I_LNMW] + l * D, P->in[I_LNMB] + l * D, XB, nullptr); }
        SEAM(pb + 6);
        REPEAT(7) if (IN(pb + 7)) {
            PHASE_PTRS
            { pg8::Gemm g{XB, (const bf16*)(wl + WO_UP), M, 2 * DFF, D, D, D, 0, 0}; pg8::StaticOrder S; S.init(M, 2 * DFF, G, bx);
              pg8::EpiFfnUp E{(bf16*)R2, P->in[I_CONV] + (size_t)l * 3 * DFF, (float*)(P->ws + WS_HALO), (float*)(P->ws + WS_HALO + HALO_ONE), (float*)(P->ws + WS_HALO + 2 * HALO_ONE), (LAS float*)(lds + LDS_XCH)};
              pg8::gemm_phase<pg8::EpiFfnUp, pg8::StaticOrder, true, true>(lds, g, S, E); }
            if (rep_ == 0) { pg8::Gemm g{XB, (const bf16*)(wl + WO_PG), M, D, D, D, D, 0, 0}; pg8::StaticOrder S; S.init(M, D, G, bx);
              pg8::EpiPleGate E{(bf16*)(P->ws + WS_PPLE)};
              pg8::gemm_phase<pg8::EpiPleGate, pg8::StaticOrder, true, true>(lds, g, S, E); }
        }
        SEAM(pb + 7);
        REPEAT(8) if (IN(pb + 8)) {
            PHASE_PTRS
            pg8::Gemm g{(const bf16*)R2, (const bf16*)(wl + WO_DN), M, D, DFF, DFF, DFF, 0, 0}; pg8::StaticOrder S; S.init(M, D, G, bx);
            { pg8::Unit u; for (int i = 0; S.next(i, u); ++i) ffn_fixup_panel(P, l, u.pm); }
            asm volatile("s_waitcnt vmcnt(0)" ::: "memory"); sync_wg();
            pg8::EpiResBf16 E{XB, (const bf16*)(P->ws + WS_PPLE), ALPHA};
            pg8::gemm_phase<pg8::EpiResBf16, pg8::StaticOrder, true, true>(lds, g, S, E);
        }
        SEAM(pb + 8);
        if (IN(pb + 9)) { PHASE_PTRS ln_phase<true>(XB, P->in[I_LNFW] + l * D, P->in[I_LNFB] + l * D, (l == DEPTH - 1) ? nullptr : XB, (l == DEPTH - 1) ? P->out : nullptr); }
        SEAM(pb + 9);
    }
#undef IN
#undef SEAM
}

extern "C" void kernel_launch(void* const* d_in, const int* in_sizes, int n_in, void* d_out, int out_size, void* d_ws, size_t ws_size, hipStream_t stream) {
    static int grid = 0;
    if (grid == 0) {
        if (n_in != 32 || out_size != M * D || ws_size < WS_END) { fprintf(stderr, "kernel_launch: unexpected shapes (n_in %d, out %d, ws %zu)\n", n_in, out_size, ws_size); grid = -1; return; }
        int dev = 0, cus = 0, per_cu = 0;
        if (hipGetDevice(&dev) != hipSuccess || hipDeviceGetAttribute(&cus, hipDeviceAttributeMultiprocessorCount, dev) != hipSuccess) { grid = -1; return; }
        if (hipFuncSetAttribute((const void*)mega, hipFuncAttributeMaxDynamicSharedMemorySize, LDS_BYTES) != hipSuccess) { fprintf(stderr, "kernel_launch: hipFuncSetAttribute failed\n"); grid = -1; return; }
        if (hipOccupancyMaxActiveBlocksPerMultiprocessor(&per_cu, (const void*)mega, NWAVES * 64, LDS_BYTES) != hipSuccess || per_cu < 1) fprintf(stderr, "kernel_launch: occupancy query reports %d\n", per_cu);
        (void)hipGetLastError();
        grid = cus;
    }
    if (grid < 0) return;
    (void)hipMemsetAsync((char*)d_ws + WS_CTL, 0, CTL_ZERO_BYTES, stream);
    Params p{};
    for (int i = 0; i < 32; ++i) p.in[i] = (const float*)d_in[i];
    p.out = (float*)d_out; p.ws = (unsigned char*)d_ws;
#if ONE_LAUNCH
    p.ph_lo = 0; p.ph_hi = NPH;
    hipLaunchKernelGGL(mega, dim3(grid), dim3(NWAVES * 64), LDS_BYTES, stream, p);
#else
    for (int ph = 0; ph < NPH; ++ph) { p.ph_lo = ph; p.ph_hi = ph + 1; hipLaunchKernelGGL(mega, dim3(grid), dim3(NWAVES * 64), LDS_BYTES, stream, p); }
#endif
}
```

```cpp
#include <hip/hip_runtime.h>
#include <cstdio>
#include <cstdint>
#if defined(__HIP_DEVICE_COMPILE__)
#define NOPK __attribute__((target("no-packed-fp32-ops")))
#else
#define NOPK
#endif

typedef float f32x2g __attribute__((ext_vector_type(2)));
__device__ __forceinline__ NOPK void sync_wg() { __builtin_amdgcn_fence(__ATOMIC_RELEASE, "workgroup"); __builtin_amdgcn_s_barrier(); __builtin_amdgcn_fence(__ATOMIC_ACQUIRE, "workgroup"); }
__device__ __forceinline__ NOPK float u2f(unsigned u) { return __builtin_bit_cast(float, u); }
__device__ __forceinline__ NOPK float shfl_(float v, int src) { return __builtin_bit_cast(float, __builtin_amdgcn_ds_bpermute(src << 2, __builtin_bit_cast(int, v))); }
__device__ __forceinline__ NOPK float shfl_xor_(float v, int m) { const int lane_ = __builtin_amdgcn_mbcnt_hi(~0u, __builtin_amdgcn_mbcnt_lo(~0u, 0u)); return shfl_(v, lane_ ^ m); }
namespace pg8 {
#define PG8_LAS __attribute__((address_space(3)))
typedef unsigned short bf16_t;
typedef short bf16x8 __attribute__((ext_vector_type(8)));
typedef float f32x4 __attribute__((ext_vector_type(4)));
typedef float f32x2 __attribute__((ext_vector_type(2)));
typedef unsigned u32x4 __attribute__((ext_vector_type(4)));
typedef unsigned u32x2 __attribute__((ext_vector_type(2)));
constexpr int BM = 256, BK = 64, HALF = 128, HTB = HALF * BK * 2  , STAGE_BYTES = 8 * HTB, NXCD = 8, WGM = 8;

__host__ __device__ __forceinline__ NOPK int lds_byte(int r, int c) { const int st = (r >> 4) * 2 + (c >> 5), rr = r & 15, cc = c & 31, ob = rr * 64 + cc * 2; return st * 1024 + (ob ^ (((ob >> 9) & 1) << 5)); }
__host__ __device__ __forceinline__ NOPK void stage_rc(int b, int& R, int& C) { const int st = b / 1024, sb = b % 1024, swz = sb ^ (((sb >> 9) & 1) << 5); R = (st >> 1) * 16 + swz / 64; C = (st & 1) * 32 + (swz % 64) / 2; }
__host__ __device__ __forceinline__ NOPK int perm32(int rho) { const int n = rho >> 4, i = rho & 15; return 8 * (i >> 2) + 4 * n + (i & 3); }

struct Unit { int pm, pn; };
struct Gemm { const bf16_t* A; const bf16_t* Bt; int M, N, K, lda, ldb, a_div, a_coloff; };
__device__ __forceinline__ NOPK size_t a_unit_off(const Gemm& g, const Unit& u) { return g.a_div ? (size_t)((u.pn / g.a_div) * g.a_coloff) * 2u : (size_t)0; }

struct StaticOrder {
    int nM, nN, nwg, G, c;
    __host__ __device__ __forceinline__ NOPK void init(int M, int N, int G_, int c_) { nM = M / BM; nN = N / BM; nwg = nM * nN; G = G_; c = c_; }
    __host__ __device__ __forceinline__ NOPK bool next(int i, Unit& u) const {
        const long L = (long)i * G + c; if (L >= nwg) return false;
        int wgid = (int)L; { const int q = nwg / NXCD, r = nwg % NXCD, xcd = wgid % NXCD, off = wgid / NXCD; wgid = (xcd < r ? xcd * (q + 1) : r * (q + 1) + (xcd - r) * q) + off; }
        const int nig = WGM * nN, gid = wgid / nig, fm = gid * WGM, gsz = (nM - fm) < WGM ? (nM - fm) : WGM;
        u.pm = fm + ((wgid % nig) % gsz); u.pn = (wgid % nig) / gsz; return true;
    }
    __device__ __forceinline__ NOPK void a_ready(const Unit&) const {}
    __device__ __forceinline__ NOPK void done(const Unit&) const {}
};

typedef __bf16 bf16x2_t __attribute__((ext_vector_type(2)));
__device__ __forceinline__ NOPK unsigned cvt_pk_bf16(float lo, float hi) { const f32x2 v = {lo, hi}; const bf16x2_t b = __builtin_convertvector(v, bf16x2_t); return __builtin_bit_cast(unsigned, b); }
__device__ __forceinline__ NOPK float bf_lo(unsigned w) { return u2f(w << 16); }
__device__ __forceinline__ NOPK float bf_hi(unsigned w) { return u2f(w & 0xffff0000u); }
__device__ __forceinline__ NOPK float sigmoid_f(float x) { return __builtin_amdgcn_rcpf(1.0f + __builtin_amdgcn_exp2f(-1.44269504089f * x)); }

template <class Epi, class Sched, bool ALIGN_EPI = false, bool SP2 = false>
__device__ __forceinline__ NOPK void gemm_phase(PG8_LAS unsigned char* lds, const Gemm g, const Sched& S, const Epi& E) {
    int tid_o = threadIdx.x; asm volatile("" : "+v"(tid_o));
    const int tid = tid_o, wid = __builtin_amdgcn_readfirstlane(tid >> 6), lane = tid & 63, wr = wid >> 2, wc = wid & 3, fr = lane & 15, fq = lane >> 4;
    const int K = g.K, nt = K / BK;
    unsigned voffA[2], voffB[2];
#pragma unroll
    for (int i = 0; i < 2; ++i) { int R, C; stage_rc(tid * 16 + i * 8192, R, C); const int Rb = Epi::PERM ? ((R & ~31) + perm32(R & 31)) : R;
        voffA[i] = (unsigned)(R * g.lda + C) * 2u; voffB[i] = (unsigned)(Rb * g.ldb + C) * 2u; }
    const size_t kstep = (size_t)(BK * 2);
    const size_t hstepA = (size_t)HALF * g.lda * 2, hstepB = (size_t)HALF * g.ldb * 2;
    const size_t tstepA = 2 * hstepA, tstepB = 2 * hstepB;
    const unsigned ldsw = (unsigned)wid * 1024u;
    const int aoff = lds_byte(wr * 64 + fr, fq * 8), boff = lds_byte(wc * 32 + fr, fq * 8);
#define PG8_SA(b, h) (((b) * 2 + (h)) * HTB)
#define PG8_SB(b, h) ((4 + (b) * 2 + (h)) * HTB)
#define PG8_STAGE(bufoff, gbase, voff) do { _Pragma("unroll") for (int _i = 0; _i < 2; ++_i) \
        __builtin_amdgcn_global_load_lds((const unsigned*)((const char*)(gbase) + (voff)[_i]), (PG8_LAS unsigned*)(lds + (bufoff) + ldsw + _i * 8192), 16, 0, 0); } while (0)
#define PG8_LDA(dst, b, h) do { _Pragma("unroll") for (int m = 0; m < 4; ++m) _Pragma("unroll") for (int k = 0; k < 2; ++k) dst[m][k] = *(const PG8_LAS bf16x8*)(lds + PG8_SA(b, h) + aoff + m * 2048 + k * 1024); } while (0)
#define PG8_LDB(dst, b, h) do { _Pragma("unroll") for (int n = 0; n < 2; ++n) _Pragma("unroll") for (int k = 0; k < 2; ++k) dst[n][k] = *(const PG8_LAS bf16x8*)(lds + PG8_SB(b, h) + boff + n * 2048 + k * 1024); } while (0)
#define PG8_MMA(ai, bj, At, Bt) do { __builtin_amdgcn_s_setprio(1); _Pragma("unroll") for (int m = 0; m < 4; ++m) _Pragma("unroll") for (int n = 0; n < 2; ++n) _Pragma("unroll") for (int k = 0; k < 2; ++k) \
        acc[ai][bj][m][n] = __builtin_amdgcn_mfma_f32_16x16x32_bf16(Bt[n][k], At[m][k], acc[ai][bj][m][n], 0, 0, 0); __builtin_amdgcn_s_setprio(0); } while (0)
#define PG8_WAIT_V(n) asm volatile("s_waitcnt vmcnt(" #n ")" ::: "memory")
#define PG8_WAIT_L(n) asm volatile("s_waitcnt lgkmcnt(" #n ")" ::: "memory")
#define PG8_BAR __builtin_amdgcn_s_barrier()
#define PG8_SCHED __builtin_amdgcn_sched_barrier(0)
    Unit cur, nxt; int ui = 0;
    if (!S.next(0, cur)) return;
    f32x4 acc[2][2][4][2];
#pragma unroll
    for (int a = 0; a < 2; ++a)
#pragma unroll
        for (int b = 0; b < 2; ++b)
#pragma unroll
            for (int m = 0; m < 4; ++m)
#pragma unroll
                for (int n = 0; n < 2; ++n) acc[a][b][m][n] = (f32x4){0.f, 0.f, 0.f, 0.f};
    bf16x8 At[4][2], B0[2][2], B1[2][2];
    const char* cA = (const char*)g.A + (size_t)cur.pm * tstepA + a_unit_off(g, cur); const char* cB = (const char*)g.Bt + (size_t)cur.pn * tstepB;
    S.a_ready(cur);
    if constexpr (SP2) {
        PG8_STAGE(PG8_SB(0, 0), cB, voffB); PG8_STAGE(PG8_SB(0, 1), cB + hstepB, voffB); PG8_STAGE(PG8_SA(0, 0), cA, voffA); PG8_STAGE(PG8_SA(0, 1), cA + hstepA, voffA);
        if (wr == 1) PG8_BAR;
        PG8_WAIT_V(2); PG8_BAR;
        PG8_STAGE(PG8_SB(1, 0), cB + kstep, voffB); PG8_STAGE(PG8_SA(1, 0), cA + kstep, voffA); PG8_STAGE(PG8_SB(1, 1), cB + hstepB + kstep, voffB);
        PG8_WAIT_V(6); PG8_BAR;
    } else {
        PG8_STAGE(PG8_SB(0, 0), cB, voffB); PG8_STAGE(PG8_SA(0, 0), cA, voffA); PG8_STAGE(PG8_SB(0, 1), cB + hstepB, voffB); PG8_STAGE(PG8_SA(0, 1), cA + hstepA, voffA);
        if (wr == 1) PG8_BAR;
        PG8_WAIT_V(4); PG8_BAR;
        PG8_STAGE(PG8_SB(1, 0), cB + kstep, voffB); PG8_STAGE(PG8_SA(1, 0), cA + kstep, voffA); PG8_STAGE(PG8_SB(1, 1), cB + hstepB + kstep, voffB);
        PG8_WAIT_V(6); PG8_BAR;
    }
    for (;;) {
        const bool has_next = S.next(ui + 1, nxt);
        const char* nA = has_next ? (const char*)g.A + (size_t)nxt.pm * tstepA + a_unit_off(g, nxt) : cA; const char* nB = has_next ? (const char*)g.Bt + (size_t)nxt.pn * tstepB : cB;
        for (int t = 0; t < nt; t += 2) {
            const bool last = (t == nt - 2);
            const char* a1 = cA + (size_t)(t + 1) * kstep;
            const char* a2 = last ? nA : cA + (size_t)(t + 2) * kstep; const char* b2 = last ? nB : cB + (size_t)(t + 2) * kstep;
            const char* a3 = a2 + kstep; const char* b3 = b2 + kstep;
            if (last && has_next) S.a_ready(nxt);
            if constexpr (SP2) {
            PG8_LDB(B0, 0, 0); PG8_LDB(B1, 0, 1); PG8_SCHED; PG8_LDA(At, 0, 0); PG8_STAGE(PG8_SA(1, 1), a1 + hstepA, voffA);
            PG8_WAIT_V(8); PG8_WAIT_L(0); PG8_BAR; PG8_MMA(0, 0, At, B0); PG8_MMA(0, 1, At, B1); PG8_BAR; PG8_SCHED;
            PG8_LDA(At, 0, 1); PG8_STAGE(PG8_SB(0, 0), b2, voffB); PG8_STAGE(PG8_SB(0, 1), b2 + hstepB, voffB); PG8_STAGE(PG8_SA(0, 0), a2, voffA);
            PG8_WAIT_V(8); PG8_WAIT_L(0); PG8_BAR; PG8_MMA(1, 0, At, B0); PG8_MMA(1, 1, At, B1); PG8_BAR; PG8_SCHED;
            PG8_LDB(B0, 1, 0); PG8_LDB(B1, 1, 1); PG8_SCHED; PG8_LDA(At, 1, 0); PG8_STAGE(PG8_SA(0, 1), a2 + hstepA, voffA);
            PG8_WAIT_V(8); PG8_WAIT_L(0); PG8_BAR; PG8_MMA(0, 0, At, B0); PG8_MMA(0, 1, At, B1); PG8_BAR; PG8_SCHED;
            PG8_LDA(At, 1, 1); PG8_STAGE(PG8_SB(1, 0), b3, voffB); PG8_STAGE(PG8_SB(1, 1), b3 + hstepB, voffB); PG8_STAGE(PG8_SA(1, 0), a3, voffA);
            PG8_WAIT_V(8); PG8_WAIT_L(0); PG8_BAR; PG8_MMA(1, 0, At, B0); PG8_MMA(1, 1, At, B1); PG8_BAR; PG8_SCHED;
            } else {
            PG8_LDB(B0, 0, 0); PG8_SCHED; PG8_LDA(At, 0, 0); PG8_STAGE(PG8_SA(1, 1), a1 + hstepA, voffA);
            PG8_WAIT_L(8); PG8_BAR; PG8_WAIT_L(0); PG8_MMA(0, 0, At, B0); PG8_BAR; PG8_SCHED;
            PG8_LDB(B1, 0, 1); PG8_STAGE(PG8_SB(0, 0), b2, voffB);
            PG8_BAR; PG8_WAIT_L(0); PG8_MMA(0, 1, At, B1); PG8_BAR;
            PG8_LDA(At, 0, 1); PG8_STAGE(PG8_SA(0, 0), a2, voffA);
            PG8_BAR; PG8_WAIT_L(0); PG8_MMA(1, 0, At, B0); PG8_BAR; PG8_SCHED;
            PG8_STAGE(PG8_SB(0, 1), b2 + hstepB, voffB);
            PG8_WAIT_V(6); PG8_BAR; PG8_MMA(1, 1, At, B1); PG8_BAR;
            PG8_LDB(B0, 1, 0); PG8_SCHED; PG8_LDA(At, 1, 0); PG8_STAGE(PG8_SA(0, 1), a2 + hstepA, voffA);
            PG8_WAIT_L(8); PG8_BAR; PG8_WAIT_L(0); PG8_MMA(0, 0, At, B0); PG8_BAR; PG8_SCHED;
            PG8_LDB(B1, 1, 1); PG8_STAGE(PG8_SB(1, 0), b3, voffB);
            PG8_BAR; PG8_WAIT_L(0); PG8_MMA(0, 1, At, B1); PG8_BAR;
            PG8_LDA(At, 1, 1); PG8_STAGE(PG8_SA(1, 0), a3, voffA);
            PG8_BAR; PG8_WAIT_L(0); PG8_MMA(1, 0, At, B0); PG8_BAR; PG8_SCHED;
            PG8_STAGE(PG8_SB(1, 1), b3 + hstepB, voffB);
            PG8_WAIT_V(6); PG8_BAR; PG8_MMA(1, 1, At, B1); PG8_BAR;
            }
        }
        if constexpr (ALIGN_EPI) { if (wr == 0) PG8_BAR; }
        if constexpr (!Epi::AFTER_DRAIN) { E(acc, cur, wr, wc, fr, fq); S.done(cur); }
        if (!has_next) break;
#pragma unroll
        for (int a = 0; a < 2; ++a)
#pragma unroll
            for (int b = 0; b < 2; ++b)
#pragma unroll
                for (int m = 0; m < 4; ++m)
#pragma unroll
                    for (int n = 0; n < 2; ++n) acc[a][b][m][n] = (f32x4){0.f, 0.f, 0.f, 0.f};
        cur = nxt; cA = nA; cB = nB; ++ui;
        if constexpr (ALIGN_EPI) { if (wr == 1) PG8_BAR; }
    }
    PG8_WAIT_V(0);
    if constexpr (!ALIGN_EPI) { if (wr == 0) PG8_BAR; }
    PG8_BAR;
    if constexpr (Epi::AFTER_DRAIN) { E.fused(acc, cur, wr, wc, fr, fq, lds, wid, lane); S.done(cur); }
#undef PG8_SA
#undef PG8_SB
#undef PG8_STAGE
#undef PG8_LDA
#undef PG8_LDB
#undef PG8_MMA
#undef PG8_WAIT_V
#undef PG8_WAIT_L
#undef PG8_BAR
#undef PG8_SCHED
}


struct EpiStoreBf16 {
    static constexpr bool PERM = true, AFTER_DRAIN = false;
    bf16_t* O; int ldc;
    __device__ __forceinline__ NOPK void operator()(const f32x4 (&acc)[2][2][4][2], const Unit& u, int wr, int wc, int fr, int fq) const {
        const int row0 = u.pm * BM + wr * 64 + fr, col0 = u.pn * BM + wc * 32 + 8 * fq;
#pragma unroll
        for (int ai = 0; ai < 2; ++ai)
#pragma unroll
            for (int m = 0; m < 4; ++m) { bf16_t* rowp = O + (size_t)(row0 + ai * HALF + m * 16) * ldc + col0;
#pragma unroll
                for (int bj = 0; bj < 2; ++bj) { const f32x4 v0 = acc[ai][bj][m][0], v1 = acc[ai][bj][m][1];
                    u32x4 w; w.x = cvt_pk_bf16(v0[0], v0[1]); w.y = cvt_pk_bf16(v0[2], v0[3]); w.z = cvt_pk_bf16(v1[0], v1[1]); w.w = cvt_pk_bf16(v1[2], v1[3]);
                    *(u32x4*)(rowp + bj * HALF) = w; } }
    }
};
struct EpiPleGate {
    static constexpr bool PERM = true, AFTER_DRAIN = false;
    bf16_t* PP;
    __device__ __forceinline__ NOPK void operator()(const f32x4 (&acc)[2][2][4][2], const Unit& u, int wr, int wc, int fr, int fq) const {
        const int row0 = u.pm * BM + wr * 64 + fr, col0 = u.pn * BM + wc * 32 + 8 * fq;
        u32x4 pp[2][4][2];
#pragma unroll
        for (int ai = 0; ai < 2; ++ai)
#pragma unroll
            for (int m = 0; m < 4; ++m) { const bf16_t* rowp = PP + (size_t)(row0 + ai * HALF + m * 16) * 1024 + col0;
#pragma unroll
                for (int bj = 0; bj < 2; ++bj) pp[ai][m][bj] = *(const u32x4*)(rowp + bj * HALF); }
#pragma unroll
        for (int ai = 0; ai < 2; ++ai)
#pragma unroll
            for (int m = 0; m < 4; ++m) { bf16_t* rowp = PP + (size_t)(row0 + ai * HALF + m * 16) * 1024 + col0;
#pragma unroll
                for (int bj = 0; bj < 2; ++bj) { const f32x4 v0 = acc[ai][bj][m][0], v1 = acc[ai][bj][m][1];
                    const u32x4 p = pp[ai][m][bj];
                    u32x4 w;
                    w.x = cvt_pk_bf16(sigmoid_f(v0[0]) * bf_lo(p.x), sigmoid_f(v0[1]) * bf_hi(p.x));
                    w.y = cvt_pk_bf16(sigmoid_f(v0[2]) * bf_lo(p.y), sigmoid_f(v0[3]) * bf_hi(p.y));
                    w.z = cvt_pk_bf16(sigmoid_f(v1[0]) * bf_lo(p.z), sigmoid_f(v1[1]) * bf_hi(p.z));
                    w.w = cvt_pk_bf16(sigmoid_f(v1[2]) * bf_lo(p.w), sigmoid_f(v1[3]) * bf_hi(p.w));
                    *(u32x4*)(rowp + bj * HALF) = w; } }
    }
};
struct EpiMerge {
    static constexpr bool PERM = false, AFTER_DRAIN = false;
    const bf16_t* P; bf16_t* MG;
    __device__ __forceinline__ NOPK void operator()(const f32x4 (&acc)[2][2][4][2], const Unit& u, int wr, int wc, int fr, int fq) const {
        const int row0 = u.pm * BM + wr * 64 + fr, oc = u.pn * 64 + wc * 16 + fq * 4;
        u32x2 pv[2][4][4];
#pragma unroll
        for (int ai = 0; ai < 2; ++ai)
#pragma unroll
            for (int m = 0; m < 4; ++m) { const bf16_t* prow = P + (size_t)(row0 + ai * HALF + m * 16) * 4096 + oc;
#pragma unroll
                for (int b = 0; b < 4; ++b) pv[ai][m][b] = *(const u32x2*)(prow + b * 1024); }
#pragma unroll
        for (int ai = 0; ai < 2; ++ai)
#pragma unroll
            for (int m = 0; m < 4; ++m) { const size_t row = (size_t)(row0 + ai * HALF + m * 16);
                f32x4 s = (f32x4){0.f, 0.f, 0.f, 0.f};
#pragma unroll
                for (int b = 0; b < 4; ++b) { const u32x2 p = pv[ai][m][b]; const f32x4 g = acc[ai][b >> 1][m][b & 1];
                    s[0] += sigmoid_f(g[0]) * bf_lo(p.x); s[1] += sigmoid_f(g[1]) * bf_hi(p.x); s[2] += sigmoid_f(g[2]) * bf_lo(p.y); s[3] += sigmoid_f(g[3]) * bf_hi(p.y); }
                u32x2 w; w.x = cvt_pk_bf16(s[0], s[1]); w.y = cvt_pk_bf16(s[2], s[3]);
                *(u32x2*)(MG + row * 1024 + oc) = w; }
    }
};
struct EpiResF32 {
    static constexpr bool PERM = false, AFTER_DRAIN = false;
    const bf16_t* X; const bf16_t* PLE; float* V; float alpha;
    __device__ __forceinline__ NOPK void operator()(const f32x4 (&acc)[2][2][4][2], const Unit& u, int wr, int wc, int fr, int fq) const {
        const int row0 = u.pm * BM + wr * 64 + fr, col0 = u.pn * BM + wc * 32 + 4 * fq;
#pragma unroll
        for (int ai = 0; ai < 2; ++ai) {
            u32x2 xv[4][2][2], pv[4][2][2];
#pragma unroll
            for (int m = 0; m < 4; ++m) { const size_t off = (size_t)(row0 + ai * HALF + m * 16) * 1024 + col0;
#pragma unroll
                for (int bj = 0; bj < 2; ++bj)
#pragma unroll
                    for (int n = 0; n < 2; ++n) { const size_t o = off + bj * HALF + n * 16; xv[m][bj][n] = *(const u32x2*)(X + o); if (PLE) pv[m][bj][n] = *(const u32x2*)(PLE + o); else pv[m][bj][n] = (u32x2){0u, 0u}; } }
#pragma unroll
            for (int m = 0; m < 4; ++m) { const size_t off = (size_t)(row0 + ai * HALF + m * 16) * 1024 + col0;
#pragma unroll
                for (int bj = 0; bj < 2; ++bj)
#pragma unroll
                    for (int n = 0; n < 2; ++n) { const size_t o = off + bj * HALF + n * 16; const u32x2 x2 = xv[m][bj][n], p2 = pv[m][bj][n];
                        f32x4 r = acc[ai][bj][m][n];
                        r[0] += alpha * bf_lo(x2.x) + bf_lo(p2.x); r[1] += alpha * bf_hi(x2.x) + bf_hi(p2.x); r[2] += alpha * bf_lo(x2.y) + bf_lo(p2.y); r[3] += alpha * bf_hi(x2.y) + bf_hi(p2.y);
                        *(f32x4*)(V + o) = r; } } }
    }
};
struct EpiResBf16 {
    static constexpr bool PERM = true, AFTER_DRAIN = false;
    bf16_t* X; const bf16_t* PLE; float alpha;
    __device__ __forceinline__ NOPK void operator()(const f32x4 (&acc)[2][2][4][2], const Unit& u, int wr, int wc, int fr, int fq) const {
        const int row0 = u.pm * BM + wr * 64 + fr, col0 = u.pn * BM + wc * 32 + 8 * fq;
#pragma unroll
        for (int ai = 0; ai < 2; ++ai) {
            u32x4 xv[4][2], pv[4][2];
#pragma unroll
            for (int m = 0; m < 4; ++m) { const size_t off = (size_t)(row0 + ai * HALF + m * 16) * 1024 + col0;
#pragma unroll
                for (int bj = 0; bj < 2; ++bj) { xv[m][bj] = *(const u32x4*)(X + off + bj * HALF); if (PLE) pv[m][bj] = *(const u32x4*)(PLE + off + bj * HALF); else pv[m][bj] = (u32x4){0u, 0u, 0u, 0u}; } }
#pragma unroll
            for (int m = 0; m < 4; ++m) { const size_t off = (size_t)(row0 + ai * HALF + m * 16) * 1024 + col0;
#pragma unroll
                for (int bj = 0; bj < 2; ++bj) { const f32x4 v0 = acc[ai][bj][m][0], v1 = acc[ai][bj][m][1]; const u32x4 x4 = xv[m][bj], p4 = pv[m][bj];
                    u32x4 w;
                    w.x = cvt_pk_bf16(v0[0] + alpha * bf_lo(x4.x) + bf_lo(p4.x), v0[1] + alpha * bf_hi(x4.x) + bf_hi(p4.x));
                    w.y = cvt_pk_bf16(v0[2] + alpha * bf_lo(x4.y) + bf_lo(p4.y), v0[3] + alpha * bf_hi(x4.y) + bf_hi(p4.y));
                    w.z = cvt_pk_bf16(v1[0] + alpha * bf_lo(x4.z) + bf_lo(p4.z), v1[1] + alpha * bf_hi(x4.z) + bf_hi(p4.z));
                    w.w = cvt_pk_bf16(v1[2] + alpha * bf_lo(x4.w) + bf_lo(p4.w), v1[3] + alpha * bf_hi(x4.w) + bf_hi(p4.w));
                    *(u32x4*)(X + off + bj * HALF) = w; } } }
    }
};
__device__ __forceinline__ NOPK float gelu_tanh_f(float x) {
    const float inner = x * (0.7978845608f + 0.0356774081f * x * x);
    return x * __builtin_amdgcn_rcpf(1.0f + __builtin_amdgcn_exp2f(-2.885390082f * inner));
}
struct EpiFfnUp {
    static constexpr bool PERM = false, AFTER_DRAIN = false;
    bf16_t* ACT; const float* conv; float* uhead; float* vhead; float* utail; PG8_LAS float* xch;
    __device__ __forceinline__ NOPK void operator()(const f32x4 (&acc)[2][2][4][2], const Unit& u, int wr, int wc, int fr, int fq) const {
        const int lane = threadIdx.x & 63;
        const int cc0 = wc * 32 + 4 * fq, colg = u.pn * 128 + cc0;
        f32x4 c0[2], c1[2], c2[2];
#pragma unroll
        for (int n = 0; n < 2; ++n) { c0[n] = *(const f32x4*)(conv + colg + 16 * n); c1[n] = *(const f32x4*)(conv + 2816 + colg + 16 * n); c2[n] = *(const f32x4*)(conv + 2 * 2816 + colg + 16 * n); }
        if (fr >= 14) {
#pragma unroll
            for (int ai = 0; ai < 2; ++ai)
#pragma unroll
                for (int n = 0; n < 2; ++n) *(PG8_LAS f32x4*)(xch + ((2 * ai + wr) * 2 + (fr - 14)) * 128 + cc0 + 16 * n) = acc[ai][0][3][n];
            if (wr == 1) {
#pragma unroll
                for (int n = 0; n < 2; ++n) *(f32x4*)(utail + ((size_t)u.pm * 2 + (fr - 14)) * 2816 + colg + 16 * n) = acc[1][0][3][n];
            }
        }
        if (wr == 0 && fr < 2) {
#pragma unroll
            for (int n = 0; n < 2; ++n) { *(f32x4*)(uhead + ((size_t)u.pm * 2 + fr) * 2816 + colg + 16 * n) = acc[0][0][0][n];
                                          *(f32x4*)(vhead + ((size_t)u.pm * 2 + fr) * 2816 + colg + 16 * n) = acc[0][1][0][n]; }
        }
        asm volatile("s_waitcnt lgkmcnt(0)" ::: "memory"); __builtin_amdgcn_s_barrier(); asm volatile("" ::: "memory");
        const int src1 = (lane & 48) | ((fr + 15) & 15), src2 = (lane & 48) | ((fr + 14) & 15);
#pragma unroll
        for (int ai = 0; ai < 2; ++ai)
#pragma unroll
            for (int m = 0; m < 4; ++m) { const size_t row = (size_t)(u.pm * BM + ai * HALF + wr * 64 + m * 16 + fr);
#pragma unroll
                for (int n = 0; n < 2; ++n) {
                    const f32x4 cur = acc[ai][0][m][n];
                    f32x4 e1, e2, r1, r2;
                    if (m > 0) { const f32x4 pg = acc[ai][0][m > 0 ? m - 1 : 0][n];
#pragma unroll
                        for (int j = 0; j < 4; ++j) { e1[j] = shfl_(pg[j], src1); e2[j] = shfl_(pg[j], src2); } }
                    else { const int rb = 2 * ai + wr;
                        if (rb > 0) { const f32x4 x62 = *(const PG8_LAS f32x4*)(xch + ((rb - 1) * 2 + 0) * 128 + cc0 + 16 * n), x63 = *(const PG8_LAS f32x4*)(xch + ((rb - 1) * 2 + 1) * 128 + cc0 + 16 * n);
                            e1 = x63; e2 = (fr == 0) ? x62 : x63; }
                        else { e1 = (f32x4){0.f, 0.f, 0.f, 0.f}; e2 = e1; } }
#pragma unroll
                    for (int j = 0; j < 4; ++j) { r1[j] = shfl_(cur[j], src1); r2[j] = shfl_(cur[j], src2); }
                    const f32x4 p1 = (fr >= 1) ? r1 : e1, p2 = (fr >= 2) ? r2 : e2;
                    const f32x4 cv = c2[n] * cur + c1[n] * p1 + c0[n] * p2;
                    const f32x4 vv = acc[ai][1][m][n];
                    u32x2 w; w.x = cvt_pk_bf16(gelu_tanh_f(cv[0]) * vv[0], gelu_tanh_f(cv[1]) * vv[1]); w.y = cvt_pk_bf16(gelu_tanh_f(cv[2]) * vv[2], gelu_tanh_f(cv[3]) * vv[3]);
                    *(u32x2*)(ACT + row * 2816 + colg + 16 * n) = w; } }
    }
};
}

constexpr int D = 1024, BATCH = 16, SEQ = 2048, DEPTH = 2, M = BATCH * SEQ;
constexpr int NMIX = 3600, NMIXP = 3840, NMIXG = 3584  , NIN = 7696, DFF = 2816, PLE = 256, NCHUNK = SEQ / 64;
constexpr float ALPHA = 1.41421356237f;
constexpr float LN_EPS = 1e-5f;
constexpr int NWAVES = 8;
#ifndef ONE_LAUNCH
#define ONE_LAUNCH 1
#endif

constexpr size_t MiB = 1u << 20;
constexpr size_t WS_CTL = 0, CTL_ZERO_BYTES = 1 * MiB;
constexpr size_t WS_W = 1 * MiB, W_LAYER = 39 * MiB;
constexpr size_t WO_IN = 0, WO_G = 15 * MiB / 2, WO_B = 31 * MiB / 2, WO_MIX = 35 * MiB / 2, WO_UP = 39 * MiB / 2, WO_DN = 61 * MiB / 2, WO_PG = 36 * MiB, WO_PP = 38 * MiB;
constexpr size_t WS_PB = 79 * MiB;
constexpr size_t WS_XB = 111 * MiB;
constexpr size_t WS_R2 = 175 * MiB;
constexpr size_t R2_PPLE = 176 * MiB;
constexpr size_t WS_ROPE = 431 * MiB;
constexpr size_t WS_HALO = 432 * MiB, HALO_ONE = (size_t)128 * 2 * DFF * 4;
constexpr size_t WS_RST = 442 * MiB;
constexpr size_t WS_PPLE = 444 * MiB;
constexpr size_t WS_END = 508 * MiB;
static_assert(WS_HALO + 3 * HALO_ONE <= WS_END && WS_R2 + 256 * MiB <= WS_ROPE, "ws map");
constexpr int CW_BAR = 4096;

constexpr int LDS_BYTES = 163840;
constexpr int LDS_XCH = 131072;
constexpr int LDS_MISC = 163840 - 256;

#define LAS __attribute__((address_space(3)))
typedef unsigned short bf16;
typedef float f32x4 __attribute__((ext_vector_type(4)));
typedef unsigned v4u __attribute__((ext_vector_type(4)));
typedef unsigned v2u __attribute__((ext_vector_type(2)));
#define LDS_WAIT() asm volatile("s_waitcnt lgkmcnt(0)" ::: "memory")
using pg8::cvt_pk_bf16; using pg8::bf_lo; using pg8::bf_hi; using pg8::sigmoid_f;

#define XB_TMO      128
#define XB_XCNT(j)  (256  + 64 * (j))
#define XB_XSUB(j)  (1280 + 64 * (j))
#define XB_XGEN(j)  (2304 + 64 * (j))
#define XB_TOP      3328
#define XB_TOPGEN   3392
#define XCD_BAR_WORDS 3456
#define XB_SPIN_CAP (1u << 18)
__device__ __forceinline__ NOPK unsigned xb_ld(unsigned* p)              { return __hip_atomic_load(p, __ATOMIC_RELAXED, __HIP_MEMORY_SCOPE_AGENT); }
__device__ __forceinline__ NOPK unsigned xb_add(unsigned* p, unsigned v) { return __hip_atomic_fetch_add(p, v, __ATOMIC_RELAXED, __HIP_MEMORY_SCOPE_AGENT); }
__device__ __forceinline__ NOPK unsigned xb_xcc_id() { return (unsigned)__builtin_amdgcn_s_getreg((3 << 11) | 20) & 0xFu; }
#define XB_SPIN(cond, bar) do { unsigned _sp = 0; while (cond) { __builtin_amdgcn_s_sleep(1); \
    if ((++_sp & 255u) == 0u) { if (xb_ld(&(bar)[XB_TMO])) break; if (_sp > XB_SPIN_CAP) { (void)xb_add(&(bar)[XB_TMO], 1u); break; } } } } while (0)
struct XcdBarrier { unsigned* bar; unsigned x; volatile LAS unsigned* st; };
__device__ __forceinline__ NOPK XcdBarrier xcd_barrier_post(unsigned* bar, volatile LAS unsigned* st) {
    XcdBarrier b; b.bar = bar; b.x = xb_xcc_id(); b.st = st;
    if (threadIdx.x == 0) (void)xb_add(&bar[XB_XCNT(b.x)], 1u);
    return b;
}
__device__ __forceinline__ NOPK void xcd_barrier_complete(unsigned* bar, unsigned x, unsigned& nloc, unsigned& nx) {
    const unsigned G = gridDim.x * gridDim.y * gridDim.z;
    unsigned sum, cnt, mine, sp = 0u;
    for (;;) {
        sum = 0u; cnt = 0u; mine = 0u;
#pragma unroll
        for (unsigned j = 0; j < 16; ++j) { const unsigned c = xb_ld(&bar[XB_XCNT(j)]); sum += c; cnt += (c > 0u) ? 1u : 0u; mine = (j == x) ? c : mine; }
        if (sum == G) break;
        __builtin_amdgcn_s_sleep(1);
        if ((++sp & 255u) == 0u) { if (xb_ld(&bar[XB_TMO])) break; if (sp > XB_SPIN_CAP) { (void)xb_add(&bar[XB_TMO], 1u); break; } }
    }
    nloc = mine > 0u ? mine : 1u; nx = cnt > 0u ? cnt : 1u;
}
__device__ __forceinline__ NOPK void xcd_barrier(const XcdBarrier& b) {
    asm volatile("s_waitcnt vmcnt(0)" ::: "memory");
    sync_wg();
    if (threadIdx.x == 0) {
        unsigned* bar = b.bar;
        __builtin_amdgcn_s_waitcnt(0);
        unsigned nloc = b.st[0], nx = b.st[1];
        if (nloc == 0u) { xcd_barrier_complete(bar, b.x, nloc, nx); b.st[0] = nloc; b.st[1] = nx; }
        const unsigned old = xb_add(&bar[XB_XSUB(b.x)], 1u);
        const unsigned gen = old / nloc;
        if (old + 1u == (gen + 1u) * nloc) {
            __builtin_amdgcn_fence(__ATOMIC_RELEASE, "agent");
            asm volatile("s_waitcnt vmcnt(0)" ::: "memory");
            const unsigned og = xb_add(&bar[XB_TOP], 1u);
            const unsigned tg = og / nx;
            if (og + 1u == (tg + 1u) * nx) xb_add(&bar[XB_TOPGEN], 1u);
            else XB_SPIN(xb_ld(&bar[XB_TOPGEN]) == tg, bar);
            __builtin_amdgcn_fence(__ATOMIC_ACQUIRE, "agent");
            xb_add(&bar[XB_XGEN(b.x)], 1u);
            asm volatile("s_waitcnt vmcnt(0)" ::: "memory");
        } else {
            XB_SPIN(xb_ld(&bar[XB_XGEN(b.x)]) == gen, bar);
            __builtin_amdgcn_fence(__ATOMIC_ACQUIRE, "agent");
            asm volatile("s_waitcnt vmcnt(0)" ::: "memory");
        }
    }
    sync_wg();
}

struct Params {
    const float* in[32];
    float* out; unsigned char* ws;
    int ph_lo, ph_hi;
};
enum { I_X = 0, I_P, I_LNINW, I_LNINB, I_WIN, I_MU, I_W0, I_W2, I_A0, I_A2, I_G2, I_KK, I_KA, I_RK, I_RLNW, I_RLNB, I_GLAW2, I_GLAB, I_GLANW, I_HLB, I_HNW,
       I_WBR, I_WMIX, I_LNMW, I_LNMB, I_WUP, I_CONV, I_WDN, I_WPG, I_WPP, I_LNFW, I_LNFB };

typedef const __attribute__((address_space(4))) Params* KP;
__device__ __forceinline__ NOPK KP kparams() { KP p = (KP)__builtin_amdgcn_kernarg_segment_ptr(); asm volatile("" : "+s"(p)); return p; }
__device__ __forceinline__ NOPK float wave_sum(float v) {
#pragma unroll
    for (int o = 1; o < 64; o <<= 1) v += shfl_xor_(v, o);
    return v;
}
__device__ __forceinline__ NOPK int opaque_tid() { int t = threadIdx.x; asm volatile("" : "+v"(t)); return t; }
__device__ __forceinline__ NOPK float red8(float v) { v += shfl_xor_(v, 1); v += shfl_xor_(v, 2); v += shfl_xor_(v, 4); return v; }

__constant__ double ROPE_THETA[16] = {1.0, 0.5411695265464637, 0.2928644564625237, 0.15848931924611134, 0.08576958985908942, 0.046415888336127795, 0.025118864315095794, 0.013593563908785255, 0.007356422544596414, 0.003981071705534973, 0.0021544346900318843, 0.0011659144011798323, 0.000630957344480193, 0.0003414548873833601, 0.00018478497974222906, 0.0001};
__device__ __forceinline__ NOPK int map_row(int mode, int c) {
    if (mode == 1) { const int b = c >> 10, of = c & 1023, pn = of >> 6, oc = of & 63; return 256 * pn + 128 * (b >> 1) + 32 * (oc >> 4) + 16 * (b & 1) + (oc & 15); }
    if (mode == 2) { return c < DFF ? 256 * (c >> 7) + (c & 127) : 256 * ((c - DFF) >> 7) + 128 + ((c - DFF) & 127); }
    return c;
}
__device__ __forceinline__ NOPK void cvt_item(const float* W, int K, int srcld, int c0, int cnt, bf16* dst, int mode, LAS float* scr, int item, int lane) {
    const int nblk = (cnt + 31) / 32, kb = item / nblk, nb = item % nblk, k0 = 64 * kb, n0 = 32 * nb;
    const bool okr = (n0 + (lane & 31)) < cnt;
    float xin[32];
#pragma unroll
    for (int i = 0; i < 32; ++i) { const int kk = 2 * i + (lane >> 5); xin[i] = okr ? W[(size_t)(k0 + kk) * srcld + c0 + n0 + (lane & 31)] : 0.f; }
#pragma unroll
    for (int i = 0; i < 32; ++i) { const int kk = 2 * i + (lane >> 5); scr[kk * 33 + (lane & 31)] = xin[i]; }
    LDS_WAIT(); asm volatile("" ::: "memory");
    const int c = lane & 7;
#pragma unroll
    for (int j = 0; j < 4; ++j) { const int n = (lane >> 3) + 8 * j; const LAS float* s = scr + (8 * c) * 33 + n;
        v4u o; o.x = cvt_pk_bf16(s[0 * 33], s[1 * 33]); o.y = cvt_pk_bf16(s[2 * 33], s[3 * 33]); o.z = cvt_pk_bf16(s[4 * 33], s[5 * 33]); o.w = cvt_pk_bf16(s[6 * 33], s[7 * 33]);
        if (n0 + n < cnt) *(v4u*)(dst + (size_t)map_row(mode, n0 + n) * K + k0 + 8 * c) = o; }
    LDS_WAIT(); asm volatile("" ::: "memory");
}
struct CvtJob { const float* W; int K, srcld, c0, cnt, mode; bf16* dst; int items; };
__device__ __forceinline__ NOPK CvtJob get_job(KP P, int j) {
    const int l = j / 11, k = j % 11; unsigned char* wl = P->ws + WS_W + (size_t)l * W_LAYER; CvtJob J;
    if (k == 0)      { J.W = P->in[I_WIN] + (size_t)l * D * NIN; J.K = D; J.srcld = NIN; J.c0 = 0; J.cnt = NMIX; J.mode = 0; J.dst = (bf16*)(wl + WO_IN); }
    else if (k == 1) { J.W = P->in[I_WIN] + (size_t)l * D * NIN; J.K = D; J.srcld = NIN; J.c0 = NMIX; J.cnt = 4096; J.mode = 1; J.dst = (bf16*)(wl + WO_G); }
    else if (k < 6)  { const int b = k - 2; J.W = P->in[I_WBR] + (size_t)(l * 4 + b) * 256 * D; J.K = 256; J.srcld = D; J.c0 = 0; J.cnt = D; J.mode = 0; J.dst = (bf16*)(wl + WO_B) + (size_t)b * D * 256; }
    else if (k == 6) { J.W = P->in[I_WMIX] + (size_t)l * D * D; J.K = D; J.srcld = D; J.c0 = 0; J.cnt = D; J.mode = 0; J.dst = (bf16*)(wl + WO_MIX); }
    else if (k == 7) { J.W = P->in[I_WUP] + (size_t)l * D * 2 * DFF; J.K = D; J.srcld = 2 * DFF; J.c0 = 0; J.cnt = 2 * DFF; J.mode = 2; J.dst = (bf16*)(wl + WO_UP); }
    else if (k == 8) { J.W = P->in[I_WDN] + (size_t)l * DFF * D; J.K = DFF; J.srcld = D; J.c0 = 0; J.cnt = D; J.mode = 0; J.dst = (bf16*)(wl + WO_DN); }
    else if (k == 9) { J.W = P->in[I_WPG] + (size_t)l * D * D; J.K = D; J.srcld = D; J.c0 = 0; J.cnt = D; J.mode = 0; J.dst = (bf16*)(wl + WO_PG); }
    else             { J.W = P->in[I_WPP] + (size_t)l * PLE * D; J.K = PLE; J.srcld = D; J.c0 = 0; J.cnt = D; J.mode = 0; J.dst = (bf16*)(wl + WO_PP); }
    J.items = (J.K / 64) * ((J.cnt + 31) / 32);
    return J;
}
template <int NR, bool SRCBF>
__device__ __forceinline__ NOPK void ln_rows(const void* xsrc, const float* w, const float* b, bf16* o0, float* f0, int lane) {
    f32x4 v[NR][4];
    if (SRCBF) { v2u t[NR][4];
#pragma unroll
        for (int r = 0; r < NR; ++r)
#pragma unroll
            for (int j = 0; j < 4; ++j) t[r][j] = ((const v2u*)((const bf16*)xsrc + (size_t)r * D))[lane + 64 * j];
#pragma unroll
        for (int r = 0; r < NR; ++r)
#pragma unroll
            for (int j = 0; j < 4; ++j) v[r][j] = (f32x4){u2f(t[r][j].x << 16), u2f(t[r][j].x & 0xffff0000u), u2f(t[r][j].y << 16), u2f(t[r][j].y & 0xffff0000u)};
    } else {
#pragma unroll
        for (int r = 0; r < NR; ++r)
#pragma unroll
            for (int j = 0; j < 4; ++j) v[r][j] = ((const f32x4*)((const float*)xsrc + (size_t)r * D))[lane + 64 * j];
    }
    f32x4 wv[4], bv[4];
#pragma unroll
    for (int j = 0; j < 4; ++j) { wv[j] = ((const f32x4*)w)[lane + 64 * j]; bv[j] = ((const f32x4*)b)[lane + 64 * j]; }
#pragma unroll
    for (int r = 0; r < NR; ++r) { float s = 0.f;
#pragma unroll
        for (int j = 0; j < 4; ++j) s += (v[r][j].x + v[r][j].y) + (v[r][j].z + v[r][j].w);
        const float mean = wave_sum(s) * (1.f / D); float q = 0.f;
#pragma unroll
        for (int j = 0; j < 4; ++j) { v[r][j] = v[r][j] - mean; q += (v[r][j].x * v[r][j].x + v[r][j].y * v[r][j].y) + (v[r][j].z * v[r][j].z + v[r][j].w * v[r][j].w); }
        const float rstd = 1.f / sqrtf(wave_sum(q) * (1.f / D) + LN_EPS);
#pragma unroll
        for (int j = 0; j < 4; ++j) { const f32x4 a = v[r][j] * rstd * wv[j] + bv[j];
            if (o0) { v2u pk; pk.x = cvt_pk_bf16(a.x, a.y); pk.y = cvt_pk_bf16(a.z, a.w); ((v2u*)(o0 + (size_t)r * D))[lane + 64 * j] = pk; }
            if (f0) ((f32x4*)(f0 + (size_t)r * D))[lane + 64 * j] = a; } }
}
template <bool SRCBF>
__device__ __forceinline__ NOPK void ln_phase(const void* V, const float* w, const float* b, bf16* XB, float* OUTF) {
    const int tid = opaque_tid(), lane = tid & 63, gw = blockIdx.x * NWAVES + (tid >> 6), NGW = gridDim.x * NWAVES;
    for (int m = 4 * gw; m < M; m += 4 * NGW)
        ln_rows<4, SRCBF>(SRCBF ? (const void*)((const bf16*)V + (size_t)m * D) : (const void*)((const float*)V + (size_t)m * D), w, b, XB ? XB + (size_t)m * D : nullptr, OUTF ? OUTF + (size_t)m * D : nullptr, lane);
}
__device__ __forceinline__ NOPK void prep_layers(KP P, LAS unsigned char* lds, int l0, int l1, int wk, int nwk) {
    const int tid = opaque_tid(), lane = tid & 63, wave = __builtin_amdgcn_readfirstlane(tid >> 6);
    LAS float* scr = (LAS float*)(lds + wave * 16384);
    const int gw = wk * NWAVES + wave, NGW = nwk * NWAVES;
    const int gt = wk * (NWAVES * 64) + tid, NGT = nwk * NWAVES * 64;
    int total = 0;
    for (int j = 11 * l0; j < 11 * l1; ++j) total += get_job(P, j).items;
    for (int it = gw; it < total; it += NGW) {
        int r = it, j = 11 * l0; CvtJob J = get_job(P, j);
        while (r >= J.items) { r -= J.items; ++j; J = get_job(P, j); }
        cvt_item(J.W, J.K, J.srcld, J.c0, J.cnt, J.dst, J.mode, scr, r, lane);
    }
    { const f32x4* ps = (const f32x4*)P->in[I_P] + (size_t)l0 * M * PLE / 4; v2u* pd = (v2u*)(P->ws + WS_PB) + (size_t)l0 * M * PLE / 4;
        const size_t NP4 = (size_t)(l1 - l0) * M * PLE / 4;
        for (size_t i = gt; i < NP4; i += (size_t)4 * NGT) { f32x4 v[4];
#pragma unroll
            for (int q = 0; q < 4; ++q) if (i + (size_t)q * NGT < NP4) v[q] = ps[i + (size_t)q * NGT];
#pragma unroll
            for (int q = 0; q < 4; ++q) if (i + (size_t)q * NGT < NP4) { v2u o; o.x = cvt_pk_bf16(v[q].x, v[q].y); o.y = cvt_pk_bf16(v[q].z, v[q].w); pd[i + (size_t)q * NGT] = o; } } }
}
__device__ __forceinline__ NOPK void prologue(KP P, LAS unsigned char* lds) {
    const int tid = opaque_tid();
    const int gt = blockIdx.x * (NWAVES * 64) + tid, NGT = gridDim.x * NWAVES * 64;
    prep_layers(P, lds, 0, (DEPTH > 1) ? 1 : DEPTH, blockIdx.x, gridDim.x);
    { f32x2g* rt = (f32x2g*)(P->ws + WS_ROPE);
        for (int i = gt; i < SEQ * 16; i += NGT) { const int t = i >> 4, k = i & 15; const double a = (double)t * ROPE_THETA[k];
            const double n = __builtin_rint(a * 0.15915494309189535); const double r = a - n * 6.283185307179586, r2 = r * r;
            double ts = r, ss = r, tc = 1.0, sc = 1.0;
            for (int q = 1; q <= 14; ++q) { tc *= -r2 / (double)((2 * q - 1) * (2 * q)); sc += tc; ts *= -r2 / (double)((2 * q) * (2 * q + 1)); ss += ts; }
            rt[i] = (f32x2g){(float)sc, (float)ss}; } }
    ln_phase<false>(P->in[I_X], P->in[I_LNINW], P->in[I_LNINB], (bf16*)(P->ws + WS_XB), nullptr);
}

#ifndef REP_PREP
#define REP_PREP 1
#endif
#ifndef REP_REC
#define REP_REC 1
#endif

__device__ __forceinline__ NOPK void ld8(const bf16* p, float (&o)[8]) { const v4u w = *(const v4u*)p; o[0] = bf_lo(w.x); o[1] = bf_hi(w.x); o[2] = bf_lo(w.y); o[3] = bf_hi(w.y); o[4] = bf_lo(w.z); o[5] = bf_hi(w.z); o[6] = bf_lo(w.w); o[7] = bf_hi(w.w); }
__device__ __forceinline__ NOPK void st8(bf16* p, const float (&o)[8]) { v4u w; w.x = cvt_pk_bf16(o[0], o[1]); w.y = cvt_pk_bf16(o[2], o[3]); w.z = cvt_pk_bf16(o[4], o[5]); w.w = cvt_pk_bf16(o[6], o[7]); *(v4u*)p = w; }
__device__ __forceinline__ NOPK float sigmoid_acc(float x) { return __builtin_amdgcn_rcpf(1.0f + __expf(-x)); }
__device__ __forceinline__ NOPK float tanh_fast(float x) { return 2.0f * __builtin_amdgcn_rcpf(1.0f + __expf(-2.0f * x)) - 1.0f; }

typedef short bf16x8v __attribute__((ext_vector_type(8)));
#define SWZ(r, c) ((r) * 64 + ((((c) >> 3) ^ ((r) & 7)) << 3) + ((c) & 7))
__device__ __forceinline__ NOPK bf16x8v frag64(const LAS bf16* arr, int row, int ch) { return *(const LAS bf16x8v*)(arr + row * 64 + ((ch ^ (row & 7)) << 3)); }
template <int MX>
__device__ __forceinline__ NOPK void linattn_fast(LAS unsigned char* lds, KP P, int layer, int b, int h) {
    constexpr int DK = (MX == 3) ? 64 : 32, NDT = DK / 16, NKS = DK / 32, QN = DK / 8;
    asm volatile("" : "+s"(h), "+s"(b));
    const int tid = opaque_tid(), lane = tid & 63, wave = __builtin_amdgcn_readfirstlane(tid >> 6), fr = lane & 15, fq = lane >> 4;
    LAS float* slg = (LAS float*)lds;
    LAS bf16* sQ = (LAS bf16*)(lds + 16384); LAS bf16* sK = (LAS bf16*)(lds + 24576); LAS bf16* sKT = (LAS bf16*)(lds + 32768); LAS bf16* sVT = (LAS bf16*)(lds + 40960);
    LAS bf16* sP = (LAS bf16*)(lds + 49152); LAS bf16* sST = (LAS bf16*)(lds + 57344); LAS bf16* sG = (LAS bf16*)(lds + 65536);
    LAS float* sw2 = (LAS float*)(lds + 73728); LAS float* sbb = sw2 + 512;
    const bf16* Z = (const bf16*)(P->ws + WS_R2);
    bf16* O = (bf16*)P->out;
    const int t8 = tid >> 3, e0 = (tid & 7) * 8, dd0 = (tid & 7) * QN;
    constexpr int zbase = (MX == 0) ? 0 : (MX == 2) ? 1792 : 2576;
    constexpr int qcol = 0, kcol = (MX == 3) ? 256 : 128, vcol = (MX == 3) ? 512 : 256, gcol = (MX == 0) ? 512 : (MX == 2) ? 528 : 768;
    const float lgam = (MX == 0) ? logf(1.0f - exp2f(-5.0f - (float)h)) : 0.f;
    sync_wg();
    if (MX == 2) { sw2[tid] = P->in[I_GLAW2][(size_t)layer * 16 * 128 + (tid >> 5) * 128 + h * 32 + (tid & 31)]; if (tid < 32) sbb[tid] = P->in[I_GLAB][layer * 128 + h * 32 + tid]; sync_wg(); }
    float lbv[8];
#pragma unroll
    for (int i = 0; i < 8; ++i) { lbv[i] = 0.f; if (MX == 3 && layer > 0) lbv[i] = sigmoid_acc(P->in[I_HLB][256 + h * 64 + e0 + i] - P->in[I_HLB][h * 64 + e0 + i]); }
    float nw[16];
#pragma unroll
    for (int i = 0; i < 16; ++i) { const int e = 16 * (i >> 2) + 4 * fq + (i & 3); nw[i] = (MX == 2) ? P->in[I_GLANW][layer * 64 + e] : (MX == 3) ? P->in[I_HNW][layer * 64 + e] : 1.f; }
    f32x4 S[NDT];
#pragma unroll
    for (int i = 0; i < NDT; ++i) S[i] = (f32x4){0.f, 0.f, 0.f, 0.f};
#pragma unroll 1
    for (int c = 0; c < NCHUNK; ++c) {
        const size_t rowbase = (size_t)b * SEQ + c * 64;
        const bf16* zr = Z + (rowbase + t8) * NMIXP + zbase;
        float qr[QN], kr[QN];
        { const v4u vw = *(const v4u*)(zr + vcol + h * 64 + e0);
          const unsigned vv[4] = {vw.x, vw.y, vw.z, vw.w};
#pragma unroll
          for (int i = 0; i < 4; ++i) { sVT[SWZ(e0 + 2 * i, t8)] = (bf16)(vv[i] & 0xffffu); sVT[SWZ(e0 + 2 * i + 1, t8)] = (bf16)(vv[i] >> 16); }
          *(LAS v4u*)(sG + SWZ(t8, e0)) = *(const v4u*)(zr + gcol + h * 64 + e0); }
        if (MX == 3) {
            float a[8], f[8]; ld8(zr + qcol + h * 64 + e0, a); ld8(zr + kcol + h * 64 + e0, f);
#pragma unroll
            for (int i = 0; i < 8; ++i) { qr[i] = a[i]; const float ff = lbv[i] + (1.f - lbv[i]) * sigmoid_acc(f[i]); kr[i] = (1.f - lbv[i]) * sigmoid_acc(-f[i]); slg[t8 * 64 + e0 + i] = logf(ff); }
        } else {
            const v2u qw = *(const v2u*)(zr + qcol + h * 32 + dd0), kw = *(const v2u*)(zr + kcol + h * 32 + dd0);
            float q4[4] = {bf_lo(qw.x), bf_hi(qw.x), bf_lo(qw.y), bf_hi(qw.y)}, k4[4] = {bf_lo(kw.x), bf_hi(kw.x), bf_lo(kw.y), bf_hi(kw.y)};
            if (MX == 0) { const f32x2g* rope = (const f32x2g*)(P->ws + WS_ROPE) + (c * 64 + t8) * 16 + (dd0 >> 1);
#pragma unroll
                for (int p2 = 0; p2 < 2; ++p2) { const f32x2g cs = rope[p2]; const float q1 = q4[2 * p2], q2 = q4[2 * p2 + 1], k1 = k4[2 * p2] * 0.17677669529663687f, k2 = k4[2 * p2 + 1] * 0.17677669529663687f;
                    qr[2 * p2] = q1 * cs.x - q2 * cs.y; qr[2 * p2 + 1] = q1 * cs.y + q2 * cs.x; kr[2 * p2] = k1 * cs.x - k2 * cs.y; kr[2 * p2 + 1] = k1 * cs.y + k2 * cs.x; }
            } else { float gl[16]; { float a[8]; ld8(zr + 512, a);
#pragma unroll
                    for (int i = 0; i < 8; ++i) gl[i] = a[i];
                    ld8(zr + 520, a);
#pragma unroll
                    for (int i = 0; i < 8; ++i) gl[8 + i] = a[i]; }
#pragma unroll
                for (int i = 0; i < 4; ++i) { qr[i] = q4[i] * 0.17677669529663687f; kr[i] = k4[i]; float acc = sbb[dd0 + i];
#pragma unroll
                    for (int j = 0; j < 16; ++j) acc += gl[j] * sw2[j * 32 + dd0 + i];
                    slg[t8 * 64 + dd0 + i] = (fminf(acc, 0.f) - log1pf(__expf(-fabsf(acc)))) * 0.0625f; } }
        }
        if (MX != 0) {
            sync_wg();
            if (tid < DK) { float run = 0.f;
#pragma unroll 1
                for (int tb = 0; tb < 64; tb += 16) { float x[16];
#pragma unroll
                    for (int i = 0; i < 16; ++i) x[i] = slg[(tb + i) * 64 + tid];
#pragma unroll
                    for (int i = 0; i < 16; ++i) { run += x[i]; x[i] = run; }
#pragma unroll
                    for (int i = 0; i < 16; ++i) slg[(tb + i) * 64 + tid] = x[i]; } }
            sync_wg();
        }
        { float qs[QN], ks[QN];
#pragma unroll
          for (int i = 0; i < QN; ++i) { float dq;
              if (MX == 0) dq = (float)(t8 - 31) * lgam; else dq = slg[t8 * 64 + dd0 + i] - slg[31 * 64 + dd0 + i];
              qs[i] = qr[i] * __expf(dq); ks[i] = kr[i] * __expf(-dq); }
          if (QN == 8) { v4u o; o.x = cvt_pk_bf16(qs[0], qs[1]); o.y = cvt_pk_bf16(qs[2], qs[3]); o.z = cvt_pk_bf16(qs[4], qs[5]); o.w = cvt_pk_bf16(qs[6], qs[7]); *(LAS v4u*)(sQ + SWZ(t8, dd0)) = o;
                         v4u p; p.x = cvt_pk_bf16(ks[0], ks[1]); p.y = cvt_pk_bf16(ks[2], ks[3]); p.z = cvt_pk_bf16(ks[4], ks[5]); p.w = cvt_pk_bf16(ks[6], ks[7]); *(LAS v4u*)(sK + SWZ(t8, dd0)) = p; }
          else { v2u o; o.x = cvt_pk_bf16(qs[0], qs[1]); o.y = cvt_pk_bf16(qs[2], qs[3]); *(LAS v2u*)(sQ + SWZ(t8, dd0)) = o;
                 v2u p; p.x = cvt_pk_bf16(ks[0], ks[1]); p.y = cvt_pk_bf16(ks[2], ks[3]); *(LAS v2u*)(sK + SWZ(t8, dd0)) = p; }
#pragma unroll
          for (int i = 0; i < QN; i += 2) { const unsigned w = cvt_pk_bf16(ks[i], ks[i + 1]); sKT[SWZ(dd0 + i, t8)] = (bf16)(w & 0xffffu); sKT[SWZ(dd0 + i + 1, t8)] = (bf16)(w >> 16); } }
        sync_wg();
        bf16x8v bq[NKS];
        if (wave < 4) {
            const int t = 16 * wave + fr;
#pragma unroll
            for (int ks = 0; ks < NKS; ++ks) bq[ks] = frag64(sQ, t, 4 * ks + fq);
#pragma unroll
            for (int j = 0; j < 4; ++j) { f32x4 acc = (f32x4){0.f, 0.f, 0.f, 0.f};
                if (j <= wave) {
#pragma unroll
                    for (int ks = 0; ks < NKS; ++ks) acc = __builtin_amdgcn_mfma_f32_16x16x32_bf16(frag64(sK, 16 * j + fr, 4 * ks + fq), bq[ks], acc, 0, 0, 0); }
                float pv[4];
#pragma unroll
                for (int rg = 0; rg < 4; ++rg) pv[rg] = (j < wave || (j == wave && 4 * fq + rg <= fr)) ? acc[rg] : 0.f;
                v2u o; o.x = cvt_pk_bf16(pv[0], pv[1]); o.y = cvt_pk_bf16(pv[2], pv[3]);
                *(LAS v2u*)(sP + t * 64 + (((2 * j + (fq >> 1)) ^ (t & 7)) << 3) + 4 * (fq & 1)) = o; }
        } else {
            const int e = 16 * (wave - 4) + fr;
#pragma unroll
            for (int i = 0; i < NDT; ++i) { float sc[4];
#pragma unroll
                for (int rg = 0; rg < 4; ++rg) sc[rg] = (MX == 0) ? __expf(32.f * lgam) : __expf(slg[31 * 64 + 16 * i + 4 * fq + rg]);
                v2u o; o.x = cvt_pk_bf16(S[i][0] * sc[0], S[i][1] * sc[1]); o.y = cvt_pk_bf16(S[i][2] * sc[2], S[i][3] * sc[3]);
                *(LAS v2u*)(sST + e * 64 + (((2 * i + (fq >> 1)) ^ (e & 7)) << 3) + 4 * (fq & 1)) = o; }
        }
        sync_wg();
        if (wave < 4) {
            const int t = 16 * wave + fr;
            bf16x8v bp[2];
#pragma unroll
            for (int ks = 0; ks < 2; ++ks) bp[ks] = frag64(sP, t, 4 * ks + fq);
            f32x4 oacc[4];
#pragma unroll
            for (int i = 0; i < 4; ++i) { f32x4 acc = (f32x4){0.f, 0.f, 0.f, 0.f};
                acc = __builtin_amdgcn_mfma_f32_16x16x32_bf16(frag64(sVT, 16 * i + fr, fq), bp[0], acc, 0, 0, 0);
                if (wave >= 2) acc = __builtin_amdgcn_mfma_f32_16x16x32_bf16(frag64(sVT, 16 * i + fr, 4 + fq), bp[1], acc, 0, 0, 0);
#pragma unroll
                for (int ks = 0; ks < NKS; ++ks) acc = __builtin_amdgcn_mfma_f32_16x16x32_bf16(frag64(sST, 16 * i + fr, 4 * ks + fq), bq[ks], acc, 0, 0, 0);
                oacc[i] = acc; }
            float s1 = 0.f;
#pragma unroll
            for (int i = 0; i < 4; ++i)
#pragma unroll
                for (int rg = 0; rg < 4; ++rg) s1 += (MX == 0) ? oacc[i][rg] : oacc[i][rg] * oacc[i][rg];
            s1 += shfl_xor_(s1, 16); s1 += shfl_xor_(s1, 32);
            float rs;
            if (MX == 0) { const float mean = s1 * (1.f / 64.f); float q2 = 0.f;
#pragma unroll
                for (int i = 0; i < 4; ++i)
#pragma unroll
                    for (int rg = 0; rg < 4; ++rg) { oacc[i][rg] -= mean; q2 += oacc[i][rg] * oacc[i][rg]; }
                q2 += shfl_xor_(q2, 16); q2 += shfl_xor_(q2, 32); rs = 1.0f / sqrtf(q2 * (1.f / 64.f) + 1e-6f);
            } else rs = 1.0f / sqrtf(s1 * (1.f / 64.f) + 1e-6f);
#pragma unroll
            for (int i = 0; i < 4; ++i) { const v2u gw = *(const LAS v2u*)(sG + t * 64 + (((2 * i + (fq >> 1)) ^ (t & 7)) << 3) + 4 * (fq & 1));
                const float g4[4] = {bf_lo(gw.x), bf_hi(gw.x), bf_lo(gw.y), bf_hi(gw.y)}; float y[4];
#pragma unroll
                for (int rg = 0; rg < 4; ++rg) y[rg] = oacc[i][rg] * rs * nw[4 * i + rg] * g4[rg] * sigmoid_acc(g4[rg]);
                v2u o; o.x = cvt_pk_bf16(y[0], y[1]); o.y = cvt_pk_bf16(y[2], y[3]);
                *(v2u*)(O + (rowbase + t) * D + MX * 256 + h * 64 + 16 * i + 4 * fq) = o; }
        } else {
            const int e = 16 * (wave - 4) + fr;
            bf16x8v bv[2];
#pragma unroll
            for (int ks = 0; ks < 2; ++ks) bv[ks] = frag64(sVT, e, 4 * ks + fq);
#pragma unroll
            for (int i = 0; i < NDT; ++i) { f32x4 acc = (f32x4){0.f, 0.f, 0.f, 0.f};
#pragma unroll
                for (int ks = 0; ks < 2; ++ks) acc = __builtin_amdgcn_mfma_f32_16x16x32_bf16(frag64(sKT, 16 * i + fr, 4 * ks + fq), bv[ks], acc, 0, 0, 0);
#pragma unroll
                for (int rg = 0; rg < 4; ++rg) { float el, er;
                    if (MX == 0) { el = __expf(64.f * lgam); er = __expf(32.f * lgam); }
                    else { const float bl = slg[63 * 64 + 16 * i + 4 * fq + rg], br = slg[31 * 64 + 16 * i + 4 * fq + rg]; el = __expf(bl); er = __expf(bl - br); }
                    S[i][rg] = el * S[i][rg] + er * acc[rg]; } }
        }
        sync_wg();
    }
}

__device__ __forceinline__ NOPK float dpp_f(float x, const int ctrl_sel) {
    const int xi = __builtin_bit_cast(int, x); int r;
    if (ctrl_sel == 0) r = __builtin_amdgcn_update_dpp(0, xi, 0xB1, 0xf, 0xf, true);
    else if (ctrl_sel == 1) r = __builtin_amdgcn_update_dpp(0, xi, 0x4E, 0xf, 0xf, true);
    else if (ctrl_sel == 2) r = __builtin_amdgcn_update_dpp(0, xi, 0x141, 0xf, 0xf, true);
    else r = __builtin_amdgcn_update_dpp(0, xi, 0x140, 0xf, 0xf, true);
    return __builtin_bit_cast(float, r);
}
__device__ __forceinline__ NOPK float sum16_dpp(float v) { v += dpp_f(v, 0); v += dpp_f(v, 1); v += dpp_f(v, 2); v += dpp_f(v, 3); return v; }
#define DPP_SUM16_2(a_, b_) asm volatile( \
    "s_nop 1\n\t" \
    "v_add_f32_dpp %0, %0, %0 quad_perm:[1,0,3,2] row_mask:0xf bank_mask:0xf bound_ctrl:1\n\t" \
    "v_add_f32_dpp %1, %1, %1 quad_perm:[1,0,3,2] row_mask:0xf bank_mask:0xf bound_ctrl:1\n\t" \
    "s_nop 0\n\t" \
    "v_add_f32_dpp %0, %0, %0 quad_perm:[2,3,0,1] row_mask:0xf bank_mask:0xf bound_ctrl:1\n\t" \
    "v_add_f32_dpp %1, %1, %1 quad_perm:[2,3,0,1] row_mask:0xf bank_mask:0xf bound_ctrl:1\n\t" \
    "s_nop 0\n\t" \
    "v_add_f32_dpp %0, %0, %0 row_half_mirror row_mask:0xf bank_mask:0xf bound_ctrl:1\n\t" \
    "v_add_f32_dpp %1, %1, %1 row_half_mirror row_mask:0xf bank_mask:0xf bound_ctrl:1\n\t" \
    "s_nop 0\n\t" \
    "v_add_f32_dpp %0, %0, %0 row_mirror row_mask:0xf bank_mask:0xf bound_ctrl:1\n\t" \
    "v_add_f32_dpp %1, %1, %1 row_mirror row_mask:0xf bank_mask:0xf bound_ctrl:1\n\t" \
    : "+v"(a_), "+v"(b_));
__device__ __forceinline__ NOPK float sum8_dpp(float v) { v += dpp_f(v, 0); v += dpp_f(v, 1); v += dpp_f(v, 2); return v; }

constexpr int RW_SET = 40960;
constexpr int RW_SV = 81920, RW_SY = 90112, RW_SG = 98304, RW_SB = 106496;
constexpr int RW_SCR = 108544;
constexpr int RW_W2T = 124928, RW_A2T = 133120, RW_G2T = 141312;
constexpr int RW_MU = 149504, RW_PAR = 151296;
__device__ __forceinline__ NOPK void rwkv_task2(LAS unsigned char* lds, KP P, int layer, int b, int h, int half) {
    asm volatile("" : "+s"(h), "+s"(b), "+s"(half));
    const int tid = opaque_tid(), lane = tid & 63, wave = __builtin_amdgcn_readfirstlane(tid >> 6);
    LAS bf16* w2T = (LAS bf16*)(lds + RW_W2T); LAS bf16* a2T = (LAS bf16*)(lds + RW_A2T); LAS bf16* g2T = (LAS bf16*)(lds + RW_G2T);
    LAS float* smu = (LAS float*)(lds + RW_MU); LAS float* spar = (LAS float*)(lds + RW_PAR);
    const bf16* Z = (const bf16*)(P->ws + WS_R2);
    const int colh = h * 64;
    constexpr int NC2 = SEQ / 32;
    sync_wg();
    if (tid < 448) { const int seg = tid >> 6, j = tid & 63; const int col = (seg < 3) ? seg * 256 + colh + j : 768 + (seg - 3) * 64 + j; smu[tid] = P->in[I_MU][layer * 1024 + col]; }
    if (tid < 320) { const int seg = tid >> 6, j = tid & 63; const float* src = (seg == 0) ? P->in[I_KK] + layer * 256 + colh : (seg == 1) ? P->in[I_KA] + layer * 256 + colh : (seg == 2) ? P->in[I_RK] + (layer * 4 + h) * 64
                                                                             : (seg == 3) ? P->in[I_RLNW] + layer * 256 + colh : P->in[I_RLNB] + layer * 256 + colh; spar[tid] = src[j]; }
    { const int cc = tid & 63, jb = tid >> 6;
      const float* w2 = P->in[I_W2] + (size_t)layer * 64 * 256 + colh + cc; const float* a2 = P->in[I_A2] + (size_t)layer * 64 * 256 + colh + cc;
      float x[8];
#pragma unroll
      for (int i = 0; i < 8; ++i) x[i] = w2[(8 * jb + i) * 256];
      { v4u o; o.x = cvt_pk_bf16(x[0], x[1]); o.y = cvt_pk_bf16(x[2], x[3]); o.z = cvt_pk_bf16(x[4], x[5]); o.w = cvt_pk_bf16(x[6], x[7]); *(LAS v4u*)(w2T + cc * 64 + ((jb ^ (cc & 7)) << 3)) = o; }
#pragma unroll
      for (int i = 0; i < 8; ++i) x[i] = a2[(8 * jb + i) * 256];
      { v4u o; o.x = cvt_pk_bf16(x[0], x[1]); o.y = cvt_pk_bf16(x[2], x[3]); o.z = cvt_pk_bf16(x[4], x[5]); o.w = cvt_pk_bf16(x[6], x[7]); *(LAS v4u*)(a2T + cc * 64 + ((jb ^ (cc & 7)) << 3)) = o; }
      const int cg = tid & 31, ch = tid >> 5; const float* g2 = P->in[I_G2] + (size_t)layer * 128 * 256 + colh + 32 * half + cg;
#pragma unroll
      for (int i = 0; i < 8; ++i) x[i] = g2[(8 * ch + i) * 256];
      { v4u o; o.x = cvt_pk_bf16(x[0], x[1]); o.y = cvt_pk_bf16(x[2], x[3]); o.z = cvt_pk_bf16(x[4], x[5]); o.w = cvt_pk_bf16(x[6], x[7]); *(LAS v4u*)(g2T + cg * 128 + ((ch ^ (cg & 7)) << 3)) = o; } }
    sync_wg();
    const int wrole = wave >> 2, widx = wave & 3;
    if (wrole) {
        const int pw = widx, tl = lane >> 3, e0 = (lane & 7) * 8, tk = 8 * pw + tl;
        const int fr = lane & 15, fq = lane >> 4;
        LAS bf16* tw = (LAS bf16*)(lds + RW_SCR + pw * 4096); LAS bf16* ta = tw + 512; LAS bf16* tg = tw + 1024;
        float w0v[4], a0v[4];
#pragma unroll
        for (int q = 0; q < 4; ++q) { w0v[q] = P->in[I_W0][layer * 256 + colh + 16 * q + fr]; a0v[q] = P->in[I_A0][layer * 256 + colh + 16 * q + fr]; }
        v4u R[7], Rp[7];
#define RW2_LOAD(cc_) { const size_t row_ = (size_t)b * SEQ + (cc_) * 32 + tk; const bf16* zr_ = Z + row_ * NMIXP + 768; const bf16* zp_ = ((cc_) == 0 && tk == 0) ? zr_ : zr_ - NMIXP; \
        const int cols_[7] = {colh + e0, 256 + colh + e0, 512 + colh + e0, 768 + e0, 832 + e0, 896 + e0, 960 + e0}; \
        _Pragma("unroll") for (int q_ = 0; q_ < 7; ++q_) { R[q_] = *(const v4u*)(zr_ + cols_[q_]); Rp[q_] = *(const v4u*)(zp_ + cols_[q_]); } }
        RW2_LOAD(0)
#pragma unroll 1
        for (int it = -1; it <= NC2; ++it) {
            if (it >= 1) { const int oc = it - 1, ob = oc & 1; const int c4 = (lane & 7) * 4;
                const LAS float* sy = (const LAS float*)(lds + RW_SY + ob * 4096); const LAS float* sv = (const LAS float*)(lds + RW_SV + ob * 4096); const LAS float* sg = (const LAS float*)(lds + RW_SG + ob * 4096);
                const f32x4 yv = *(const LAS f32x4*)(sy + tk * 32 + c4), vv = *(const LAS f32x4*)(sv + tk * 32 + c4), gv = *(const LAS f32x4*)(sg + tk * 32 + c4);
                float s = (yv.x + yv.y) + (yv.z + yv.w); s = red8(s); const float mean = s * (1.f / 32.f);
                const f32x4 d = yv - mean; float q = (d.x * d.x + d.y * d.y) + (d.z * d.z + d.w * d.w); q = red8(q);
                const float bon = ((const LAS float*)(lds + RW_SB + ob * 128))[tk];
                const size_t row = (size_t)b * SEQ + oc * 32 + tk; const size_t off = row * 256 + colh + 32 * half + c4;
                *(f32x4*)((float*)(P->out + (size_t)M * D / 2) + off) = yv;
                v2u ad; ad.x = cvt_pk_bf16(bon * vv.x, bon * vv.y); ad.y = cvt_pk_bf16(bon * vv.z, bon * vv.w);
                *(v2u*)((bf16*)(P->out + (size_t)M * D / 2 + (size_t)M * 256) + off) = ad;
                v2u gt; gt.x = cvt_pk_bf16(gv.x, gv.y); gt.y = cvt_pk_bf16(gv.z, gv.w);
                *(v2u*)((bf16*)(P->out + (size_t)M * D / 2 + (size_t)M * 256) + (size_t)M * 256 + off) = gt;
                if ((lane & 7) == 0) ((f32x2g*)(P->ws + WS_RST))[(row * 4 + h) * 2 + half] = (f32x2g){mean, q}; }
            if (it + 1 < NC2) { const int pc = it + 1, pb = pc & 1;
                LAS float* sr = (LAS float*)(lds + pb * RW_SET); LAS float* skm = sr + 2048; LAS float* sw = sr + 4096; LAS float* skk = sr + 6144; LAS float* ska = sr + 8192;
                LAS float* sv = (LAS float*)(lds + RW_SV + pb * 4096); LAS float* sg = (LAS float*)(lds + RW_SG + pb * 4096); LAS float* sb = (LAS float*)(lds + RW_SB + pb * 128);
                { const bool first = (pc == 0 && tk == 0); float a[8], p[8], z[8];
#define UNPK2(vv_, o_) { const v4u u_ = vv_; o_[0] = bf_lo(u_.x); o_[1] = bf_hi(u_.x); o_[2] = bf_lo(u_.y); o_[3] = bf_hi(u_.y); o_[4] = bf_lo(u_.z); o_[5] = bf_hi(u_.z); o_[6] = bf_lo(u_.w); o_[7] = bf_hi(u_.w); }
#define SHIFT2(idx) { UNPK2(R[idx], a) UNPK2(Rp[idx], p) _Pragma("unroll") for (int i = 0; i < 8; ++i) { const float pv = first ? 0.f : p[i]; z[i] = a[i] + (pv - a[i]) * smu[(idx) * 64 + e0 + i]; } }
                  SHIFT2(0)
                  *(LAS f32x4*)(sr + tk * 64 + e0) = (f32x4){z[0], z[1], z[2], z[3]}; *(LAS f32x4*)(sr + tk * 64 + e0 + 4) = (f32x4){z[4], z[5], z[6], z[7]};
                  SHIFT2(1)
                  *(LAS f32x4*)(skm + tk * 64 + e0) = (f32x4){z[0], z[1], z[2], z[3]}; *(LAS f32x4*)(skm + tk * 64 + e0 + 4) = (f32x4){z[4], z[5], z[6], z[7]};
                  SHIFT2(2)
                  if ((e0 >> 5) == half) { *(LAS f32x4*)(sv + tk * 32 + (e0 & 31)) = (f32x4){z[0], z[1], z[2], z[3]}; *(LAS f32x4*)(sv + tk * 32 + (e0 & 31) + 4) = (f32x4){z[4], z[5], z[6], z[7]}; }
                  const int sw8 = ((lane & 7) ^ (tl & 7)) << 3;
                  SHIFT2(3)
                  { v4u o; o.x = cvt_pk_bf16(tanh_fast(z[0]), tanh_fast(z[1])); o.y = cvt_pk_bf16(tanh_fast(z[2]), tanh_fast(z[3])); o.z = cvt_pk_bf16(tanh_fast(z[4]), tanh_fast(z[5])); o.w = cvt_pk_bf16(tanh_fast(z[6]), tanh_fast(z[7])); *(LAS v4u*)(tw + tl * 64 + sw8) = o; }
                  SHIFT2(4)
                  { v4u o; o.x = cvt_pk_bf16(z[0], z[1]); o.y = cvt_pk_bf16(z[2], z[3]); o.z = cvt_pk_bf16(z[4], z[5]); o.w = cvt_pk_bf16(z[6], z[7]); *(LAS v4u*)(ta + tl * 64 + sw8) = o; }
                  SHIFT2(5)
                  { v4u o; o.x = cvt_pk_bf16(sigmoid_acc(z[0]), sigmoid_acc(z[1])); o.y = cvt_pk_bf16(sigmoid_acc(z[2]), sigmoid_acc(z[3])); o.z = cvt_pk_bf16(sigmoid_acc(z[4]), sigmoid_acc(z[5])); o.w = cvt_pk_bf16(sigmoid_acc(z[6]), sigmoid_acc(z[7])); *(LAS v4u*)(tg + tl * 128 + sw8) = o; }
                  SHIFT2(6)
                  { v4u o; o.x = cvt_pk_bf16(sigmoid_acc(z[0]), sigmoid_acc(z[1])); o.y = cvt_pk_bf16(sigmoid_acc(z[2]), sigmoid_acc(z[3])); o.z = cvt_pk_bf16(sigmoid_acc(z[4]), sigmoid_acc(z[5])); o.w = cvt_pk_bf16(sigmoid_acc(z[6]), sigmoid_acc(z[7])); *(LAS v4u*)(tg + tl * 128 + 64 + sw8) = o; }
#undef SHIFT2
#undef UNPK2
                }
                if (pc + 1 < NC2) RW2_LOAD(pc + 1)
                asm volatile("s_waitcnt lgkmcnt(0)" ::: "memory");
                { const int ar = fr & 7;
                  f32x4 wacc[4], aacc[4], gacc[2];
#pragma unroll
                  for (int q = 0; q < 4; ++q) { wacc[q] = (f32x4){0.f, 0.f, 0.f, 0.f}; aacc[q] = wacc[q]; }
                  gacc[0] = (f32x4){0.f, 0.f, 0.f, 0.f}; gacc[1] = gacc[0];
#pragma unroll
                  for (int ks = 0; ks < 2; ++ks) { const int ch = ks * 4 + fq;
                      const bf16x8v Aw = *(const LAS bf16x8v*)(tw + ar * 64 + ((ch ^ (ar & 7)) << 3)), Aa = *(const LAS bf16x8v*)(ta + ar * 64 + ((ch ^ (ar & 7)) << 3));
#pragma unroll
                      for (int q = 0; q < 4; ++q) { const int br = 16 * q + fr;
                          const bf16x8v Bw = *(const LAS bf16x8v*)(w2T + br * 64 + ((ch ^ (br & 7)) << 3)), Ba = *(const LAS bf16x8v*)(a2T + br * 64 + ((ch ^ (br & 7)) << 3));
                          wacc[q] = __builtin_amdgcn_mfma_f32_16x16x32_bf16(Aw, Bw, wacc[q], 0, 0, 0); aacc[q] = __builtin_amdgcn_mfma_f32_16x16x32_bf16(Aa, Ba, aacc[q], 0, 0, 0); } }
#pragma unroll
                  for (int ks = 0; ks < 4; ++ks) { const int ch = ks * 4 + fq;
                      const bf16x8v Ag = *(const LAS bf16x8v*)(tg + ar * 128 + ((ch ^ (ar & 7)) << 3));
#pragma unroll
                      for (int q = 0; q < 2; ++q) { const int br = 16 * q + fr;
                          const bf16x8v Bg = *(const LAS bf16x8v*)(g2T + br * 128 + ((ch ^ (br & 7)) << 3));
                          gacc[q] = __builtin_amdgcn_mfma_f32_16x16x32_bf16(Ag, Bg, gacc[q], 0, 0, 0); } }
                  if (fq < 2) {
#pragma unroll
                      for (int rg = 0; rg < 4; ++rg) { const int t = 8 * pw + 4 * fq + rg;
#pragma unroll
                          for (int q = 0; q < 4; ++q) { const int cc = 16 * q + fr;
                              sw[t * 64 + cc] = __expf(-0.6065306597126334f * sigmoid_acc(w0v[q] + wacc[q][rg])); ska[t * 64 + cc] = sigmoid_acc(a0v[q] + aacc[q][rg]); }
#pragma unroll
                          for (int q = 0; q < 2; ++q) sg[t * 32 + 16 * q + fr] = gacc[q][rg]; } } }
                asm volatile("s_waitcnt lgkmcnt(0)" ::: "memory");
                { float ss = 0.f, bon = 0.f; float kk[8], av[8];
#pragma unroll
                  for (int i = 0; i < 8; ++i) { const int cc = e0 + i; const float kv = skm[tk * 64 + cc]; av[i] = ska[tk * 64 + cc];
                      kk[i] = kv * spar[cc]; ss += kk[i] * kk[i];
                      const float km = kv * (1.f + (av[i] - 1.f) * spar[64 + cc]); skm[tk * 64 + cc] = km;
                      bon += sr[tk * 64 + cc] * km * spar[128 + cc]; }
                  ss = red8(ss); bon = red8(bon); const float inv = 1.0f / sqrtf(ss + 1e-12f);
#pragma unroll
                  for (int i = 0; i < 8; ++i) { const float kn = kk[i] * inv; skk[tk * 64 + e0 + i] = kn; ska[tk * 64 + e0 + i] = kn * av[i]; }
                  if ((lane & 7) == 0) sb[tk] = bon; }
            }
            sync_wg();
        }
#undef RW2_LOAD
    } else {
        const int kq = lane & 15, vloc = 2 * (4 * widx + (lane >> 4));
        typedef float f32x2 __attribute__((ext_vector_type(2)));
        f32x2 S2[4];
#pragma unroll
        for (int i = 0; i < 4; ++i) S2[i] = (f32x2){0.f, 0.f};
        sync_wg();
#pragma unroll 1
        for (int it = 0; it < NC2; ++it) { const int cb = it & 1;
            const LAS f32x4* pr = (const LAS f32x4*)(lds + cb * RW_SET + 16 * kq); const LAS f32x4* pkm = pr + 512; const LAS f32x4* pw = pr + 1024; const LAS f32x4* pkk = pr + 1536; const LAS f32x4* pka = pr + 2048;
            const LAS f32x2* pv = (const LAS f32x2*)(lds + RW_SV + cb * 4096 + 4 * vloc); LAS float* sy = (LAS float*)(lds + RW_SY + cb * 4096);
            const f32x2 Ssv0 = S2[0], Ssv1 = S2[1], Ssv2 = S2[2], Ssv3 = S2[3];
            for (int rr_ = 0; rr_ < REP_REC; ++rr_) { S2[0] = Ssv0; S2[1] = Ssv1; S2[2] = Ssv2; S2[3] = Ssv3;
            f32x4 wA = pw[0], kA = pkk[0], aA = pka[0], mA = pkm[0], rA = pr[0]; f32x2 vA = pv[0];
            f32x4 wB, kB, aB, mB, rB; f32x2 vB;
#define RWKV_STEP(tcur, tn, wX, kX, aX, mX, rX, vX, wY, kY, aY, mY, rY, vY) { \
              wY = pw[(tn) * 16]; kY = pkk[(tn) * 16]; aY = pka[(tn) * 16]; mY = pkm[(tn) * 16]; rY = pr[(tn) * 16]; vY = pv[(tn) * 16]; \
              f32x2 sa = S2[0] * kX.x; sa = S2[1] * kX.y + sa; sa = S2[2] * kX.z + sa; sa = S2[3] * kX.w + sa; \
              const f32x2 tm0 = S2[0] * wX.x + vX * mX.x, tm1 = S2[1] * wX.y + vX * mX.y, tm2 = S2[2] * wX.z + vX * mX.z, tm3 = S2[3] * wX.w + vX * mX.w; \
              float s0 = sa.x, s1 = sa.y; DPP_SUM16_2(s0, s1) \
              const f32x2 sar = (f32x2){s0, s1}; \
              S2[0] = tm0 - sar * aX.x; S2[1] = tm1 - sar * aX.y; S2[2] = tm2 - sar * aX.z; S2[3] = tm3 - sar * aX.w; \
              f32x2 yy = S2[0] * rX.x; yy = S2[1] * rX.y + yy; yy = S2[2] * rX.z + yy; yy = S2[3] * rX.w + yy; \
              float y0 = yy.x, y1 = yy.y; DPP_SUM16_2(y0, y1) \
              if (kq == 0) *(LAS f32x2*)(sy + (tcur) * 32 + vloc) = (f32x2){y0, y1}; }
#pragma unroll 1
            for (int t = 0; t < 32; t += 2) {
                RWKV_STEP(t, t + 1, wA, kA, aA, mA, rA, vA, wB, kB, aB, mB, rB, vB)
                RWKV_STEP(t + 1, (t + 2) & 31, wB, kB, aB, mB, rB, vB, wA, kA, aA, mA, rA, vA) }
#undef RWKV_STEP
            }
            sync_wg();
        }
        sync_wg();
    }
}

__device__ __forceinline__ NOPK void rwkv_finalize(KP P, int layer) {
    const int gt = blockIdx.x * (NWAVES * 64) + opaque_tid(), NGT = gridDim.x * NWAVES * 64;
    const float* YR = P->out + (size_t)M * D / 2; const bf16* AD = (const bf16*)(YR + (size_t)M * 256); const bf16* GT = AD + (size_t)M * 256;
    const f32x2g* ST = (const f32x2g*)(P->ws + WS_RST); bf16* O = (bf16*)P->out;
    for (int i = gt; i < M * 64; i += NGT) { const int row = i >> 6, c4 = (i & 63) * 4, h = c4 >> 6;
        const f32x2g sa = ST[(row * 4 + h) * 2], sb = ST[(row * 4 + h) * 2 + 1];
        const float mean = 0.5f * (sa.x + sb.x), dm = sa.x - sb.x, m2 = sa.y + sb.y + 16.f * dm * dm, rs = 1.0f / sqrtf(m2 * (1.f / 64.f) + 64e-5f);
        const f32x4 y = *(const f32x4*)(YR + (size_t)row * 256 + c4); const v2u ad = *(const v2u*)(AD + (size_t)row * 256 + c4), g = *(const v2u*)(GT + (size_t)row * 256 + c4);
        const f32x4 lw = *(const f32x4*)(P->in[I_RLNW] + layer * 256 + c4), lb = *(const f32x4*)(P->in[I_RLNB] + layer * 256 + c4);
        v2u o; o.x = cvt_pk_bf16(((y.x - mean) * rs * lw.x + lb.x + bf_lo(ad.x)) * bf_lo(g.x), ((y.y - mean) * rs * lw.y + lb.y + bf_hi(ad.x)) * bf_hi(g.x));
        o.y = cvt_pk_bf16(((y.z - mean) * rs * lw.z + lb.z + bf_lo(ad.y)) * bf_lo(g.y), ((y.w - mean) * rs * lw.w + lb.w + bf_hi(ad.y)) * bf_hi(g.y));
        *(v2u*)(O + (size_t)row * D + 256 + c4) = o; }
}

__device__ __forceinline__ NOPK void ffn_fixup_panel(KP P, int layer, int pm) {
    const int tid = opaque_tid();
    const float* uh = (const float*)(P->ws + WS_HALO); const float* vh = (const float*)(P->ws + WS_HALO + HALO_ONE); const float* ut = (const float*)(P->ws + WS_HALO + 2 * HALO_ONE);
    const float* conv = P->in[I_CONV] + (size_t)layer * 3 * DFF; bf16* ACT = (bf16*)(P->ws + WS_R2);
    for (int i = tid; i < 2 * DFF; i += NWAVES * 64) { const int rr = i / DFF, cc = i % DFF;
        const float u0 = uh[((size_t)pm * 2) * DFF + cc], u1 = uh[((size_t)pm * 2 + 1) * DFF + cc];
        float t0 = 0.f, t1 = 0.f; if (pm & 7) { t0 = ut[((size_t)(pm - 1) * 2) * DFF + cc]; t1 = ut[((size_t)(pm - 1) * 2 + 1) * DFF + cc]; }
        const float c0 = conv[cc], c1 = conv[DFF + cc], c2 = conv[2 * DFF + cc];
        const float cv = rr ? (c2 * u1 + c1 * u0 + c0 * t1) : (c2 * u0 + c1 * t1 + c0 * t0);
        const float a = pg8::gelu_tanh_f(cv) * vh[((size_t)pm * 2 + rr) * DFF + cc];
        ACT[((size_t)pm * 256 + rr) * DFF + cc] = (bf16)(cvt_pk_bf16(a, 0.f) & 0xffffu); }
}

__device__ __forceinline__ NOPK void z_tail16(const bf16* XB, const bf16* Wt, bf16* Z) {
    const int tid = opaque_tid(), lane = tid & 63, wave = __builtin_amdgcn_readfirstlane(tid >> 6), fr = lane & 15, fq = lane >> 4;
    for (int rb = blockIdx.x * NWAVES + wave; rb < M / 16; rb += gridDim.x * NWAVES) {
        const bf16* xr = XB + (size_t)(rb * 16 + fr) * D + 8 * fq;
        const bf16* wr = Wt + (size_t)(NMIXG + fr) * D + 8 * fq;
        f32x4 acc = (f32x4){0.f, 0.f, 0.f, 0.f};
#pragma unroll 1
        for (int h = 0; h < 2; ++h) {
            bf16x8v a[16], b[16];
#pragma unroll
            for (int s = 0; s < 16; ++s) { a[s] = *(const bf16x8v*)(xr + (h * 16 + s) * 32); b[s] = *(const bf16x8v*)(wr + (h * 16 + s) * 32); }
#pragma unroll
            for (int s = 0; s < 16; ++s) acc = __builtin_amdgcn_mfma_f32_16x16x32_bf16(b[s], a[s], acc, 0, 0, 0);
        }
        v2u pk; pk.x = cvt_pk_bf16(acc[0], acc[1]); pk.y = cvt_pk_bf16(acc[2], acc[3]);
        *(v2u*)(Z + (size_t)(rb * 16 + fr) * NMIXP + NMIXG + 4 * fq) = pk;
    }
}
constexpr int NPH = 1 + 10 * DEPTH;
#ifndef REP_MIX
#define REP_MIX -1
#endif
#ifndef REP_PHASE
#define REP_PHASE -1
#endif
#define REPEAT(k) for (int rep_ = 0; rep_ < ((REP_PHASE == (k)) ? 2 : 1); ++rep_)
__global__ void __launch_bounds__(NWAVES * 64, 2) NOPK mega(Params Pk) {
    KP P = kparams();
    extern __shared__ __attribute__((aligned(16))) unsigned char lds_raw[];
    LAS unsigned char* lds = (LAS unsigned char*)lds_raw;
    volatile LAS unsigned* MISC = (volatile LAS unsigned*)(lds + LDS_MISC);
    const int tid = threadIdx.x;
    const int G = gridDim.x, bx = blockIdx.x;
    if (tid < 64) MISC[tid] = 0u;
    sync_wg();
    const int lo = P->ph_lo, hi = P->ph_hi;
    XcdBarrier bar; bar.bar = (unsigned*)(P->ws + WS_CTL) + CW_BAR; bar.x = 0; bar.st = nullptr;
    if (hi - lo > 1) bar = xcd_barrier_post((unsigned*)(P->ws + WS_CTL) + CW_BAR, MISC + 8);
#define IN(k) (lo <= (k) && (k) < hi)
#define STAGGER(n) for (int d_ = ((bx >> 3) & 7) * (n); d_ > 0; --d_) __builtin_amdgcn_s_sleep(32);
#define SEAM(k) do { if (IN(k) && IN((k) + 1)) xcd_barrier(bar); } while (0)
#define PHASE_PTRS KP P = kparams(); unsigned char* const wl = P->ws + WS_W + (size_t)l * W_LAYER; bf16* const XB = (bf16*)(P->ws + WS_XB); unsigned char* const R2 = P->ws + WS_R2; \
        bf16* const OB = (bf16*)P->out;   bf16* const MG = (bf16*)P->out + (size_t)M * D;   \
        (void)wl; (void)XB; (void)R2; (void)OB; (void)MG;

    REPEAT(100) if (IN(0)) prologue(kparams(), lds);
    SEAM(0);
    for (int l = 0; l < DEPTH; ++l) {
        const int pb = 1 + 10 * l;
        REPEAT(0) if (IN(pb + 0)) {
            PHASE_PTRS
            z_tail16(XB, (const bf16*)(wl + WO_IN), (bf16*)R2);
            pg8::Gemm g{XB, (const bf16*)(wl + WO_IN), M, NMIXG, D, D, D, 0, 0}; pg8::StaticOrder S; S.init(M, NMIXG, G, bx);
            pg8::EpiStoreBf16 E{(bf16*)R2, NMIXP};
            pg8::gemm_phase<pg8::EpiStoreBf16, pg8::StaticOrder, true, true>(lds, g, S, E);
        }
        SEAM(pb + 0);
        REPEAT(1) if (IN(pb + 1)) {
            PHASE_PTRS
#ifndef NO_MIX
            for (int slot = bx; slot < 256; slot += G) {
                if (slot < 128) { const int bh = slot >> 1; rwkv_task2(lds, P, l, bh >> 2, bh & 3, slot & 1); }
                else if (slot < 192) { const int bh = slot - 128; linattn_fast<0>(lds, P, l, bh >> 2, bh & 3); linattn_fast<2>(lds, P, l, bh >> 2, bh & 3);
                    if (l == 0 && DEPTH > 1 && rep_ == 0) { sync_wg(); prep_layers(P, lds, 1, DEPTH, slot - 128, 128); } }
                else { const int bh = slot - 192; linattn_fast<3>(lds, P, l, bh >> 2, bh & 3);
                    pg8::Gemm g{(const bf16*)(P->ws + WS_PB) + (size_t)l * M * PLE, (const bf16*)(wl + WO_PP), M, D, PLE, PLE, PLE, 0, 0}; pg8::StaticOrder S; S.init(M, D, 64, slot - 192);
                    pg8::EpiStoreBf16 E{(bf16*)(P->ws + WS_PPLE), D};
                    pg8::gemm_phase<pg8::EpiStoreBf16, pg8::StaticOrder, true, true>(lds, g, S, E);
                    if (l == 0 && DEPTH > 1 && rep_ == 0) { sync_wg(); prep_layers(P, lds, 1, DEPTH, slot - 128, 128); } } }
#endif
        }
        SEAM(pb + 1);
        REPEAT(2) if (IN(pb + 2)) rwkv_finalize(kparams(), l);
        SEAM(pb + 2);
        REPEAT(3) if (IN(pb + 3)) {
            PHASE_PTRS
            pg8::Gemm g{OB, (const bf16*)(wl + WO_B), M, 4096, 256, D, 256, 4, 256}; pg8::StaticOrder S; S.init(M, 4096, G, bx);
            pg8::EpiStoreBf16 E{(bf16*)R2, 4096};
            STAGGER(1)
            pg8::gemm_phase<pg8::EpiStoreBf16, pg8::StaticOrder, true, true>(lds, g, S, E);
        }
        SEAM(pb + 3);
        REPEAT(4) if (IN(pb + 4)) {
            PHASE_PTRS
            pg8::Gemm g{XB, (const bf16*)(wl + WO_G), M, 4096, D, D, D, 0, 0}; pg8::StaticOrder S; S.init(M, 4096, G, bx);
            pg8::EpiMerge E{(const bf16*)R2, MG};
            pg8::gemm_phase<pg8::EpiMerge, pg8::StaticOrder, true, true>(lds, g, S, E);
        }
        SEAM(pb + 4);
        REPEAT(5) if (IN(pb + 5)) {
            PHASE_PTRS
            pg8::Gemm g{MG, (const bf16*)(wl + WO_MIX), M, D, D, D, D, 0, 0}; pg8::StaticOrder S; S.init(M, D, G, bx);
            pg8::EpiResBf16 E{XB, nullptr, ALPHA};
            pg8::gemm_phase<pg8::EpiResBf16, pg8::StaticOrder, true, true>(lds, g, S, E);
        }
        SEAM(pb + 5);
        REPEAT(6) if (IN(pb + 6)) { PHASE_PTRS ln_phase<true>(XB, P->in[I_LNMW] + l * D, P->in[I_LNMB] + l * D, XB, nullptr); }
        SEAM(pb + 6);
        REPEAT(7) if (IN(pb + 7)) {
            PHASE_PTRS
            { pg8::Gemm g{XB, (const bf16*)(wl + WO_UP), M, 2 * DFF, D, D, D, 0, 0}; pg8::StaticOrder S; S.init(M, 2 * DFF, G, bx);
              pg8::EpiFfnUp E{(bf16*)R2, P->in[I_CONV] + (size_t)l * 3 * DFF, (float*)(P->ws + WS_HALO), (float*)(P->ws + WS_HALO + HALO_ONE), (float*)(P->ws + WS_HALO + 2 * HALO_ONE), (LAS float*)(lds + LDS_XCH)};
              pg8::gemm_phase<pg8::EpiFfnUp, pg8::StaticOrder, true, true>(lds, g, S, E); }
            if (rep_ == 0) { pg8::Gemm g{XB, (const bf16*)(wl + WO_PG), M, D, D, D, D, 0, 0}; pg8::StaticOrder S; S.init(M, D, G, bx);
              pg8::EpiPleGate E{(bf16*)(P->ws + WS_PPLE)};
              pg8::gemm_phase<pg8::EpiPleGate, pg8::StaticOrder, true, true>(lds, g, S, E); }
        }
        SEAM(pb + 7);
        REPEAT(8) if (IN(pb + 8)) {
            PHASE_PTRS
            pg8::Gemm g{(const bf16*)R2, (const bf16*)(wl + WO_DN), M, D, DFF, DFF, DFF, 0, 0}; pg8::StaticOrder S; S.init(M, D, G, bx);
            { pg8::Unit u; for (int i = 0; S.next(i, u); ++i) ffn_fixup_panel(P, l, u.pm); }
            asm volatile("s_waitcnt vmcnt(0)" ::: "memory"); sync_wg();
            pg8::EpiResBf16 E{XB, (const bf16*)(P->ws + WS_PPLE), ALPHA};
            pg8::gemm_phase<pg8::EpiResBf16, pg8::StaticOrder, true, true>(lds, g, S, E);
        }
        SEAM(pb + 8);
        if (IN(pb + 9)) { PHASE_PTRS ln_phase<true>(XB, P->in[I_LNFW] + l * D, P->in[I_LNFB] + l * D, (l == DEPTH - 1) ? nullptr : XB, (l == DEPTH - 1) ? P->out : nullptr); }
        SEAM(pb + 9);
    }
#undef IN
#undef SEAM
}

extern "C" void kernel_launch(void* const* d_in, const int* in_sizes, int n_in, void* d_out, int out_size, void* d_ws, size_t ws_size, hipStream_t stream) {
    static int grid = 0;
    if (grid == 0) {
        if (n_in != 32 || out_size != M * D || ws_size < WS_END) { fprintf(stderr, "kernel_launch: unexpected shapes (n_in %d, out %d, ws %zu)\n", n_in, out_size, ws_size); grid = -1; return; }
        int dev = 0, cus = 0, per_cu = 0;
        if (hipGetDevice(&dev) != hipSuccess || hipDeviceGetAttribute(&cus, hipDeviceAttributeMultiprocessorCount, dev) != hipSuccess) { grid = -1; return; }
        if (hipFuncSetAttribute((const void*)mega, hipFuncAttributeMaxDynamicSharedMemorySize, LDS_BYTES) != hipSuccess) { fprintf(stderr, "kernel_launch: hipFuncSetAttribute failed\n"); grid = -1; return; }
        if (hipOccupancyMaxActiveBlocksPerMultiprocessor(&per_cu, (const void*)mega, NWAVES * 64, LDS_BYTES) != hipSuccess || per_cu < 1) fprintf(stderr, "kernel_launch: occupancy query reports %d\n", per_cu);
        (void)hipGetLastError();
        grid = cus;
    }
    if (grid < 0) return;
    (void)hipMemsetAsync((char*)d_ws + WS_CTL, 0, CTL_ZERO_BYTES, stream);
    Params p{};
    for (int i = 0; i < 32; ++i) p.in[i] = (const float*)d_in[i];
    p.out = (float*)d_out; p.ws = (unsigned char*)d_ws;
#if ONE_LAUNCH
    p.ph_lo = 0; p.ph_hi = NPH;
    hipLaunchKernelGGL(mega, dim3(grid), dim3(NWAVES * 64), LDS_BYTES, stream, p);
#else
    for (int ph = 0; ph < NPH; ++ph) { p.ph_lo = ph; p.ph_hi = ph + 1; hipLaunchKernelGGL(mega, dim3(grid), dim3(NWAVES * 64), LDS_BYTES, stream, p); }
#endif
}
```
